# Optimizing an MI355X kernel written in HIP

```python
import math
import jax, jax.numpy as jnp
from jax import lax
import numpy as np

D_MODEL = 1024
BATCH = 8
SEQ = 4096
DEPTH = 4

GRID_W = 64
CTX_LEN = 256

BRANCH_W = D_MODEL // 2
N_BRANCHES = 3
GLA_HEADS = 4
GLA_DV = BRANCH_W // GLA_HEADS
GLA_DK = GLA_DV // 2
GLA_RANK = 16
GLA_TAU = 16.0
GLA_CHUNK = 64
DIFF_HEADS = 4
DIFF_DV = BRANCH_W // DIFF_HEADS
DIFF_DH = DIFF_DV // 2
DIFF_QBLOCK = 128
NA_HEADS = 8
NA_DH = BRANCH_W // NA_HEADS
NA_WIN_H = 8
NA_WIN_W = 16
NA_QCOLS = 16
NA_KCOLS = NA_QCOLS + NA_WIN_W
N_EXPERTS = 16
N_GROUPS = 4
EXPERTS_PER_GROUP = N_EXPERTS // N_GROUPS
TOP_K = 2
D_EXPERT = D_MODEL // 2
ROPE_BASE = 10000.0
LN_EPS = 1e-5
RMS_EPS = 1e-6
NEG_BIG = -1e30
DEEPNORM_ALPHA = (2 * DEPTH) ** 0.25
DEEPNORM_BETA = (8 * DEPTH) ** -0.25
IN_SPLITS = (
    GLA_HEADS * GLA_DK, GLA_HEADS * GLA_DK, GLA_HEADS * GLA_DV, GLA_HEADS * GLA_DV, 2 * GLA_RANK,
    DIFF_HEADS * 2 * DIFF_DH, DIFF_HEADS * 2 * DIFF_DH, DIFF_HEADS * DIFF_DV,
    NA_HEADS * NA_DH, NA_HEADS * NA_DH, NA_HEADS * NA_DH,
    N_BRANCHES * D_MODEL,
)
D_IN = sum(IN_SPLITS)

kernel_name = "hybrid_gla_diffattn_natten_groupmoe_dit"


def _layernorm(x, g, b):
    xf = x.astype(jnp.float32)
    mu = jnp.mean(xf, -1, keepdims=True)
    var = jnp.mean(jnp.square(xf - mu), -1, keepdims=True)
    return ((xf - mu) * lax.rsqrt(var + LN_EPS) * g + b).astype(x.dtype)


def _rms(x, g):
    xf = x.astype(jnp.float32)
    return (xf * lax.rsqrt(jnp.mean(xf * xf, -1, keepdims=True) + RMS_EPS) * g).astype(x.dtype)


def _heads(t, h):
    b, l, _ = t.shape
    return t.reshape(b, l, h, -1).transpose(0, 2, 1, 3)


def _merge_heads(o):
    b, h, l, d = o.shape
    return o.transpose(0, 2, 1, 3).reshape(b, l, h * d)


def _axial_rope(n_tok, dim):
    t = jnp.arange(n_tok)
    row = (t // GRID_W).astype(jnp.float32)
    col = (t % GRID_W).astype(jnp.float32)
    n_freq = dim // 4
    inv = ROPE_BASE ** (-jnp.arange(n_freq, dtype=jnp.float32) / n_freq)
    ang = jnp.concatenate([row[:, None] * inv, col[:, None] * inv], -1)
    return jnp.cos(ang), jnp.sin(ang)


def _rope(x, cos, sin):
    x1, x2 = jnp.split(x, 2, axis=-1)
    c = cos.astype(x.dtype)
    s = sin.astype(x.dtype)
    return jnp.concatenate([x1 * c - x2 * s, x1 * s + x2 * c], -1)


def _gla_chunk_scan(q, k, v, logd, s0):
    b, h, l, dk = q.shape
    dv = v.shape[-1]
    n = l // GLA_CHUNK

    def chunks(t):
        return t.reshape(b, h, n, GLA_CHUNK, t.shape[-1]).transpose(2, 0, 1, 3, 4)

    qc, kc, vc, gc = chunks(q), chunks(k), chunks(v), chunks(logd)
    cum = jnp.cumsum(gc, axis=-2)
    last = cum[..., -1:, :]
    q_in = qc * jnp.exp(cum)
    k_in = kc * jnp.exp(-cum)
    k_st = kc * jnp.exp(last - cum)
    causal_in_chunk = jnp.tril(jnp.ones((GLA_CHUNK, GLA_CHUNK), dtype=bool))
    att = jnp.where(causal_in_chunk, jnp.einsum('nbhid,nbhjd->nbhij', q_in, k_in), 0.0)
    o_intra = jnp.einsum('nbhij,nbhjv->nbhiv', att, vc)
    kv = jnp.einsum('nbhjd,nbhjv->nbhdv', k_st, vc)
    decay = jnp.exp(last[..., 0, :])

    def step(s, inp):
        dec, kv_n = inp
        return dec[..., None] * s + kv_n, s

    s_final, s_start = lax.scan(step, s0, (decay, kv))
    o_inter = jnp.einsum('nbhid,nbhdv->nbhiv', q_in, s_start)
    o = (o_intra + o_inter).transpose(1, 2, 0, 3, 4).reshape(b, h, l, dv)
    return o, s_final


def _gla_mixer(parts_l, parts_c, w_decay, b_decay, norm_g, need_ctx):
    f32 = jnp.float32

    def prep(parts):
        q, k, v, _, r = parts
        b, l, _ = q.shape
        qh = _heads(q.astype(f32), GLA_HEADS) * (GLA_DK ** -0.5)
        kh = _heads(k.astype(f32), GLA_HEADS)
        vh = _heads(v.astype(f32), GLA_HEADS)
        r2 = r.astype(f32).reshape(b, l, 2, GLA_RANK)
        z = jnp.einsum('bldr,drk->dblk', r2, w_decay.astype(f32)) + b_decay.astype(f32)[:, None, None, :]
        logd = jax.nn.log_sigmoid(z) / GLA_TAU
        return qh, kh, vh, _heads(logd[0], GLA_HEADS), _heads(logd[1], GLA_HEADS)

    qL, kL, vL, dLf, dLb = prep(parts_l)
    qC, kC, vC, dCf, dCb = prep(parts_c)
    b = qL.shape[0]
    s_zero = jnp.zeros((b, GLA_HEADS, GLA_DK, GLA_DV), f32)
    flip = lambda t: t[:, :, ::-1]
    oCf, sCf = _gla_chunk_scan(qC, kC, vC, dCf, s_zero)
    oLf, _ = _gla_chunk_scan(qL, kL, vL, dLf, sCf)
    oCb, sCb = _gla_chunk_scan(flip(qC), flip(kC), flip(vC), flip(dCb), s_zero)
    oLb, _ = _gla_chunk_scan(flip(qL), flip(kL), flip(vL), flip(dLb), sCb)

    def finish(o, g):
        o = _merge_heads(_rms(o, norm_g.astype(f32)))
        return (o * jax.nn.silu(g.astype(f32))).astype(g.dtype)

    out_l = finish(oLf + flip(oLb), parts_l[3])
    out_c = finish(oCf + flip(oCb), parts_c[3]) if need_ctx else None
    return out_l, out_c


def _diff_mixer(qL, kL, vL, qC, kC, vC, lam_q, lam_k, norm_g, lam_init, need_ctx):
    b, l, _ = qL.shape
    scale = DIFF_DH ** -0.5

    def qk_heads(t):
        return t.reshape(b, t.shape[1], DIFF_HEADS, 2, DIFF_DH).transpose(0, 2, 3, 1, 4)

    cos, sin = _axial_rope(l, DIFF_DH)
    qLh = _rope(qk_heads(qL), cos, sin) * scale
    kLh = _rope(qk_heads(kL), cos, sin)
    qCh = qk_heads(qC) * scale
    kCh = qk_heads(kC)
    vLh = _heads(vL, DIFF_HEADS)
    vCh = _heads(vC, DIFF_HEADS)
    lq = lam_q.astype(jnp.float32)
    lk = lam_k.astype(jnp.float32)
    lam = jnp.exp(jnp.sum(lq[0] * lk[0])) - jnp.exp(jnp.sum(lq[1] * lk[1])) + lam_init

    def attend(q, k, v):
        s = jnp.einsum('bhcqd,bhckd->bhcqk', q, k).astype(jnp.float32)
        p = jax.nn.softmax(s, axis=-1)
        w = (p[:, :, 0] - lam * p[:, :, 1]).astype(v.dtype)
        return jnp.einsum('bhqk,bhkv->bhqv', w, v)

    k_all = jnp.concatenate([kCh, kLh], axis=3)
    v_all = jnp.concatenate([vCh, vLh], axis=2)
    nb = l // DIFF_QBLOCK
    q_blocks = qLh.reshape(b, DIFF_HEADS, 2, nb, DIFF_QBLOCK, DIFF_DH).transpose(3, 0, 1, 2, 4, 5)
    oL = lax.map(lambda qb: attend(qb, k_all, v_all), q_blocks)
    oL = oL.transpose(1, 2, 0, 3, 4).reshape(b, DIFF_HEADS, l, DIFF_DV)

    def finish(o):
        return _merge_heads(_rms(o, norm_g) * (1.0 - lam_init))

    out_c = finish(attend(qCh, kCh, vCh)) if need_ctx else None
    return finish(oL), out_c


def _na_mixer(qL, kL, vL, qC, kC, vC, rpb, need_ctx):
    b, l, _ = qL.shape
    rows = l // GRID_W
    wh = min(NA_WIN_H, rows)
    ncb = GRID_W // NA_QCOLS
    n_loc = wh * NA_KCOLS
    q = _heads(qL, NA_HEADS) * (NA_DH ** -0.5)
    k_grid = _heads(kL, NA_HEADS).reshape(b, NA_HEADS, rows, GRID_W, NA_DH)
    v_grid = _heads(vL, NA_HEADS).reshape(b, NA_HEADS, rows, GRID_W, NA_DH)
    kc = _heads(kC, NA_HEADS)
    vc = _heads(vC, NA_HEADS)
    qcol = np.arange(GRID_W).reshape(ncb, NA_QCOLS)
    kstart = np.clip(qcol[:, 0] - NA_WIN_W // 2, 0, GRID_W - NA_KCOLS)
    kcol = kstart[:, None] + np.arange(NA_KCOLS)
    cstart = np.clip(qcol - NA_WIN_W // 2, 0, GRID_W - NA_WIN_W)
    kc_b = kcol[:, None, :]
    col_in = (kc_b >= cstart[..., None]) & (kc_b < cstart[..., None] + NA_WIN_W)
    col_idx = np.clip(kc_b - qcol[:, :, None] + NA_WIN_W - 1, 0, 2 * NA_WIN_W - 2)
    loc_mask = np.broadcast_to(col_in[:, :, None, :], (ncb, NA_QCOLS, wh, NA_KCOLS)).reshape(
        ncb, NA_QCOLS, n_loc)
    q_rows = q.reshape(b, NA_HEADS, rows, GRID_W, NA_DH).transpose(2, 0, 1, 3, 4)

    def row_block(inp):
        r, q_r = inp
        rs = jnp.clip(r - NA_WIN_H // 2, 0, rows - wh)
        k_rows = lax.dynamic_slice_in_dim(k_grid, rs, wh, axis=2)
        v_rows = lax.dynamic_slice_in_dim(v_grid, rs, wh, axis=2)
        k_blk = k_rows[:, :, :, kcol].transpose(0, 1, 3, 2, 4, 5).reshape(b, NA_HEADS, ncb, n_loc, NA_DH)
        v_blk = v_rows[:, :, :, kcol].transpose(0, 1, 3, 2, 4, 5).reshape(b, NA_HEADS, ncb, n_loc, NA_DH)
        q_blk = q_r.reshape(b, NA_HEADS, ncb, NA_QCOLS, NA_DH)
        row_idx = rs + jnp.arange(wh) - r + (NA_WIN_H - 1)
        bias = rpb[:, row_idx][:, :, col_idx]
        bias = bias.transpose(0, 2, 3, 1, 4).reshape(NA_HEADS, ncb, NA_QCOLS, n_loc).astype(jnp.float32)
        s_loc = jnp.einsum('bhnqd,bhnkd->bhnqk', q_blk, k_blk).astype(jnp.float32) + bias
        s_loc = jnp.where(loc_mask, s_loc, NEG_BIG)
        s_ctx = jnp.einsum('bhnqd,bhkd->bhnqk', q_blk, kc).astype(jnp.float32)
        p = jax.nn.softmax(jnp.concatenate([s_loc, s_ctx], -1), axis=-1).astype(v_blk.dtype)
        o = (jnp.einsum('bhnqk,bhnkd->bhnqd', p[..., :n_loc], v_blk)
             + jnp.einsum('bhnqk,bhkd->bhnqd', p[..., n_loc:], vc))
        return o.reshape(b, NA_HEADS, GRID_W, NA_DH)

    o = lax.map(row_block, (jnp.arange(rows, dtype=jnp.int32), q_rows))
    out_l = _merge_heads(o.transpose(1, 2, 0, 3, 4).reshape(b, NA_HEADS, l, NA_DH))
    out_c = None
    if need_ctx:
        qch = _heads(qC, NA_HEADS) * (NA_DH ** -0.5)
        p = jax.nn.softmax(jnp.einsum('bhqd,bhkd->bhqk', qch, kc).astype(jnp.float32), axis=-1)
        out_c = _merge_heads(jnp.einsum('bhqk,bhkd->bhqd', p.astype(vc.dtype), vc))
    return out_l, out_c


def _merge(branches, gate_logits, w_branch, w_o):
    b, l = gate_logits.shape[:2]
    proj = jnp.einsum('blne,ned->blnd', branches, w_branch)
    gates = jax.nn.sigmoid(gate_logits.reshape(b, l, N_BRANCHES, -1))
    return jnp.sum(gates * proj, axis=2) @ w_o


def _mixer_sublayer(hL, hC, w_in, w_decay, b_decay, gla_g, lam_q, lam_k, diff_g, lam_init, rpb,
                    w_branch, w_o, need_ctx):
    splits = [int(i) for i in np.cumsum(IN_SPLITS)[:-1]]
    pL = jnp.split(hL @ w_in, splits, axis=-1)
    pC = jnp.split(hC @ w_in, splits, axis=-1)
    gla_l, gla_c = _gla_mixer(pL[0:5], pC[0:5], w_decay, b_decay, gla_g, need_ctx)
    diff_l, diff_c = _diff_mixer(pL[5], pL[6], pL[7], pC[5], pC[6], pC[7], lam_q, lam_k, diff_g,
                                 lam_init, need_ctx)
    na_l, na_c = _na_mixer(pL[8], pL[9], pL[10], pC[8], pC[9], pC[10], rpb, need_ctx)
    y_l = _merge(jnp.stack([gla_l, diff_l, na_l], axis=2), pL[11], w_branch, w_o)
    y_c = _merge(jnp.stack([gla_c, diff_c, na_c], axis=2), pC[11], w_branch, w_o) if need_ctx else None
    return y_l, y_c


def _moe(h, w_router, b_router, w_gate, w_up, w_down):
    b, t, _ = h.shape
    aff = jax.nn.sigmoid(jnp.einsum('btd,de->bte', h, w_router).astype(jnp.float32))
    sel = aff + b_router.astype(jnp.float32)
    group_score = jnp.sum(lax.top_k(sel.reshape(b, t, N_GROUPS, EXPERTS_PER_GROUP), TOP_K)[0], -1)
    best_group = jnp.argmax(group_score, axis=-1)
    in_group = (jnp.arange(N_EXPERTS) // EXPERTS_PER_GROUP) == best_group[..., None]
    _, top_idx = lax.top_k(jnp.where(in_group, sel, -jnp.inf), TOP_K)
    top_aff = jnp.take_along_axis(aff, top_idx, axis=-1)
    top_w = top_aff / jnp.sum(top_aff, -1, keepdims=True)
    combine = jnp.sum(jax.nn.one_hot(top_idx, N_EXPERTS, dtype=jnp.float32) * top_w[..., None], -2)
    combine = combine.astype(h.dtype)
    out = jnp.zeros_like(h)
    for e in range(N_EXPERTS):
        a = jax.nn.silu(h @ w_gate[e]) * (h @ w_up[e])
        out = out + combine[..., e:e + 1] * (a @ w_down[e])
    return out


def setup_inputs(seed: int = 0) -> dict:
    key = jax.random.key(seed)
    ks = jax.random.split(key, 24)
    f32 = jnp.float32
    d = D_MODEL

    def nrm(k, shape, s):
        return jax.random.normal(k, shape, f32) * s

    return {
        "x": nrm(ks[0], (BATCH, SEQ, d), 1.0),
        "c": nrm(ks[1], (BATCH, d), 1.0),
        "ctx": nrm(ks[2], (BATCH, CTX_LEN, d), 1.0),
        "c_ctx": nrm(ks[3], (d,), 1.0),
        "w_ada": nrm(ks[4], (DEPTH, d, 6 * d), 0.5 * d ** -0.5),
        "b_ada": nrm(ks[5], (DEPTH, 6 * d), 0.02),
        "w_in": nrm(ks[6], (DEPTH, d, D_IN), d ** -0.5),
        "gla_w_decay": nrm(ks[7], (DEPTH, 2, GLA_RANK, GLA_HEADS * GLA_DK), GLA_RANK ** -0.5),
        "gla_b_decay": nrm(ks[8], (DEPTH, 2, GLA_HEADS * GLA_DK), 0.1),
        "gla_norm_g": 1.0 + nrm(ks[9], (DEPTH, GLA_DV), 0.02),
        "diff_lam_q": nrm(ks[10], (DEPTH, 2, DIFF_DH), 0.1),
        "diff_lam_k": nrm(ks[11], (DEPTH, 2, DIFF_DH), 0.1),
        "diff_norm_g": 1.0 + nrm(ks[12], (DEPTH, DIFF_DV), 0.02),
        "na_rpb": nrm(ks[13], (DEPTH, NA_HEADS, 2 * NA_WIN_H - 1, 2 * NA_WIN_W - 1), 0.1),
        "w_branch": nrm(ks[14], (DEPTH, N_BRANCHES, BRANCH_W, d), BRANCH_W ** -0.5),
        "w_o": nrm(ks[15], (DEPTH, d, d), DEEPNORM_BETA * d ** -0.5),
        "ln_g": 1.0 + nrm(ks[16], (DEPTH, 2, d), 0.02),
        "ln_b": nrm(ks[17], (DEPTH, 2, d), 0.02),
        "w_router": nrm(ks[18], (d, N_EXPERTS), d ** -0.5),
        "b_router": nrm(ks[19], (N_EXPERTS,), 0.01),
        "w_exp_gate": nrm(ks[20], (DEPTH, N_EXPERTS, d, D_EXPERT), d ** -0.5),
        "w_exp_up": nrm(ks[21], (DEPTH, N_EXPERTS, d, D_EXPERT), d ** -0.5),
        "w_exp_down": nrm(ks[22], (DEPTH, N_EXPERTS, D_EXPERT, d), DEEPNORM_BETA * D_EXPERT ** -0.5),
    }


def reference(x, c, ctx, c_ctx, w_ada, b_ada, w_in, gla_w_decay, gla_b_decay, gla_norm_g,
              diff_lam_q, diff_lam_k, diff_norm_g, na_rpb, w_branch, w_o, ln_g, ln_b,
              w_router, b_router, w_exp_gate, w_exp_up, w_exp_down):
    b, l, d = x.shape
    lc = ctx.shape[1]
    xL, xC = x, ctx
    for layer in range(DEPTH):
        need_ctx = layer < DEPTH - 1
        lam_init = 0.8 - 0.6 * math.exp(-0.3 * layer)
        mL = (jax.nn.silu(c) @ w_ada[layer] + b_ada[layer]).reshape(b, 6, 1, d)
        mC = (jax.nn.silu(c_ctx) @ w_ada[layer] + b_ada[layer]).reshape(6, d)
        hL = xL * (1.0 + mL[:, 1]) + mL[:, 0]
        hC = xC * (1.0 + mC[1]) + mC[0]
        yL, yC = _mixer_sublayer(hL, hC, w_in[layer], gla_w_decay[layer], gla_b_decay[layer],
                                 gla_norm_g[layer], diff_lam_q[layer], diff_lam_k[layer],
                                 diff_norm_g[layer], lam_init, na_rpb[layer], w_branch[layer],
                                 w_o[layer], need_ctx)
        xL = _layernorm(DEEPNORM_ALPHA * xL + mL[:, 2] * yL, ln_g[layer, 0], ln_b[layer, 0])
        hL = xL * (1.0 + mL[:, 4]) + mL[:, 3]
        if need_ctx:
            xC = _layernorm(DEEPNORM_ALPHA * xC + mC[2] * yC, ln_g[layer, 0], ln_b[layer, 0])
            hC = xC * (1.0 + mC[4]) + mC[3]
            y = _moe(jnp.concatenate([hC, hL], axis=1), w_router, b_router,
                     w_exp_gate[layer], w_exp_up[layer], w_exp_down[layer])
            yC, yL = y[:, :lc], y[:, lc:]
            xC = _layernorm(DEEPNORM_ALPHA * xC + mC[5] * yC, ln_g[layer, 1], ln_b[layer, 1])
        else:
            yL = _moe(hL, w_router, b_router, w_exp_gate[layer], w_exp_up[layer], w_exp_down[layer])
        xL = _layernorm(DEEPNORM_ALPHA * xL + mL[:, 5] * yL, ln_g[layer, 1], ln_b[layer, 1])
    return xL
```

```cpp
#include <hip/hip_runtime.h>
#include <stdint.h>
#include <stdio.h>

#ifndef MEGA
#define MEGA 0
#endif

constexpr int NB = 8, LL = 4096, LC = 256, LB = LL + LC  , T = NB * LB  , D = 1024, DEPTH = 4;
constexpr int NPANEL = T / 256;
constexpr int PB = LB / 256;
constexpr int PAIR_ROWS = 2 * T + 16 * 256;
constexpr float ALPHA = 1.681792830507429f;
constexpr float LN_EPS = 1e-5f, RMS_EPS = 1e-6f;

constexpr size_t AL256(size_t x) { return (x + 255) & ~(size_t)255; }
constexpr size_t OFF_BAR = 0;
constexpr size_t OFF_CNT = 16384;
constexpr size_t ZERO_BYTES = 32768;
constexpr size_t OFF_MOD = ZERO_BYTES;
constexpr size_t OFF_ROPE = AL256(OFF_MOD + (size_t)DEPTH * 9 * 6144 * 4);
constexpr size_t OFF_TOK = AL256(OFF_ROPE + (size_t)4096 * 32 * 2 * 4);
constexpr size_t OFF_GR = AL256(OFF_TOK + (size_t)T * 8 * 4);
constexpr size_t OFF_XS = AL256(OFF_GR + (size_t)T * 32 * 4);
constexpr size_t OFF_H = AL256(OFF_XS + (size_t)T * D * 4);
constexpr size_t OFF_W = AL256(OFF_H + (size_t)T * D * 2);
constexpr size_t W_IN_ROWS = 4864 + 3072;
constexpr size_t OFF_WIN = OFF_W;
constexpr size_t OFF_WB = OFF_WIN + W_IN_ROWS * 1024 * 2;
constexpr size_t OFF_WO = OFF_WB + (size_t)3 * 1024 * 512 * 2;
constexpr size_t OFF_WUP = OFF_WO + (size_t)1024 * 1024 * 2;
constexpr size_t OFF_WDN = OFF_WUP + (size_t)16 * 1024 * 1024 * 2;
constexpr size_t OFF_P = AL256(OFF_WDN + (size_t)16 * 1024 * 512 * 2);
constexpr size_t PCOL = (size_t)T * 2;
constexpr size_t OFF_GQ = OFF_P, OFF_GK = OFF_P + 256 * PCOL, OFF_GV = OFF_P + 512 * PCOL;
constexpr size_t OFF_DK = OFF_P + 1024 * PCOL, OFF_DV = OFF_P + 1536 * PCOL;
constexpr size_t OFF_NK = OFF_P + 2048 * PCOL, OFF_NV = OFF_P + 2560 * PCOL;
constexpr size_t OFF_BR = OFF_P + 3072 * PCOL;
constexpr size_t OFF_GG = OFF_BR, OFF_DQ = OFF_BR + 512 * PCOL, OFF_NQ = OFF_BR + 1024 * PCOL;
constexpr size_t OFF_GATE = OFF_P;
constexpr size_t OFF_S1 = AL256(OFF_P + 4608 * PCOL);
constexpr size_t OFF_S2 = AL256(OFF_S1 + (size_t)T * 512 * 4);
constexpr size_t OFF_END1 = AL256(OFF_S2 + (size_t)T * 512 * 4);
constexpr size_t OFF_XA = OFF_P;
constexpr size_t OFF_ACT = AL256(OFF_XA + (size_t)PAIR_ROWS * 1024 * 2);
constexpr size_t OFF_Y = AL256(OFF_ACT + (size_t)PAIR_ROWS * 512 * 2);
constexpr size_t OFF_END2 = AL256(OFF_Y + (size_t)PAIR_ROWS * 1024 * 2);
constexpr size_t WS_NEED = OFF_END1 > OFF_END2 ? OFF_END1 : OFF_END2;
static_assert(WS_NEED < (size_t)800 * 1000 * 1000, "workspace budget");

constexpr int LDS_STAGE = 131072;
constexpr int LDS_BYTES = LDS_STAGE + 256;

typedef unsigned short bf16_t;

struct Params {
    const float* in[23];
    float* out;
    char* ws;
};
enum { I_X = 0, I_C, I_CTX, I_CCTX, I_WADA, I_BADA, I_WIN, I_GWD, I_GBD, I_GNG, I_LQ, I_LK, I_DNG, I_RPB, I_WBR, I_WO, I_LNG, I_LNB, I_WR, I_BR, I_WEG, I_WEU, I_WED };

__device__ __forceinline__ float bf2f(bf16_t v) { return __uint_as_float(((unsigned)v) << 16); }
__device__ __forceinline__ float bflo(unsigned u) { return __uint_as_float(u << 16); }
__device__ __forceinline__ float bfhi(unsigned u) { return __uint_as_float(u & 0xffff0000u); }
__device__ __forceinline__ unsigned pk2(float lo, float hi) { unsigned r; asm volatile("v_cvt_pk_bf16_f32 %0, %1, %2" : "=v"(r) : "v"(lo), "v"(hi)); return r; }
__device__ __forceinline__ bf16_t f2bf(float f) { return (bf16_t)(pk2(f, 0.f) & 0xffffu); }
__device__ __forceinline__ float wave_sum(float v) {
#pragma unroll
    for (int o = 32; o >= 1; o >>= 1) v += __shfl_xor(v, o);
    return v;
}
__device__ __forceinline__ float sigmoidf_(float x) { return 1.f / (1.f + __expf(-x)); }
__device__ __forceinline__ float siluf_(float x) { return x / (1.f + __expf(-x)); }
__device__ __forceinline__ int row_slot(int row) { const int b = row / LB, t = row - b * LB; return t < LC ? 8 : b; }
#include <hip/hip_runtime.h>
namespace pg8 {
#define PG8_LAS __attribute__((address_space(3)))
typedef unsigned short bf16_t;
typedef short bf16x8 __attribute__((ext_vector_type(8)));
typedef float f32x4 __attribute__((ext_vector_type(4)));
typedef unsigned u32x4 __attribute__((ext_vector_type(4)));
constexpr int BM = 256, BK = 64, HALF = 128, HTB = HALF * BK * 2  , STAGE_BYTES = 8 * HTB, NXCD = 8, WGM = 8;

__host__ __device__ __forceinline__ int lds_byte(int r, int c) { const int st = (r >> 4) * 2 + (c >> 5), rr = r & 15, cc = c & 31, ob = rr * 64 + cc * 2; return st * 1024 + (ob ^ (((ob >> 9) & 1) << 5)); }
__host__ __device__ __forceinline__ void stage_rc(int b, int& R, int& C) { const int st = b / 1024, sb = b % 1024, swz = sb ^ (((sb >> 9) & 1) << 5); R = (st >> 1) * 16 + swz / 64; C = (st & 1) * 32 + (swz % 64) / 2; }
__host__ __device__ __forceinline__ int perm32(int rho) { const int n = rho >> 4, i = rho & 15; return 8 * (i >> 2) + 4 * n + (i & 3); }

struct Unit { int pm, pn; };
struct Gemm { const bf16_t* A; const bf16_t* Bt; int M, N, K; };
__device__ __forceinline__ unsigned cvt_pk_bf16(float lo, float hi) { unsigned r; asm volatile("v_cvt_pk_bf16_f32 %0, %1, %2" : "=v"(r) : "v"(lo), "v"(hi)); return r; }

template <class Epi, class Sched, bool STAMP = false>
__device__ __forceinline__ void gemm_phase(PG8_LAS unsigned char* lds, const Gemm g, const Sched& S, const Epi& E, unsigned long long* stamps) {
    const int tid = threadIdx.x, wid = __builtin_amdgcn_readfirstlane(tid >> 6), lane = tid & 63, wr = wid >> 2, wc = wid & 3, fr = lane & 15, fq = lane >> 4;
    const int K = g.K, nt = K / BK;
    int ts_lo = 0, ts_hi = 0, nts = 0; const unsigned long long rt_entry = STAMP ? (unsigned long long)wall_clock64() : 0ull;
#define PG8_STAMP() do { if (STAMP && wid == 0 && nts < 64) { const unsigned long long _c = (unsigned long long)clock64(); \
        ts_lo = (lane == nts) ? (int)(unsigned)_c : ts_lo; ts_hi = (lane == nts) ? (int)(unsigned)(_c >> 32) : ts_hi; ++nts; } } while (0)
    PG8_STAMP();
    unsigned voffA[2], voffB[2];
#pragma unroll
    for (int i = 0; i < 2; ++i) { int R, C; stage_rc(tid * 16 + i * 8192, R, C); const int Rb = Epi::PERM ? ((R & ~31) + perm32(R & 31)) : R;
        voffA[i] = (unsigned)(R * K + C) * 2u; voffB[i] = (unsigned)(Rb * K + C) * 2u; }
    const size_t kstep = (size_t)(BK * 2);
    const size_t hstep = (size_t)HALF * K * 2;
    const size_t tstep = 2 * hstep;
    const unsigned ldsw = (unsigned)wid * 1024u;
    const int aoff = lds_byte(wr * 64 + fr, fq * 8), boff = lds_byte(wc * 32 + fr, fq * 8);
#define PG8_SA(b, h) (((b) * 2 + (h)) * HTB)
#define PG8_SB(b, h) ((4 + (b) * 2 + (h)) * HTB)
#define PG8_STAGE(bufoff, gbase, voff) do { _Pragma("unroll") for (int _i = 0; _i < 2; ++_i) \
        __builtin_amdgcn_global_load_lds((const unsigned*)((const char*)(gbase) + (voff)[_i]), (PG8_LAS unsigned*)(lds + (bufoff) + ldsw + _i * 8192), 16, 0, 0); } while (0)
#define PG8_LDA(dst, b, h) do { _Pragma("unroll") for (int m = 0; m < 4; ++m) _Pragma("unroll") for (int k = 0; k < 2; ++k) dst[m][k] = *(const PG8_LAS bf16x8*)(lds + PG8_SA(b, h) + aoff + m * 2048 + k * 1024); } while (0)
#define PG8_LDB(dst, b, h) do { _Pragma("unroll") for (int n = 0; n < 2; ++n) _Pragma("unroll") for (int k = 0; k < 2; ++k) dst[n][k] = *(const PG8_LAS bf16x8*)(lds + PG8_SB(b, h) + boff + n * 2048 + k * 1024); } while (0)
#define PG8_MMA(ai, bj, At, Bt) do { __builtin_amdgcn_s_setprio(1); _Pragma("unroll") for (int m = 0; m < 4; ++m) _Pragma("unroll") for (int n = 0; n < 2; ++n) _Pragma("unroll") for (int k = 0; k < 2; ++k) \
        acc[ai][bj][m][n] = __builtin_amdgcn_mfma_f32_16x16x32_bf16(Bt[n][k], At[m][k], acc[ai][bj][m][n], 0, 0, 0); __builtin_amdgcn_s_setprio(0); } while (0)
#define PG8_WAIT_V(n) asm volatile("s_waitcnt vmcnt(" #n ")" ::: "memory")
#define PG8_WAIT_L(n) asm volatile("s_waitcnt lgkmcnt(" #n ")" ::: "memory")
#define PG8_BAR __builtin_amdgcn_s_barrier()
#define PG8_SCHED __builtin_amdgcn_sched_barrier(0)
    Unit cur, nxt; int ui = 0;
    if (!S.next(0, cur)) return;
    f32x4 acc[2][2][4][2];
#pragma unroll
    for (int a = 0; a < 2; ++a)
#pragma unroll
        for (int b = 0; b < 2; ++b)
#pragma unroll
            for (int m = 0; m < 4; ++m)
#pragma unroll
                for (int n = 0; n < 2; ++n) acc[a][b][m][n] = (f32x4){0.f, 0.f, 0.f, 0.f};
    bf16x8 At[4][2], B0[2][2], B1[2][2];
    const char* cA = (const char*)g.A + (size_t)cur.pm * tstep; const char* cB = (const char*)g.Bt + (size_t)cur.pn * tstep;
    S.a_ready(cur);
    PG8_STAGE(PG8_SB(0, 0), cB, voffB); PG8_STAGE(PG8_SA(0, 0), cA, voffA); PG8_STAGE(PG8_SB(0, 1), cB + hstep, voffB); PG8_STAGE(PG8_SA(0, 1), cA + hstep, voffA);
    if (wr == 1) PG8_BAR;
    PG8_WAIT_V(4); PG8_BAR;
    PG8_STAGE(PG8_SB(1, 0), cB + kstep, voffB); PG8_STAGE(PG8_SA(1, 0), cA + kstep, voffA); PG8_STAGE(PG8_SB(1, 1), cB + hstep + kstep, voffB);
    PG8_WAIT_V(6); PG8_BAR;
    PG8_STAMP();
    for (;;) {
        const bool has_next = S.next(ui + 1, nxt);
        const char* nA = has_next ? (const char*)g.A + (size_t)nxt.pm * tstep : cA; const char* nB = has_next ? (const char*)g.Bt + (size_t)nxt.pn * tstep : cB;
        for (int t = 0; t < nt; t += 2) {
            const bool last = (t == nt - 2);
            const char* a1 = cA + (size_t)(t + 1) * kstep;
            const char* a2 = last ? nA : cA + (size_t)(t + 2) * kstep; const char* b2 = last ? nB : cB + (size_t)(t + 2) * kstep;
            const char* a3 = a2 + kstep; const char* b3 = b2 + kstep;
            if (last && has_next) S.a_ready(nxt);
            PG8_LDB(B0, 0, 0); PG8_SCHED; PG8_LDA(At, 0, 0); PG8_STAGE(PG8_SA(1, 1), a1 + hstep, voffA);
            PG8_WAIT_L(8); PG8_BAR; PG8_WAIT_L(0); PG8_MMA(0, 0, At, B0); PG8_BAR; PG8_SCHED;
            PG8_LDB(B1, 0, 1); PG8_STAGE(PG8_SB(0, 0), b2, voffB);
            PG8_BAR; PG8_WAIT_L(0); PG8_MMA(0, 1, At, B1); PG8_BAR;
            PG8_LDA(At, 0, 1); PG8_STAGE(PG8_SA(0, 0), a2, voffA);
            PG8_BAR; PG8_WAIT_L(0); PG8_MMA(1, 0, At, B0); PG8_BAR; PG8_SCHED;
            PG8_STAGE(PG8_SB(0, 1), b2 + hstep, voffB);
            PG8_WAIT_V(6); PG8_BAR; PG8_MMA(1, 1, At, B1); PG8_BAR;
            PG8_LDB(B0, 1, 0); PG8_SCHED; PG8_LDA(At, 1, 0); PG8_STAGE(PG8_SA(0, 1), a2 + hstep, voffA);
            PG8_WAIT_L(8); PG8_BAR; PG8_WAIT_L(0); PG8_MMA(0, 0, At, B0); PG8_BAR; PG8_SCHED;
            PG8_LDB(B1, 1, 1); PG8_STAGE(PG8_SB(1, 0), b3, voffB);
            PG8_BAR; PG8_WAIT_L(0); PG8_MMA(0, 1, At, B1); PG8_BAR;
            PG8_LDA(At, 1, 1); PG8_STAGE(PG8_SA(1, 0), a3, voffA);
            PG8_BAR; PG8_WAIT_L(0); PG8_MMA(1, 0, At, B0); PG8_BAR; PG8_SCHED;
            PG8_STAGE(PG8_SB(1, 1), b3 + hstep, voffB);
            PG8_WAIT_V(6); PG8_BAR; PG8_MMA(1, 1, At, B1); PG8_BAR;
        }
        PG8_STAMP();
        if constexpr (!Epi::AFTER_DRAIN) { E(acc, cur, wr, wc, fr, fq); S.done(cur); }
        PG8_STAMP();
        if (!has_next) break;
#pragma unroll
        for (int a = 0; a < 2; ++a)
#pragma unroll
            for (int b = 0; b < 2; ++b)
#pragma unroll
                for (int m = 0; m < 4; ++m)
#pragma unroll
                    for (int n = 0; n < 2; ++n) acc[a][b][m][n] = (f32x4){0.f, 0.f, 0.f, 0.f};
        cur = nxt; cA = nA; cB = nB; ++ui;
    }
    PG8_WAIT_V(0);
    if (wr == 0) PG8_BAR;
    PG8_BAR;
    if constexpr (Epi::AFTER_DRAIN) { E.fused(acc, cur, wr, wc, fr, fq, lds, wid, lane); S.done(cur); }
    PG8_STAMP();
    if (STAMP && wid == 0) { stamps[lane] = lane < nts ? (((unsigned long long)(unsigned)ts_hi << 32) | (unsigned)ts_lo) : 0ull;
        if (lane == 62) stamps[62] = rt_entry; if (lane == 63) stamps[63] = (unsigned long long)wall_clock64(); }
#undef PG8_STAMP
#undef PG8_SA
#undef PG8_SB
#undef PG8_STAGE
#undef PG8_LDA
#undef PG8_LDB
#undef PG8_MMA
#undef PG8_WAIT_V
#undef PG8_WAIT_L
#undef PG8_BAR
#undef PG8_SCHED
}
}
#define XB_TMO      128
#define XB_XCNT(j)  (256  + 64 * (j))
#define XB_XSUB(j)  (1280 + 64 * (j))
#define XB_XGEN(j)  (2304 + 64 * (j))
#define XB_TOP      3328
#define XB_TOPGEN   3392
#define XCD_BAR_WORDS 3456
#define XB_SPIN_CAP (1u << 18)
#define LAS __attribute__((address_space(3)))

__device__ __forceinline__ unsigned xb_ld(unsigned* p)              { return __hip_atomic_load(p, __ATOMIC_RELAXED, __HIP_MEMORY_SCOPE_AGENT); }
__device__ __forceinline__ unsigned xb_add(unsigned* p, unsigned v) { return __hip_atomic_fetch_add(p, v, __ATOMIC_RELAXED, __HIP_MEMORY_SCOPE_AGENT); }
__device__ __forceinline__ unsigned xb_xcc_id() { return (unsigned)__builtin_amdgcn_s_getreg((3 << 11) | 20) & 0xFu; }
#define XB_SPIN(cond, bar) do { unsigned _sp = 0; while (cond) { __builtin_amdgcn_s_sleep(1); \
    if ((++_sp & 255u) == 0u) { if (xb_ld(&(bar)[XB_TMO])) break; if (_sp > XB_SPIN_CAP) { atomicAdd(&(bar)[XB_TMO], 1u); break; } } } } while (0)

struct XcdBarrier {
    unsigned* bar; unsigned x;
    volatile LAS unsigned* st;
};

__device__ __forceinline__ XcdBarrier xcd_barrier_post(unsigned* bar, volatile LAS unsigned* st) {
    XcdBarrier b; b.bar = bar; b.x = xb_xcc_id(); b.st = st;
    if (threadIdx.x == 0) (void)xb_add(&bar[XB_XCNT(b.x)], 1u);
    return b;
}
__device__ __forceinline__ void xcd_barrier_complete(unsigned* bar, unsigned x, unsigned& nloc, unsigned& nx) {
    const unsigned G = gridDim.x * gridDim.y * gridDim.z;
    unsigned sum, cnt, mine, sp = 0u;
    for (;;) {
        sum = 0u; cnt = 0u; mine = 0u;
#pragma unroll
        for (unsigned j = 0; j < 16; ++j) { const unsigned c = xb_ld(&bar[XB_XCNT(j)]); sum += c; cnt += (c > 0u) ? 1u : 0u; mine = (j == x) ? c : mine; }
        if (sum == G) break;
        __builtin_amdgcn_s_sleep(1);
        if ((++sp & 255u) == 0u) { if (xb_ld(&bar[XB_TMO])) break; if (sp > XB_SPIN_CAP) { atomicAdd(&bar[XB_TMO], 1u); break; } }
    }
    nloc = mine > 0u ? mine : 1u; nx = cnt > 0u ? cnt : 1u;
}

__device__ __forceinline__ void xcd_barrier(const XcdBarrier& b) {
    asm volatile("s_waitcnt vmcnt(0)" ::: "memory");
    __syncthreads();
    if (threadIdx.x == 0) {
        unsigned* bar = b.bar;
        __builtin_amdgcn_s_waitcnt(0);
        unsigned nloc = b.st[0], nx = b.st[1];
        if (nloc == 0u) { xcd_barrier_complete(bar, b.x, nloc, nx); b.st[0] = nloc; b.st[1] = nx; }
        const unsigned old = xb_add(&bar[XB_XSUB(b.x)], 1u);
        const unsigned gen = old / nloc;
        if (old + 1u == (gen + 1u) * nloc) {
            __builtin_amdgcn_fence(__ATOMIC_RELEASE, "agent");
            asm volatile("s_waitcnt vmcnt(0)" ::: "memory");
            const unsigned og = xb_add(&bar[XB_TOP], 1u);
            const unsigned tg = og / nx;
            if (og + 1u == (tg + 1u) * nx) xb_add(&bar[XB_TOPGEN], 1u);
            else XB_SPIN(xb_ld(&bar[XB_TOPGEN]) == tg, bar);
            __builtin_amdgcn_fence(__ATOMIC_ACQUIRE, "agent");
            xb_add(&bar[XB_XGEN(b.x)], 1u);
            asm volatile("s_waitcnt vmcnt(0)" ::: "memory");
        } else {
            XB_SPIN(xb_ld(&bar[XB_XGEN(b.x)]) == gen, bar);
            __builtin_amdgcn_fence(__ATOMIC_ACQUIRE, "agent");
            asm volatile("s_waitcnt vmcnt(0)" ::: "memory");
        }
    }
    __syncthreads();
}

using pg8::f32x4;
using pg8::Unit;
typedef unsigned u32x4_t __attribute__((ext_vector_type(4)));
typedef unsigned u32x2_t __attribute__((ext_vector_type(2)));

struct SchedGrid {
    int nM, nN, pn0, G, c;
    __device__ __forceinline__ bool next(int i, Unit& u) const {
        const int L = i * G + c; if (L >= nM * nN) return false;
        u.pm = L / nN; u.pn = pn0 + (L - u.pm * nN); return true;
    }
    __device__ __forceinline__ void a_ready(const Unit&) const {}
    __device__ __forceinline__ void done(const Unit&) const {}
};
struct SchedMerge {
    int G, c;
    __device__ __forceinline__ bool next(int i, Unit& u) const {
        const int i3 = i / 3, n = i - i3 * 3, ti = i3 * G + c; if (ti >= NPANEL * 4) return false;
        u.pm = n * NPANEL + (ti >> 2); u.pn = n * 4 + (ti & 3); return true;
    }
    __device__ __forceinline__ void a_ready(const Unit&) const {}
    __device__ __forceinline__ void done(const Unit&) const {}
};
struct SchedMoe {
    int cum[17]; int G, c;
    __device__ __forceinline__ void init(const unsigned* cnt, int G_, int c_) {
        G = G_; c = c_; int s = 0;
#pragma unroll
        for (int e = 0; e < 16; ++e) { cum[e] = s; const unsigned n = __builtin_amdgcn_readfirstlane(cnt[e]); s += (int)((n + 255u) >> 8); }
        cum[16] = s;
    }
    __device__ __forceinline__ bool next(int i, Unit& u) const {
        const int L = i * G + c; if (L >= cum[16] * 4) return false;
        const int rt = L >> 2; int e = 0;
#pragma unroll
        for (int j = 1; j < 16; ++j) e += (rt >= cum[j]) ? 1 : 0;
        u.pm = rt; u.pn = e * 4 + (L & 3); return true;
    }
    __device__ __forceinline__ void a_ready(const Unit&) const {}
    __device__ __forceinline__ void done(const Unit&) const {}
};

__device__ __forceinline__ u32x4_t pack8(const f32x4& a, const f32x4& b) {
    u32x4_t r; r[0] = pk2(a[0], a[1]); r[1] = pk2(a[2], a[3]); r[2] = pk2(b[0], b[1]); r[3] = pk2(b[2], b[3]); return r;
}
struct EpiInProj {
    static constexpr bool PERM = true, AFTER_DRAIN = false;
    char* ws;
    __device__ __forceinline__ void operator()(const f32x4 (&acc)[2][2][4][2], const Unit& u, int wr, int wc, int fr, int fq) const {
        const int pn = u.pn; const int row0 = u.pm * 256 + wr * 64 + fr;
        if (pn == 6) {
            if (wc == 0) { float* gr = (float*)(ws + OFF_GR);
#pragma unroll
                for (int ai = 0; ai < 2; ++ai)
#pragma unroll
                    for (int m = 0; m < 4; ++m) { float* rp = gr + (size_t)(row0 + ai * 128 + m * 16) * 32 + 8 * fq;
                        *(f32x4*)(rp) = acc[ai][0][m][0]; *(f32x4*)(rp + 4) = acc[ai][0][m][1]; } }
            return;
        }
        size_t off; int ld, col0;
        if (pn == 0) { off = OFF_GQ; ld = 256; col0 = 0; }
        else if (pn == 1) { off = OFF_GK; ld = 256; col0 = 0; }
        else if (pn < 4) { off = OFF_GV; ld = 512; col0 = (pn - 2) * 256; }
        else if (pn < 6) { off = OFF_GG; ld = 512; col0 = (pn - 4) * 256; }
        else if (pn < 9) { off = OFF_DQ; ld = 512; col0 = (pn - 7) * 256; }
        else if (pn < 11) { off = OFF_DK; ld = 512; col0 = (pn - 9) * 256; }
        else if (pn < 13) { off = OFF_DV; ld = 512; col0 = (pn - 11) * 256; }
        else if (pn < 15) { off = OFF_NQ; ld = 512; col0 = (pn - 13) * 256; }
        else if (pn < 17) { off = OFF_NK; ld = 512; col0 = (pn - 15) * 256; }
        else { off = OFF_NV; ld = 512; col0 = (pn - 17) * 256; }
        bf16_t* base = (bf16_t*)(ws + off) + col0 + wc * 32 + 8 * fq;
#pragma unroll
        for (int ai = 0; ai < 2; ++ai)
#pragma unroll
            for (int m = 0; m < 4; ++m) { bf16_t* rp = base + (size_t)(row0 + ai * 128 + m * 16) * ld;
#pragma unroll
                for (int bj = 0; bj < 2; ++bj) *(u32x4_t*)(rp + bj * 128) = pack8(acc[ai][bj][m][0], acc[ai][bj][m][1]); }
    }
};
struct EpiGates {
    static constexpr bool PERM = true, AFTER_DRAIN = false;
    char* ws;
    __device__ __forceinline__ void operator()(const f32x4 (&acc)[2][2][4][2], const Unit& u, int wr, int wc, int fr, int fq) const {
        const int pl = u.pn - 19, n = pl >> 2, col0 = (pl & 3) * 256; const int row0 = u.pm * 256 + wr * 64 + fr;
        bf16_t* base = (bf16_t*)(ws + OFF_GATE) + (size_t)n * T * 1024 + col0 + wc * 32 + 8 * fq;
#pragma unroll
        for (int ai = 0; ai < 2; ++ai)
#pragma unroll
            for (int m = 0; m < 4; ++m) { bf16_t* rp = base + (size_t)(row0 + ai * 128 + m * 16) * 1024;
#pragma unroll
                for (int bj = 0; bj < 2; ++bj) { f32x4 a = acc[ai][bj][m][0], b = acc[ai][bj][m][1];
#pragma unroll
                    for (int j = 0; j < 4; ++j) { a[j] = sigmoidf_(a[j]); b[j] = sigmoidf_(b[j]); }
                    *(u32x4_t*)(rp + bj * 128) = pack8(a, b); } }
    }
};
struct EpiMerge {
    static constexpr bool PERM = true, AFTER_DRAIN = false;
    char* ws;
    __device__ __forceinline__ void operator()(const f32x4 (&acc)[2][2][4][2], const Unit& u, int wr, int wc, int fr, int fq) const {
        const int n = u.pm / NPANEL, pm = u.pm - n * NPANEL, pn = u.pn & 3; const int row0 = pm * 256 + wr * 64 + fr;
        const size_t cb = (size_t)pn * 256 + wc * 32 + 8 * fq;
        const bf16_t* gbase = (const bf16_t*)(ws + OFF_GATE) + (size_t)n * T * 1024 + cb;
        bf16_t* obase = (bf16_t*)(ws + OFF_H) + cb;
#pragma unroll
        for (int ai = 0; ai < 2; ++ai)
#pragma unroll
            for (int m = 0; m < 4; ++m) { const size_t ro = (size_t)(row0 + ai * 128 + m * 16) * 1024;
#pragma unroll
                for (int bj = 0; bj < 2; ++bj) {
                    const u32x4_t g = *(const u32x4_t*)(gbase + ro + bj * 128);
                    f32x4 a = acc[ai][bj][m][0], b = acc[ai][bj][m][1];
                    a[0] *= bflo(g[0]); a[1] *= bfhi(g[0]); a[2] *= bflo(g[1]); a[3] *= bfhi(g[1]);
                    b[0] *= bflo(g[2]); b[1] *= bfhi(g[2]); b[2] *= bflo(g[3]); b[3] *= bfhi(g[3]);
                    if (n > 0) { const u32x4_t o = *(const u32x4_t*)(obase + ro + bj * 128);
                        a[0] += bflo(o[0]); a[1] += bfhi(o[0]); a[2] += bflo(o[1]); a[3] += bfhi(o[1]);
                        b[0] += bflo(o[2]); b[1] += bfhi(o[2]); b[2] += bflo(o[3]); b[3] += bfhi(o[3]); }
                    *(u32x4_t*)(obase + ro + bj * 128) = pack8(a, b); } }
    }
};
struct EpiWo {
    static constexpr bool PERM = false, AFTER_DRAIN = false;
    char* ws; int layer;
    __device__ __forceinline__ void operator()(const f32x4 (&acc)[2][2][4][2], const Unit& u, int wr, int wc, int fr, int fq) const {
        const int b = u.pm / PB, slot = (u.pm - b * PB) == 0 ? 8 : b;
        const int row0 = u.pm * 256 + wr * 64 + fr, col0 = u.pn * 256 + wc * 32 + 4 * fq;
        const float* mg = (const float*)(ws + OFF_MOD) + ((size_t)(layer * 9 + slot) * 6 + 2) * 1024 + col0;
        float* xs = (float*)(ws + OFF_XS) + col0;
        f32x4 g[2][2];
#pragma unroll
        for (int bj = 0; bj < 2; ++bj)
#pragma unroll
            for (int n = 0; n < 2; ++n) g[bj][n] = *(const f32x4*)(mg + bj * 128 + n * 16);
#pragma unroll
        for (int ai = 0; ai < 2; ++ai)
#pragma unroll
            for (int m = 0; m < 4; ++m) { float* rp = xs + (size_t)(row0 + ai * 128 + m * 16) * 1024;
#pragma unroll
                for (int bj = 0; bj < 2; ++bj)
#pragma unroll
                    for (int n = 0; n < 2; ++n) { f32x4 x = *(const f32x4*)(rp + bj * 128 + n * 16);
                        *(f32x4*)(rp + bj * 128 + n * 16) = x * ALPHA + g[bj][n] * acc[ai][bj][m][n]; } }
    }
};
struct EpiUp {
    static constexpr bool PERM = true, AFTER_DRAIN = false;
    char* ws;
    __device__ __forceinline__ void operator()(const f32x4 (&acc)[2][2][4][2], const Unit& u, int wr, int wc, int fr, int fq) const {
        const int ct = u.pn & 3; const int row0 = u.pm * 256 + wr * 64 + fr;
        bf16_t* base = (bf16_t*)(ws + OFF_ACT) + ct * 128 + wc * 32 + 8 * fq;
#pragma unroll
        for (int ai = 0; ai < 2; ++ai)
#pragma unroll
            for (int m = 0; m < 4; ++m) { f32x4 a, b;
#pragma unroll
                for (int j = 0; j < 4; ++j) { a[j] = siluf_(acc[ai][0][m][0][j]) * acc[ai][1][m][0][j]; b[j] = siluf_(acc[ai][0][m][1][j]) * acc[ai][1][m][1][j]; }
                *(u32x4_t*)(base + (size_t)(row0 + ai * 128 + m * 16) * 512) = pack8(a, b); }
    }
};
struct EpiDown {
    static constexpr bool PERM = true, AFTER_DRAIN = false;
    char* ws;
    __device__ __forceinline__ void operator()(const f32x4 (&acc)[2][2][4][2], const Unit& u, int wr, int wc, int fr, int fq) const {
        const int ct = u.pn & 3; const int row0 = u.pm * 256 + wr * 64 + fr;
        bf16_t* base = (bf16_t*)(ws + OFF_Y) + ct * 256 + wc * 32 + 8 * fq;
#pragma unroll
        for (int ai = 0; ai < 2; ++ai)
#pragma unroll
            for (int m = 0; m < 4; ++m) { bf16_t* rp = base + (size_t)(row0 + ai * 128 + m * 16) * 1024;
#pragma unroll
                for (int bj = 0; bj < 2; ++bj) *(u32x4_t*)(rp + bj * 128) = pack8(acc[ai][bj][m][0], acc[ai][bj][m][1]); }
    }
};

#define GSTRIDE_BEGIN(var, n) for (long var = (long)blockIdx.x * blockDim.x + threadIdx.x; var < (long)(n); var += (long)gridDim.x * blockDim.x)

__device__ __forceinline__ void phase_mod(const Params& p, float* lds) {
    const int tid = threadIdx.x;
    for (int i = tid; i < 9 * 1024; i += blockDim.x) { const int s = i >> 10, k = i & 1023; const float v = s < 8 ? p.in[I_C][s * 1024 + k] : p.in[I_CCTX][k]; lds[i] = siluf_(v); }
    __syncthreads();
    float* mod = (float*)(p.ws + OFF_MOD);
    GSTRIDE_BEGIN(idx, DEPTH * 6144) {
        const int l = (int)(idx / 6144), j = (int)(idx - (long)l * 6144);
        const float* w = p.in[I_WADA] + (size_t)l * 1024 * 6144 + j;
        float acc[9];
#pragma unroll
        for (int s = 0; s < 9; ++s) acc[s] = 0.f;
        for (int k = 0; k < 1024; ++k) { const float wv = w[(size_t)k * 6144];
#pragma unroll
            for (int s = 0; s < 9; ++s) acc[s] += lds[s * 1024 + k] * wv; }
        const float bv = p.in[I_BADA][l * 6144 + j];
#pragma unroll
        for (int s = 0; s < 9; ++s) mod[(size_t)(l * 9 + s) * 6144 + j] = acc[s] + bv;
    }
    float* rope = (float*)(p.ws + OFF_ROPE);
    GSTRIDE_BEGIN(idx, 4096 * 32) {
        const int t = (int)(idx >> 5), i = (int)(idx & 31);
        const float pos = (float)(i < 16 ? (t >> 6) : (t & 63));
        const float inv = powf(10000.0f, -(float)(i & 15) / 16.0f);
        const float ang = pos * inv;
        rope[idx * 2] = cosf(ang); rope[idx * 2 + 1] = sinf(ang);
    }
    __syncthreads();
}

__device__ __forceinline__ void phase_init(const Params& p) {
    const float* mod = (const float*)(p.ws + OFF_MOD);
    float* xs = (float*)(p.ws + OFF_XS); bf16_t* h = (bf16_t*)(p.ws + OFF_H);
    GSTRIDE_BEGIN(idx, (long)T * 256) {
        const int row = (int)(idx >> 8), c4 = (int)(idx & 255) * 4;
        const int b = row / LB, t = row - b * LB;
        const float* src = t < LC ? p.in[I_CTX] + ((size_t)(b * LC + t)) * 1024 : p.in[I_X] + ((size_t)(b * LL + (t - LC))) * 1024;
        const int slot = t < LC ? 8 : b;
        const f32x4 v = *(const f32x4*)(src + c4);
        const f32x4 sh = *(const f32x4*)(mod + (size_t)(slot * 6 + 0) * 1024 + c4), sc = *(const f32x4*)(mod + (size_t)(slot * 6 + 1) * 1024 + c4);
        *(f32x4*)(xs + (size_t)row * 1024 + c4) = v;
        const f32x4 hv = v * (sc + 1.0f) + sh;
        u32x2_t o; o[0] = pk2(hv[0], hv[1]); o[1] = pk2(hv[2], hv[3]);
        *(u32x2_t*)(h + (size_t)row * 1024 + c4) = o;
    }
}

__device__ __forceinline__ int winmap(int rho, float& scale) {
    scale = 1.f;
    if (rho < 1568) { if (rho < 256) scale = 0.125f; return rho; }
    if (rho < 1792) return -1;
    if (rho < 2304 || (rho >= 3328 && rho < 3840)) scale = 0.125f;
    return rho - 224;
}
__device__ __forceinline__ void convert_job(const float* src, const float* src2, int ld, int K, bf16_t* dst, int nrows, int mode, float* lds, int& tilectr) {
    const int tid = threadIdx.x, ntk = K >> 6, ntiles = (nrows >> 6) * ntk;
    for (int ti = 0; ti < ntiles; ++ti, ++tilectr) {
        if ((tilectr % (int)gridDim.x) != (int)blockIdx.x) continue;
        const int rt = ti / ntk, kt = ti - rt * ntk, r0 = rt * 64, k0 = kt * 64;
        __syncthreads();
        { const int nn = tid & 63, rho = r0 + nn; float sc = 1.f; int col; const float* s = src;
          if (mode == 0) col = winmap(rho, sc);
          else if (mode == 1) col = rho;
          else { const int ct = rho >> 8, half = (rho >> 7) & 1, i = rho & 127; col = ct * 128 + i; s = half ? src2 : src; }
#pragma unroll
          for (int i = 0; i < 8; ++i) { const int kk = (tid >> 6) + 8 * i;
              const float v = col >= 0 ? s[(size_t)(k0 + kk) * ld + col] * sc : 0.f;
              lds[nn * 65 + kk] = v; } }
        __syncthreads();
        { const int nn = tid >> 3, k8 = (tid & 7) * 8; const float* lp = lds + nn * 65 + k8;
          u32x4_t o; o[0] = pk2(lp[0], lp[1]); o[1] = pk2(lp[2], lp[3]); o[2] = pk2(lp[4], lp[5]); o[3] = pk2(lp[6], lp[7]);
          *(u32x4_t*)(dst + (size_t)(r0 + nn) * K + k0 + k8) = o; }
    }
}
__device__ __forceinline__ void phase_convert(const Params& p, int l, float* lds) {
    int ctr = 0;
    convert_job(p.in[I_WIN] + (size_t)l * 1024 * 7712, nullptr, 7712, 1024, (bf16_t*)(p.ws + OFF_WIN), (int)W_IN_ROWS, 0, lds, ctr);
    for (int n = 0; n < 3; ++n)
        convert_job(p.in[I_WBR] + ((size_t)l * 3 + n) * 512 * 1024, nullptr, 1024, 512, (bf16_t*)(p.ws + OFF_WB) + (size_t)n * 1024 * 512, 1024, 1, lds, ctr);
    convert_job(p.in[I_WO] + (size_t)l * 1024 * 1024, nullptr, 1024, 1024, (bf16_t*)(p.ws + OFF_WO), 1024, 1, lds, ctr);
    for (int e = 0; e < 16; ++e) {
        const size_t eo = ((size_t)l * 16 + e) * 1024 * 512;
        convert_job(p.in[I_WEG] + eo, p.in[I_WEU] + eo, 512, 1024, (bf16_t*)(p.ws + OFF_WUP) + (size_t)e * 1024 * 1024, 1024, 2, lds, ctr);
        convert_job(p.in[I_WED] + eo, nullptr, 1024, 512, (bf16_t*)(p.ws + OFF_WDN) + (size_t)e * 1024 * 512, 1024, 1, lds, ctr);
    }
    __syncthreads();
}

__device__ __forceinline__ void phase_rope_decay(const Params& p, int l) {
    const float* rope = (const float*)(p.ws + OFF_ROPE);
    GSTRIDE_BEGIN(idx, (long)NB * LL * 2 * 8 * 8) {
        const int i4 = (int)(idx & 7) * 4, hc = (int)(idx >> 3) & 7, which = (int)(idx >> 6) & 1; const int lat = (int)(idx >> 7);
        const int b = lat >> 12, t = lat & 4095; const int row = b * LB + LC + t;
        bf16_t* base = (bf16_t*)(p.ws + (which ? OFF_DK : OFF_DQ)) + (size_t)row * 512 + hc * 64 + i4;
        const u32x2_t a = *(const u32x2_t*)base, bq = *(const u32x2_t*)(base + 32);
        const float x1[4] = {bflo(a[0]), bfhi(a[0]), bflo(a[1]), bfhi(a[1])}, x2[4] = {bflo(bq[0]), bfhi(bq[0]), bflo(bq[1]), bfhi(bq[1])};
        float y1[4], y2[4];
#pragma unroll
        for (int j = 0; j < 4; ++j) { const float cs = rope[((size_t)t * 32 + i4 + j) * 2], sn = rope[((size_t)t * 32 + i4 + j) * 2 + 1];
            y1[j] = x1[j] * cs - x2[j] * sn; y2[j] = x1[j] * sn + x2[j] * cs; }
        u32x2_t o1, o2; o1[0] = pk2(y1[0], y1[1]); o1[1] = pk2(y1[2], y1[3]); o2[0] = pk2(y2[0], y2[1]); o2[1] = pk2(y2[2], y2[3]);
        *(u32x2_t*)base = o1; *(u32x2_t*)(base + 32) = o2;
    }
    const float* gr = (const float*)(p.ws + OFF_GR); float* dec = (float*)(p.ws + OFF_S1);
    const float* wd = p.in[I_GWD] + (size_t)l * 2 * 16 * 256; const float* bd = p.in[I_GBD] + (size_t)l * 2 * 256;
    GSTRIDE_BEGIN(idx, (long)T * 512) {
        const int row = (int)(idx >> 9), dj = (int)(idx & 511), dir = dj >> 8, j = dj & 255;
        float z = bd[dir * 256 + j];
#pragma unroll
        for (int r = 0; r < 16; ++r) z += gr[(size_t)row * 32 + dir * 16 + r] * wd[(dir * 16 + r) * 256 + j];
        const float ls = fminf(z, 0.f) - log1pf(__expf(-fabsf(z)));
        dec[idx] = __expf(ls * (1.0f / 16.0f));
    }
}

template <int DIR>
__device__ __forceinline__ void gla_naive_dir(const Params& p, int l, int b, float* lds) {
    const int tid = threadIdx.x, hh = tid >> 7, vc = tid & 127, wv = tid >> 6;
    const bf16_t* GQ = (const bf16_t*)(p.ws + OFF_GQ); const bf16_t* GK = (const bf16_t*)(p.ws + OFF_GK); const bf16_t* GV = (const bf16_t*)(p.ws + OFF_GV);
    bf16_t* GG = (bf16_t*)(p.ws + OFF_GG); const float* DEC = (const float*)(p.ws + OFF_S1); float* OF = (float*)(p.ws + OFF_S2);
    float* sq = lds; float* sk = lds + 16 * 256; float* sd = lds + 32 * 256; float* red = lds + 48 * 256;
    float* sv = lds + 49 * 256;
    const float gn = p.in[I_GNG][l * 128 + vc];
    const int row0 = b * LB;
    float S[64];
#pragma unroll
    for (int d = 0; d < 64; ++d) S[d] = 0.f;
    for (int blk = 0; blk < LB / 16; ++blk) {
        int t0;
        if (DIR == 0) t0 = blk * 16; else t0 = blk < 16 ? (15 - blk) * 16 : (LB / 16 - 1 - (blk - 16)) * 16;
        __syncthreads();
        for (int i = tid; i < 16 * 256; i += 512) { const int r = i >> 8, j = i & 255; const size_t row = row0 + t0 + r;
            sq[i] = bf2f(GQ[row * 256 + j]); sk[i] = bf2f(GK[row * 256 + j]); sd[i] = DEC[(row * 2 + DIR) * 256 + j]; }
#pragma unroll 1
        for (int r = 0; r < 16; ++r) sv[r * 512 + tid] = bf2f(GV[(size_t)(row0 + t0 + r) * 512 + hh * 128 + vc]);
        __syncthreads();
#pragma unroll 1
        for (int rr = 0; rr < 16; ++rr) {
            const int r = DIR == 0 ? rr : 15 - rr;
            const float* pq = sq + r * 256 + hh * 64; const float* pk = sk + r * 256 + hh * 64; const float* pd = sd + r * 256 + hh * 64;
            const float vr = sv[r * 512 + tid];
            float o = 0.f;
#pragma unroll
            for (int d = 0; d < 64; ++d) { S[d] = pd[d] * S[d] + pk[d] * vr; o += pq[d] * S[d]; }
            const size_t oi = (size_t)(row0 + t0 + r) * 512 + hh * 128 + vc;
            if (DIR == 0) OF[oi] = o;
            else {
                const float tot = o + OF[oi];
                sv[r * 512 + tid] = tot;
                const float ss = wave_sum(tot * tot); if ((tid & 63) == 0) red[r * 8 + wv] = ss;
            }
        }
        if (DIR == 1) {
            __syncthreads();
#pragma unroll 1
            for (int r = 0; r < 16; ++r) {
                const float ms = (red[r * 8 + hh * 2] + red[r * 8 + hh * 2 + 1]) * (1.0f / 128.0f);
                const size_t gi = (size_t)(row0 + t0 + r) * 512 + hh * 128 + vc;
                const float gate = bf2f(GG[gi]);
                GG[gi] = f2bf(sv[r * 512 + tid] * rsqrtf(ms + RMS_EPS) * gn * siluf_(gate));
            }
        }
    }
    __syncthreads();
}
__device__ __forceinline__ void gla_naive_batch(const Params& p, int l, int b, float* lds) {
    gla_naive_dir<0>(p, l, b, lds);
    gla_naive_dir<1>(p, l, b, lds);
}

__device__ __forceinline__ void diff_naive_tile(const Params& p, int l, int unit, float* lds) {
    const int tid = threadIdx.x, qi = tid & 127, c = (tid >> 7) & 1, hv = tid >> 8;
    const int qt = unit % 34, bh = unit / 34, hh = bh & 3, b = bh >> 2;
    const int nkeys = qt < 2 ? LC : LB;
    const size_t rowq = (size_t)b * LB + qt * 128 + qi;
    bf16_t* DQ = (bf16_t*)(p.ws + OFF_DQ); const bf16_t* DK = (const bf16_t*)(p.ws + OFF_DK); const bf16_t* DV = (const bf16_t*)(p.ws + OFF_DV);
    float q[64], o[64];
    { const bf16_t* qp = DQ + rowq * 512 + hh * 128 + c * 64;
#pragma unroll
      for (int d8 = 0; d8 < 8; ++d8) { const u32x4_t v = *(const u32x4_t*)(qp + d8 * 8);
#pragma unroll
          for (int j = 0; j < 4; ++j) { q[d8 * 8 + 2 * j] = bflo(v[j]); q[d8 * 8 + 2 * j + 1] = bfhi(v[j]); } } }
#pragma unroll
    for (int d = 0; d < 64; ++d) o[d] = 0.f;
    float m = -INFINITY, lsum = 0.f;
    float* kb = lds; float* vb = lds + 16 * 128;
    for (int k0 = 0; k0 < nkeys; k0 += 16) {
        __syncthreads();
        for (int i = tid; i < 16 * 128; i += 512) { const int r = i >> 7, j = i & 127; const size_t row = (size_t)b * LB + k0 + r;
            kb[i] = bf2f(DK[row * 512 + hh * 128 + j]); vb[i] = bf2f(DV[row * 512 + hh * 128 + j]); }
        __syncthreads();
        float s[16]; float mt = -INFINITY;
#pragma unroll
        for (int j = 0; j < 16; ++j) { const float* kp = kb + j * 128 + c * 64; float a = 0.f;
#pragma unroll
            for (int d = 0; d < 64; ++d) a += q[d] * kp[d];
            s[j] = a; mt = fmaxf(mt, a); }
        const float mn = fmaxf(m, mt), corr = __expf(m - mn);
        lsum *= corr;
#pragma unroll
        for (int d = 0; d < 64; ++d) o[d] *= corr;
#pragma unroll
        for (int j = 0; j < 16; ++j) { const float pj = __expf(s[j] - mn); lsum += pj; const float* vp = vb + j * 128 + hv * 64;
#pragma unroll
            for (int d = 0; d < 64; ++d) o[d] += pj * vp[d]; }
        m = mn;
    }
    __syncthreads();
    { const float inv = 1.f / lsum; float* cp = lds + ((size_t)qi * 2 + c) * 128 + hv * 64;
#pragma unroll
      for (int d = 0; d < 64; ++d) cp[d] = o[d] * inv; }
    __syncthreads();
    {
        float dq = 0.f, dk2 = 0.f; const float* lq = p.in[I_LQ] + l * 128; const float* lk = p.in[I_LK] + l * 128;
        for (int d = 0; d < 64; ++d) { dq += lq[d] * lk[d]; dk2 += lq[64 + d] * lk[64 + d]; }
        const float lam_init = 0.8f - 0.6f * expf(-0.3f * (float)l);
        const float lam = expf(dq) - expf(dk2) + lam_init;
        const int q2 = tid >> 2, part = tid & 3;
        const float* c0 = lds + ((size_t)q2 * 2) * 128 + part * 32; const float* c1 = c0 + 128;
        float v[32]; float ss = 0.f;
#pragma unroll
        for (int d = 0; d < 32; ++d) { v[d] = c0[d] - lam * c1[d]; ss += v[d] * v[d]; }
        ss += __shfl_xor(ss, 1); ss += __shfl_xor(ss, 2);
        const float sc = rsqrtf(ss * (1.0f / 128.0f) + RMS_EPS) * (1.0f - lam_init);
        const float* g = p.in[I_DNG] + l * 128 + part * 32;
        bf16_t* op = DQ + ((size_t)b * LB + qt * 128 + q2) * 512 + hh * 128 + part * 32;
#pragma unroll
        for (int d = 0; d < 32; d += 2) *(unsigned*)(op + d) = pk2(v[d] * sc * g[d], v[d + 1] * sc * g[d + 1]);
    }
    __syncthreads();
}

__device__ __forceinline__ void na_naive_unit(const Params& p, int l, int unit) {
    const int tid = threadIdx.x, h = tid >> 6, lane = tid & 63;
    const size_t row = (size_t)unit * 64 + lane; const int b = (int)(row / LB), t = (int)(row - (size_t)b * LB);
    bf16_t* NQ = (bf16_t*)(p.ws + OFF_NQ); const bf16_t* NK = (const bf16_t*)(p.ws + OFF_NK); const bf16_t* NV = (const bf16_t*)(p.ws + OFF_NV);
    const float* rpb = p.in[I_RPB] + ((size_t)l * 8 + h) * 15 * 31;
    float q[64], o[64];
    { const bf16_t* qp = NQ + row * 512 + h * 64;
#pragma unroll
      for (int d8 = 0; d8 < 8; ++d8) { const u32x4_t v = *(const u32x4_t*)(qp + d8 * 8);
#pragma unroll
          for (int j = 0; j < 4; ++j) { q[d8 * 8 + 2 * j] = bflo(v[j]); q[d8 * 8 + 2 * j + 1] = bfhi(v[j]); } } }
#pragma unroll
    for (int d = 0; d < 64; ++d) o[d] = 0.f;
    float m = -INFINITY, lsum = 0.f;
    const bool lat = t >= LC; const int tp = t - LC, r = tp >> 6, qc = tp & 63;
    const int rs = min(max(r - 4, 0), 56), cs = min(max(qc - 8, 0), 48);
    const int nloc = lat ? 128 : 0;
    for (int kk = 0; kk < nloc + LC; ++kk) {
        size_t krow; float bias = 0.f;
        if (kk < nloc) { const int kr = rs + (kk >> 4), kc = cs + (kk & 15); krow = (size_t)b * LB + LC + kr * 64 + kc; bias = rpb[(kr - r + 7) * 31 + (kc - qc + 15)]; }
        else krow = (size_t)b * LB + (kk - nloc);
        const bf16_t* kp = NK + krow * 512 + h * 64; const bf16_t* vp = NV + krow * 512 + h * 64;
        float s = bias;
#pragma unroll
        for (int d8 = 0; d8 < 8; ++d8) { const u32x4_t v = *(const u32x4_t*)(kp + d8 * 8);
#pragma unroll
            for (int j = 0; j < 4; ++j) { s += q[d8 * 8 + 2 * j] * bflo(v[j]); s += q[d8 * 8 + 2 * j + 1] * bfhi(v[j]); } }
        const float mn = fmaxf(m, s), corr = __expf(m - mn), pj = __expf(s - mn);
        lsum = lsum * corr + pj; m = mn;
#pragma unroll
        for (int d8 = 0; d8 < 8; ++d8) { const u32x4_t v = *(const u32x4_t*)(vp + d8 * 8);
#pragma unroll
            for (int j = 0; j < 4; ++j) { o[d8 * 8 + 2 * j] = o[d8 * 8 + 2 * j] * corr + pj * bflo(v[j]); o[d8 * 8 + 2 * j + 1] = o[d8 * 8 + 2 * j + 1] * corr + pj * bfhi(v[j]); } }
    }
    const float inv = 1.f / lsum;
    bf16_t* op = NQ + row * 512 + h * 64;
#pragma unroll
    for (int d8 = 0; d8 < 8; ++d8) { u32x4_t v;
#pragma unroll
        for (int j = 0; j < 4; ++j) v[j] = pk2(o[d8 * 8 + 2 * j] * inv, o[d8 * 8 + 2 * j + 1] * inv);
        *(u32x4_t*)(op + d8 * 8) = v; }
}

__device__ __forceinline__ void ln_row(float (&v)[16], const float* g, const float* bb, int lane) {
    float s = 0.f;
#pragma unroll
    for (int i = 0; i < 16; ++i) s += v[i];
    const float mu = wave_sum(s) * (1.0f / 1024.0f);
    float q = 0.f;
#pragma unroll
    for (int i = 0; i < 16; ++i) { v[i] -= mu; q += v[i] * v[i]; }
    const float rstd = rsqrtf(wave_sum(q) * (1.0f / 1024.0f) + LN_EPS);
#pragma unroll
    for (int i = 0; i < 4; ++i) { const f32x4 gv = *(const f32x4*)(g + i * 256 + lane * 4), bv = *(const f32x4*)(bb + i * 256 + lane * 4);
#pragma unroll
        for (int j = 0; j < 4; ++j) v[i * 4 + j] = v[i * 4 + j] * rstd * gv[j] + bv[j]; }
}

__device__ __forceinline__ void top2of4(const float s0, const float s1, const float s2, const float s3, int& i1, int& i2, float& sum) {
    i1 = 0; float m1 = s0;
    if (s1 > m1) { m1 = s1; i1 = 1; } if (s2 > m1) { m1 = s2; i1 = 2; } if (s3 > m1) { m1 = s3; i1 = 3; }
    float m2 = -INFINITY; i2 = 0;
    if (i1 != 0 && s0 > m2) { m2 = s0; i2 = 0; } if (i1 != 1 && s1 > m2) { m2 = s1; i2 = 1; }
    if (i1 != 2 && s2 > m2) { m2 = s2; i2 = 2; } if (i1 != 3 && s3 > m2) { m2 = s3; i2 = 3; }
    sum = m1 + m2;
}

__device__ __forceinline__ void phase_ln1_router(const Params& p, int l) {
    const int lane = threadIdx.x & 63, wv = threadIdx.x >> 6, wpb = blockDim.x >> 6;
    float* xs = (float*)(p.ws + OFF_XS); bf16_t* h = (bf16_t*)(p.ws + OFF_H); const float* mod = (const float*)(p.ws + OFF_MOD);
    int* tok = (int*)(p.ws + OFF_TOK); unsigned* cnt = (unsigned*)(p.ws + OFF_CNT) + l * 16;
    const float* g = p.in[I_LNG] + (size_t)(l * 2 + 0) * 1024; const float* bb = p.in[I_LNB] + (size_t)(l * 2 + 0) * 1024;
    const float* wr = p.in[I_WR]; const float* br = p.in[I_BR];
    for (int row = blockIdx.x * wpb + wv; row < T; row += gridDim.x * wpb) {
        const int slot = row_slot(row);
        const float* msh = mod + ((size_t)(l * 9 + slot) * 6 + 3) * 1024; const float* msc = msh + 1024;
        float v[16];
#pragma unroll
        for (int i = 0; i < 4; ++i) { const f32x4 t4 = *(const f32x4*)(xs + (size_t)row * 1024 + i * 256 + lane * 4);
#pragma unroll
            for (int j = 0; j < 4; ++j) v[i * 4 + j] = t4[j]; }
        ln_row(v, g, bb, lane);
        float lg[16];
#pragma unroll
        for (int e = 0; e < 16; ++e) lg[e] = 0.f;
#pragma unroll
        for (int i = 0; i < 4; ++i) {
            const int c0 = i * 256 + lane * 4;
            f32x4 x4; x4[0] = v[i * 4]; x4[1] = v[i * 4 + 1]; x4[2] = v[i * 4 + 2]; x4[3] = v[i * 4 + 3];
            *(f32x4*)(xs + (size_t)row * 1024 + c0) = x4;
            const f32x4 sh = *(const f32x4*)(msh + c0), sc = *(const f32x4*)(msc + c0);
            const f32x4 hv = x4 * (sc + 1.0f) + sh;
            u32x2_t o; o[0] = pk2(hv[0], hv[1]); o[1] = pk2(hv[2], hv[3]);
            *(u32x2_t*)(h + (size_t)row * 1024 + c0) = o;
#pragma unroll
            for (int j = 0; j < 4; ++j) { const float* wp = wr + (size_t)(c0 + j) * 16;
#pragma unroll
                for (int e4 = 0; e4 < 4; ++e4) { const f32x4 w4 = *(const f32x4*)(wp + e4 * 4);
#pragma unroll
                    for (int k = 0; k < 4; ++k) lg[e4 * 4 + k] += hv[j] * w4[k]; } }
        }
        float aff[16], sel[16];
#pragma unroll
        for (int e = 0; e < 16; ++e) { lg[e] = wave_sum(lg[e]); aff[e] = sigmoidf_(lg[e]); sel[e] = aff[e] + br[e]; }
        int bi1 = 0, bi2 = 0, bg = 0; float best = -INFINITY;
#pragma unroll
        for (int gq = 0; gq < 4; ++gq) { int i1, i2; float sm; top2of4(sel[gq * 4], sel[gq * 4 + 1], sel[gq * 4 + 2], sel[gq * 4 + 3], i1, i2, sm);
            if (sm > best) { best = sm; bg = gq; bi1 = i1; bi2 = i2; } }
        const int e1 = bg * 4 + bi1, e2 = bg * 4 + bi2;
        float a1 = 0.f, a2 = 0.f;
#pragma unroll
        for (int e = 0; e < 16; ++e) { a1 = (e == e1) ? aff[e] : a1; a2 = (e == e2) ? aff[e] : a2; }
        const float inv = 1.f / (a1 + a2);
        if (lane == 0) {
            const unsigned s1 = atomicAdd(cnt + e1, 1u), s2 = atomicAdd(cnt + e2, 1u);
            int* tp = tok + (size_t)row * 8;
            tp[0] = e1; tp[1] = e2; tp[2] = (int)s1; tp[3] = (int)s2; tp[4] = __float_as_int(a1 * inv); tp[5] = __float_as_int(a2 * inv);
        }
    }
}

__device__ __forceinline__ void phase_gather(const Params& p, int l) {
    const int lane = threadIdx.x & 63, wv = threadIdx.x >> 6, wpb = blockDim.x >> 6;
    const unsigned* cnt = (const unsigned*)(p.ws + OFF_CNT) + l * 16;
    int base[16]; { int s = 0;
#pragma unroll
        for (int e = 0; e < 16; ++e) { base[e] = s; s += (int)((cnt[e] + 255u) >> 8) * 256; } }
    const bf16_t* h = (const bf16_t*)(p.ws + OFF_H); bf16_t* xa = (bf16_t*)(p.ws + OFF_XA); int* tok = (int*)(p.ws + OFF_TOK);
    for (int row = blockIdx.x * wpb + wv; row < T; row += gridDim.x * wpb) {
        int* tp = tok + (size_t)row * 8;
        const int e1 = tp[0], e2 = tp[1], s1 = tp[2], s2 = tp[3];
        int b1 = 0, b2 = 0;
#pragma unroll
        for (int e = 0; e < 16; ++e) { b1 = (e == e1) ? base[e] : b1; b2 = (e == e2) ? base[e] : b2; }
        const int p1 = b1 + s1, p2 = b2 + s2;
        const u32x4_t v0 = *(const u32x4_t*)(h + (size_t)row * 1024 + lane * 8), v1 = *(const u32x4_t*)(h + (size_t)row * 1024 + 512 + lane * 8);
        *(u32x4_t*)(xa + (size_t)p1 * 1024 + lane * 8) = v0; *(u32x4_t*)(xa + (size_t)p1 * 1024 + 512 + lane * 8) = v1;
        *(u32x4_t*)(xa + (size_t)p2 * 1024 + lane * 8) = v0; *(u32x4_t*)(xa + (size_t)p2 * 1024 + 512 + lane * 8) = v1;
        if (lane == 0) { tp[6] = p1; tp[7] = p2; }
    }
}

__device__ __forceinline__ void phase_ln2(const Params& p, int l) {
    const int lane = threadIdx.x & 63, wv = threadIdx.x >> 6, wpb = blockDim.x >> 6;
    float* xs = (float*)(p.ws + OFF_XS); bf16_t* h = (bf16_t*)(p.ws + OFF_H); const float* mod = (const float*)(p.ws + OFF_MOD);
    const int* tok = (const int*)(p.ws + OFF_TOK); const bf16_t* y = (const bf16_t*)(p.ws + OFF_Y);
    const float* g = p.in[I_LNG] + (size_t)(l * 2 + 1) * 1024; const float* bb = p.in[I_LNB] + (size_t)(l * 2 + 1) * 1024;
    for (int row = blockIdx.x * wpb + wv; row < T; row += gridDim.x * wpb) {
        const int slot = row_slot(row);
        const int* tp = tok + (size_t)row * 8;
        const float w0 = __int_as_float(tp[4]), w1 = __int_as_float(tp[5]); const size_t p0 = (size_t)tp[6], p1 = (size_t)tp[7];
        const float* mg = mod + ((size_t)(l * 9 + slot) * 6 + 5) * 1024;
        float v[16];
#pragma unroll
        for (int i = 0; i < 4; ++i) { const int c0 = i * 256 + lane * 4;
            const f32x4 x4 = *(const f32x4*)(xs + (size_t)row * 1024 + c0), g4 = *(const f32x4*)(mg + c0);
            const u32x2_t ya = *(const u32x2_t*)(y + p0 * 1024 + c0), yb = *(const u32x2_t*)(y + p1 * 1024 + c0);
            v[i * 4 + 0] = ALPHA * x4[0] + g4[0] * (w0 * bflo(ya[0]) + w1 * bflo(yb[0]));
            v[i * 4 + 1] = ALPHA * x4[1] + g4[1] * (w0 * bfhi(ya[0]) + w1 * bfhi(yb[0]));
            v[i * 4 + 2] = ALPHA * x4[2] + g4[2] * (w0 * bflo(ya[1]) + w1 * bflo(yb[1]));
            v[i * 4 + 3] = ALPHA * x4[3] + g4[3] * (w0 * bfhi(ya[1]) + w1 * bfhi(yb[1])); }
        ln_row(v, g, bb, lane);
        const int b = row / LB, t = row - b * LB;
        if (l == DEPTH - 1) {
            if (t >= LC) { float* op = p.out + ((size_t)b * LL + (t - LC)) * 1024;
#pragma unroll
                for (int i = 0; i < 4; ++i) { f32x4 x4; x4[0] = v[i * 4]; x4[1] = v[i * 4 + 1]; x4[2] = v[i * 4 + 2]; x4[3] = v[i * 4 + 3]; *(f32x4*)(op + i * 256 + lane * 4) = x4; } }
        } else {
            const float* msh = mod + ((size_t)((l + 1) * 9 + slot) * 6 + 0) * 1024; const float* msc = msh + 1024;
#pragma unroll
            for (int i = 0; i < 4; ++i) { const int c0 = i * 256 + lane * 4;
                f32x4 x4; x4[0] = v[i * 4]; x4[1] = v[i * 4 + 1]; x4[2] = v[i * 4 + 2]; x4[3] = v[i * 4 + 3];
                *(f32x4*)(xs + (size_t)row * 1024 + c0) = x4;
                const f32x4 sh = *(const f32x4*)(msh + c0), sc = *(const f32x4*)(msc + c0);
                const f32x4 hv = x4 * (sc + 1.0f) + sh;
                u32x2_t o; o[0] = pk2(hv[0], hv[1]); o[1] = pk2(hv[2], hv[3]);
                *(u32x2_t*)(h + (size_t)row * 1024 + c0) = o; }
        }
    }
}

enum { PH_MOD = 0, PH_INIT, PH_CONVERT, PH_INPROJ, PH_ROPEDEC, PH_MIX_GLA, PH_MIX_DIFF, PH_MIX_NA, PH_GATES, PH_MERGE, PH_WO, PH_LN1, PH_GATHER, PH_UP, PH_DOWN, PH_LN2, PH_COUNT };

template <class Epi, class Sched>
__device__ __forceinline__ void run_gemm(PG8_LAS unsigned char* lds, const void* A, const void* Bt, int K, const Sched& S, const Epi& E) {
    pg8::Gemm g; g.A = (const pg8::bf16_t*)A; g.Bt = (const pg8::bf16_t*)Bt; g.M = 0; g.N = 0; g.K = K;
    pg8::gemm_phase<Epi, Sched, false>(lds, g, S, E, nullptr);
}

template <int PH>
__device__ __forceinline__ void run_phase(const Params& p, int l, unsigned char* shm) {
    PG8_LAS unsigned char* lds = (PG8_LAS unsigned char*)shm;
    float* ldsf = (float*)shm;
    const int G = gridDim.x, c = blockIdx.x;
    if constexpr (PH == PH_MOD) phase_mod(p, ldsf);
    else if constexpr (PH == PH_INIT) phase_init(p);
    else if constexpr (PH == PH_CONVERT) phase_convert(p, l, ldsf);
    else if constexpr (PH == PH_INPROJ) { SchedGrid S{NPANEL, 19, 0, G, c}; EpiInProj E{p.ws}; run_gemm(lds, p.ws + OFF_H, p.ws + OFF_WIN, 1024, S, E); }
    else if constexpr (PH == PH_ROPEDEC) phase_rope_decay(p, l);
    else if constexpr (PH == PH_MIX_GLA) { for (int u = blockIdx.x; u < NB; u += gridDim.x) gla_naive_batch(p, l, u, ldsf); }
    else if constexpr (PH == PH_MIX_DIFF) { for (int u = blockIdx.x; u < NB * 4 * 34; u += gridDim.x) diff_naive_tile(p, l, u, ldsf); }
    else if constexpr (PH == PH_MIX_NA) { for (int u = blockIdx.x; u < T / 64; u += gridDim.x) na_naive_unit(p, l, u); }
    else if constexpr (PH == PH_GATES) { SchedGrid S{NPANEL, 12, 19, G, c}; EpiGates E{p.ws}; run_gemm(lds, p.ws + OFF_H, p.ws + OFF_WIN, 1024, S, E); }
    else if constexpr (PH == PH_MERGE) { SchedMerge S{G, c}; EpiMerge E{p.ws}; run_gemm(lds, p.ws + OFF_BR, p.ws + OFF_WB, 512, S, E); }
    else if constexpr (PH == PH_WO) { SchedGrid S{NPANEL, 4, 0, G, c}; EpiWo E{p.ws, l}; run_gemm(lds, p.ws + OFF_H, p.ws + OFF_WO, 1024, S, E); }
    else if constexpr (PH == PH_LN1) phase_ln1_router(p, l);
    else if constexpr (PH == PH_GATHER) phase_gather(p, l);
    else if constexpr (PH == PH_UP) { SchedMoe S; S.init((const unsigned*)(p.ws + OFF_CNT) + l * 16, G, c); EpiUp E{p.ws}; run_gemm(lds, p.ws + OFF_XA, p.ws + OFF_WUP, 1024, S, E); }
    else if constexpr (PH == PH_DOWN) { SchedMoe S; S.init((const unsigned*)(p.ws + OFF_CNT) + l * 16, G, c); EpiDown E{p.ws}; run_gemm(lds, p.ws + OFF_ACT, p.ws + OFF_WDN, 512, S, E); }
    else if constexpr (PH == PH_LN2) phase_ln2(p, l);
}

#if !MEGA
template <int PH>
__global__ void __launch_bounds__(512, 2) k_phase(Params p, int l) {
    extern __shared__ __attribute__((aligned(16))) unsigned char shm[];
    run_phase<PH>(p, l, shm);
}
template <int PH> static void launch_phase(const Params& p, int l, hipStream_t st) {
    static bool attr = false;
    if (!attr) { (void)hipFuncSetAttribute((const void*)k_phase<PH>, hipFuncAttributeMaxDynamicSharedMemorySize, LDS_BYTES); attr = true; }
    hipLaunchKernelGGL((k_phase<PH>), dim3(256), dim3(512), LDS_BYTES, st, p, l);
}
#else
__global__ void __launch_bounds__(512, 2) k_mega(Params p) {
    extern __shared__ __attribute__((aligned(16))) unsigned char shm[];
    volatile LAS unsigned* xbw = (volatile LAS unsigned*)(shm + LDS_STAGE);
    if (threadIdx.x == 0) { xbw[0] = 0u; xbw[1] = 0u; xbw[2] = 0u; xbw[3] = 0u; }
    __syncthreads();
    XcdBarrier bar = xcd_barrier_post((unsigned*)(p.ws + OFF_BAR), xbw);
    run_phase<PH_MOD>(p, 0, shm);
    run_phase<PH_CONVERT>(p, 0, shm);
    xcd_barrier(bar);
    run_phase<PH_INIT>(p, 0, shm);
    xcd_barrier(bar);
    for (int l = 0; l < DEPTH; ++l) {
        if (l > 0) { run_phase<PH_CONVERT>(p, l, shm); xcd_barrier(bar); }
        run_phase<PH_INPROJ>(p, l, shm); xcd_barrier(bar);
        run_phase<PH_ROPEDEC>(p, l, shm); xcd_barrier(bar);
        run_phase<PH_MIX_GLA>(p, l, shm); run_phase<PH_MIX_DIFF>(p, l, shm); run_phase<PH_MIX_NA>(p, l, shm); xcd_barrier(bar);
        run_phase<PH_GATES>(p, l, shm); xcd_barrier(bar);
        run_phase<PH_MERGE>(p, l, shm); xcd_barrier(bar);
        run_phase<PH_WO>(p, l, shm); xcd_barrier(bar);
        run_phase<PH_LN1>(p, l, shm); xcd_barrier(bar);
        run_phase<PH_GATHER>(p, l, shm); xcd_barrier(bar);
        run_phase<PH_UP>(p, l, shm); xcd_barrier(bar);
        run_phase<PH_DOWN>(p, l, shm); xcd_barrier(bar);
        run_phase<PH_LN2>(p, l, shm); xcd_barrier(bar);
    }
}
#endif

extern "C" void kernel_launch(void* const* d_in, const int* in_sizes, int n_in, void* d_out, int out_size, void* d_ws, size_t ws_size, hipStream_t stream) {
    (void)in_sizes; (void)n_in; (void)out_size;
    if (ws_size < WS_NEED) { fprintf(stderr, "workspace too small: %zu < %zu\n", ws_size, (size_t)WS_NEED); return; }
    Params p{};
    for (int i = 0; i < 23; ++i) p.in[i] = (const float*)d_in[i];
    p.out = (float*)d_out; p.ws = (char*)d_ws;
    (void)hipMemsetAsync(d_ws, 0, ZERO_BYTES, stream);
#if !MEGA
    launch_phase<PH_MOD>(p, 0, stream);
    launch_phase<PH_INIT>(p, 0, stream);
    for (int l = 0; l < DEPTH; ++l) {
        launch_phase<PH_CONVERT>(p, l, stream);
        launch_phase<PH_INPROJ>(p, l, stream);
        launch_phase<PH_ROPEDEC>(p, l, stream);
        launch_phase<PH_MIX_GLA>(p, l, stream);
        launch_phase<PH_MIX_DIFF>(p, l, stream);
        launch_phase<PH_MIX_NA>(p, l, stream);
        launch_phase<PH_GATES>(p, l, stream);
        launch_phase<PH_MERGE>(p, l, stream);
        launch_phase<PH_WO>(p, l, stream);
        launch_phase<PH_LN1>(p, l, stream);
        launch_phase<PH_GATHER>(p, l, stream);
        launch_phase<PH_UP>(p, l, stream);
        launch_phase<PH_DOWN>(p, l, stream);
        launch_phase<PH_LN2>(p, l, stream);
    }
#else
    static bool attr = false;
    if (!attr) { (void)hipFuncSetAttribute((const void*)k_mega, hipFuncAttributeMaxDynamicSharedMemorySize, LDS_BYTES); attr = true; }
    hipLaunchKernelGGL(k_mega, dim3(256), dim3(512), LDS_BYTES, stream, p);
#endif
}
```

```cpp
#define MEGA 1
#include <hip/hip_runtime.h>
#include <stdint.h>
#include <stdio.h>

#ifndef MEGA
#define MEGA 0
#endif

constexpr int NB = 8, LL = 4096, LC = 256, LB = LL + LC  , T = NB * LB  , D = 1024, DEPTH = 4;
constexpr int NPANEL = T / 256;
constexpr int PB = LB / 256;
constexpr int PAIR_ROWS = 2 * T + 16 * 256;
constexpr float ALPHA = 1.681792830507429f;
constexpr float LN_EPS = 1e-5f, RMS_EPS = 1e-6f;

constexpr size_t AL256(size_t x) { return (x + 255) & ~(size_t)255; }
constexpr size_t OFF_BAR = 0;
constexpr size_t OFF_CNT = 16384;
constexpr size_t ZERO_BYTES = 32768;
constexpr size_t OFF_MOD = ZERO_BYTES;
constexpr size_t OFF_ROPE = AL256(OFF_MOD + (size_t)DEPTH * 9 * 6144 * 4);
constexpr size_t OFF_TOK = AL256(OFF_ROPE + (size_t)4096 * 32 * 2 * 4);
constexpr size_t OFF_GR = AL256(OFF_TOK + (size_t)T * 8 * 4);
constexpr size_t OFF_XS = AL256(OFF_GR + (size_t)T * 32 * 4);
constexpr size_t OFF_H = AL256(OFF_XS + (size_t)T * D * 4);
constexpr size_t OFF_W = AL256(OFF_H + (size_t)T * D * 2);
constexpr size_t W_IN_ROWS = 4864 + 3072;
constexpr size_t OFF_WIN = OFF_W;
constexpr size_t OFF_WB = OFF_WIN + W_IN_ROWS * 1024 * 2;
constexpr size_t OFF_WO = OFF_WB + (size_t)3 * 1024 * 512 * 2;
constexpr size_t OFF_WUP = OFF_WO + (size_t)1024 * 1024 * 2;
constexpr size_t OFF_WDN = OFF_WUP + (size_t)16 * 1024 * 1024 * 2;
constexpr size_t OFF_P = AL256(OFF_WDN + (size_t)16 * 1024 * 512 * 2);
constexpr size_t PCOL = (size_t)T * 2;
constexpr size_t OFF_GQ = OFF_P, OFF_GK = OFF_P + 256 * PCOL, OFF_GV = OFF_P + 512 * PCOL;
constexpr size_t OFF_DK = OFF_P + 1024 * PCOL, OFF_DV = OFF_P + 1536 * PCOL;
constexpr size_t OFF_NK = OFF_P + 2048 * PCOL, OFF_NV = OFF_P + 2560 * PCOL;
constexpr size_t OFF_BR = OFF_P + 3072 * PCOL;
constexpr size_t OFF_GG = OFF_BR, OFF_DQ = OFF_BR + 512 * PCOL, OFF_NQ = OFF_BR + 1024 * PCOL;
constexpr size_t OFF_GATE = OFF_P;
constexpr size_t OFF_S1 = AL256(OFF_P + 4608 * PCOL);
constexpr size_t OFF_S2 = AL256(OFF_S1 + (size_t)T * 512 * 4);
constexpr size_t OFF_END1 = AL256(OFF_S2 + (size_t)T * 512 * 4);
constexpr size_t OFF_XA = OFF_P;
constexpr size_t OFF_ACT = AL256(OFF_XA + (size_t)PAIR_ROWS * 1024 * 2);
constexpr size_t OFF_Y = AL256(OFF_ACT + (size_t)PAIR_ROWS * 512 * 2);
constexpr size_t OFF_END2 = AL256(OFF_Y + (size_t)PAIR_ROWS * 1024 * 2);
constexpr size_t WS_NEED = OFF_END1 > OFF_END2 ? OFF_END1 : OFF_END2;
static_assert(WS_NEED < (size_t)800 * 1000 * 1000, "workspace budget");

constexpr int LDS_STAGE = 131072;
constexpr int LDS_BYTES = LDS_STAGE + 256;

typedef unsigned short bf16_t;

struct Params {
    const float* in[23];
    float* out;
    char* ws;
};
enum { I_X = 0, I_C, I_CTX, I_CCTX, I_WADA, I_BADA, I_WIN, I_GWD, I_GBD, I_GNG, I_LQ, I_LK, I_DNG, I_RPB, I_WBR, I_WO, I_LNG, I_LNB, I_WR, I_BR, I_WEG, I_WEU, I_WED };

__device__ __forceinline__ float bf2f(bf16_t v) { return __uint_as_float(((unsigned)v) << 16); }
__device__ __forceinline__ float bflo(unsigned u) { return __uint_as_float(u << 16); }
__device__ __forceinline__ float bfhi(unsigned u) { return __uint_as_float(u & 0xffff0000u); }
__device__ __forceinline__ unsigned pk2(float lo, float hi) { unsigned r; asm volatile("v_cvt_pk_bf16_f32 %0, %1, %2" : "=v"(r) : "v"(lo), "v"(hi)); return r; }
__device__ __forceinline__ bf16_t f2bf(float f) { return (bf16_t)(pk2(f, 0.f) & 0xffffu); }
__device__ __forceinline__ float wave_sum(float v) {
#pragma unroll
    for (int o = 32; o >= 1; o >>= 1) v += __shfl_xor(v, o);
    return v;
}
__device__ __forceinline__ float sigmoidf_(float x) { return 1.f / (1.f + __expf(-x)); }
__device__ __forceinline__ float siluf_(float x) { return x / (1.f + __expf(-x)); }
__device__ __forceinline__ int row_slot(int row) { const int b = row / LB, t = row - b * LB; return t < LC ? 8 : b; }
__device__ __forceinline__ int ltid() { int t = threadIdx.x; asm volatile("" : "+v"(t)); return t; }
#include <hip/hip_runtime.h>
namespace pg8 {
#define PG8_LAS __attribute__((address_space(3)))
typedef unsigned short bf16_t;
typedef short bf16x8 __attribute__((ext_vector_type(8)));
typedef float f32x4 __attribute__((ext_vector_type(4)));
typedef unsigned u32x4 __attribute__((ext_vector_type(4)));
constexpr int BM = 256, BK = 64, HALF = 128, HTB = HALF * BK * 2  , STAGE_BYTES = 8 * HTB, NXCD = 8, WGM = 8;

__host__ __device__ __forceinline__ int lds_byte(int r, int c) { const int st = (r >> 4) * 2 + (c >> 5), rr = r & 15, cc = c & 31, ob = rr * 64 + cc * 2; return st * 1024 + (ob ^ (((ob >> 9) & 1) << 5)); }
__host__ __device__ __forceinline__ void stage_rc(int b, int& R, int& C) { const int st = b / 1024, sb = b % 1024, swz = sb ^ (((sb >> 9) & 1) << 5); R = (st >> 1) * 16 + swz / 64; C = (st & 1) * 32 + (swz % 64) / 2; }
__host__ __device__ __forceinline__ int perm32(int rho) { const int n = rho >> 4, i = rho & 15; return 8 * (i >> 2) + 4 * n + (i & 3); }

struct Unit { int pm, pn; };
struct Gemm { const bf16_t* A; const bf16_t* Bt; int M, N, K; };
__device__ __forceinline__ unsigned cvt_pk_bf16(float lo, float hi) { unsigned r; asm volatile("v_cvt_pk_bf16_f32 %0, %1, %2" : "=v"(r) : "v"(lo), "v"(hi)); return r; }

template <class Epi, class Sched, bool STAMP = false>
__device__ __forceinline__ void gemm_phase(PG8_LAS unsigned char* lds, const Gemm g, const Sched& S, const Epi& E, unsigned long long* stamps) {
    int tid_l = threadIdx.x; asm volatile("" : "+v"(tid_l));
    const int tid = tid_l, wid = __builtin_amdgcn_readfirstlane(tid >> 6), lane = tid & 63, wr = wid >> 2, wc = wid & 3, fr = lane & 15, fq = lane >> 4;
    const int K = g.K, nt = K / BK;
    int ts_lo = 0, ts_hi = 0, nts = 0; const unsigned long long rt_entry = STAMP ? (unsigned long long)wall_clock64() : 0ull;
#define PG8_STAMP() do { if (STAMP && wid == 0 && nts < 64) { const unsigned long long _c = (unsigned long long)clock64(); \
        ts_lo = (lane == nts) ? (int)(unsigned)_c : ts_lo; ts_hi = (lane == nts) ? (int)(unsigned)(_c >> 32) : ts_hi; ++nts; } } while (0)
    PG8_STAMP();
    unsigned voffA[2], voffB[2];
#pragma unroll
    for (int i = 0; i < 2; ++i) { int R, C; stage_rc(tid * 16 + i * 8192, R, C); const int Rb = Epi::PERM ? ((R & ~31) + perm32(R & 31)) : R;
        voffA[i] = (unsigned)(R * K + C) * 2u; voffB[i] = (unsigned)(Rb * K + C) * 2u; }
    const size_t kstep = (size_t)(BK * 2);
    const size_t hstep = (size_t)HALF * K * 2;
    const size_t tstep = 2 * hstep;
    const unsigned ldsw = (unsigned)wid * 1024u;
    const int aoff = lds_byte(wr * 64 + fr, fq * 8), boff = lds_byte(wc * 32 + fr, fq * 8);
#define PG8_SA(b, h) (((b) * 2 + (h)) * HTB)
#define PG8_SB(b, h) ((4 + (b) * 2 + (h)) * HTB)
#define PG8_STAGE(bufoff, gbase, voff) do { _Pragma("unroll") for (int _i = 0; _i < 2; ++_i) \
        __builtin_amdgcn_global_load_lds((const unsigned*)((const char*)(gbase) + (voff)[_i]), (PG8_LAS unsigned*)(lds + (bufoff) + ldsw + _i * 8192), 16, 0, 0); } while (0)
#define PG8_LDA(dst, b, h) do { _Pragma("unroll") for (int m = 0; m < 4; ++m) _Pragma("unroll") for (int k = 0; k < 2; ++k) dst[m][k] = *(const PG8_LAS bf16x8*)(lds + PG8_SA(b, h) + aoff + m * 2048 + k * 1024); } while (0)
#define PG8_LDB(dst, b, h) do { _Pragma("unroll") for (int n = 0; n < 2; ++n) _Pragma("unroll") for (int k = 0; k < 2; ++k) dst[n][k] = *(const PG8_LAS bf16x8*)(lds + PG8_SB(b, h) + boff + n * 2048 + k * 1024); } while (0)
#define PG8_MMA(ai, bj, At, Bt) do { __builtin_amdgcn_s_setprio(1); _Pragma("unroll") for (int m = 0; m < 4; ++m) _Pragma("unroll") for (int n = 0; n < 2; ++n) _Pragma("unroll") for (int k = 0; k < 2; ++k) \
        acc[ai][bj][m][n] = __builtin_amdgcn_mfma_f32_16x16x32_bf16(Bt[n][k], At[m][k], acc[ai][bj][m][n], 0, 0, 0); __builtin_amdgcn_s_setprio(0); } while (0)
#define PG8_WAIT_V(n) asm volatile("s_waitcnt vmcnt(" #n ")" ::: "memory")
#define PG8_WAIT_L(n) asm volatile("s_waitcnt lgkmcnt(" #n ")" ::: "memory")
#define PG8_BAR __builtin_amdgcn_s_barrier()
#define PG8_SCHED __builtin_amdgcn_sched_barrier(0)
    Unit cur, nxt; int ui = 0;
    if (!S.next(0, cur)) return;
    f32x4 acc[2][2][4][2];
#pragma unroll
    for (int a = 0; a < 2; ++a)
#pragma unroll
        for (int b = 0; b < 2; ++b)
#pragma unroll
            for (int m = 0; m < 4; ++m)
#pragma unroll
                for (int n = 0; n < 2; ++n) acc[a][b][m][n] = (f32x4){0.f, 0.f, 0.f, 0.f};
    bf16x8 At[4][2], B0[2][2], B1[2][2];
    const char* cA = (const char*)g.A + (size_t)cur.pm * tstep; const char* cB = (const char*)g.Bt + (size_t)cur.pn * tstep;
    S.a_ready(cur);
    PG8_STAGE(PG8_SB(0, 0), cB, voffB); PG8_STAGE(PG8_SA(0, 0), cA, voffA); PG8_STAGE(PG8_SB(0, 1), cB + hstep, voffB); PG8_STAGE(PG8_SA(0, 1), cA + hstep, voffA);
    if (wr == 1) PG8_BAR;
    PG8_WAIT_V(4); PG8_BAR;
    PG8_STAGE(PG8_SB(1, 0), cB + kstep, voffB); PG8_STAGE(PG8_SA(1, 0), cA + kstep, voffA); PG8_STAGE(PG8_SB(1, 1), cB + hstep + kstep, voffB);
    PG8_WAIT_V(6); PG8_BAR;
    PG8_STAMP();
    for (;;) {
        const bool has_next = S.next(ui + 1, nxt);
        const char* nA = has_next ? (const char*)g.A + (size_t)nxt.pm * tstep : cA; const char* nB = has_next ? (const char*)g.Bt + (size_t)nxt.pn * tstep : cB;
        for (int t = 0; t < nt; t += 2) {
            const bool last = (t == nt - 2);
            const char* a1 = cA + (size_t)(t + 1) * kstep;
            const char* a2 = last ? nA : cA + (size_t)(t + 2) * kstep; const char* b2 = last ? nB : cB + (size_t)(t + 2) * kstep;
            const char* a3 = a2 + kstep; const char* b3 = b2 + kstep;
            if (last && has_next) S.a_ready(nxt);
            PG8_LDB(B0, 0, 0); PG8_SCHED; PG8_LDA(At, 0, 0); PG8_STAGE(PG8_SA(1, 1), a1 + hstep, voffA);
            PG8_WAIT_L(8); PG8_BAR; PG8_WAIT_L(0); PG8_MMA(0, 0, At, B0); PG8_BAR; PG8_SCHED;
            PG8_LDB(B1, 0, 1); PG8_STAGE(PG8_SB(0, 0), b2, voffB);
            PG8_BAR; PG8_WAIT_L(0); PG8_MMA(0, 1, At, B1); PG8_BAR;
            PG8_LDA(At, 0, 1); PG8_STAGE(PG8_SA(0, 0), a2, voffA);
            PG8_BAR; PG8_WAIT_L(0); PG8_MMA(1, 0, At, B0); PG8_BAR; PG8_SCHED;
            PG8_STAGE(PG8_SB(0, 1), b2 + hstep, voffB);
            PG8_WAIT_V(6); PG8_BAR; PG8_MMA(1, 1, At, B1); PG8_BAR;
            PG8_LDB(B0, 1, 0); PG8_SCHED; PG8_LDA(At, 1, 0); PG8_STAGE(PG8_SA(0, 1), a2 + hstep, voffA);
            PG8_WAIT_L(8); PG8_BAR; PG8_WAIT_L(0); PG8_MMA(0, 0, At, B0); PG8_BAR; PG8_SCHED;
            PG8_LDB(B1, 1, 1); PG8_STAGE(PG8_SB(1, 0), b3, voffB);
            PG8_BAR; PG8_WAIT_L(0); PG8_MMA(0, 1, At, B1); PG8_BAR;
            PG8_LDA(At, 1, 1); PG8_STAGE(PG8_SA(1, 0), a3, voffA);
            PG8_BAR; PG8_WAIT_L(0); PG8_MMA(1, 0, At, B0); PG8_BAR; PG8_SCHED;
            PG8_STAGE(PG8_SB(1, 1), b3 + hstep, voffB);
            PG8_WAIT_V(6); PG8_BAR; PG8_MMA(1, 1, At, B1); PG8_BAR;
        }
        PG8_STAMP();
        if constexpr (!Epi::AFTER_DRAIN) { E(acc, cur, wr, wc, fr, fq); S.done(cur); }
        PG8_STAMP();
        if (!has_next) break;
#pragma unroll
        for (int a = 0; a < 2; ++a)
#pragma unroll
            for (int b = 0; b < 2; ++b)
#pragma unroll
                for (int m = 0; m < 4; ++m)
#pragma unroll
                    for (int n = 0; n < 2; ++n) acc[a][b][m][n] = (f32x4){0.f, 0.f, 0.f, 0.f};
        cur = nxt; cA = nA; cB = nB; ++ui;
    }
    PG8_WAIT_V(0);
    if (wr == 0) PG8_BAR;
    PG8_BAR;
    if constexpr (Epi::AFTER_DRAIN) { E.fused(acc, cur, wr, wc, fr, fq, lds, wid, lane); S.done(cur); }
    PG8_STAMP();
    if (STAMP && wid == 0) { stamps[lane] = lane < nts ? (((unsigned long long)(unsigned)ts_hi << 32) | (unsigned)ts_lo) : 0ull;
        if (lane == 62) stamps[62] = rt_entry; if (lane == 63) stamps[63] = (unsigned long long)wall_clock64(); }
#undef PG8_STAMP
#undef PG8_SA
#undef PG8_SB
#undef PG8_STAGE
#undef PG8_LDA
#undef PG8_LDB
#undef PG8_MMA
#undef PG8_WAIT_V
#undef PG8_WAIT_L
#undef PG8_BAR
#undef PG8_SCHED
}
}
#define XB_TMO      128
#define XB_XCNT(j)  (256  + 64 * (j))
#define XB_XSUB(j)  (1280 + 64 * (j))
#define XB_XGEN(j)  (2304 + 64 * (j))
#define XB_TOP      3328
#define XB_TOPGEN   3392
#define XCD_BAR_WORDS 3456
#define XB_SPIN_CAP (1u << 18)
#define LAS __attribute__((address_space(3)))

__device__ __forceinline__ unsigned xb_ld(unsigned* p)              { return __hip_atomic_load(p, __ATOMIC_RELAXED, __HIP_MEMORY_SCOPE_AGENT); }
__device__ __forceinline__ unsigned xb_add(unsigned* p, unsigned v) { return __hip_atomic_fetch_add(p, v, __ATOMIC_RELAXED, __HIP_MEMORY_SCOPE_AGENT); }
__device__ __forceinline__ unsigned xb_xcc_id() { return (unsigned)__builtin_amdgcn_s_getreg((3 << 11) | 20) & 0xFu; }
#define XB_SPIN(cond, bar) do { unsigned _sp = 0; while (cond) { __builtin_amdgcn_s_sleep(1); \
    if ((++_sp & 255u) == 0u) { if (xb_ld(&(bar)[XB_TMO])) break; if (_sp > XB_SPIN_CAP) { atomicAdd(&(bar)[XB_TMO], 1u); break; } } } } while (0)

struct XcdBarrier {
    unsigned* bar; unsigned x;
    volatile LAS unsigned* st;
};

__device__ __forceinline__ XcdBarrier xcd_barrier_post(unsigned* bar, volatile LAS unsigned* st) {
    XcdBarrier b; b.bar = bar; b.x = xb_xcc_id(); b.st = st;
    if (threadIdx.x == 0) (void)xb_add(&bar[XB_XCNT(b.x)], 1u);
    return b;
}
__device__ __forceinline__ void xcd_barrier_complete(unsigned* bar, unsigned x, unsigned& nloc, unsigned& nx) {
    const unsigned G = gridDim.x * gridDim.y * gridDim.z;
    unsigned sum, cnt, mine, sp = 0u;
    for (;;) {
        sum = 0u; cnt = 0u; mine = 0u;
#pragma unroll
        for (unsigned j = 0; j < 16; ++j) { const unsigned c = xb_ld(&bar[XB_XCNT(j)]); sum += c; cnt += (c > 0u) ? 1u : 0u; mine = (j == x) ? c : mine; }
        if (sum == G) break;
        __builtin_amdgcn_s_sleep(1);
        if ((++sp & 255u) == 0u) { if (xb_ld(&bar[XB_TMO])) break; if (sp > XB_SPIN_CAP) { atomicAdd(&bar[XB_TMO], 1u); break; } }
    }
    nloc = mine > 0u ? mine : 1u; nx = cnt > 0u ? cnt : 1u;
}

__device__ __forceinline__ void xcd_barrier(const XcdBarrier& b) {
    asm volatile("s_waitcnt vmcnt(0)" ::: "memory");
    __syncthreads();
    if (threadIdx.x == 0) {
        unsigned* bar = b.bar;
        __builtin_amdgcn_s_waitcnt(0);
        unsigned nloc = b.st[0], nx = b.st[1];
        if (nloc == 0u) { xcd_barrier_complete(bar, b.x, nloc, nx); b.st[0] = nloc; b.st[1] = nx; }
        const unsigned old = xb_add(&bar[XB_XSUB(b.x)], 1u);
        const unsigned gen = old / nloc;
        if (old + 1u == (gen + 1u) * nloc) {
            __builtin_amdgcn_fence(__ATOMIC_RELEASE, "agent");
            asm volatile("s_waitcnt vmcnt(0)" ::: "memory");
            const unsigned og = xb_add(&bar[XB_TOP], 1u);
            const unsigned tg = og / nx;
            if (og + 1u == (tg + 1u) * nx) xb_add(&bar[XB_TOPGEN], 1u);
            else XB_SPIN(xb_ld(&bar[XB_TOPGEN]) == tg, bar);
            __builtin_amdgcn_fence(__ATOMIC_ACQUIRE, "agent");
            xb_add(&bar[XB_XGEN(b.x)], 1u);
            asm volatile("s_waitcnt vmcnt(0)" ::: "memory");
        } else {
            XB_SPIN(xb_ld(&bar[XB_XGEN(b.x)]) == gen, bar);
            __builtin_amdgcn_fence(__ATOMIC_ACQUIRE, "agent");
            asm volatile("s_waitcnt vmcnt(0)" ::: "memory");
        }
    }
    __syncthreads();
}

using pg8::f32x4;
using pg8::Unit;
typedef unsigned u32x4_t __attribute__((ext_vector_type(4)));
typedef unsigned u32x2_t __attribute__((ext_vector_type(2)));

struct SchedGrid {
    int nM, nN, pn0, G, c;
    __device__ __forceinline__ bool next(int i, Unit& u) const {
        const int L = i * G + c; if (L >= nM * nN) return false;
        u.pm = L / nN; u.pn = pn0 + (L - u.pm * nN); return true;
    }
    __device__ __forceinline__ void a_ready(const Unit&) const {}
    __device__ __forceinline__ void done(const Unit&) const {}
};
struct SchedMerge {
    int G, c;
    __device__ __forceinline__ bool next(int i, Unit& u) const {
        const int i3 = i / 3, n = i - i3 * 3, ti = i3 * G + c; if (ti >= NPANEL * 4) return false;
        u.pm = n * NPANEL + (ti >> 2); u.pn = n * 4 + (ti & 3); return true;
    }
    __device__ __forceinline__ void a_ready(const Unit&) const {}
    __device__ __forceinline__ void done(const Unit&) const {}
};
struct SchedMoe {
    int cum[17]; int G, c;
    __device__ __forceinline__ void init(const unsigned* cnt, int G_, int c_) {
        G = G_; c = c_; int s = 0;
#pragma unroll
        for (int e = 0; e < 16; ++e) { cum[e] = s; const unsigned n = __builtin_amdgcn_readfirstlane(cnt[e]); s += (int)((n + 255u) >> 8); }
        cum[16] = s;
    }
    __device__ __forceinline__ bool next(int i, Unit& u) const {
        const int L = i * G + c; if (L >= cum[16] * 4) return false;
        const int rt = L >> 2; int e = 0;
#pragma unroll
        for (int j = 1; j < 16; ++j) e += (rt >= cum[j]) ? 1 : 0;
        u.pm = rt; u.pn = e * 4 + (L & 3); return true;
    }
    __device__ __forceinline__ void a_ready(const Unit&) const {}
    __device__ __forceinline__ void done(const Unit&) const {}
};

__device__ __forceinline__ u32x4_t pack8(const f32x4& a, const f32x4& b) {
    u32x4_t r; r[0] = pk2(a[0], a[1]); r[1] = pk2(a[2], a[3]); r[2] = pk2(b[0], b[1]); r[3] = pk2(b[2], b[3]); return r;
}
struct EpiInProj {
    static constexpr bool PERM = true, AFTER_DRAIN = false;
    char* ws;
    __device__ __forceinline__ void operator()(const f32x4 (&acc)[2][2][4][2], const Unit& u, int wr, int wc, int fr, int fq) const {
        const int pn = u.pn; const int row0 = u.pm * 256 + wr * 64 + fr;
        if (pn == 6) {
            if (wc == 0) { float* gr = (float*)(ws + OFF_GR);
#pragma unroll
                for (int ai = 0; ai < 2; ++ai)
#pragma unroll
                    for (int m = 0; m < 4; ++m) { float* rp = gr + (size_t)(row0 + ai * 128 + m * 16) * 32 + 8 * fq;
                        *(f32x4*)(rp) = acc[ai][0][m][0]; *(f32x4*)(rp + 4) = acc[ai][0][m][1]; } }
            return;
        }
        size_t off; int ld, col0;
        if (pn == 0) { off = OFF_GQ; ld = 256; col0 = 0; }
        else if (pn == 1) { off = OFF_GK; ld = 256; col0 = 0; }
        else if (pn < 4) { off = OFF_GV; ld = 512; col0 = (pn - 2) * 256; }
        else if (pn < 6) { off = OFF_GG; ld = 512; col0 = (pn - 4) * 256; }
        else if (pn < 9) { off = OFF_DQ; ld = 512; col0 = (pn - 7) * 256; }
        else if (pn < 11) { off = OFF_DK; ld = 512; col0 = (pn - 9) * 256; }
        else if (pn < 13) { off = OFF_DV; ld = 512; col0 = (pn - 11) * 256; }
        else if (pn < 15) { off = OFF_NQ; ld = 512; col0 = (pn - 13) * 256; }
        else if (pn < 17) { off = OFF_NK; ld = 512; col0 = (pn - 15) * 256; }
        else { off = OFF_NV; ld = 512; col0 = (pn - 17) * 256; }
        bf16_t* base = (bf16_t*)(ws + off) + col0 + wc * 32 + 8 * fq;
#pragma unroll
        for (int ai = 0; ai < 2; ++ai)
#pragma unroll
            for (int m = 0; m < 4; ++m) { bf16_t* rp = base + (size_t)(row0 + ai * 128 + m * 16) * ld;
#pragma unroll
                for (int bj = 0; bj < 2; ++bj) *(u32x4_t*)(rp + bj * 128) = pack8(acc[ai][bj][m][0], acc[ai][bj][m][1]); }
    }
};
struct EpiGates {
    static constexpr bool PERM = true, AFTER_DRAIN = false;
    char* ws;
    __device__ __forceinline__ void operator()(const f32x4 (&acc)[2][2][4][2], const Unit& u, int wr, int wc, int fr, int fq) const {
        const int pl = u.pn - 19, n = pl >> 2, col0 = (pl & 3) * 256; const int row0 = u.pm * 256 + wr * 64 + fr;
        bf16_t* base = (bf16_t*)(ws + OFF_GATE) + (size_t)n * T * 1024 + col0 + wc * 32 + 8 * fq;
#pragma unroll
        for (int ai = 0; ai < 2; ++ai)
#pragma unroll
            for (int m = 0; m < 4; ++m) { bf16_t* rp = base + (size_t)(row0 + ai * 128 + m * 16) * 1024;
#pragma unroll
                for (int bj = 0; bj < 2; ++bj) { f32x4 a = acc[ai][bj][m][0], b = acc[ai][bj][m][1];
#pragma unroll
                    for (int j = 0; j < 4; ++j) { a[j] = sigmoidf_(a[j]); b[j] = sigmoidf_(b[j]); }
                    *(u32x4_t*)(rp + bj * 128) = pack8(a, b); } }
    }
};
struct EpiMerge {
    static constexpr bool PERM = true, AFTER_DRAIN = false;
    char* ws;
    __device__ __forceinline__ void operator()(const f32x4 (&acc)[2][2][4][2], const Unit& u, int wr, int wc, int fr, int fq) const {
        const int n = u.pm / NPANEL, pm = u.pm - n * NPANEL, pn = u.pn & 3; const int row0 = pm * 256 + wr * 64 + fr;
        const size_t cb = (size_t)pn * 256 + wc * 32 + 8 * fq;
        const bf16_t* gbase = (const bf16_t*)(ws + OFF_GATE) + (size_t)n * T * 1024 + cb;
        bf16_t* obase = (bf16_t*)(ws + OFF_H) + cb;
#pragma unroll
        for (int ai = 0; ai < 2; ++ai)
#pragma unroll
            for (int m = 0; m < 4; ++m) { const size_t ro = (size_t)(row0 + ai * 128 + m * 16) * 1024;
#pragma unroll
                for (int bj = 0; bj < 2; ++bj) {
                    const u32x4_t g = *(const u32x4_t*)(gbase + ro + bj * 128);
                    f32x4 a = acc[ai][bj][m][0], b = acc[ai][bj][m][1];
                    a[0] *= bflo(g[0]); a[1] *= bfhi(g[0]); a[2] *= bflo(g[1]); a[3] *= bfhi(g[1]);
                    b[0] *= bflo(g[2]); b[1] *= bfhi(g[2]); b[2] *= bflo(g[3]); b[3] *= bfhi(g[3]);
                    if (n > 0) { const u32x4_t o = *(const u32x4_t*)(obase + ro + bj * 128);
                        a[0] += bflo(o[0]); a[1] += bfhi(o[0]); a[2] += bflo(o[1]); a[3] += bfhi(o[1]);
                        b[0] += bflo(o[2]); b[1] += bfhi(o[2]); b[2] += bflo(o[3]); b[3] += bfhi(o[3]); }
                    *(u32x4_t*)(obase + ro + bj * 128) = pack8(a, b); } }
    }
};
struct EpiWo {
    static constexpr bool PERM = false, AFTER_DRAIN = false;
    char* ws; int layer;
    __device__ __forceinline__ void operator()(const f32x4 (&acc)[2][2][4][2], const Unit& u, int wr, int wc, int fr, int fq) const {
        const int b = u.pm / PB, slot = (u.pm - b * PB) == 0 ? 8 : b;
        const int row0 = u.pm * 256 + wr * 64 + fr, col0 = u.pn * 256 + wc * 32 + 4 * fq;
        const float* mg = (const float*)(ws + OFF_MOD) + ((size_t)(layer * 9 + slot) * 6 + 2) * 1024 + col0;
        float* xs = (float*)(ws + OFF_XS) + col0;
        f32x4 g[2][2];
#pragma unroll
        for (int bj = 0; bj < 2; ++bj)
#pragma unroll
            for (int n = 0; n < 2; ++n) g[bj][n] = *(const f32x4*)(mg + bj * 128 + n * 16);
#pragma unroll
        for (int ai = 0; ai < 2; ++ai)
#pragma unroll
            for (int m = 0; m < 4; ++m) { float* rp = xs + (size_t)(row0 + ai * 128 + m * 16) * 1024;
#pragma unroll
                for (int bj = 0; bj < 2; ++bj)
#pragma unroll
                    for (int n = 0; n < 2; ++n) { f32x4 x = *(const f32x4*)(rp + bj * 128 + n * 16);
                        *(f32x4*)(rp + bj * 128 + n * 16) = x * ALPHA + g[bj][n] * acc[ai][bj][m][n]; } }
    }
};
struct EpiUp {
    static constexpr bool PERM = true, AFTER_DRAIN = false;
    char* ws;
    __device__ __forceinline__ void operator()(const f32x4 (&acc)[2][2][4][2], const Unit& u, int wr, int wc, int fr, int fq) const {
        const int ct = u.pn & 3; const int row0 = u.pm * 256 + wr * 64 + fr;
        bf16_t* base = (bf16_t*)(ws + OFF_ACT) + ct * 128 + wc * 32 + 8 * fq;
#pragma unroll
        for (int ai = 0; ai < 2; ++ai)
#pragma unroll
            for (int m = 0; m < 4; ++m) { f32x4 a, b;
#pragma unroll
                for (int j = 0; j < 4; ++j) { a[j] = siluf_(acc[ai][0][m][0][j]) * acc[ai][1][m][0][j]; b[j] = siluf_(acc[ai][0][m][1][j]) * acc[ai][1][m][1][j]; }
                *(u32x4_t*)(base + (size_t)(row0 + ai * 128 + m * 16) * 512) = pack8(a, b); }
    }
};
struct EpiDown {
    static constexpr bool PERM = true, AFTER_DRAIN = false;
    char* ws;
    __device__ __forceinline__ void operator()(const f32x4 (&acc)[2][2][4][2], const Unit& u, int wr, int wc, int fr, int fq) const {
        const int ct = u.pn & 3; const int row0 = u.pm * 256 + wr * 64 + fr;
        bf16_t* base = (bf16_t*)(ws + OFF_Y) + ct * 256 + wc * 32 + 8 * fq;
#pragma unroll
        for (int ai = 0; ai < 2; ++ai)
#pragma unroll
            for (int m = 0; m < 4; ++m) { bf16_t* rp = base + (size_t)(row0 + ai * 128 + m * 16) * 1024;
#pragma unroll
                for (int bj = 0; bj < 2; ++bj) *(u32x4_t*)(rp + bj * 128) = pack8(acc[ai][bj][m][0], acc[ai][bj][m][1]); }
    }
};

#define GSTRIDE_BEGIN(var, n) for (long var = (long)blockIdx.x * blockDim.x + ltid(); var < (long)(n); var += (long)gridDim.x * blockDim.x)

__device__ __forceinline__ void phase_mod(const Params& p, float* lds) {
    const int tid = ltid();
    for (int i = tid; i < 9 * 1024; i += blockDim.x) { const int s = i >> 10, k = i & 1023; const float v = s < 8 ? p.in[I_C][s * 1024 + k] : p.in[I_CCTX][k]; lds[i] = siluf_(v); }
    __syncthreads();
    float* mod = (float*)(p.ws + OFF_MOD);
    GSTRIDE_BEGIN(idx, DEPTH * 6144) {
        const int l = (int)(idx / 6144), j = (int)(idx - (long)l * 6144);
        const float* w = p.in[I_WADA] + (size_t)l * 1024 * 6144 + j;
        float acc[9];
#pragma unroll
        for (int s = 0; s < 9; ++s) acc[s] = 0.f;
        for (int k = 0; k < 1024; ++k) { const float wv = w[(size_t)k * 6144];
#pragma unroll
            for (int s = 0; s < 9; ++s) acc[s] += lds[s * 1024 + k] * wv; }
        const float bv = p.in[I_BADA][l * 6144 + j];
#pragma unroll
        for (int s = 0; s < 9; ++s) mod[(size_t)(l * 9 + s) * 6144 + j] = acc[s] + bv;
    }
    float* rope = (float*)(p.ws + OFF_ROPE);
    GSTRIDE_BEGIN(idx, 4096 * 32) {
        const int t = (int)(idx >> 5), i = (int)(idx & 31);
        const float pos = (float)(i < 16 ? (t >> 6) : (t & 63));
        const float inv = powf(10000.0f, -(float)(i & 15) / 16.0f);
        const float ang = pos * inv;
        rope[idx * 2] = cosf(ang); rope[idx * 2 + 1] = sinf(ang);
    }
    __syncthreads();
}

__device__ __forceinline__ void phase_init(const Params& p) {
    const float* mod = (const float*)(p.ws + OFF_MOD);
    float* xs = (float*)(p.ws + OFF_XS); bf16_t* h = (bf16_t*)(p.ws + OFF_H);
    GSTRIDE_BEGIN(idx, (long)T * 256) {
        const int row = (int)(idx >> 8), c4 = (int)(idx & 255) * 4;
        const int b = row / LB, t = row - b * LB;
        const float* src = t < LC ? p.in[I_CTX] + ((size_t)(b * LC + t)) * 1024 : p.in[I_X] + ((size_t)(b * LL + (t - LC))) * 1024;
        const int slot = t < LC ? 8 : b;
        const f32x4 v = *(const f32x4*)(src + c4);
        const f32x4 sh = *(const f32x4*)(mod + (size_t)(slot * 6 + 0) * 1024 + c4), sc = *(const f32x4*)(mod + (size_t)(slot * 6 + 1) * 1024 + c4);
        *(f32x4*)(xs + (size_t)row * 1024 + c4) = v;
        const f32x4 hv = v * (sc + 1.0f) + sh;
        u32x2_t o; o[0] = pk2(hv[0], hv[1]); o[1] = pk2(hv[2], hv[3]);
        *(u32x2_t*)(h + (size_t)row * 1024 + c4) = o;
    }
}

__device__ __forceinline__ int winmap(int rho, float& scale) {
    scale = 1.f;
    if (rho < 1568) { if (rho < 256) scale = 0.125f; return rho; }
    if (rho < 1792) return -1;
    if (rho < 2304 || (rho >= 3328 && rho < 3840)) scale = 0.125f;
    return rho - 224;
}
__device__ __forceinline__ void convert_job(const float* src, const float* src2, int ld, int K, bf16_t* dst, int nrows, int mode, float* lds, int& tilectr) {
    const int tid = ltid(), ntk = K >> 6, ntiles = (nrows >> 6) * ntk;
    for (int ti = 0; ti < ntiles; ++ti, ++tilectr) {
        if ((tilectr % (int)gridDim.x) != (int)blockIdx.x) continue;
        const int rt = ti / ntk, kt = ti - rt * ntk, r0 = rt * 64, k0 = kt * 64;
        __syncthreads();
        { const int nn = tid & 63, rho = r0 + nn; float sc = 1.f; int col; const float* s = src;
          if (mode == 0) col = winmap(rho, sc);
          else if (mode == 1) col = rho;
          else { const int ct = rho >> 8, half = (rho >> 7) & 1, i = rho & 127; col = ct * 128 + i; s = half ? src2 : src; }
#pragma unroll
          for (int i = 0; i < 8; ++i) { const int kk = (tid >> 6) + 8 * i;
              const float v = col >= 0 ? s[(size_t)(k0 + kk) * ld + col] * sc : 0.f;
              lds[nn * 65 + kk] = v; } }
        __syncthreads();
        { const int nn = tid >> 3, k8 = (tid & 7) * 8; const float* lp = lds + nn * 65 + k8;
          u32x4_t o; o[0] = pk2(lp[0], lp[1]); o[1] = pk2(lp[2], lp[3]); o[2] = pk2(lp[4], lp[5]); o[3] = pk2(lp[6], lp[7]);
          *(u32x4_t*)(dst + (size_t)(r0 + nn) * K + k0 + k8) = o; }
    }
}
__device__ __forceinline__ void phase_convert(const Params& p, int l, float* lds) {
    int ctr = 0;
    convert_job(p.in[I_WIN] + (size_t)l * 1024 * 7712, nullptr, 7712, 1024, (bf16_t*)(p.ws + OFF_WIN), (int)W_IN_ROWS, 0, lds, ctr);
    for (int n = 0; n < 3; ++n)
        convert_job(p.in[I_WBR] + ((size_t)l * 3 + n) * 512 * 1024, nullptr, 1024, 512, (bf16_t*)(p.ws + OFF_WB) + (size_t)n * 1024 * 512, 1024, 1, lds, ctr);
    convert_job(p.in[I_WO] + (size_t)l * 1024 * 1024, nullptr, 1024, 1024, (bf16_t*)(p.ws + OFF_WO), 1024, 1, lds, ctr);
    for (int e = 0; e < 16; ++e) {
        const size_t eo = ((size_t)l * 16 + e) * 1024 * 512;
        convert_job(p.in[I_WEG] + eo, p.in[I_WEU] + eo, 512, 1024, (bf16_t*)(p.ws + OFF_WUP) + (size_t)e * 1024 * 1024, 1024, 2, lds, ctr);
        convert_job(p.in[I_WED] + eo, nullptr, 1024, 512, (bf16_t*)(p.ws + OFF_WDN) + (size_t)e * 1024 * 512, 1024, 1, lds, ctr);
    }
    __syncthreads();
}

__device__ __forceinline__ void phase_rope_decay(const Params& p, int l) {
    const float* rope = (const float*)(p.ws + OFF_ROPE);
    GSTRIDE_BEGIN(idx, (long)NB * LL * 2 * 8 * 8) {
        const int i4 = (int)(idx & 7) * 4, hc = (int)(idx >> 3) & 7, which = (int)(idx >> 6) & 1; const int lat = (int)(idx >> 7);
        const int b = lat >> 12, t = lat & 4095; const int row = b * LB + LC + t;
        bf16_t* base = (bf16_t*)(p.ws + (which ? OFF_DK : OFF_DQ)) + (size_t)row * 512 + hc * 64 + i4;
        const u32x2_t a = *(const u32x2_t*)base, bq = *(const u32x2_t*)(base + 32);
        const float x1[4] = {bflo(a[0]), bfhi(a[0]), bflo(a[1]), bfhi(a[1])}, x2[4] = {bflo(bq[0]), bfhi(bq[0]), bflo(bq[1]), bfhi(bq[1])};
        float y1[4], y2[4];
#pragma unroll
        for (int j = 0; j < 4; ++j) { const float cs = rope[((size_t)t * 32 + i4 + j) * 2], sn = rope[((size_t)t * 32 + i4 + j) * 2 + 1];
            y1[j] = x1[j] * cs - x2[j] * sn; y2[j] = x1[j] * sn + x2[j] * cs; }
        u32x2_t o1, o2; o1[0] = pk2(y1[0], y1[1]); o1[1] = pk2(y1[2], y1[3]); o2[0] = pk2(y2[0], y2[1]); o2[1] = pk2(y2[2], y2[3]);
        *(u32x2_t*)base = o1; *(u32x2_t*)(base + 32) = o2;
    }
    const float* gr = (const float*)(p.ws + OFF_GR); float* dec = (float*)(p.ws + OFF_S1);
    const float* wd = p.in[I_GWD] + (size_t)l * 2 * 16 * 256; const float* bd = p.in[I_GBD] + (size_t)l * 2 * 256;
    GSTRIDE_BEGIN(idx, (long)T * 512) {
        const int row = (int)(idx >> 9), dj = (int)(idx & 511), dir = dj >> 8, j = dj & 255;
        float z = bd[dir * 256 + j];
#pragma unroll
        for (int r = 0; r < 16; ++r) z += gr[(size_t)row * 32 + dir * 16 + r] * wd[(dir * 16 + r) * 256 + j];
        const float ls = fminf(z, 0.f) - log1pf(__expf(-fabsf(z)));
        dec[idx] = __expf(ls * (1.0f / 16.0f));
    }
}

template <int DIR>
__device__ __forceinline__ void gla_naive_dir(const Params& p, int l, int b, float* lds) {
    const int tid = ltid(), hh = tid >> 7, vc = tid & 127, wv = tid >> 6;
    const bf16_t* GQ = (const bf16_t*)(p.ws + OFF_GQ); const bf16_t* GK = (const bf16_t*)(p.ws + OFF_GK); const bf16_t* GV = (const bf16_t*)(p.ws + OFF_GV);
    bf16_t* GG = (bf16_t*)(p.ws + OFF_GG); const float* DEC = (const float*)(p.ws + OFF_S1); float* OF = (float*)(p.ws + OFF_S2);
    float* sq = lds; float* sk = lds + 16 * 256; float* sd = lds + 32 * 256; float* red = lds + 48 * 256;
    float* sv = lds + 49 * 256;
    const float gn = p.in[I_GNG][l * 128 + vc];
    const int row0 = b * LB;
    float S[64];
#pragma unroll
    for (int d = 0; d < 64; ++d) S[d] = 0.f;
    for (int blk = 0; blk < LB / 16; ++blk) {
        int t0;
        if (DIR == 0) t0 = blk * 16; else t0 = blk < 16 ? (15 - blk) * 16 : (LB / 16 - 1 - (blk - 16)) * 16;
        __syncthreads();
        for (int i = tid; i < 16 * 256; i += 512) { const int r = i >> 8, j = i & 255; const size_t row = row0 + t0 + r;
            sq[i] = bf2f(GQ[row * 256 + j]); sk[i] = bf2f(GK[row * 256 + j]); sd[i] = DEC[(row * 2 + DIR) * 256 + j]; }
#pragma unroll 1
        for (int r = 0; r < 16; ++r) sv[r * 512 + tid] = bf2f(GV[(size_t)(row0 + t0 + r) * 512 + hh * 128 + vc]);
        __syncthreads();
#pragma unroll 1
        for (int rr = 0; rr < 16; ++rr) {
            const int r = DIR == 0 ? rr : 15 - rr;
            const float* pq = sq + r * 256 + hh * 64; const float* pk = sk + r * 256 + hh * 64; const float* pd = sd + r * 256 + hh * 64;
            const float vr = sv[r * 512 + tid];
            float o = 0.f;
#pragma unroll
            for (int d = 0; d < 64; ++d) { S[d] = pd[d] * S[d] + pk[d] * vr; o += pq[d] * S[d]; }
            const size_t oi = (size_t)(row0 + t0 + r) * 512 + hh * 128 + vc;
            if (DIR == 0) OF[oi] = o;
            else {
                const float tot = o + OF[oi];
                sv[r * 512 + tid] = tot;
                const float ss = wave_sum(tot * tot); if ((tid & 63) == 0) red[r * 8 + wv] = ss;
            }
        }
        if (DIR == 1) {
            __syncthreads();
#pragma unroll 1
            for (int r = 0; r < 16; ++r) {
                const float ms = (red[r * 8 + hh * 2] + red[r * 8 + hh * 2 + 1]) * (1.0f / 128.0f);
                const size_t gi = (size_t)(row0 + t0 + r) * 512 + hh * 128 + vc;
                const float gate = bf2f(GG[gi]);
                GG[gi] = f2bf(sv[r * 512 + tid] * rsqrtf(ms + RMS_EPS) * gn * siluf_(gate));
            }
        }
    }
    __syncthreads();
}
__device__ __forceinline__ void gla_naive_batch(const Params& p, int l, int b, float* lds) {
    gla_naive_dir<0>(p, l, b, lds);
    gla_naive_dir<1>(p, l, b, lds);
}

__device__ __forceinline__ void diff_naive_tile(const Params& p, int l, int unit, float* lds) {
    const int tid = ltid(), qi = tid & 127, c = (tid >> 7) & 1, hv = tid >> 8;
    const int qt = unit % 34, bh = unit / 34, hh = bh & 3, b = bh >> 2;
    const int nkeys = qt < 2 ? LC : LB;
    const size_t rowq = (size_t)b * LB + qt * 128 + qi;
    bf16_t* DQ = (bf16_t*)(p.ws + OFF_DQ); const bf16_t* DK = (const bf16_t*)(p.ws + OFF_DK); const bf16_t* DV = (const bf16_t*)(p.ws + OFF_DV);
    float q[64], o[64];
    { const bf16_t* qp = DQ + rowq * 512 + hh * 128 + c * 64;
#pragma unroll
      for (int d8 = 0; d8 < 8; ++d8) { const u32x4_t v = *(const u32x4_t*)(qp + d8 * 8);
#pragma unroll
          for (int j = 0; j < 4; ++j) { q[d8 * 8 + 2 * j] = bflo(v[j]); q[d8 * 8 + 2 * j + 1] = bfhi(v[j]); } } }
#pragma unroll
    for (int d = 0; d < 64; ++d) o[d] = 0.f;
    float m = -INFINITY, lsum = 0.f;
    constexpr int KT = 8; float* kb = lds; float* vb = lds + KT * 128;
    for (int k0 = 0; k0 < nkeys; k0 += KT) {
        __syncthreads();
        for (int i = tid; i < KT * 128; i += 512) { const int r = i >> 7, j = i & 127; const size_t row = (size_t)b * LB + k0 + r;
            kb[i] = bf2f(DK[row * 512 + hh * 128 + j]); vb[i] = bf2f(DV[row * 512 + hh * 128 + j]); }
        __syncthreads();
        float s[KT]; float mt = -INFINITY;
#pragma unroll
        for (int j = 0; j < KT; ++j) { const float* kp = kb + j * 128 + c * 64; float a = 0.f;
#pragma unroll
            for (int d = 0; d < 64; ++d) a += q[d] * kp[d];
            s[j] = a; mt = fmaxf(mt, a); }
        const float mn = fmaxf(m, mt), corr = __expf(m - mn);
        lsum *= corr;
#pragma unroll
        for (int d = 0; d < 64; ++d) o[d] *= corr;
#pragma unroll
        for (int j = 0; j < KT; ++j) { const float pj = __expf(s[j] - mn); lsum += pj; const float* vp = vb + j * 128 + hv * 64;
#pragma unroll
            for (int d = 0; d < 64; ++d) o[d] += pj * vp[d]; }
        m = mn;
    }
    __syncthreads();
    { const float inv = 1.f / lsum; float* cp = lds + ((size_t)qi * 2 + c) * 128 + hv * 64;
#pragma unroll
      for (int d = 0; d < 64; ++d) cp[d] = o[d] * inv; }
    __syncthreads();
    {
        float dq = 0.f, dk2 = 0.f; const float* lq = p.in[I_LQ] + l * 128; const float* lk = p.in[I_LK] + l * 128;
        for (int d = 0; d < 64; ++d) { dq += lq[d] * lk[d]; dk2 += lq[64 + d] * lk[64 + d]; }
        const float lam_init = 0.8f - 0.6f * expf(-0.3f * (float)l);
        const float lam = expf(dq) - expf(dk2) + lam_init;
        const int q2 = tid >> 2, part = tid & 3;
        const float* c0 = lds + ((size_t)q2 * 2) * 128 + part * 32; const float* c1 = c0 + 128;
        float v[32]; float ss = 0.f;
#pragma unroll
        for (int d = 0; d < 32; ++d) { v[d] = c0[d] - lam * c1[d]; ss += v[d] * v[d]; }
        ss += __shfl_xor(ss, 1); ss += __shfl_xor(ss, 2);
        const float sc = rsqrtf(ss * (1.0f / 128.0f) + RMS_EPS) * (1.0f - lam_init);
        const float* g = p.in[I_DNG] + l * 128 + part * 32;
        bf16_t* op = DQ + ((size_t)b * LB + qt * 128 + q2) * 512 + hh * 128 + part * 32;
#pragma unroll
        for (int d = 0; d < 32; d += 2) *(unsigned*)(op + d) = pk2(v[d] * sc * g[d], v[d + 1] * sc * g[d + 1]);
    }
    __syncthreads();
}

__device__ __forceinline__ void na_naive_unit(const Params& p, int l, int unit) {
    const int tid = ltid(), h = tid >> 6, lane = tid & 63;
    const size_t row = (size_t)unit * 64 + lane; const int b = (int)(row / LB), t = (int)(row - (size_t)b * LB);
    bf16_t* NQ = (bf16_t*)(p.ws + OFF_NQ); const bf16_t* NK = (const bf16_t*)(p.ws + OFF_NK); const bf16_t* NV = (const bf16_t*)(p.ws + OFF_NV);
    const float* rpb = p.in[I_RPB] + ((size_t)l * 8 + h) * 15 * 31;
    float q[64], o[64];
    { const bf16_t* qp = NQ + row * 512 + h * 64;
#pragma unroll
      for (int d8 = 0; d8 < 8; ++d8) { const u32x4_t v = *(const u32x4_t*)(qp + d8 * 8);
#pragma unroll
          for (int j = 0; j < 4; ++j) { q[d8 * 8 + 2 * j] = bflo(v[j]); q[d8 * 8 + 2 * j + 1] = bfhi(v[j]); } } }
#pragma unroll
    for (int d = 0; d < 64; ++d) o[d] = 0.f;
    float m = -INFINITY, lsum = 0.f;
    const bool lat = t >= LC; const int tp = t - LC, r = tp >> 6, qc = tp & 63;
    const int rs = min(max(r - 4, 0), 56), cs = min(max(qc - 8, 0), 48);
    const int nloc = lat ? 128 : 0;
    for (int kk = 0; kk < nloc + LC; ++kk) {
        size_t krow; float bias = 0.f;
        if (kk < nloc) { const int kr = rs + (kk >> 4), kc = cs + (kk & 15); krow = (size_t)b * LB + LC + kr * 64 + kc; bias = rpb[(kr - r + 7) * 31 + (kc - qc + 15)]; }
        else krow = (size_t)b * LB + (kk - nloc);
        const bf16_t* kp = NK + krow * 512 + h * 64; const bf16_t* vp = NV + krow * 512 + h * 64;
        float s = bias;
#pragma unroll
        for (int d8 = 0; d8 < 8; ++d8) { const u32x4_t v = *(const u32x4_t*)(kp + d8 * 8);
#pragma unroll
            for (int j = 0; j < 4; ++j) { s += q[d8 * 8 + 2 * j] * bflo(v[j]); s += q[d8 * 8 + 2 * j + 1] * bfhi(v[j]); } }
        const float mn = fmaxf(m, s), corr = __expf(m - mn), pj = __expf(s - mn);
        lsum = lsum * corr + pj; m = mn;
#pragma unroll
        for (int d8 = 0; d8 < 8; ++d8) { const u32x4_t v = *(const u32x4_t*)(vp + d8 * 8);
#pragma unroll
            for (int j = 0; j < 4; ++j) { o[d8 * 8 + 2 * j] = o[d8 * 8 + 2 * j] * corr + pj * bflo(v[j]); o[d8 * 8 + 2 * j + 1] = o[d8 * 8 + 2 * j + 1] * corr + pj * bfhi(v[j]); } }
    }
    const float inv = 1.f / lsum;
    bf16_t* op = NQ + row * 512 + h * 64;
#pragma unroll
    for (int d8 = 0; d8 < 8; ++d8) { u32x4_t v;
#pragma unroll
        for (int j = 0; j < 4; ++j) v[j] = pk2(o[d8 * 8 + 2 * j] * inv, o[d8 * 8 + 2 * j + 1] * inv);
        *(u32x4_t*)(op + d8 * 8) = v; }
}

__device__ __forceinline__ void ln_row(float (&v)[16], const float* g, const float* bb, int lane) {
    float s = 0.f;
#pragma unroll
    for (int i = 0; i < 16; ++i) s += v[i];
    const float mu = wave_sum(s) * (1.0f / 1024.0f);
    float q = 0.f;
#pragma unroll
    for (int i = 0; i < 16; ++i) { v[i] -= mu; q += v[i] * v[i]; }
    const float rstd = rsqrtf(wave_sum(q) * (1.0f / 1024.0f) + LN_EPS);
#pragma unroll
    for (int i = 0; i < 4; ++i) { const f32x4 gv = *(const f32x4*)(g + i * 256 + lane * 4), bv = *(const f32x4*)(bb + i * 256 + lane * 4);
#pragma unroll
        for (int j = 0; j < 4; ++j) v[i * 4 + j] = v[i * 4 + j] * rstd * gv[j] + bv[j]; }
}

__device__ __forceinline__ void top2of4(const float s0, const float s1, const float s2, const float s3, int& i1, int& i2, float& sum) {
    i1 = 0; float m1 = s0;
    if (s1 > m1) { m1 = s1; i1 = 1; } if (s2 > m1) { m1 = s2; i1 = 2; } if (s3 > m1) { m1 = s3; i1 = 3; }
    float m2 = -INFINITY; i2 = 0;
    if (i1 != 0 && s0 > m2) { m2 = s0; i2 = 0; } if (i1 != 1 && s1 > m2) { m2 = s1; i2 = 1; }
    if (i1 != 2 && s2 > m2) { m2 = s2; i2 = 2; } if (i1 != 3 && s3 > m2) { m2 = s3; i2 = 3; }
    sum = m1 + m2;
}

__device__ __forceinline__ void phase_ln1_router(const Params& p, int l) {
    const int lane = ltid() & 63, wv = ltid() >> 6, wpb = blockDim.x >> 6;
    float* xs = (float*)(p.ws + OFF_XS); bf16_t* h = (bf16_t*)(p.ws + OFF_H); const float* mod = (const float*)(p.ws + OFF_MOD);
    int* tok = (int*)(p.ws + OFF_TOK); unsigned* cnt = (unsigned*)(p.ws + OFF_CNT) + l * 16;
    const float* g = p.in[I_LNG] + (size_t)(l * 2 + 0) * 1024; const float* bb = p.in[I_LNB] + (size_t)(l * 2 + 0) * 1024;
    const float* wr = p.in[I_WR]; const float* br = p.in[I_BR];
    for (int row = blockIdx.x * wpb + wv; row < T; row += gridDim.x * wpb) {
        const int slot = row_slot(row);
        const float* msh = mod + ((size_t)(l * 9 + slot) * 6 + 3) * 1024; const float* msc = msh + 1024;
        float v[16];
#pragma unroll
        for (int i = 0; i < 4; ++i) { const f32x4 t4 = *(const f32x4*)(xs + (size_t)row * 1024 + i * 256 + lane * 4);
#pragma unroll
            for (int j = 0; j < 4; ++j) v[i * 4 + j] = t4[j]; }
        ln_row(v, g, bb, lane);
        float lg[16];
#pragma unroll
        for (int e = 0; e < 16; ++e) lg[e] = 0.f;
#pragma unroll
        for (int i = 0; i < 4; ++i) {
            const int c0 = i * 256 + lane * 4;
            f32x4 x4; x4[0] = v[i * 4]; x4[1] = v[i * 4 + 1]; x4[2] = v[i * 4 + 2]; x4[3] = v[i * 4 + 3];
            *(f32x4*)(xs + (size_t)row * 1024 + c0) = x4;
            const f32x4 sh = *(const f32x4*)(msh + c0), sc = *(const f32x4*)(msc + c0);
            const f32x4 hv = x4 * (sc + 1.0f) + sh;
            u32x2_t o; o[0] = pk2(hv[0], hv[1]); o[1] = pk2(hv[2], hv[3]);
            *(u32x2_t*)(h + (size_t)row * 1024 + c0) = o;
#pragma unroll
            for (int j = 0; j < 4; ++j) { const float* wp = wr + (size_t)(c0 + j) * 16;
#pragma unroll
                for (int e4 = 0; e4 < 4; ++e4) { const f32x4 w4 = *(const f32x4*)(wp + e4 * 4);
#pragma unroll
                    for (int k = 0; k < 4; ++k) lg[e4 * 4 + k] += hv[j] * w4[k]; } }
        }
        float aff[16], sel[16];
#pragma unroll
        for (int e = 0; e < 16; ++e) { lg[e] = wave_sum(lg[e]); aff[e] = sigmoidf_(lg[e]); sel[e] = aff[e] + br[e]; }
        int bi1 = 0, bi2 = 0, bg = 0; float best = -INFINITY;
#pragma unroll
        for (int gq = 0; gq < 4; ++gq) { int i1, i2; float sm; top2of4(sel[gq * 4], sel[gq * 4 + 1], sel[gq * 4 + 2], sel[gq * 4 + 3], i1, i2, sm);
            if (sm > best) { best = sm; bg = gq; bi1 = i1; bi2 = i2; } }
        const int e1 = bg * 4 + bi1, e2 = bg * 4 + bi2;
        float a1 = 0.f, a2 = 0.f;
#pragma unroll
        for (int e = 0; e < 16; ++e) { a1 = (e == e1) ? aff[e] : a1; a2 = (e == e2) ? aff[e] : a2; }
        const float inv = 1.f / (a1 + a2);
        if (lane == 0) {
            const unsigned s1 = atomicAdd(cnt + e1, 1u), s2 = atomicAdd(cnt + e2, 1u);
            int* tp = tok + (size_t)row * 8;
            tp[0] = e1; tp[1] = e2; tp[2] = (int)s1; tp[3] = (int)s2; tp[4] = __float_as_int(a1 * inv); tp[5] = __float_as_int(a2 * inv);
        }
    }
}

__device__ __forceinline__ void phase_gather(const Params& p, int l) {
    const int lane = ltid() & 63, wv = ltid() >> 6, wpb = blockDim.x >> 6;
    const unsigned* cnt = (const unsigned*)(p.ws + OFF_CNT) + l * 16;
    int base[16]; { int s = 0;
#pragma unroll
        for (int e = 0; e < 16; ++e) { base[e] = s; s += (int)((cnt[e] + 255u) >> 8) * 256; } }
    const bf16_t* h = (const bf16_t*)(p.ws + OFF_H); bf16_t* xa = (bf16_t*)(p.ws + OFF_XA); int* tok = (int*)(p.ws + OFF_TOK);
    for (int row = blockIdx.x * wpb + wv; row < T; row += gridDim.x * wpb) {
        int* tp = tok + (size_t)row * 8;
        const int e1 = tp[0], e2 = tp[1], s1 = tp[2], s2 = tp[3];
        int b1 = 0, b2 = 0;
#pragma unroll
        for (int e = 0; e < 16; ++e) { b1 = (e == e1) ? base[e] : b1; b2 = (e == e2) ? base[e] : b2; }
        const int p1 = b1 + s1, p2 = b2 + s2;
        const u32x4_t v0 = *(const u32x4_t*)(h + (size_t)row * 1024 + lane * 8), v1 = *(const u32x4_t*)(h + (size_t)row * 1024 + 512 + lane * 8);
        *(u32x4_t*)(xa + (size_t)p1 * 1024 + lane * 8) = v0; *(u32x4_t*)(xa + (size_t)p1 * 1024 + 512 + lane * 8) = v1;
        *(u32x4_t*)(xa + (size_t)p2 * 1024 + lane * 8) = v0; *(u32x4_t*)(xa + (size_t)p2 * 1024 + 512 + lane * 8) = v1;
        if (lane == 0) { tp[6] = p1; tp[7] = p2; }
    }
}

__device__ __forceinline__ void phase_ln2(const Params& p, int l) {
    const int lane = ltid() & 63, wv = ltid() >> 6, wpb = blockDim.x >> 6;
    float* xs = (float*)(p.ws + OFF_XS); bf16_t* h = (bf16_t*)(p.ws + OFF_H); const float* mod = (const float*)(p.ws + OFF_MOD);
    const int* tok = (const int*)(p.ws + OFF_TOK); const bf16_t* y = (const bf16_t*)(p.ws + OFF_Y);
    const float* g = p.in[I_LNG] + (size_t)(l * 2 + 1) * 1024; const float* bb = p.in[I_LNB] + (size_t)(l * 2 + 1) * 1024;
    for (int row = blockIdx.x * wpb + wv; row < T; row += gridDim.x * wpb) {
        const int slot = row_slot(row);
        const int* tp = tok + (size_t)row * 8;
        const float w0 = __int_as_float(tp[4]), w1 = __int_as_float(tp[5]); const size_t p0 = (size_t)tp[6], p1 = (size_t)tp[7];
        const float* mg = mod + ((size_t)(l * 9 + slot) * 6 + 5) * 1024;
        float v[16];
#pragma unroll
        for (int i = 0; i < 4; ++i) { const int c0 = i * 256 + lane * 4;
            const f32x4 x4 = *(const f32x4*)(xs + (size_t)row * 1024 + c0), g4 = *(const f32x4*)(mg + c0);
            const u32x2_t ya = *(const u32x2_t*)(y + p0 * 1024 + c0), yb = *(const u32x2_t*)(y + p1 * 1024 + c0);
            v[i * 4 + 0] = ALPHA * x4[0] + g4[0] * (w0 * bflo(ya[0]) + w1 * bflo(yb[0]));
            v[i * 4 + 1] = ALPHA * x4[1] + g4[1] * (w0 * bfhi(ya[0]) + w1 * bfhi(yb[0]));
            v[i * 4 + 2] = ALPHA * x4[2] + g4[2] * (w0 * bflo(ya[1]) + w1 * bflo(yb[1]));
            v[i * 4 + 3] = ALPHA * x4[3] + g4[3] * (w0 * bfhi(ya[1]) + w1 * bfhi(yb[1])); }
        ln_row(v, g, bb, lane);
        const int b = row / LB, t = row - b * LB;
        if (l == DEPTH - 1) {
            if (t >= LC) { float* op = p.out + ((size_t)b * LL + (t - LC)) * 1024;
#pragma unroll
                for (int i = 0; i < 4; ++i) { f32x4 x4; x4[0] = v[i * 4]; x4[1] = v[i * 4 + 1]; x4[2] = v[i * 4 + 2]; x4[3] = v[i * 4 + 3]; *(f32x4*)(op + i * 256 + lane * 4) = x4; } }
        } else {
            const float* msh = mod + ((size_t)((l + 1) * 9 + slot) * 6 + 0) * 1024; const float* msc = msh + 1024;
#pragma unroll
            for (int i = 0; i < 4; ++i) { const int c0 = i * 256 + lane * 4;
                f32x4 x4; x4[0] = v[i * 4]; x4[1] = v[i * 4 + 1]; x4[2] = v[i * 4 + 2]; x4[3] = v[i * 4 + 3];
                *(f32x4*)(xs + (size_t)row * 1024 + c0) = x4;
                const f32x4 sh = *(const f32x4*)(msh + c0), sc = *(const f32x4*)(msc + c0);
                const f32x4 hv = x4 * (sc + 1.0f) + sh;
                u32x2_t o; o[0] = pk2(hv[0], hv[1]); o[1] = pk2(hv[2], hv[3]);
                *(u32x2_t*)(h + (size_t)row * 1024 + c0) = o; }
        }
    }
}

enum { PH_MOD = 0, PH_INIT, PH_CONVERT, PH_INPROJ, PH_ROPEDEC, PH_MIX_GLA, PH_MIX_DIFF, PH_MIX_NA, PH_GATES, PH_MERGE, PH_WO, PH_LN1, PH_GATHER, PH_UP, PH_DOWN, PH_LN2, PH_COUNT };

template <class Epi, class Sched>
__device__ __forceinline__ void run_gemm(PG8_LAS unsigned char* lds, const void* A, const void* Bt, int K, const Sched& S, const Epi& E) {
    pg8::Gemm g; g.A = (const pg8::bf16_t*)A; g.Bt = (const pg8::bf16_t*)Bt; g.M = 0; g.N = 0; g.K = K;
    pg8::gemm_phase<Epi, Sched, false>(lds, g, S, E, nullptr);
}

#ifndef PHASE_INLINE
#define PHASE_INLINE __forceinline__
#endif
template <int PH>
__device__ PHASE_INLINE void run_phase(const Params& p, int l, unsigned char* shm) {
#ifdef SKIP_MASK
    if constexpr ((SKIP_MASK >> PH) & 1) return;
#endif
    PG8_LAS unsigned char* lds = (PG8_LAS unsigned char*)shm;
    float* ldsf = (float*)shm;
    const int G = gridDim.x, c = blockIdx.x;
    if constexpr (PH == PH_MOD) phase_mod(p, ldsf);
    else if constexpr (PH == PH_INIT) phase_init(p);
    else if constexpr (PH == PH_CONVERT) phase_convert(p, l, ldsf);
    else if constexpr (PH == PH_INPROJ) { SchedGrid S{NPANEL, 19, 0, G, c}; EpiInProj E{p.ws}; run_gemm(lds, p.ws + OFF_H, p.ws + OFF_WIN, 1024, S, E); }
    else if constexpr (PH == PH_ROPEDEC) phase_rope_decay(p, l);
    else if constexpr (PH == PH_MIX_GLA) { for (int u = blockIdx.x; u < NB; u += gridDim.x) gla_naive_batch(p, l, u, ldsf); }
    else if constexpr (PH == PH_MIX_DIFF) { for (int u = blockIdx.x; u < NB * 4 * 34; u += gridDim.x) diff_naive_tile(p, l, u, ldsf); }
    else if constexpr (PH == PH_MIX_NA) { for (int u = blockIdx.x; u < T / 64; u += gridDim.x) na_naive_unit(p, l, u); }
    else if constexpr (PH == PH_GATES) { SchedGrid S{NPANEL, 12, 19, G, c}; EpiGates E{p.ws}; run_gemm(lds, p.ws + OFF_H, p.ws + OFF_WIN, 1024, S, E); }
    else if constexpr (PH == PH_MERGE) { SchedMerge S{G, c}; EpiMerge E{p.ws}; run_gemm(lds, p.ws + OFF_BR, p.ws + OFF_WB, 512, S, E); }
    else if constexpr (PH == PH_WO) { SchedGrid S{NPANEL, 4, 0, G, c}; EpiWo E{p.ws, l}; run_gemm(lds, p.ws + OFF_H, p.ws + OFF_WO, 1024, S, E); }
    else if constexpr (PH == PH_LN1) phase_ln1_router(p, l);
    else if constexpr (PH == PH_GATHER) phase_gather(p, l);
    else if constexpr (PH == PH_UP) { SchedMoe S; S.init((const unsigned*)(p.ws + OFF_CNT) + l * 16, G, c); EpiUp E{p.ws}; run_gemm(lds, p.ws + OFF_XA, p.ws + OFF_WUP, 1024, S, E); }
    else if constexpr (PH == PH_DOWN) { SchedMoe S; S.init((const unsigned*)(p.ws + OFF_CNT) + l * 16, G, c); EpiDown E{p.ws}; run_gemm(lds, p.ws + OFF_ACT, p.ws + OFF_WDN, 512, S, E); }
    else if constexpr (PH == PH_LN2) phase_ln2(p, l);
}

#if !MEGA
template <int PH>
__global__ void __launch_bounds__(512, 2) k_phase(Params p, int l) {
    extern __shared__ __attribute__((aligned(16))) unsigned char shm[];
    run_phase<PH>(p, l, shm);
}
template <int PH> static void launch_phase(const Params& p, int l, hipStream_t st) {
    static bool attr = false;
    if (!attr) { (void)hipFuncSetAttribute((const void*)k_phase<PH>, hipFuncAttributeMaxDynamicSharedMemorySize, LDS_BYTES); attr = true; }
    hipLaunchKernelGGL((k_phase<PH>), dim3(256), dim3(512), LDS_BYTES, st, p, l);
}
#else
__global__ void __launch_bounds__(512, 2) k_mega(Params p) {
    extern __shared__ __attribute__((aligned(16))) unsigned char shm[];
    volatile LAS unsigned* xbw = (volatile LAS unsigned*)(shm + LDS_STAGE);
    if (threadIdx.x == 0) { xbw[0] = 0u; xbw[1] = 0u; xbw[2] = 0u; xbw[3] = 0u; }
    __syncthreads();
    XcdBarrier bar = xcd_barrier_post((unsigned*)(p.ws + OFF_BAR), xbw);
    run_phase<PH_MOD>(p, 0, shm);
    run_phase<PH_CONVERT>(p, 0, shm);
    xcd_barrier(bar);
    run_phase<PH_INIT>(p, 0, shm);
    xcd_barrier(bar);
    for (int l = 0; l < DEPTH; ++l) {
        if (l > 0) { run_phase<PH_CONVERT>(p, l, shm); xcd_barrier(bar); }
        run_phase<PH_INPROJ>(p, l, shm); xcd_barrier(bar);
        run_phase<PH_ROPEDEC>(p, l, shm); xcd_barrier(bar);
        run_phase<PH_MIX_GLA>(p, l, shm); run_phase<PH_MIX_DIFF>(p, l, shm); run_phase<PH_MIX_NA>(p, l, shm); xcd_barrier(bar);
        run_phase<PH_GATES>(p, l, shm); xcd_barrier(bar);
        run_phase<PH_MERGE>(p, l, shm); xcd_barrier(bar);
        run_phase<PH_WO>(p, l, shm); xcd_barrier(bar);
        run_phase<PH_LN1>(p, l, shm); xcd_barrier(bar);
        run_phase<PH_GATHER>(p, l, shm); xcd_barrier(bar);
        run_phase<PH_UP>(p, l, shm); xcd_barrier(bar);
        run_phase<PH_DOWN>(p, l, shm); xcd_barrier(bar);
        run_phase<PH_LN2>(p, l, shm); xcd_barrier(bar);
    }
}
#endif

extern "C" void kernel_launch(void* const* d_in, const int* in_sizes, int n_in, void* d_out, int out_size, void* d_ws, size_t ws_size, hipStream_t stream) {
    (void)in_sizes; (void)n_in; (void)out_size;
    if (ws_size < WS_NEED) { fprintf(stderr, "workspace too small: %zu < %zu\n", ws_size, (size_t)WS_NEED); return; }
    Params p{};
    for (int i = 0; i < 23; ++i) p.in[i] = (const float*)d_in[i];
    p.out = (float*)d_out; p.ws = (char*)d_ws;
    (void)hipMemsetAsync(d_ws, 0, ZERO_BYTES, stream);
#if !MEGA
    launch_phase<PH_MOD>(p, 0, stream);
    launch_phase<PH_INIT>(p, 0, stream);
    for (int l = 0; l < DEPTH; ++l) {
        launch_phase<PH_CONVERT>(p, l, stream);
        launch_phase<PH_INPROJ>(p, l, stream);
        launch_phase<PH_ROPEDEC>(p, l, stream);
        launch_phase<PH_MIX_GLA>(p, l, stream);
        launch_phase<PH_MIX_DIFF>(p, l, stream);
        launch_phase<PH_MIX_NA>(p, l, stream);
        launch_phase<PH_GATES>(p, l, stream);
        launch_phase<PH_MERGE>(p, l, stream);
        launch_phase<PH_WO>(p, l, stream);
        launch_phase<PH_LN1>(p, l, stream);
        launch_phase<PH_GATHER>(p, l, stream);
        launch_phase<PH_UP>(p, l, stream);
        launch_phase<PH_DOWN>(p, l, stream);
        launch_phase<PH_LN2>(p, l, stream);
    }
#else
    static int grid = 0;
    if (!grid) {
        (void)hipFuncSetAttribute((const void*)k_mega, hipFuncAttributeMaxDynamicSharedMemorySize, LDS_BYTES);
        int dev = 0, cus = 0, per_cu = 0;
        (void)hipGetDevice(&dev);
        (void)hipDeviceGetAttribute(&cus, hipDeviceAttributeMultiprocessorCount, dev);
        (void)hipOccupancyMaxActiveBlocksPerMultiprocessor(&per_cu, (const void*)k_mega, 512, LDS_BYTES);
        if (cus <= 0) cus = 256;
        grid = per_cu >= 1 ? cus : 0;
        if (!grid) { fprintf(stderr, "k_mega does not fit a CU\n"); return; }
    }
    hipLaunchKernelGGL(k_mega, dim3(grid), dim3(512), LDS_BYTES, stream, p);
#endif
}
```

```cpp
#define MEGA 1
#include <hip/hip_runtime.h>
#include <stdint.h>
#include <stdio.h>

#ifndef MEGA
#define MEGA 0
#endif

constexpr int NB = 8, LL = 4096, LC = 256, LB = LL + LC  , T = NB * LB  , D = 1024, DEPTH = 4;
constexpr int NPANEL = T / 256;
constexpr int PB = LB / 256;
constexpr int PAIR_ROWS = 2 * T + 16 * 256;
constexpr float ALPHA = 1.681792830507429f;
constexpr float LN_EPS = 1e-5f, RMS_EPS = 1e-6f;

constexpr size_t AL256(size_t x) { return (x + 255) & ~(size_t)255; }
constexpr size_t OFF_BAR = 0;
constexpr size_t OFF_CNT = 16384;
constexpr size_t ZERO_BYTES = 32768;
constexpr size_t OFF_MOD = ZERO_BYTES;
constexpr size_t OFF_ROPE = AL256(OFF_MOD + (size_t)DEPTH * 9 * 6144 * 4);
constexpr size_t OFF_TOK = AL256(OFF_ROPE + (size_t)4096 * 32 * 2 * 4);
constexpr size_t OFF_GR = AL256(OFF_TOK + (size_t)T * 8 * 4);
constexpr size_t OFF_XS = AL256(OFF_GR + (size_t)T * 32 * 4);
constexpr size_t OFF_H = AL256(OFF_XS + (size_t)T * D * 4);
constexpr size_t OFF_W = AL256(OFF_H + (size_t)T * D * 2);
constexpr size_t W_IN_ROWS = 4864 + 3072;
constexpr size_t OFF_WIN = OFF_W;
constexpr size_t OFF_WB = OFF_WIN + W_IN_ROWS * 1024 * 2;
constexpr size_t OFF_WO = OFF_WB + (size_t)3 * 1024 * 512 * 2;
constexpr size_t OFF_WUP = OFF_WO + (size_t)1024 * 1024 * 2;
constexpr size_t OFF_WDN = OFF_WUP + (size_t)16 * 1024 * 1024 * 2;
constexpr size_t OFF_P = AL256(OFF_WDN + (size_t)16 * 1024 * 512 * 2);
constexpr size_t PCOL = (size_t)T * 2;
constexpr size_t OFF_GQ = OFF_P, OFF_GK = OFF_P + 256 * PCOL, OFF_GV = OFF_P + 512 * PCOL;
constexpr size_t OFF_DK = OFF_P + 1024 * PCOL, OFF_DV = OFF_P + 1536 * PCOL;
constexpr size_t OFF_NK = OFF_P + 2048 * PCOL, OFF_NV = OFF_P + 2560 * PCOL;
constexpr size_t OFF_BR = OFF_P + 3072 * PCOL;
constexpr size_t OFF_GG = OFF_BR, OFF_DQ = OFF_BR + 512 * PCOL, OFF_NQ = OFF_BR + 1024 * PCOL;
constexpr size_t OFF_GATE = OFF_P;
constexpr size_t OFF_S1 = AL256(OFF_P + 4608 * PCOL);
constexpr size_t OFF_S2 = AL256(OFF_S1 + (size_t)T * 512 * 4);
constexpr size_t OFF_VT = AL256(OFF_S2 + (size_t)T * 512 * 4);
constexpr size_t OFF_END1 = AL256(OFF_VT + (size_t)T * 512 * 2);
constexpr size_t OFF_XA = OFF_P;
constexpr size_t OFF_ACT = AL256(OFF_XA + (size_t)PAIR_ROWS * 1024 * 2);
constexpr size_t OFF_Y = AL256(OFF_ACT + (size_t)PAIR_ROWS * 512 * 2);
constexpr size_t OFF_END2 = AL256(OFF_Y + (size_t)PAIR_ROWS * 1024 * 2);
constexpr size_t WS_NEED = OFF_END1 > OFF_END2 ? OFF_END1 : OFF_END2;
static_assert(WS_NEED < (size_t)800 * 1000 * 1000, "workspace budget");

constexpr int LDS_STAGE = 131072;
constexpr int LDS_BYTES = LDS_STAGE + 256;

typedef unsigned short bf16_t;

struct Params {
    const float* in[23];
    float* out;
    char* ws;
};
enum { I_X = 0, I_C, I_CTX, I_CCTX, I_WADA, I_BADA, I_WIN, I_GWD, I_GBD, I_GNG, I_LQ, I_LK, I_DNG, I_RPB, I_WBR, I_WO, I_LNG, I_LNB, I_WR, I_BR, I_WEG, I_WEU, I_WED };

__device__ __forceinline__ float bf2f(bf16_t v) { return __uint_as_float(((unsigned)v) << 16); }
__device__ __forceinline__ float bflo(unsigned u) { return __uint_as_float(u << 16); }
__device__ __forceinline__ float bfhi(unsigned u) { return __uint_as_float(u & 0xffff0000u); }
__device__ __forceinline__ unsigned pk2(float lo, float hi) { unsigned r; asm volatile("v_cvt_pk_bf16_f32 %0, %1, %2" : "=v"(r) : "v"(lo), "v"(hi)); return r; }
__device__ __forceinline__ bf16_t f2bf(float f) { return (bf16_t)(pk2(f, 0.f) & 0xffffu); }
__device__ __forceinline__ float wave_sum(float v) {
#pragma unroll
    for (int o = 32; o >= 1; o >>= 1) v += __shfl_xor(v, o);
    return v;
}
__device__ __forceinline__ float sigmoidf_(float x) { return 1.f / (1.f + __expf(-x)); }
__device__ __forceinline__ float siluf_(float x) { return x / (1.f + __expf(-x)); }
__device__ __forceinline__ int row_slot(int row) { const int b = row / LB, t = row - b * LB; return t < LC ? 8 : b; }
__device__ __forceinline__ int ltid() { int t = threadIdx.x; asm volatile("" : "+v"(t)); return t; }
#include <hip/hip_runtime.h>
namespace pg8 {
#define PG8_LAS __attribute__((address_space(3)))
typedef unsigned short bf16_t;
typedef short bf16x8 __attribute__((ext_vector_type(8)));
typedef float f32x4 __attribute__((ext_vector_type(4)));
typedef unsigned u32x4 __attribute__((ext_vector_type(4)));
constexpr int BM = 256, BK = 64, HALF = 128, HTB = HALF * BK * 2  , STAGE_BYTES = 8 * HTB, NXCD = 8, WGM = 8;

__host__ __device__ __forceinline__ int lds_byte(int r, int c) { const int st = (r >> 4) * 2 + (c >> 5), rr = r & 15, cc = c & 31, ob = rr * 64 + cc * 2; return st * 1024 + (ob ^ (((ob >> 9) & 1) << 5)); }
__host__ __device__ __forceinline__ void stage_rc(int b, int& R, int& C) { const int st = b / 1024, sb = b % 1024, swz = sb ^ (((sb >> 9) & 1) << 5); R = (st >> 1) * 16 + swz / 64; C = (st & 1) * 32 + (swz % 64) / 2; }
__host__ __device__ __forceinline__ int perm32(int rho) { const int n = rho >> 4, i = rho & 15; return 8 * (i >> 2) + 4 * n + (i & 3); }

struct Unit { int pm, pn; };
struct Gemm { const bf16_t* A; const bf16_t* Bt; int M, N, K; };
__device__ __forceinline__ unsigned cvt_pk_bf16(float lo, float hi) { unsigned r; asm volatile("v_cvt_pk_bf16_f32 %0, %1, %2" : "=v"(r) : "v"(lo), "v"(hi)); return r; }

template <class Epi, class Sched, bool STAMP = false>
__device__ __forceinline__ void gemm_phase(PG8_LAS unsigned char* lds, const Gemm g, const Sched& S, const Epi& E, unsigned long long* stamps) {
    int tid_l = threadIdx.x; asm volatile("" : "+v"(tid_l));
    const int tid = tid_l, wid = __builtin_amdgcn_readfirstlane(tid >> 6), lane = tid & 63, wr = wid >> 2, wc = wid & 3, fr = lane & 15, fq = lane >> 4;
    const int K = g.K, nt = K / BK;
    int ts_lo = 0, ts_hi = 0, nts = 0; const unsigned long long rt_entry = STAMP ? (unsigned long long)wall_clock64() : 0ull;
#define PG8_STAMP() do { if (STAMP && wid == 0 && nts < 64) { const unsigned long long _c = (unsigned long long)clock64(); \
        ts_lo = (lane == nts) ? (int)(unsigned)_c : ts_lo; ts_hi = (lane == nts) ? (int)(unsigned)(_c >> 32) : ts_hi; ++nts; } } while (0)
    PG8_STAMP();
    unsigned voffA[2], voffB[2];
#pragma unroll
    for (int i = 0; i < 2; ++i) { int R, C; stage_rc(tid * 16 + i * 8192, R, C); const int Rb = Epi::PERM ? ((R & ~31) + perm32(R & 31)) : R;
        voffA[i] = (unsigned)(R * K + C) * 2u; voffB[i] = (unsigned)(Rb * K + C) * 2u; }
    const size_t kstep = (size_t)(BK * 2);
    const size_t hstep = (size_t)HALF * K * 2;
    const size_t tstep = 2 * hstep;
    const unsigned ldsw = (unsigned)wid * 1024u;
    const int aoff = lds_byte(wr * 64 + fr, fq * 8), boff = lds_byte(wc * 32 + fr, fq * 8);
#define PG8_SA(b, h) (((b) * 2 + (h)) * HTB)
#define PG8_SB(b, h) ((4 + (b) * 2 + (h)) * HTB)
#define PG8_STAGE(bufoff, gbase, voff) do { _Pragma("unroll") for (int _i = 0; _i < 2; ++_i) \
        __builtin_amdgcn_global_load_lds((const unsigned*)((const char*)(gbase) + (voff)[_i]), (PG8_LAS unsigned*)(lds + (bufoff) + ldsw + _i * 8192), 16, 0, 0); } while (0)
#define PG8_LDA(dst, b, h) do { _Pragma("unroll") for (int m = 0; m < 4; ++m) _Pragma("unroll") for (int k = 0; k < 2; ++k) dst[m][k] = *(const PG8_LAS bf16x8*)(lds + PG8_SA(b, h) + aoff + m * 2048 + k * 1024); } while (0)
#define PG8_LDB(dst, b, h) do { _Pragma("unroll") for (int n = 0; n < 2; ++n) _Pragma("unroll") for (int k = 0; k < 2; ++k) dst[n][k] = *(const PG8_LAS bf16x8*)(lds + PG8_SB(b, h) + boff + n * 2048 + k * 1024); } while (0)
#define PG8_MMA(ai, bj, At, Bt) do { __builtin_amdgcn_s_setprio(1); _Pragma("unroll") for (int m = 0; m < 4; ++m) _Pragma("unroll") for (int n = 0; n < 2; ++n) _Pragma("unroll") for (int k = 0; k < 2; ++k) \
        acc[ai][bj][m][n] = __builtin_amdgcn_mfma_f32_16x16x32_bf16(Bt[n][k], At[m][k], acc[ai][bj][m][n], 0, 0, 0); __builtin_amdgcn_s_setprio(0); } while (0)
#define PG8_WAIT_V(n) asm volatile("s_waitcnt vmcnt(" #n ")" ::: "memory")
#define PG8_WAIT_L(n) asm volatile("s_waitcnt lgkmcnt(" #n ")" ::: "memory")
#define PG8_BAR __builtin_amdgcn_s_barrier()
#define PG8_SCHED __builtin_amdgcn_sched_barrier(0)
    Unit cur, nxt; int ui = 0;
    if (!S.next(0, cur)) return;
    f32x4 acc[2][2][4][2];
#pragma unroll
    for (int a = 0; a < 2; ++a)
#pragma unroll
        for (int b = 0; b < 2; ++b)
#pragma unroll
            for (int m = 0; m < 4; ++m)
#pragma unroll
                for (int n = 0; n < 2; ++n) acc[a][b][m][n] = (f32x4){0.f, 0.f, 0.f, 0.f};
    bf16x8 At[4][2], B0[2][2], B1[2][2];
    const char* cA = (const char*)g.A + (size_t)cur.pm * tstep; const char* cB = (const char*)g.Bt + (size_t)cur.pn * tstep;
    S.a_ready(cur);
    PG8_STAGE(PG8_SB(0, 0), cB, voffB); PG8_STAGE(PG8_SA(0, 0), cA, voffA); PG8_STAGE(PG8_SB(0, 1), cB + hstep, voffB); PG8_STAGE(PG8_SA(0, 1), cA + hstep, voffA);
    if (wr == 1) PG8_BAR;
    PG8_WAIT_V(4); PG8_BAR;
    PG8_STAGE(PG8_SB(1, 0), cB + kstep, voffB); PG8_STAGE(PG8_SA(1, 0), cA + kstep, voffA); PG8_STAGE(PG8_SB(1, 1), cB + hstep + kstep, voffB);
    PG8_WAIT_V(6); PG8_BAR;
    PG8_STAMP();
    for (;;) {
        const bool has_next = S.next(ui + 1, nxt);
        const char* nA = has_next ? (const char*)g.A + (size_t)nxt.pm * tstep : cA; const char* nB = has_next ? (const char*)g.Bt + (size_t)nxt.pn * tstep : cB;
        for (int t = 0; t < nt; t += 2) {
            const bool last = (t == nt - 2);
            const char* a1 = cA + (size_t)(t + 1) * kstep;
            const char* a2 = last ? nA : cA + (size_t)(t + 2) * kstep; const char* b2 = last ? nB : cB + (size_t)(t + 2) * kstep;
            const char* a3 = a2 + kstep; const char* b3 = b2 + kstep;
            if (last && has_next) S.a_ready(nxt);
            PG8_LDB(B0, 0, 0); PG8_SCHED; PG8_LDA(At, 0, 0); PG8_STAGE(PG8_SA(1, 1), a1 + hstep, voffA);
            PG8_WAIT_L(8); PG8_BAR; PG8_WAIT_L(0); PG8_MMA(0, 0, At, B0); PG8_BAR; PG8_SCHED;
            PG8_LDB(B1, 0, 1); PG8_STAGE(PG8_SB(0, 0), b2, voffB);
            PG8_BAR; PG8_WAIT_L(0); PG8_MMA(0, 1, At, B1); PG8_BAR;
            PG8_LDA(At, 0, 1); PG8_STAGE(PG8_SA(0, 0), a2, voffA);
            PG8_BAR; PG8_WAIT_L(0); PG8_MMA(1, 0, At, B0); PG8_BAR; PG8_SCHED;
            PG8_STAGE(PG8_SB(0, 1), b2 + hstep, voffB);
            PG8_WAIT_V(6); PG8_BAR; PG8_MMA(1, 1, At, B1); PG8_BAR;
            PG8_LDB(B0, 1, 0); PG8_SCHED; PG8_LDA(At, 1, 0); PG8_STAGE(PG8_SA(0, 1), a2 + hstep, voffA);
            PG8_WAIT_L(8); PG8_BAR; PG8_WAIT_L(0); PG8_MMA(0, 0, At, B0); PG8_BAR; PG8_SCHED;
            PG8_LDB(B1, 1, 1); PG8_STAGE(PG8_SB(1, 0), b3, voffB);
            PG8_BAR; PG8_WAIT_L(0); PG8_MMA(0, 1, At, B1); PG8_BAR;
            PG8_LDA(At, 1, 1); PG8_STAGE(PG8_SA(1, 0), a3, voffA);
            PG8_BAR; PG8_WAIT_L(0); PG8_MMA(1, 0, At, B0); PG8_BAR; PG8_SCHED;
            PG8_STAGE(PG8_SB(1, 1), b3 + hstep, voffB);
            PG8_WAIT_V(6); PG8_BAR; PG8_MMA(1, 1, At, B1); PG8_BAR;
        }
        PG8_STAMP();
        if constexpr (!Epi::AFTER_DRAIN) { E(acc, cur, wr, wc, fr, fq); S.done(cur); }
        PG8_STAMP();
        if (!has_next) break;
#pragma unroll
        for (int a = 0; a < 2; ++a)
#pragma unroll
            for (int b = 0; b < 2; ++b)
#pragma unroll
                for (int m = 0; m < 4; ++m)
#pragma unroll
                    for (int n = 0; n < 2; ++n) acc[a][b][m][n] = (f32x4){0.f, 0.f, 0.f, 0.f};
        cur = nxt; cA = nA; cB = nB; ++ui;
    }
    PG8_WAIT_V(0);
    if (wr == 0) PG8_BAR;
    PG8_BAR;
    if constexpr (Epi::AFTER_DRAIN) { E.fused(acc, cur, wr, wc, fr, fq, lds, wid, lane); S.done(cur); }
    PG8_STAMP();
    if (STAMP && wid == 0) { stamps[lane] = lane < nts ? (((unsigned long long)(unsigned)ts_hi << 32) | (unsigned)ts_lo) : 0ull;
        if (lane == 62) stamps[62] = rt_entry; if (lane == 63) stamps[63] = (unsigned long long)wall_clock64(); }
#undef PG8_STAMP
#undef PG8_SA
#undef PG8_SB
#undef PG8_STAGE
#undef PG8_LDA
#undef PG8_LDB
#undef PG8_MMA
#undef PG8_WAIT_V
#undef PG8_WAIT_L
#undef PG8_BAR
#undef PG8_SCHED
}
}
#define XB_TMO      128
#define XB_XCNT(j)  (256  + 64 * (j))
#define XB_XSUB(j)  (1280 + 64 * (j))
#define XB_XGEN(j)  (2304 + 64 * (j))
#define XB_TOP      3328
#define XB_TOPGEN   3392
#define XCD_BAR_WORDS 3456
#define XB_SPIN_CAP (1u << 18)
#define LAS __attribute__((address_space(3)))

__device__ __forceinline__ unsigned xb_ld(unsigned* p)              { return __hip_atomic_load(p, __ATOMIC_RELAXED, __HIP_MEMORY_SCOPE_AGENT); }
__device__ __forceinline__ unsigned xb_add(unsigned* p, unsigned v) { return __hip_atomic_fetch_add(p, v, __ATOMIC_RELAXED, __HIP_MEMORY_SCOPE_AGENT); }
__device__ __forceinline__ unsigned xb_xcc_id() { return (unsigned)__builtin_amdgcn_s_getreg((3 << 11) | 20) & 0xFu; }
#define XB_SPIN(cond, bar) do { unsigned _sp = 0; while (cond) { __builtin_amdgcn_s_sleep(1); \
    if ((++_sp & 255u) == 0u) { if (xb_ld(&(bar)[XB_TMO])) break; if (_sp > XB_SPIN_CAP) { atomicAdd(&(bar)[XB_TMO], 1u); break; } } } } while (0)

struct XcdBarrier {
    unsigned* bar; unsigned x;
    volatile LAS unsigned* st;
};

__device__ __forceinline__ XcdBarrier xcd_barrier_post(unsigned* bar, volatile LAS unsigned* st) {
    XcdBarrier b; b.bar = bar; b.x = xb_xcc_id(); b.st = st;
    if (threadIdx.x == 0) (void)xb_add(&bar[XB_XCNT(b.x)], 1u);
    return b;
}
__device__ __forceinline__ void xcd_barrier_complete(unsigned* bar, unsigned x, unsigned& nloc, unsigned& nx) {
    const unsigned G = gridDim.x * gridDim.y * gridDim.z;
    unsigned sum, cnt, mine, sp = 0u;
    for (;;) {
        sum = 0u; cnt = 0u; mine = 0u;
#pragma unroll
        for (unsigned j = 0; j < 16; ++j) { const unsigned c = xb_ld(&bar[XB_XCNT(j)]); sum += c; cnt += (c > 0u) ? 1u : 0u; mine = (j == x) ? c : mine; }
        if (sum == G) break;
        __builtin_amdgcn_s_sleep(1);
        if ((++sp & 255u) == 0u) { if (xb_ld(&bar[XB_TMO])) break; if (sp > XB_SPIN_CAP) { atomicAdd(&bar[XB_TMO], 1u); break; } }
    }
    nloc = mine > 0u ? mine : 1u; nx = cnt > 0u ? cnt : 1u;
}

__device__ __forceinline__ void xcd_barrier(const XcdBarrier& b) {
    asm volatile("s_waitcnt vmcnt(0)" ::: "memory");
    __syncthreads();
    if (threadIdx.x == 0) {
        unsigned* bar = b.bar;
        __builtin_amdgcn_s_waitcnt(0);
        unsigned nloc = b.st[0], nx = b.st[1];
        if (nloc == 0u) { xcd_barrier_complete(bar, b.x, nloc, nx); b.st[0] = nloc; b.st[1] = nx; }
        const unsigned old = xb_add(&bar[XB_XSUB(b.x)], 1u);
        const unsigned gen = old / nloc;
        if (old + 1u == (gen + 1u) * nloc) {
            __builtin_amdgcn_fence(__ATOMIC_RELEASE, "agent");
            asm volatile("s_waitcnt vmcnt(0)" ::: "memory");
            const unsigned og = xb_add(&bar[XB_TOP], 1u);
            const unsigned tg = og / nx;
            if (og + 1u == (tg + 1u) * nx) xb_add(&bar[XB_TOPGEN], 1u);
            else XB_SPIN(xb_ld(&bar[XB_TOPGEN]) == tg, bar);
            __builtin_amdgcn_fence(__ATOMIC_ACQUIRE, "agent");
            xb_add(&bar[XB_XGEN(b.x)], 1u);
            asm volatile("s_waitcnt vmcnt(0)" ::: "memory");
        } else {
            XB_SPIN(xb_ld(&bar[XB_XGEN(b.x)]) == gen, bar);
            __builtin_amdgcn_fence(__ATOMIC_ACQUIRE, "agent");
            asm volatile("s_waitcnt vmcnt(0)" ::: "memory");
        }
    }
    __syncthreads();
}

using pg8::f32x4;
using pg8::Unit;
typedef unsigned u32x4_t __attribute__((ext_vector_type(4)));
typedef unsigned u32x2_t __attribute__((ext_vector_type(2)));

struct SchedGrid {
    int nM, nN, pn0, G, c;
    __device__ __forceinline__ bool next(int i, Unit& u) const {
        const int L = i * G + c; if (L >= nM * nN) return false;
        u.pm = L / nN; u.pn = pn0 + (L - u.pm * nN); return true;
    }
    __device__ __forceinline__ void a_ready(const Unit&) const {}
    __device__ __forceinline__ void done(const Unit&) const {}
};
struct SchedMerge {
    int G, c;
    __device__ __forceinline__ bool next(int i, Unit& u) const {
        const int i3 = i / 3, n = i - i3 * 3, ti = i3 * G + c; if (ti >= NPANEL * 4) return false;
        u.pm = n * NPANEL + (ti >> 2); u.pn = n * 4 + (ti & 3); return true;
    }
    __device__ __forceinline__ void a_ready(const Unit&) const {}
    __device__ __forceinline__ void done(const Unit&) const {}
};
struct SchedMoe {
    int cum[17]; int G, c;
    __device__ __forceinline__ void init(const unsigned* cnt, int G_, int c_) {
        G = G_; c = c_; int s = 0;
#pragma unroll
        for (int e = 0; e < 16; ++e) { cum[e] = s; const unsigned n = __builtin_amdgcn_readfirstlane(cnt[e]); s += (int)((n + 255u) >> 8); }
        cum[16] = s;
    }
    __device__ __forceinline__ bool next(int i, Unit& u) const {
        const int L = i * G + c; if (L >= cum[16] * 4) return false;
        const int rt = L >> 2; int e = 0;
#pragma unroll
        for (int j = 1; j < 16; ++j) e += (rt >= cum[j]) ? 1 : 0;
        u.pm = rt; u.pn = e * 4 + (L & 3); return true;
    }
    __device__ __forceinline__ void a_ready(const Unit&) const {}
    __device__ __forceinline__ void done(const Unit&) const {}
};

__device__ __forceinline__ u32x4_t pack8(const f32x4& a, const f32x4& b) {
    u32x4_t r; r[0] = pk2(a[0], a[1]); r[1] = pk2(a[2], a[3]); r[2] = pk2(b[0], b[1]); r[3] = pk2(b[2], b[3]); return r;
}
struct EpiInProj {
    static constexpr bool PERM = true, AFTER_DRAIN = false;
    char* ws;
    __device__ __forceinline__ void operator()(const f32x4 (&acc)[2][2][4][2], const Unit& u, int wr, int wc, int fr, int fq) const {
        const int pn = u.pn; const int row0 = u.pm * 256 + wr * 64 + fr;
        if (pn == 6) {
            if (wc == 0) { float* gr = (float*)(ws + OFF_GR);
#pragma unroll
                for (int ai = 0; ai < 2; ++ai)
#pragma unroll
                    for (int m = 0; m < 4; ++m) { float* rp = gr + (size_t)(row0 + ai * 128 + m * 16) * 32 + 8 * fq;
                        *(f32x4*)(rp) = acc[ai][0][m][0]; *(f32x4*)(rp + 4) = acc[ai][0][m][1]; } }
            return;
        }
        size_t off; int ld, col0;
        if (pn == 0) { off = OFF_GQ; ld = 256; col0 = 0; }
        else if (pn == 1) { off = OFF_GK; ld = 256; col0 = 0; }
        else if (pn < 4) { off = OFF_GV; ld = 512; col0 = (pn - 2) * 256; }
        else if (pn < 6) { off = OFF_GG; ld = 512; col0 = (pn - 4) * 256; }
        else if (pn < 9) { off = OFF_DQ; ld = 512; col0 = (pn - 7) * 256; }
        else if (pn < 11) { off = OFF_DK; ld = 512; col0 = (pn - 9) * 256; }
        else if (pn < 13) { off = OFF_DV; ld = 512; col0 = (pn - 11) * 256; }
        else if (pn < 15) { off = OFF_NQ; ld = 512; col0 = (pn - 13) * 256; }
        else if (pn < 17) { off = OFF_NK; ld = 512; col0 = (pn - 15) * 256; }
        else { off = OFF_NV; ld = 512; col0 = (pn - 17) * 256; }
        bf16_t* base = (bf16_t*)(ws + off) + col0 + wc * 32 + 8 * fq;
#pragma unroll
        for (int ai = 0; ai < 2; ++ai)
#pragma unroll
            for (int m = 0; m < 4; ++m) { bf16_t* rp = base + (size_t)(row0 + ai * 128 + m * 16) * ld;
#pragma unroll
                for (int bj = 0; bj < 2; ++bj) *(u32x4_t*)(rp + bj * 128) = pack8(acc[ai][bj][m][0], acc[ai][bj][m][1]); }
    }
};
struct EpiGates {
    static constexpr bool PERM = true, AFTER_DRAIN = false;
    char* ws;
    __device__ __forceinline__ void operator()(const f32x4 (&acc)[2][2][4][2], const Unit& u, int wr, int wc, int fr, int fq) const {
        const int pl = u.pn - 19, n = pl >> 2, col0 = (pl & 3) * 256; const int row0 = u.pm * 256 + wr * 64 + fr;
        bf16_t* base = (bf16_t*)(ws + OFF_GATE) + (size_t)n * T * 1024 + col0 + wc * 32 + 8 * fq;
#pragma unroll
        for (int ai = 0; ai < 2; ++ai)
#pragma unroll
            for (int m = 0; m < 4; ++m) { bf16_t* rp = base + (size_t)(row0 + ai * 128 + m * 16) * 1024;
#pragma unroll
                for (int bj = 0; bj < 2; ++bj) { f32x4 a = acc[ai][bj][m][0], b = acc[ai][bj][m][1];
#pragma unroll
                    for (int j = 0; j < 4; ++j) { a[j] = sigmoidf_(a[j]); b[j] = sigmoidf_(b[j]); }
                    *(u32x4_t*)(rp + bj * 128) = pack8(a, b); } }
    }
};
struct EpiMerge {
    static constexpr bool PERM = true, AFTER_DRAIN = false;
    char* ws;
    __device__ __forceinline__ void operator()(const f32x4 (&acc)[2][2][4][2], const Unit& u, int wr, int wc, int fr, int fq) const {
        const int n = u.pm / NPANEL, pm = u.pm - n * NPANEL, pn = u.pn & 3; const int row0 = pm * 256 + wr * 64 + fr;
        const size_t cb = (size_t)pn * 256 + wc * 32 + 8 * fq;
        const bf16_t* gbase = (const bf16_t*)(ws + OFF_GATE) + (size_t)n * T * 1024 + cb;
        bf16_t* obase = (bf16_t*)(ws + OFF_H) + cb;
#pragma unroll
        for (int ai = 0; ai < 2; ++ai)
#pragma unroll
            for (int m = 0; m < 4; ++m) { const size_t ro = (size_t)(row0 + ai * 128 + m * 16) * 1024;
#pragma unroll
                for (int bj = 0; bj < 2; ++bj) {
                    const u32x4_t g = *(const u32x4_t*)(gbase + ro + bj * 128);
                    f32x4 a = acc[ai][bj][m][0], b = acc[ai][bj][m][1];
                    a[0] *= bflo(g[0]); a[1] *= bfhi(g[0]); a[2] *= bflo(g[1]); a[3] *= bfhi(g[1]);
                    b[0] *= bflo(g[2]); b[1] *= bfhi(g[2]); b[2] *= bflo(g[3]); b[3] *= bfhi(g[3]);
                    if (n > 0) { const u32x4_t o = *(const u32x4_t*)(obase + ro + bj * 128);
                        a[0] += bflo(o[0]); a[1] += bfhi(o[0]); a[2] += bflo(o[1]); a[3] += bfhi(o[1]);
                        b[0] += bflo(o[2]); b[1] += bfhi(o[2]); b[2] += bflo(o[3]); b[3] += bfhi(o[3]); }
                    *(u32x4_t*)(obase + ro + bj * 128) = pack8(a, b); } }
    }
};
struct EpiWo {
    static constexpr bool PERM = false, AFTER_DRAIN = false;
    char* ws; int layer;
    __device__ __forceinline__ void operator()(const f32x4 (&acc)[2][2][4][2], const Unit& u, int wr, int wc, int fr, int fq) const {
        const int b = u.pm / PB, slot = (u.pm - b * PB) == 0 ? 8 : b;
        const int row0 = u.pm * 256 + wr * 64 + fr, col0 = u.pn * 256 + wc * 32 + 4 * fq;
        const float* mg = (const float*)(ws + OFF_MOD) + ((size_t)(layer * 9 + slot) * 6 + 2) * 1024 + col0;
        float* xs = (float*)(ws + OFF_XS) + col0;
        f32x4 g[2][2];
#pragma unroll
        for (int bj = 0; bj < 2; ++bj)
#pragma unroll
            for (int n = 0; n < 2; ++n) g[bj][n] = *(const f32x4*)(mg + bj * 128 + n * 16);
#pragma unroll
        for (int ai = 0; ai < 2; ++ai)
#pragma unroll
            for (int m = 0; m < 4; ++m) { float* rp = xs + (size_t)(row0 + ai * 128 + m * 16) * 1024;
#pragma unroll
                for (int bj = 0; bj < 2; ++bj)
#pragma unroll
                    for (int n = 0; n < 2; ++n) { f32x4 x = *(const f32x4*)(rp + bj * 128 + n * 16);
                        *(f32x4*)(rp + bj * 128 + n * 16) = x * ALPHA + g[bj][n] * acc[ai][bj][m][n]; } }
    }
};
struct EpiUp {
    static constexpr bool PERM = true, AFTER_DRAIN = false;
    char* ws;
    __device__ __forceinline__ void operator()(const f32x4 (&acc)[2][2][4][2], const Unit& u, int wr, int wc, int fr, int fq) const {
        const int ct = u.pn & 3; const int row0 = u.pm * 256 + wr * 64 + fr;
        bf16_t* base = (bf16_t*)(ws + OFF_ACT) + ct * 128 + wc * 32 + 8 * fq;
#pragma unroll
        for (int ai = 0; ai < 2; ++ai)
#pragma unroll
            for (int m = 0; m < 4; ++m) { f32x4 a, b;
#pragma unroll
                for (int j = 0; j < 4; ++j) { a[j] = siluf_(acc[ai][0][m][0][j]) * acc[ai][1][m][0][j]; b[j] = siluf_(acc[ai][0][m][1][j]) * acc[ai][1][m][1][j]; }
                *(u32x4_t*)(base + (size_t)(row0 + ai * 128 + m * 16) * 512) = pack8(a, b); }
    }
};
struct EpiDown {
    static constexpr bool PERM = true, AFTER_DRAIN = false;
    char* ws;
    __device__ __forceinline__ void operator()(const f32x4 (&acc)[2][2][4][2], const Unit& u, int wr, int wc, int fr, int fq) const {
        const int ct = u.pn & 3; const int row0 = u.pm * 256 + wr * 64 + fr;
        bf16_t* base = (bf16_t*)(ws + OFF_Y) + ct * 256 + wc * 32 + 8 * fq;
#pragma unroll
        for (int ai = 0; ai < 2; ++ai)
#pragma unroll
            for (int m = 0; m < 4; ++m) { bf16_t* rp = base + (size_t)(row0 + ai * 128 + m * 16) * 1024;
#pragma unroll
                for (int bj = 0; bj < 2; ++bj) *(u32x4_t*)(rp + bj * 128) = pack8(acc[ai][bj][m][0], acc[ai][bj][m][1]); }
    }
};

#define GSTRIDE_BEGIN(var, n) for (long var = (long)blockIdx.x * blockDim.x + ltid(); var < (long)(n); var += (long)gridDim.x * blockDim.x)

__device__ __forceinline__ void phase_mod(const Params& p, float* lds) {
    const int tid = ltid();
    for (int i = tid; i < 9 * 1024; i += blockDim.x) { const int s = i >> 10, k = i & 1023; const float v = s < 8 ? p.in[I_C][s * 1024 + k] : p.in[I_CCTX][k]; lds[i] = siluf_(v); }
    __syncthreads();
    float* mod = (float*)(p.ws + OFF_MOD);
    GSTRIDE_BEGIN(idx, DEPTH * 6144) {
        const int l = (int)(idx / 6144), j = (int)(idx - (long)l * 6144);
        const float* w = p.in[I_WADA] + (size_t)l * 1024 * 6144 + j;
        float acc[9];
#pragma unroll
        for (int s = 0; s < 9; ++s) acc[s] = 0.f;
        for (int k = 0; k < 1024; ++k) { const float wv = w[(size_t)k * 6144];
#pragma unroll
            for (int s = 0; s < 9; ++s) acc[s] += lds[s * 1024 + k] * wv; }
        const float bv = p.in[I_BADA][l * 6144 + j];
#pragma unroll
        for (int s = 0; s < 9; ++s) mod[(size_t)(l * 9 + s) * 6144 + j] = acc[s] + bv;
    }
    float* rope = (float*)(p.ws + OFF_ROPE);
    GSTRIDE_BEGIN(idx, 4096 * 32) {
        const int t = (int)(idx >> 5), i = (int)(idx & 31);
        const float pos = (float)(i < 16 ? (t >> 6) : (t & 63));
        const float inv = powf(10000.0f, -(float)(i & 15) / 16.0f);
        const float ang = pos * inv;
        rope[idx * 2] = cosf(ang); rope[idx * 2 + 1] = sinf(ang);
    }
    __syncthreads();
}

__device__ __forceinline__ void phase_init(const Params& p) {
    const float* mod = (const float*)(p.ws + OFF_MOD);
    float* xs = (float*)(p.ws + OFF_XS); bf16_t* h = (bf16_t*)(p.ws + OFF_H);
    GSTRIDE_BEGIN(idx, (long)T * 256) {
        const int row = (int)(idx >> 8), c4 = (int)(idx & 255) * 4;
        const int b = row / LB, t = row - b * LB;
        const float* src = t < LC ? p.in[I_CTX] + ((size_t)(b * LC + t)) * 1024 : p.in[I_X] + ((size_t)(b * LL + (t - LC))) * 1024;
        const int slot = t < LC ? 8 : b;
        const f32x4 v = *(const f32x4*)(src + c4);
        const f32x4 sh = *(const f32x4*)(mod + (size_t)(slot * 6 + 0) * 1024 + c4), sc = *(const f32x4*)(mod + (size_t)(slot * 6 + 1) * 1024 + c4);
        *(f32x4*)(xs + (size_t)row * 1024 + c4) = v;
        const f32x4 hv = v * (sc + 1.0f) + sh;
        u32x2_t o; o[0] = pk2(hv[0], hv[1]); o[1] = pk2(hv[2], hv[3]);
        *(u32x2_t*)(h + (size_t)row * 1024 + c4) = o;
    }
}

__device__ __forceinline__ int winmap(int rho, float& scale) {
    scale = 1.f;
    if (rho < 1568) { if (rho < 256) scale = 0.125f; return rho; }
    if (rho < 1792) return -1;
    if (rho < 2304 || (rho >= 3328 && rho < 3840)) scale = 0.125f;
    return rho - 224;
}
__device__ __forceinline__ void convert_job(const float* src, const float* src2, int ld, int K, bf16_t* dst, int nrows, int mode, float* lds, int& tilectr) {
    const int tid = ltid(), ntk = K >> 6, ntiles = (nrows >> 6) * ntk;
    for (int ti = 0; ti < ntiles; ++ti, ++tilectr) {
        if ((tilectr % (int)gridDim.x) != (int)blockIdx.x) continue;
        const int rt = ti / ntk, kt = ti - rt * ntk, r0 = rt * 64, k0 = kt * 64;
        __syncthreads();
        { const int nn = tid & 63, rho = r0 + nn; float sc = 1.f; int col; const float* s = src;
          if (mode == 0) col = winmap(rho, sc);
          else if (mode == 1) col = rho;
          else { const int ct = rho >> 8, half = (rho >> 7) & 1, i = rho & 127; col = ct * 128 + i; s = half ? src2 : src; }
#pragma unroll
          for (int i = 0; i < 8; ++i) { const int kk = (tid >> 6) + 8 * i;
              const float v = col >= 0 ? s[(size_t)(k0 + kk) * ld + col] * sc : 0.f;
              lds[nn * 65 + kk] = v; } }
        __syncthreads();
        { const int nn = tid >> 3, k8 = (tid & 7) * 8; const float* lp = lds + nn * 65 + k8;
          u32x4_t o; o[0] = pk2(lp[0], lp[1]); o[1] = pk2(lp[2], lp[3]); o[2] = pk2(lp[4], lp[5]); o[3] = pk2(lp[6], lp[7]);
          *(u32x4_t*)(dst + (size_t)(r0 + nn) * K + k0 + k8) = o; }
    }
}
__device__ __forceinline__ void phase_convert(const Params& p, int l, float* lds) {
    int ctr = 0;
    convert_job(p.in[I_WIN] + (size_t)l * 1024 * 7712, nullptr, 7712, 1024, (bf16_t*)(p.ws + OFF_WIN), (int)W_IN_ROWS, 0, lds, ctr);
    for (int n = 0; n < 3; ++n)
        convert_job(p.in[I_WBR] + ((size_t)l * 3 + n) * 512 * 1024, nullptr, 1024, 512, (bf16_t*)(p.ws + OFF_WB) + (size_t)n * 1024 * 512, 1024, 1, lds, ctr);
    convert_job(p.in[I_WO] + (size_t)l * 1024 * 1024, nullptr, 1024, 1024, (bf16_t*)(p.ws + OFF_WO), 1024, 1, lds, ctr);
    for (int e = 0; e < 16; ++e) {
        const size_t eo = ((size_t)l * 16 + e) * 1024 * 512;
        convert_job(p.in[I_WEG] + eo, p.in[I_WEU] + eo, 512, 1024, (bf16_t*)(p.ws + OFF_WUP) + (size_t)e * 1024 * 1024, 1024, 2, lds, ctr);
        convert_job(p.in[I_WED] + eo, nullptr, 1024, 512, (bf16_t*)(p.ws + OFF_WDN) + (size_t)e * 1024 * 512, 1024, 1, lds, ctr);
    }
    __syncthreads();
}

__device__ __forceinline__ void phase_rope_decay(const Params& p, int l) {
    const float* rope = (const float*)(p.ws + OFF_ROPE);
    GSTRIDE_BEGIN(idx, (long)NB * LL * 2 * 8 * 8) {
        const int i4 = (int)(idx & 7) * 4, hc = (int)(idx >> 3) & 7, which = (int)(idx >> 6) & 1; const int lat = (int)(idx >> 7);
        const int b = lat >> 12, t = lat & 4095; const int row = b * LB + LC + t;
        bf16_t* base = (bf16_t*)(p.ws + (which ? OFF_DK : OFF_DQ)) + (size_t)row * 512 + hc * 64 + i4;
        const u32x2_t a = *(const u32x2_t*)base, bq = *(const u32x2_t*)(base + 32);
        const float x1[4] = {bflo(a[0]), bfhi(a[0]), bflo(a[1]), bfhi(a[1])}, x2[4] = {bflo(bq[0]), bfhi(bq[0]), bflo(bq[1]), bfhi(bq[1])};
        float y1[4], y2[4];
#pragma unroll
        for (int j = 0; j < 4; ++j) { const float cs = rope[((size_t)t * 32 + i4 + j) * 2], sn = rope[((size_t)t * 32 + i4 + j) * 2 + 1];
            y1[j] = x1[j] * cs - x2[j] * sn; y2[j] = x1[j] * sn + x2[j] * cs; }
        u32x2_t o1, o2; o1[0] = pk2(y1[0], y1[1]); o1[1] = pk2(y1[2], y1[3]); o2[0] = pk2(y2[0], y2[1]); o2[1] = pk2(y2[2], y2[3]);
        *(u32x2_t*)base = o1; *(u32x2_t*)(base + 32) = o2;
    }
    const float* gr = (const float*)(p.ws + OFF_GR); float* dec = (float*)(p.ws + OFF_S1);
    const float* wd = p.in[I_GWD] + (size_t)l * 2 * 16 * 256; const float* bd = p.in[I_GBD] + (size_t)l * 2 * 256;
    GSTRIDE_BEGIN(idx, (long)T * 512) {
        const int row = (int)(idx >> 9), dj = (int)(idx & 511), dir = dj >> 8, j = dj & 255;
        float z = bd[dir * 256 + j];
#pragma unroll
        for (int r = 0; r < 16; ++r) z += gr[(size_t)row * 32 + dir * 16 + r] * wd[(dir * 16 + r) * 256 + j];
        const float ls = fminf(z, 0.f) - log1pf(__expf(-fabsf(z)));
        dec[idx] = __expf(ls * (1.0f / 16.0f));
    }
}

template <int DIR>
__device__ __forceinline__ void gla_naive_dir(const Params& p, int l, int b, float* lds) {
    const int tid = ltid(), hh = tid >> 7, vc = tid & 127, wv = tid >> 6;
    const bf16_t* GQ = (const bf16_t*)(p.ws + OFF_GQ); const bf16_t* GK = (const bf16_t*)(p.ws + OFF_GK); const bf16_t* GV = (const bf16_t*)(p.ws + OFF_GV);
    bf16_t* GG = (bf16_t*)(p.ws + OFF_GG); const float* DEC = (const float*)(p.ws + OFF_S1); float* OF = (float*)(p.ws + OFF_S2);
    float* sq = lds; float* sk = lds + 16 * 256; float* sd = lds + 32 * 256; float* red = lds + 48 * 256;
    float* sv = lds + 49 * 256;
    const float gn = p.in[I_GNG][l * 128 + vc];
    const int row0 = b * LB;
    float S[64];
#pragma unroll
    for (int d = 0; d < 64; ++d) S[d] = 0.f;
    for (int blk = 0; blk < LB / 16; ++blk) {
        int t0;
        if (DIR == 0) t0 = blk * 16; else t0 = blk < 16 ? (15 - blk) * 16 : (LB / 16 - 1 - (blk - 16)) * 16;
        __syncthreads();
        for (int i = tid; i < 16 * 256; i += 512) { const int r = i >> 8, j = i & 255; const size_t row = row0 + t0 + r;
            sq[i] = bf2f(GQ[row * 256 + j]); sk[i] = bf2f(GK[row * 256 + j]); sd[i] = DEC[(row * 2 + DIR) * 256 + j]; }
#pragma unroll 1
        for (int r = 0; r < 16; ++r) sv[r * 512 + tid] = bf2f(GV[(size_t)(row0 + t0 + r) * 512 + hh * 128 + vc]);
        __syncthreads();
#pragma unroll 1
        for (int rr = 0; rr < 16; ++rr) {
            const int r = DIR == 0 ? rr : 15 - rr;
            const float* pq = sq + r * 256 + hh * 64; const float* pk = sk + r * 256 + hh * 64; const float* pd = sd + r * 256 + hh * 64;
            const float vr = sv[r * 512 + tid];
            float o = 0.f;
#pragma unroll
            for (int d = 0; d < 64; ++d) { S[d] = pd[d] * S[d] + pk[d] * vr; o += pq[d] * S[d]; }
            const size_t oi = (size_t)(row0 + t0 + r) * 512 + hh * 128 + vc;
            if (DIR == 0) OF[oi] = o;
            else {
                const float tot = o + OF[oi];
                sv[r * 512 + tid] = tot;
                const float ss = wave_sum(tot * tot); if ((tid & 63) == 0) red[r * 8 + wv] = ss;
            }
        }
        if (DIR == 1) {
            __syncthreads();
#pragma unroll 1
            for (int r = 0; r < 16; ++r) {
                const float ms = (red[r * 8 + hh * 2] + red[r * 8 + hh * 2 + 1]) * (1.0f / 128.0f);
                const size_t gi = (size_t)(row0 + t0 + r) * 512 + hh * 128 + vc;
                const float gate = bf2f(GG[gi]);
                GG[gi] = f2bf(sv[r * 512 + tid] * rsqrtf(ms + RMS_EPS) * gn * siluf_(gate));
            }
        }
    }
    __syncthreads();
}
__device__ __forceinline__ void gla_naive_batch(const Params& p, int l, int b, float* lds) {
    gla_naive_dir<0>(p, l, b, lds);
    gla_naive_dir<1>(p, l, b, lds);
}

__device__ __forceinline__ void diff_naive_tile(const Params& p, int l, int unit, float* lds) {
    const int tid = ltid(), qi = tid & 127, c = (tid >> 7) & 1, hv = tid >> 8;
    const int qt = unit % 34, bh = unit / 34, hh = bh & 3, b = bh >> 2;
    const int nkeys = qt < 2 ? LC : LB;
    const size_t rowq = (size_t)b * LB + qt * 128 + qi;
    bf16_t* DQ = (bf16_t*)(p.ws + OFF_DQ); const bf16_t* DK = (const bf16_t*)(p.ws + OFF_DK); const bf16_t* DV = (const bf16_t*)(p.ws + OFF_DV);
    float q[64], o[64];
    { const bf16_t* qp = DQ + rowq * 512 + hh * 128 + c * 64;
#pragma unroll
      for (int d8 = 0; d8 < 8; ++d8) { const u32x4_t v = *(const u32x4_t*)(qp + d8 * 8);
#pragma unroll
          for (int j = 0; j < 4; ++j) { q[d8 * 8 + 2 * j] = bflo(v[j]); q[d8 * 8 + 2 * j + 1] = bfhi(v[j]); } } }
#pragma unroll
    for (int d = 0; d < 64; ++d) o[d] = 0.f;
    float m = -INFINITY, lsum = 0.f;
    constexpr int KT = 8; float* kb = lds; float* vb = lds + KT * 128;
    for (int k0 = 0; k0 < nkeys; k0 += KT) {
        __syncthreads();
        for (int i = tid; i < KT * 128; i += 512) { const int r = i >> 7, j = i & 127; const size_t row = (size_t)b * LB + k0 + r;
            kb[i] = bf2f(DK[row * 512 + hh * 128 + j]); vb[i] = bf2f(DV[row * 512 + hh * 128 + j]); }
        __syncthreads();
        float s[KT]; float mt = -INFINITY;
#pragma unroll
        for (int j = 0; j < KT; ++j) { const float* kp = kb + j * 128 + c * 64; float a = 0.f;
#pragma unroll
            for (int d = 0; d < 64; ++d) a += q[d] * kp[d];
            s[j] = a; mt = fmaxf(mt, a); }
        const float mn = fmaxf(m, mt), corr = __expf(m - mn);
        lsum *= corr;
#pragma unroll
        for (int d = 0; d < 64; ++d) o[d] *= corr;
#pragma unroll
        for (int j = 0; j < KT; ++j) { const float pj = __expf(s[j] - mn); lsum += pj; const float* vp = vb + j * 128 + hv * 64;
#pragma unroll
            for (int d = 0; d < 64; ++d) o[d] += pj * vp[d]; }
        m = mn;
    }
    __syncthreads();
    { const float inv = 1.f / lsum; float* cp = lds + ((size_t)qi * 2 + c) * 128 + hv * 64;
#pragma unroll
      for (int d = 0; d < 64; ++d) cp[d] = o[d] * inv; }
    __syncthreads();
    {
        float dq = 0.f, dk2 = 0.f; const float* lq = p.in[I_LQ] + l * 128; const float* lk = p.in[I_LK] + l * 128;
        for (int d = 0; d < 64; ++d) { dq += lq[d] * lk[d]; dk2 += lq[64 + d] * lk[64 + d]; }
        const float lam_init = 0.8f - 0.6f * expf(-0.3f * (float)l);
        const float lam = expf(dq) - expf(dk2) + lam_init;
        const int q2 = tid >> 2, part = tid & 3;
        const float* c0 = lds + ((size_t)q2 * 2) * 128 + part * 32; const float* c1 = c0 + 128;
        float v[32]; float ss = 0.f;
#pragma unroll
        for (int d = 0; d < 32; ++d) { v[d] = c0[d] - lam * c1[d]; ss += v[d] * v[d]; }
        ss += __shfl_xor(ss, 1); ss += __shfl_xor(ss, 2);
        const float sc = rsqrtf(ss * (1.0f / 128.0f) + RMS_EPS) * (1.0f - lam_init);
        const float* g = p.in[I_DNG] + l * 128 + part * 32;
        bf16_t* op = DQ + ((size_t)b * LB + qt * 128 + q2) * 512 + hh * 128 + part * 32;
#pragma unroll
        for (int d = 0; d < 32; d += 2) *(unsigned*)(op + d) = pk2(v[d] * sc * g[d], v[d + 1] * sc * g[d + 1]);
    }
    __syncthreads();
}

__device__ __forceinline__ void na_naive_unit(const Params& p, int l, int unit) {
    const int tid = ltid(), h = tid >> 6, lane = tid & 63;
    const size_t row = (size_t)unit * 64 + lane; const int b = (int)(row / LB), t = (int)(row - (size_t)b * LB);
    bf16_t* NQ = (bf16_t*)(p.ws + OFF_NQ); const bf16_t* NK = (const bf16_t*)(p.ws + OFF_NK); const bf16_t* NV = (const bf16_t*)(p.ws + OFF_NV);
    const float* rpb = p.in[I_RPB] + ((size_t)l * 8 + h) * 15 * 31;
    float q[64], o[64];
    { const bf16_t* qp = NQ + row * 512 + h * 64;
#pragma unroll
      for (int d8 = 0; d8 < 8; ++d8) { const u32x4_t v = *(const u32x4_t*)(qp + d8 * 8);
#pragma unroll
          for (int j = 0; j < 4; ++j) { q[d8 * 8 + 2 * j] = bflo(v[j]); q[d8 * 8 + 2 * j + 1] = bfhi(v[j]); } } }
#pragma unroll
    for (int d = 0; d < 64; ++d) o[d] = 0.f;
    float m = -INFINITY, lsum = 0.f;
    const bool lat = t >= LC; const int tp = t - LC, r = tp >> 6, qc = tp & 63;
    const int rs = min(max(r - 4, 0), 56), cs = min(max(qc - 8, 0), 48);
    const int nloc = lat ? 128 : 0;
    for (int kk = 0; kk < nloc + LC; ++kk) {
        size_t krow; float bias = 0.f;
        if (kk < nloc) { const int kr = rs + (kk >> 4), kc = cs + (kk & 15); krow = (size_t)b * LB + LC + kr * 64 + kc; bias = rpb[(kr - r + 7) * 31 + (kc - qc + 15)]; }
        else krow = (size_t)b * LB + (kk - nloc);
        const bf16_t* kp = NK + krow * 512 + h * 64; const bf16_t* vp = NV + krow * 512 + h * 64;
        float s = bias;
#pragma unroll
        for (int d8 = 0; d8 < 8; ++d8) { const u32x4_t v = *(const u32x4_t*)(kp + d8 * 8);
#pragma unroll
            for (int j = 0; j < 4; ++j) { s += q[d8 * 8 + 2 * j] * bflo(v[j]); s += q[d8 * 8 + 2 * j + 1] * bfhi(v[j]); } }
        const float mn = fmaxf(m, s), corr = __expf(m - mn), pj = __expf(s - mn);
        lsum = lsum * corr + pj; m = mn;
#pragma unroll
        for (int d8 = 0; d8 < 8; ++d8) { const u32x4_t v = *(const u32x4_t*)(vp + d8 * 8);
#pragma unroll
            for (int j = 0; j < 4; ++j) { o[d8 * 8 + 2 * j] = o[d8 * 8 + 2 * j] * corr + pj * bflo(v[j]); o[d8 * 8 + 2 * j + 1] = o[d8 * 8 + 2 * j + 1] * corr + pj * bfhi(v[j]); } }
    }
    const float inv = 1.f / lsum;
    bf16_t* op = NQ + row * 512 + h * 64;
#pragma unroll
    for (int d8 = 0; d8 < 8; ++d8) { u32x4_t v;
#pragma unroll
        for (int j = 0; j < 4; ++j) v[j] = pk2(o[d8 * 8 + 2 * j] * inv, o[d8 * 8 + 2 * j + 1] * inv);
        *(u32x4_t*)(op + d8 * 8) = v; }
}

__device__ __forceinline__ void ln_row(float (&v)[16], const float* g, const float* bb, int lane) {
    float s = 0.f;
#pragma unroll
    for (int i = 0; i < 16; ++i) s += v[i];
    const float mu = wave_sum(s) * (1.0f / 1024.0f);
    float q = 0.f;
#pragma unroll
    for (int i = 0; i < 16; ++i) { v[i] -= mu; q += v[i] * v[i]; }
    const float rstd = rsqrtf(wave_sum(q) * (1.0f / 1024.0f) + LN_EPS);
#pragma unroll
    for (int i = 0; i < 4; ++i) { const f32x4 gv = *(const f32x4*)(g + i * 256 + lane * 4), bv = *(const f32x4*)(bb + i * 256 + lane * 4);
#pragma unroll
        for (int j = 0; j < 4; ++j) v[i * 4 + j] = v[i * 4 + j] * rstd * gv[j] + bv[j]; }
}

__device__ __forceinline__ void top2of4(const float s0, const float s1, const float s2, const float s3, int& i1, int& i2, float& sum) {
    i1 = 0; float m1 = s0;
    if (s1 > m1) { m1 = s1; i1 = 1; } if (s2 > m1) { m1 = s2; i1 = 2; } if (s3 > m1) { m1 = s3; i1 = 3; }
    float m2 = -INFINITY; i2 = 0;
    if (i1 != 0 && s0 > m2) { m2 = s0; i2 = 0; } if (i1 != 1 && s1 > m2) { m2 = s1; i2 = 1; }
    if (i1 != 2 && s2 > m2) { m2 = s2; i2 = 2; } if (i1 != 3 && s3 > m2) { m2 = s3; i2 = 3; }
    sum = m1 + m2;
}

__device__ __forceinline__ void phase_ln1_router(const Params& p, int l) {
    const int lane = ltid() & 63, wv = ltid() >> 6, wpb = blockDim.x >> 6;
    float* xs = (float*)(p.ws + OFF_XS); bf16_t* h = (bf16_t*)(p.ws + OFF_H); const float* mod = (const float*)(p.ws + OFF_MOD);
    int* tok = (int*)(p.ws + OFF_TOK); unsigned* cnt = (unsigned*)(p.ws + OFF_CNT) + l * 16;
    const float* g = p.in[I_LNG] + (size_t)(l * 2 + 0) * 1024; const float* bb = p.in[I_LNB] + (size_t)(l * 2 + 0) * 1024;
    const float* wr = p.in[I_WR]; const float* br = p.in[I_BR];
    for (int row = blockIdx.x * wpb + wv; row < T; row += gridDim.x * wpb) {
        const int slot = row_slot(row);
        const float* msh = mod + ((size_t)(l * 9 + slot) * 6 + 3) * 1024; const float* msc = msh + 1024;
        float v[16];
#pragma unroll
        for (int i = 0; i < 4; ++i) { const f32x4 t4 = *(const f32x4*)(xs + (size_t)row * 1024 + i * 256 + lane * 4);
#pragma unroll
            for (int j = 0; j < 4; ++j) v[i * 4 + j] = t4[j]; }
        ln_row(v, g, bb, lane);
        float lg[16];
#pragma unroll
        for (int e = 0; e < 16; ++e) lg[e] = 0.f;
#pragma unroll
        for (int i = 0; i < 4; ++i) {
            const int c0 = i * 256 + lane * 4;
            f32x4 x4; x4[0] = v[i * 4]; x4[1] = v[i * 4 + 1]; x4[2] = v[i * 4 + 2]; x4[3] = v[i * 4 + 3];
            *(f32x4*)(xs + (size_t)row * 1024 + c0) = x4;
            const f32x4 sh = *(const f32x4*)(msh + c0), sc = *(const f32x4*)(msc + c0);
            const f32x4 hv = x4 * (sc + 1.0f) + sh;
            u32x2_t o; o[0] = pk2(hv[0], hv[1]); o[1] = pk2(hv[2], hv[3]);
            *(u32x2_t*)(h + (size_t)row * 1024 + c0) = o;
#pragma unroll
            for (int j = 0; j < 4; ++j) { const float* wp = wr + (size_t)(c0 + j) * 16;
#pragma unroll
                for (int e4 = 0; e4 < 4; ++e4) { const f32x4 w4 = *(const f32x4*)(wp + e4 * 4);
#pragma unroll
                    for (int k = 0; k < 4; ++k) lg[e4 * 4 + k] += hv[j] * w4[k]; } }
        }
        float aff[16], sel[16];
#pragma unroll
        for (int e = 0; e < 16; ++e) { lg[e] = wave_sum(lg[e]); aff[e] = sigmoidf_(lg[e]); sel[e] = aff[e] + br[e]; }
        int bi1 = 0, bi2 = 0, bg = 0; float best = -INFINITY;
#pragma unroll
        for (int gq = 0; gq < 4; ++gq) { int i1, i2; float sm; top2of4(sel[gq * 4], sel[gq * 4 + 1], sel[gq * 4 + 2], sel[gq * 4 + 3], i1, i2, sm);
            if (sm > best) { best = sm; bg = gq; bi1 = i1; bi2 = i2; } }
        const int e1 = bg * 4 + bi1, e2 = bg * 4 + bi2;
        float a1 = 0.f, a2 = 0.f;
#pragma unroll
        for (int e = 0; e < 16; ++e) { a1 = (e == e1) ? aff[e] : a1; a2 = (e == e2) ? aff[e] : a2; }
        const float inv = 1.f / (a1 + a2);
        if (lane == 0) {
            const unsigned s1 = atomicAdd(cnt + e1, 1u), s2 = atomicAdd(cnt + e2, 1u);
            int* tp = tok + (size_t)row * 8;
            tp[0] = e1; tp[1] = e2; tp[2] = (int)s1; tp[3] = (int)s2; tp[4] = __float_as_int(a1 * inv); tp[5] = __float_as_int(a2 * inv);
        }
    }
}

__device__ __forceinline__ void phase_gather(const Params& p, int l) {
    const int lane = ltid() & 63, wv = ltid() >> 6, wpb = blockDim.x >> 6;
    const unsigned* cnt = (const unsigned*)(p.ws + OFF_CNT) + l * 16;
    int base[16]; { int s = 0;
#pragma unroll
        for (int e = 0; e < 16; ++e) { base[e] = s; s += (int)((cnt[e] + 255u) >> 8) * 256; } }
    const bf16_t* h = (const bf16_t*)(p.ws + OFF_H); bf16_t* xa = (bf16_t*)(p.ws + OFF_XA); int* tok = (int*)(p.ws + OFF_TOK);
    for (int row = blockIdx.x * wpb + wv; row < T; row += gridDim.x * wpb) {
        int* tp = tok + (size_t)row * 8;
        const int e1 = tp[0], e2 = tp[1], s1 = tp[2], s2 = tp[3];
        int b1 = 0, b2 = 0;
#pragma unroll
        for (int e = 0; e < 16; ++e) { b1 = (e == e1) ? base[e] : b1; b2 = (e == e2) ? base[e] : b2; }
        const int p1 = b1 + s1, p2 = b2 + s2;
        const u32x4_t v0 = *(const u32x4_t*)(h + (size_t)row * 1024 + lane * 8), v1 = *(const u32x4_t*)(h + (size_t)row * 1024 + 512 + lane * 8);
        *(u32x4_t*)(xa + (size_t)p1 * 1024 + lane * 8) = v0; *(u32x4_t*)(xa + (size_t)p1 * 1024 + 512 + lane * 8) = v1;
        *(u32x4_t*)(xa + (size_t)p2 * 1024 + lane * 8) = v0; *(u32x4_t*)(xa + (size_t)p2 * 1024 + 512 + lane * 8) = v1;
        if (lane == 0) { tp[6] = p1; tp[7] = p2; }
    }
}

__device__ __forceinline__ void phase_ln2(const Params& p, int l) {
    const int lane = ltid() & 63, wv = ltid() >> 6, wpb = blockDim.x >> 6;
    float* xs = (float*)(p.ws + OFF_XS); bf16_t* h = (bf16_t*)(p.ws + OFF_H); const float* mod = (const float*)(p.ws + OFF_MOD);
    const int* tok = (const int*)(p.ws + OFF_TOK); const bf16_t* y = (const bf16_t*)(p.ws + OFF_Y);
    const float* g = p.in[I_LNG] + (size_t)(l * 2 + 1) * 1024; const float* bb = p.in[I_LNB] + (size_t)(l * 2 + 1) * 1024;
    for (int row = blockIdx.x * wpb + wv; row < T; row += gridDim.x * wpb) {
        const int slot = row_slot(row);
        const int* tp = tok + (size_t)row * 8;
        const float w0 = __int_as_float(tp[4]), w1 = __int_as_float(tp[5]); const size_t p0 = (size_t)tp[6], p1 = (size_t)tp[7];
        const float* mg = mod + ((size_t)(l * 9 + slot) * 6 + 5) * 1024;
        float v[16];
#pragma unroll
        for (int i = 0; i < 4; ++i) { const int c0 = i * 256 + lane * 4;
            const f32x4 x4 = *(const f32x4*)(xs + (size_t)row * 1024 + c0), g4 = *(const f32x4*)(mg + c0);
            const u32x2_t ya = *(const u32x2_t*)(y + p0 * 1024 + c0), yb = *(const u32x2_t*)(y + p1 * 1024 + c0);
            v[i * 4 + 0] = ALPHA * x4[0] + g4[0] * (w0 * bflo(ya[0]) + w1 * bflo(yb[0]));
            v[i * 4 + 1] = ALPHA * x4[1] + g4[1] * (w0 * bfhi(ya[0]) + w1 * bfhi(yb[0]));
            v[i * 4 + 2] = ALPHA * x4[2] + g4[2] * (w0 * bflo(ya[1]) + w1 * bflo(yb[1]));
            v[i * 4 + 3] = ALPHA * x4[3] + g4[3] * (w0 * bfhi(ya[1]) + w1 * bfhi(yb[1])); }
        ln_row(v, g, bb, lane);
        const int b = row / LB, t = row - b * LB;
        if (l == DEPTH - 1) {
            if (t >= LC) { float* op = p.out + ((size_t)b * LL + (t - LC)) * 1024;
#pragma unroll
                for (int i = 0; i < 4; ++i) { f32x4 x4; x4[0] = v[i * 4]; x4[1] = v[i * 4 + 1]; x4[2] = v[i * 4 + 2]; x4[3] = v[i * 4 + 3]; *(f32x4*)(op + i * 256 + lane * 4) = x4; } }
        } else {
            const float* msh = mod + ((size_t)((l + 1) * 9 + slot) * 6 + 0) * 1024; const float* msc = msh + 1024;
#pragma unroll
            for (int i = 0; i < 4; ++i) { const int c0 = i * 256 + lane * 4;
                f32x4 x4; x4[0] = v[i * 4]; x4[1] = v[i * 4 + 1]; x4[2] = v[i * 4 + 2]; x4[3] = v[i * 4 + 3];
                *(f32x4*)(xs + (size_t)row * 1024 + c0) = x4;
                const f32x4 sh = *(const f32x4*)(msh + c0), sc = *(const f32x4*)(msc + c0);
                const f32x4 hv = x4 * (sc + 1.0f) + sh;
                u32x2_t o; o[0] = pk2(hv[0], hv[1]); o[1] = pk2(hv[2], hv[3]);
                *(u32x2_t*)(h + (size_t)row * 1024 + c0) = o; }
        }
    }
}

typedef float f32x16 __attribute__((ext_vector_type(16)));
typedef short bf16x8_t __attribute__((ext_vector_type(8)));
constexpr float LOG2E = 1.4426950408889634f;

__device__ __forceinline__ void phase_vtrans(const Params& p, bf16_t* lds) {
    const int tid = ltid();
    const bf16_t* DV = (const bf16_t*)(p.ws + OFF_DV); bf16_t* VT = (bf16_t*)(p.ws + OFF_VT);
    constexpr int LS = 72;
    for (int it = blockIdx.x; it < NB * 4 * (LB / 64) * 2; it += gridDim.x) {
        const int dh = it & 1, kt = (it >> 1) % (LB / 64), bh = (it >> 1) / (LB / 64), hh = bh & 3, b = bh >> 2;
        __syncthreads();
        { const int key = tid >> 3, d8 = (tid & 7) * 8;
          const u32x4_t v = *(const u32x4_t*)(DV + ((size_t)b * LB + kt * 64 + key) * 512 + hh * 128 + dh * 64 + d8);
#pragma unroll
          for (int j = 0; j < 4; ++j) { lds[(d8 + 2 * j) * LS + key] = (bf16_t)(v[j] & 0xffffu); lds[(d8 + 2 * j + 1) * LS + key] = (bf16_t)(v[j] >> 16); } }
        __syncthreads();
        { const int dv = tid >> 3, k8 = (tid & 7) * 8;
          const u32x4_t v = *(const u32x4_t*)(lds + dv * LS + k8);
          *(u32x4_t*)(VT + ((size_t)(bh * 128 + dh * 64 + dv)) * LB + kt * 64 + k8) = v; }
    }
    __syncthreads();
}

constexpr int DA_KS = 272, DA_VS = 136, DA_KB = 64 * DA_KS  , DA_VB = 128 * DA_VS  ;
constexpr int DA_UNITS = NB * 4 * 34;
__device__ __forceinline__ void diff_attn_unit(const Params& p, int l, int unit, unsigned char* shm) {
    const int tid = ltid(), lane = tid & 63, wid = tid >> 6, c = wid & 1, qb = wid >> 1, m32 = lane & 31, h = lane >> 5;
    int bh, qt;
    if (unit < NB * 4 * 32) { bh = unit >> 5; qt = 2 + (unit & 31); } else { const int u2 = unit - NB * 4 * 32; bh = u2 >> 1; qt = u2 & 1; }
    const int hh = bh & 3, b = bh >> 2, nkt = qt < 2 ? LC / 64 : LB / 64;
    const size_t rowb = (size_t)b * LB;
    bf16_t* DQ = (bf16_t*)(p.ws + OFF_DQ); const bf16_t* DK = (const bf16_t*)(p.ws + OFF_DK); const bf16_t* VT = (const bf16_t*)(p.ws + OFF_VT);
    const size_t qrow = rowb + qt * 128 + qb * 32 + m32;
    bf16x8_t qf[4];
#pragma unroll
    for (int s = 0; s < 4; ++s) qf[s] = *(const bf16x8_t*)(DQ + qrow * 512 + hh * 128 + c * 64 + 16 * s + 8 * h);
    f32x16 O[4];
#pragma unroll
    for (int d = 0; d < 4; ++d)
#pragma unroll
        for (int r = 0; r < 16; ++r) O[d][r] = 0.f;
    float mrun = -INFINITY, lrun = 0.f;
    const bf16_t* kg[2]; const bf16_t* vg[2]; int kl[2], vl[2];
#pragma unroll
    for (int j = 0; j < 2; ++j) { const int i = tid + j * 512;
        kg[j] = DK + (rowb + (i >> 4)) * 512 + hh * 128 + (i & 15) * 8; kl[j] = (i >> 4) * DA_KS + (i & 15) * 16;
        vg[j] = VT + ((size_t)(bh * 128 + (i >> 3))) * LB + (i & 7) * 8; vl[j] = 2 * DA_KB + (i >> 3) * DA_VS + (i & 7) * 16; }
    u32x4_t rk[2], rv[2];
    __syncthreads();
#pragma unroll
    for (int j = 0; j < 2; ++j) { rk[j] = *(const u32x4_t*)(kg[j]); rv[j] = *(const u32x4_t*)(vg[j]); }
#pragma unroll
    for (int j = 0; j < 2; ++j) { *(u32x4_t*)(shm + kl[j]) = rk[j]; u32x2_t a, bq; a[0] = rv[j][0]; a[1] = rv[j][1]; bq[0] = rv[j][2]; bq[1] = rv[j][3];
        *(u32x2_t*)(shm + vl[j]) = a; *(u32x2_t*)(shm + vl[j] + 8) = bq; }
    __syncthreads();
    for (int kt = 0; kt < nkt; ++kt) {
        const int buf = kt & 1; const bool more = kt + 1 < nkt;
        if (more) {
#pragma unroll
            for (int j = 0; j < 2; ++j) { rk[j] = *(const u32x4_t*)(kg[j] + (size_t)(kt + 1) * 64 * 512); rv[j] = *(const u32x4_t*)(vg[j] + (kt + 1) * 64); }
        }
        const unsigned char* kbase = shm + buf * DA_KB + m32 * DA_KS + (c * 64 + 8 * h) * 2;
        const unsigned char* vbase = shm + 2 * DA_KB + buf * DA_VB + m32 * DA_VS + 8 * h;
        bf16x8_t pf[4];
        {
            f32x16 S[2];
#pragma unroll
            for (int kb = 0; kb < 2; ++kb) {
#pragma unroll
                for (int r = 0; r < 16; ++r) S[kb][r] = 0.f;
#pragma unroll
                for (int s = 0; s < 4; ++s) { const bf16x8_t kf = *(const bf16x8_t*)(kbase + kb * 32 * DA_KS + s * 32);
                    S[kb] = __builtin_amdgcn_mfma_f32_32x32x16_bf16(kf, qf[s], S[kb], 0, 0, 0); }
            }
            float mx = S[0][0];
#pragma unroll
            for (int r = 1; r < 16; ++r) mx = fmaxf(mx, S[0][r]);
#pragma unroll
            for (int r = 0; r < 16; ++r) mx = fmaxf(mx, S[1][r]);
            mx = fmaxf(mx, __shfl_xor(mx, 32));
            const float mn = fmaxf(mrun, mx), corr = __builtin_amdgcn_exp2f((mrun - mn) * LOG2E), mnl = mn * LOG2E;
            mrun = mn;
            float sum = 0.f;
#pragma unroll
            for (int kb = 0; kb < 2; ++kb)
#pragma unroll
                for (int r = 0; r < 16; ++r) { const float e = __builtin_amdgcn_exp2f(S[kb][r] * LOG2E - mnl); S[kb][r] = e; sum += e; }
            sum += __shfl_xor(sum, 32);
            lrun = lrun * corr + sum;
#pragma unroll
            for (int d = 0; d < 4; ++d)
#pragma unroll
                for (int r = 0; r < 16; ++r) O[d][r] *= corr;
#pragma unroll
            for (int ks = 0; ks < 4; ++ks) { const int kb = ks >> 1, r0 = (ks & 1) * 8; u32x4_t pk;
#pragma unroll
                for (int j = 0; j < 4; ++j) pk[j] = pk2(S[kb][r0 + 2 * j], S[kb][r0 + 2 * j + 1]);
                pf[ks] = __builtin_bit_cast(bf16x8_t, pk); }
        }
#pragma unroll
        for (int d = 0; d < 4; ++d)
#pragma unroll
            for (int ks = 0; ks < 4; ++ks) {
                const u32x2_t v0 = *(const u32x2_t*)(vbase + d * 32 * DA_VS + ks * 32), v1 = *(const u32x2_t*)(vbase + d * 32 * DA_VS + ks * 32 + 16);
                u32x4_t vv; vv[0] = v0[0]; vv[1] = v0[1]; vv[2] = v1[0]; vv[3] = v1[1];
                O[d] = __builtin_amdgcn_mfma_f32_32x32x16_bf16(__builtin_bit_cast(bf16x8_t, vv), pf[ks], O[d], 0, 0, 0);
            }
        if (more) {
#pragma unroll
            for (int j = 0; j < 2; ++j) { *(u32x4_t*)(shm + (buf ^ 1) * DA_KB + kl[j]) = rk[j]; u32x2_t a, bq; a[0] = rv[j][0]; a[1] = rv[j][1]; bq[0] = rv[j][2]; bq[1] = rv[j][3];
                *(u32x2_t*)(shm + (buf ^ 1) * DA_VB + vl[j]) = a; *(u32x2_t*)(shm + (buf ^ 1) * DA_VB + vl[j] + 8) = bq; }
        }
        __syncthreads();
    }
    float* xch = (float*)shm;
    { const float inv = 1.f / lrun;
#pragma unroll
        for (int d = 0; d < 4; ++d)
#pragma unroll
            for (int r = 0; r < 16; ++r) O[d][r] *= inv; }
    if (c == 1) {
#pragma unroll
        for (int d = 0; d < 4; ++d)
#pragma unroll
            for (int r = 0; r < 16; ++r) xch[(((qb * 4 + d) * 16 + r) << 6) + lane] = O[d][r];
    }
    __syncthreads();
    if (c == 0) {
        float dq = 0.f, dk2 = 0.f; const float* lq = p.in[I_LQ] + l * 128; const float* lk = p.in[I_LK] + l * 128;
        for (int d = 0; d < 64; ++d) { dq += lq[d] * lk[d]; dk2 += lq[64 + d] * lk[64 + d]; }
        const float lam_init = 0.8f - 0.6f * expf(-0.3f * (float)l);
        const float lam = expf(dq) - expf(dk2) + lam_init;
        const float* g = p.in[I_DNG] + l * 128;
        float ss = 0.f;
#pragma unroll
        for (int d = 0; d < 4; ++d)
#pragma unroll
            for (int r = 0; r < 16; ++r) { const float v = O[d][r] - lam * xch[(((qb * 4 + d) * 16 + r) << 6) + lane]; O[d][r] = v; ss += v * v; }
        ss += __shfl_xor(ss, 32);
        const float sc = rsqrtf(ss * (1.0f / 128.0f) + RMS_EPS) * (1.0f - lam_init);
        bf16_t* op = DQ + qrow * 512 + hh * 128 + 4 * h;
#pragma unroll
        for (int d = 0; d < 4; ++d)
#pragma unroll
            for (int r4 = 0; r4 < 4; ++r4) { const int dv = 32 * d + 8 * r4; const f32x4 gv = *(const f32x4*)(g + dv + 4 * h);
                u32x2_t o; o[0] = pk2(O[d][4 * r4] * sc * gv[0], O[d][4 * r4 + 1] * sc * gv[1]); o[1] = pk2(O[d][4 * r4 + 2] * sc * gv[2], O[d][4 * r4 + 3] * sc * gv[3]);
                *(u32x2_t*)(op + dv) = o; }
    }
    __syncthreads();
}

enum { PH_MOD = 0, PH_INIT, PH_CONVERT, PH_INPROJ, PH_ROPEDEC, PH_MIX_GLA, PH_MIX_DIFF, PH_MIX_NA, PH_VTRANS, PH_DIFF, PH_GATES, PH_MERGE, PH_WO, PH_LN1, PH_GATHER, PH_UP, PH_DOWN, PH_LN2, PH_COUNT };

template <class Epi, class Sched>
__device__ __forceinline__ void run_gemm(PG8_LAS unsigned char* lds, const void* A, const void* Bt, int K, const Sched& S, const Epi& E) {
    pg8::Gemm g; g.A = (const pg8::bf16_t*)A; g.Bt = (const pg8::bf16_t*)Bt; g.M = 0; g.N = 0; g.K = K;
    pg8::gemm_phase<Epi, Sched, false>(lds, g, S, E, nullptr);
}

#ifndef PHASE_INLINE
#define PHASE_INLINE __forceinline__
#endif
template <int PH>
__device__ PHASE_INLINE void run_phase(const Params& p, int l, unsigned char* shm) {
#ifdef SKIP_MASK
    if constexpr ((SKIP_MASK >> PH) & 1) return;
#endif
    PG8_LAS unsigned char* lds = (PG8_LAS unsigned char*)shm;
    float* ldsf = (float*)shm;
    const int G = gridDim.x, c = blockIdx.x;
    if constexpr (PH == PH_MOD) phase_mod(p, ldsf);
    else if constexpr (PH == PH_INIT) phase_init(p);
    else if constexpr (PH == PH_CONVERT) phase_convert(p, l, ldsf);
    else if constexpr (PH == PH_INPROJ) { SchedGrid S{NPANEL, 19, 0, G, c}; EpiInProj E{p.ws}; run_gemm(lds, p.ws + OFF_H, p.ws + OFF_WIN, 1024, S, E); }
    else if constexpr (PH == PH_ROPEDEC) phase_rope_decay(p, l);
    else if constexpr (PH == PH_MIX_GLA) { for (int u = blockIdx.x; u < NB; u += gridDim.x) gla_naive_batch(p, l, u, ldsf); }
    else if constexpr (PH == PH_MIX_DIFF) { for (int u = blockIdx.x; u < NB * 4 * 34; u += gridDim.x) diff_naive_tile(p, l, u, ldsf); }
    else if constexpr (PH == PH_MIX_NA) { for (int u = blockIdx.x; u < T / 64; u += gridDim.x) na_naive_unit(p, l, u); }
    else if constexpr (PH == PH_VTRANS) phase_vtrans(p, (bf16_t*)shm);
    else if constexpr (PH == PH_DIFF) { for (int u = blockIdx.x; u < DA_UNITS; u += gridDim.x) diff_attn_unit(p, l, u, shm); }
    else if constexpr (PH == PH_GATES) { SchedGrid S{NPANEL, 12, 19, G, c}; EpiGates E{p.ws}; run_gemm(lds, p.ws + OFF_H, p.ws + OFF_WIN, 1024, S, E); }
    else if constexpr (PH == PH_MERGE) { SchedMerge S{G, c}; EpiMerge E{p.ws}; run_gemm(lds, p.ws + OFF_BR, p.ws + OFF_WB, 512, S, E); }
    else if constexpr (PH == PH_WO) { SchedGrid S{NPANEL, 4, 0, G, c}; EpiWo E{p.ws, l}; run_gemm(lds, p.ws + OFF_H, p.ws + OFF_WO, 1024, S, E); }
    else if constexpr (PH == PH_LN1) phase_ln1_router(p, l);
    else if constexpr (PH == PH_GATHER) phase_gather(p, l);
    else if constexpr (PH == PH_UP) { SchedMoe S; S.init((const unsigned*)(p.ws + OFF_CNT) + l * 16, G, c); EpiUp E{p.ws}; run_gemm(lds, p.ws + OFF_XA, p.ws + OFF_WUP, 1024, S, E); }
    else if constexpr (PH == PH_DOWN) { SchedMoe S; S.init((const unsigned*)(p.ws + OFF_CNT) + l * 16, G, c); EpiDown E{p.ws}; run_gemm(lds, p.ws + OFF_ACT, p.ws + OFF_WDN, 512, S, E); }
    else if constexpr (PH == PH_LN2) phase_ln2(p, l);
}

#if !MEGA
template <int PH>
__global__ void __launch_bounds__(512, 2) k_phase(Params p, int l) {
    extern __shared__ __attribute__((aligned(16))) unsigned char shm[];
    run_phase<PH>(p, l, shm);
}
template <int PH> static void launch_phase(const Params& p, int l, hipStream_t st) {
    static bool attr = false;
    if (!attr) { (void)hipFuncSetAttribute((const void*)k_phase<PH>, hipFuncAttributeMaxDynamicSharedMemorySize, LDS_BYTES); attr = true; }
    hipLaunchKernelGGL((k_phase<PH>), dim3(256), dim3(512), LDS_BYTES, st, p, l);
}
#else
__global__ void __launch_bounds__(512, 2) k_mega(Params p) {
    extern __shared__ __attribute__((aligned(16))) unsigned char shm[];
    volatile LAS unsigned* xbw = (volatile LAS unsigned*)(shm + LDS_STAGE);
    if (threadIdx.x == 0) { xbw[0] = 0u; xbw[1] = 0u; xbw[2] = 0u; xbw[3] = 0u; }
    __syncthreads();
    XcdBarrier bar = xcd_barrier_post((unsigned*)(p.ws + OFF_BAR), xbw);
    run_phase<PH_MOD>(p, 0, shm);
    run_phase<PH_CONVERT>(p, 0, shm);
    xcd_barrier(bar);
    run_phase<PH_INIT>(p, 0, shm);
    xcd_barrier(bar);
    for (int l = 0; l < DEPTH; ++l) {
        if (l > 0) { run_phase<PH_CONVERT>(p, l, shm); xcd_barrier(bar); }
        run_phase<PH_INPROJ>(p, l, shm); xcd_barrier(bar);
        run_phase<PH_ROPEDEC>(p, l, shm); run_phase<PH_VTRANS>(p, l, shm); xcd_barrier(bar);
        run_phase<PH_MIX_GLA>(p, l, shm); run_phase<PH_DIFF>(p, l, shm); run_phase<PH_MIX_NA>(p, l, shm); xcd_barrier(bar);
        run_phase<PH_GATES>(p, l, shm); xcd_barrier(bar);
        run_phase<PH_MERGE>(p, l, shm); xcd_barrier(bar);
        run_phase<PH_WO>(p, l, shm); xcd_barrier(bar);
        run_phase<PH_LN1>(p, l, shm); xcd_barrier(bar);
        run_phase<PH_GATHER>(p, l, shm); xcd_barrier(bar);
        run_phase<PH_UP>(p, l, shm); xcd_barrier(bar);
        run_phase<PH_DOWN>(p, l, shm); xcd_barrier(bar);
        run_phase<PH_LN2>(p, l, shm); xcd_barrier(bar);
    }
}
#endif

extern "C" void kernel_launch(void* const* d_in, const int* in_sizes, int n_in, void* d_out, int out_size, void* d_ws, size_t ws_size, hipStream_t stream) {
    (void)in_sizes; (void)n_in; (void)out_size;
    if (ws_size < WS_NEED) { fprintf(stderr, "workspace too small: %zu < %zu\n", ws_size, (size_t)WS_NEED); return; }
    Params p{};
    for (int i = 0; i < 23; ++i) p.in[i] = (const float*)d_in[i];
    p.out = (float*)d_out; p.ws = (char*)d_ws;
    (void)hipMemsetAsync(d_ws, 0, ZERO_BYTES, stream);
#if !MEGA
    launch_phase<PH_MOD>(p, 0, stream);
    launch_phase<PH_INIT>(p, 0, stream);
    for (int l = 0; l < DEPTH; ++l) {
        launch_phase<PH_CONVERT>(p, l, stream);
        launch_phase<PH_INPROJ>(p, l, stream);
        launch_phase<PH_ROPEDEC>(p, l, stream);
        launch_phase<PH_MIX_GLA>(p, l, stream);
        launch_phase<PH_VTRANS>(p, l, stream);
        launch_phase<PH_DIFF>(p, l, stream);
        launch_phase<PH_MIX_NA>(p, l, stream);
        launch_phase<PH_GATES>(p, l, stream);
        launch_phase<PH_MERGE>(p, l, stream);
        launch_phase<PH_WO>(p, l, stream);
        launch_phase<PH_LN1>(p, l, stream);
        launch_phase<PH_GATHER>(p, l, stream);
        launch_phase<PH_UP>(p, l, stream);
        launch_phase<PH_DOWN>(p, l, stream);
        launch_phase<PH_LN2>(p, l, stream);
    }
#else
    static int grid = 0;
    if (!grid) {
        (void)hipFuncSetAttribute((const void*)k_mega, hipFuncAttributeMaxDynamicSharedMemorySize, LDS_BYTES);
        int dev = 0, cus = 0, per_cu = 0;
        (void)hipGetDevice(&dev);
        (void)hipDeviceGetAttribute(&cus, hipDeviceAttributeMultiprocessorCount, dev);
        (void)hipOccupancyMaxActiveBlocksPerMultiprocessor(&per_cu, (const void*)k_mega, 512, LDS_BYTES);
        if (cus <= 0) cus = 256;
        grid = per_cu >= 1 ? cus : 0;
        if (!grid) { fprintf(stderr, "k_mega does not fit a CU\n"); return; }
    }
    hipLaunchKernelGGL(k_mega, dim3(grid), dim3(512), LDS_BYTES, stream, p);
#endif
}
```

```cpp
#define MEGA 1
#include <hip/hip_runtime.h>
#include <stdint.h>
#include <stdio.h>

#ifndef MEGA
#define MEGA 0
#endif

constexpr int NB = 8, LL = 4096, LC = 256, LB = LL + LC  , T = NB * LB  , D = 1024, DEPTH = 4;
constexpr int NPANEL = T / 256;
constexpr int PB = LB / 256;
constexpr int PAIR_ROWS = 2 * T + 16 * 256;
constexpr float ALPHA = 1.681792830507429f;
constexpr float LN_EPS = 1e-5f, RMS_EPS = 1e-6f;

constexpr size_t AL256(size_t x) { return (x + 255) & ~(size_t)255; }
constexpr size_t OFF_BAR = 0;
constexpr size_t OFF_CNT = 16384;
constexpr size_t ZERO_BYTES = 32768;
constexpr size_t OFF_MOD = ZERO_BYTES;
constexpr size_t OFF_ROPE = AL256(OFF_MOD + (size_t)DEPTH * 9 * 6144 * 4);
constexpr size_t OFF_TOK = AL256(OFF_ROPE + (size_t)4096 * 32 * 2 * 4);
constexpr size_t OFF_GR = AL256(OFF_TOK + (size_t)T * 8 * 4);
constexpr size_t OFF_XS = AL256(OFF_GR + (size_t)T * 32 * 4);
constexpr size_t OFF_H = AL256(OFF_XS + (size_t)T * D * 4);
constexpr size_t OFF_W = AL256(OFF_H + (size_t)T * D * 2);
constexpr size_t W_IN_ROWS = 4864 + 3072;
constexpr size_t OFF_WIN = OFF_W;
constexpr size_t OFF_WB = OFF_WIN + W_IN_ROWS * 1024 * 2;
constexpr size_t OFF_WO = OFF_WB + (size_t)3 * 1024 * 512 * 2;
constexpr size_t OFF_WUP = OFF_WO + (size_t)1024 * 1024 * 2;
constexpr size_t OFF_WDN = OFF_WUP + (size_t)16 * 1024 * 1024 * 2;
constexpr size_t OFF_P = AL256(OFF_WDN + (size_t)16 * 1024 * 512 * 2);
constexpr size_t PCOL = (size_t)T * 2;
constexpr size_t OFF_GQ = OFF_P, OFF_GK = OFF_P + 256 * PCOL, OFF_GV = OFF_P + 512 * PCOL;
constexpr size_t OFF_DK = OFF_P + 1024 * PCOL, OFF_DV = OFF_P + 1536 * PCOL;
constexpr size_t OFF_NK = OFF_P + 2048 * PCOL, OFF_NV = OFF_P + 2560 * PCOL;
constexpr size_t OFF_BR = OFF_P + 3072 * PCOL;
constexpr size_t OFF_GG = OFF_BR, OFF_DQ = OFF_BR + 512 * PCOL, OFF_NQ = OFF_BR + 1024 * PCOL;
constexpr size_t OFF_GATE = OFF_P;
constexpr size_t OFF_S1 = AL256(OFF_P + 4608 * PCOL);
constexpr size_t OFF_S2 = AL256(OFF_S1 + (size_t)T * 512 * 4);
constexpr size_t OFF_R3 = AL256(OFF_S2 + (size_t)T * 512 * 4);
constexpr size_t OFF_R4 = AL256(OFF_R3 + (size_t)T * 512 * 2);
constexpr size_t VT_BYTES = (size_t)T * 512 * 2;
#ifndef FAST_GLA
#define FAST_GLA 1
#endif
#ifndef FAST_DIFF
#define FAST_DIFF 1
#endif
#ifndef FAST_NA
#define FAST_NA 1
#endif
constexpr size_t OFF_KV = OFF_S1;
constexpr size_t OFF_GVT = OFF_S2;
constexpr size_t OFF_VT = FAST_GLA ? OFF_S2 + VT_BYTES : OFF_R3;
constexpr size_t OFF_NVT = OFF_R3;
static_assert(!(FAST_NA && FAST_DIFF && !FAST_GLA), "region 3 holds one buffer");
constexpr size_t OFF_NBT = OFF_R4;
constexpr size_t OFF_DECAY = AL256(OFF_NBT + (size_t)8 * 15 * 4 * 64 * 16 * 4);
constexpr size_t OFF_END1 = AL256(OFF_DECAY + (size_t)64 * 68 * 64 * 4);
constexpr size_t OFF_XA = OFF_P;
constexpr size_t OFF_ACT = AL256(OFF_XA + (size_t)PAIR_ROWS * 1024 * 2);
constexpr size_t OFF_Y = AL256(OFF_ACT + (size_t)PAIR_ROWS * 512 * 2);
constexpr size_t OFF_END2 = AL256(OFF_Y + (size_t)PAIR_ROWS * 1024 * 2);
constexpr size_t WS_NEED = OFF_END1 > OFF_END2 ? OFF_END1 : OFF_END2;
static_assert(WS_NEED < (size_t)812 * 1000 * 1000, "workspace budget");

constexpr int NTHR = 512;
constexpr int LDS_STAGE = 131072;
constexpr int LDS_BYTES = 159744;
constexpr int LDS_XBW = LDS_BYTES - 256;

typedef unsigned short bf16_t;

struct Params {
    const float* in[23];
    float* out;
    char* ws;
};
enum { I_X = 0, I_C, I_CTX, I_CCTX, I_WADA, I_BADA, I_WIN, I_GWD, I_GBD, I_GNG, I_LQ, I_LK, I_DNG, I_RPB, I_WBR, I_WO, I_LNG, I_LNB, I_WR, I_BR, I_WEG, I_WEU, I_WED };

__device__ __forceinline__ float bf2f(bf16_t v) { return __uint_as_float(((unsigned)v) << 16); }
__device__ __forceinline__ float bflo(unsigned u) { return __uint_as_float(u << 16); }
__device__ __forceinline__ float bfhi(unsigned u) { return __uint_as_float(u & 0xffff0000u); }
typedef float f32x2_t __attribute__((ext_vector_type(2)));
typedef __bf16 bf16x2_t __attribute__((ext_vector_type(2)));
__device__ __forceinline__ unsigned pk2(float lo, float hi) { f32x2_t v; v[0] = lo; v[1] = hi; return __builtin_bit_cast(unsigned, __builtin_convertvector(v, bf16x2_t)); }
__device__ __forceinline__ bf16_t f2bf(float f) { return (bf16_t)(pk2(f, 0.f) & 0xffffu); }
__device__ __forceinline__ float wave_sum(float v) {
#pragma unroll
    for (int o = 32; o >= 1; o >>= 1) v += __shfl_xor(v, o);
    return v;
}
__device__ __forceinline__ float sigmoidf_(float x) { return 1.f / (1.f + __expf(-x)); }
__device__ __forceinline__ float siluf_(float x) { return x / (1.f + __expf(-x)); }
__device__ __forceinline__ int row_slot(int row) { const int b = row / LB, t = row - b * LB; return t < LC ? 8 : b; }
__device__ __forceinline__ int ltid() { int t = threadIdx.x; asm volatile("" : "+v"(t)); return t; }
#include <hip/hip_runtime.h>
namespace pg8 {
#define PG8_LAS __attribute__((address_space(3)))
typedef unsigned short bf16_t;
typedef short bf16x8 __attribute__((ext_vector_type(8)));
typedef float f32x4 __attribute__((ext_vector_type(4)));
typedef unsigned u32x4 __attribute__((ext_vector_type(4)));
constexpr int BM = 256, BK = 64, HALF = 128, HTB = HALF * BK * 2  , STAGE_BYTES = 8 * HTB, NXCD = 8, WGM = 8;

__host__ __device__ __forceinline__ int lds_byte(int r, int c) { const int st = (r >> 4) * 2 + (c >> 5), rr = r & 15, cc = c & 31, ob = rr * 64 + cc * 2; return st * 1024 + (ob ^ (((ob >> 9) & 1) << 5)); }
__host__ __device__ __forceinline__ void stage_rc(int b, int& R, int& C) { const int st = b / 1024, sb = b % 1024, swz = sb ^ (((sb >> 9) & 1) << 5); R = (st >> 1) * 16 + swz / 64; C = (st & 1) * 32 + (swz % 64) / 2; }
__host__ __device__ __forceinline__ int perm32(int rho) { const int n = rho >> 4, i = rho & 15; return 8 * (i >> 2) + 4 * n + (i & 3); }

struct Unit { int pm, pn; };
struct Gemm { const bf16_t* A; const bf16_t* Bt; int M, N, K; };
__device__ __forceinline__ unsigned cvt_pk_bf16(float lo, float hi) { unsigned r; asm volatile("v_cvt_pk_bf16_f32 %0, %1, %2" : "=v"(r) : "v"(lo), "v"(hi)); return r; }

template <class Epi, class Sched, bool STAMP = false>
__device__ __forceinline__ void gemm_phase(PG8_LAS unsigned char* lds, const Gemm g, const Sched& S, const Epi& E, unsigned long long* stamps) {
    int tid_l = threadIdx.x; asm volatile("" : "+v"(tid_l));
    const int tid = tid_l, wid = __builtin_amdgcn_readfirstlane(tid >> 6), lane = tid & 63, wr = wid >> 2, wc = wid & 3, fr = lane & 15, fq = lane >> 4;
    const int K = g.K, nt = K / BK;
    int ts_lo = 0, ts_hi = 0, nts = 0; const unsigned long long rt_entry = STAMP ? (unsigned long long)wall_clock64() : 0ull;
#define PG8_STAMP() do { if (STAMP && wid == 0 && nts < 64) { const unsigned long long _c = (unsigned long long)clock64(); \
        ts_lo = (lane == nts) ? (int)(unsigned)_c : ts_lo; ts_hi = (lane == nts) ? (int)(unsigned)(_c >> 32) : ts_hi; ++nts; } } while (0)
    PG8_STAMP();
    unsigned voffA[2], voffB[2];
#pragma unroll
    for (int i = 0; i < 2; ++i) { int R, C; stage_rc(tid * 16 + i * 8192, R, C); const int Rb = Epi::PERM ? ((R & ~31) + perm32(R & 31)) : R;
        voffA[i] = (unsigned)(R * K + C) * 2u; voffB[i] = (unsigned)(Rb * K + C) * 2u; }
    const size_t kstep = (size_t)(BK * 2);
    const size_t hstep = (size_t)HALF * K * 2;
    const size_t tstep = 2 * hstep;
    const unsigned ldsw = (unsigned)wid * 1024u;
    const int aoff = lds_byte(wr * 64 + fr, fq * 8), boff = lds_byte(wc * 32 + fr, fq * 8);
#define PG8_SA(b, h) (((b) * 2 + (h)) * HTB)
#define PG8_SB(b, h) ((4 + (b) * 2 + (h)) * HTB)
#define PG8_STAGE(bufoff, gbase, voff) do { _Pragma("unroll") for (int _i = 0; _i < 2; ++_i) \
        __builtin_amdgcn_global_load_lds((const unsigned*)((const char*)(gbase) + (voff)[_i]), (PG8_LAS unsigned*)(lds + (bufoff) + ldsw + _i * 8192), 16, 0, 0); } while (0)
#define PG8_LDA(dst, b, h) do { _Pragma("unroll") for (int m = 0; m < 4; ++m) _Pragma("unroll") for (int k = 0; k < 2; ++k) dst[m][k] = *(const PG8_LAS bf16x8*)(lds + PG8_SA(b, h) + aoff + m * 2048 + k * 1024); } while (0)
#define PG8_LDB(dst, b, h) do { _Pragma("unroll") for (int n = 0; n < 2; ++n) _Pragma("unroll") for (int k = 0; k < 2; ++k) dst[n][k] = *(const PG8_LAS bf16x8*)(lds + PG8_SB(b, h) + boff + n * 2048 + k * 1024); } while (0)
#define PG8_MMA(ai, bj, At, Bt) do { __builtin_amdgcn_s_setprio(1); _Pragma("unroll") for (int m = 0; m < 4; ++m) _Pragma("unroll") for (int n = 0; n < 2; ++n) _Pragma("unroll") for (int k = 0; k < 2; ++k) \
        acc[ai][bj][m][n] = __builtin_amdgcn_mfma_f32_16x16x32_bf16(Bt[n][k], At[m][k], acc[ai][bj][m][n], 0, 0, 0); __builtin_amdgcn_s_setprio(0); } while (0)
#define PG8_WAIT_V(n) asm volatile("s_waitcnt vmcnt(" #n ")" ::: "memory")
#define PG8_WAIT_L(n) asm volatile("s_waitcnt lgkmcnt(" #n ")" ::: "memory")
#define PG8_BAR __builtin_amdgcn_s_barrier()
#define PG8_SCHED __builtin_amdgcn_sched_barrier(0)
    Unit cur, nxt; int ui = 0;
    if (!S.next(0, cur)) return;
    f32x4 acc[2][2][4][2];
#pragma unroll
    for (int a = 0; a < 2; ++a)
#pragma unroll
        for (int b = 0; b < 2; ++b)
#pragma unroll
            for (int m = 0; m < 4; ++m)
#pragma unroll
                for (int n = 0; n < 2; ++n) acc[a][b][m][n] = (f32x4){0.f, 0.f, 0.f, 0.f};
    bf16x8 At[4][2], B0[2][2], B1[2][2];
    const char* cA = (const char*)g.A + (size_t)cur.pm * tstep; const char* cB = (const char*)g.Bt + (size_t)cur.pn * tstep;
    S.a_ready(cur);
    PG8_STAGE(PG8_SB(0, 0), cB, voffB); PG8_STAGE(PG8_SA(0, 0), cA, voffA); PG8_STAGE(PG8_SB(0, 1), cB + hstep, voffB); PG8_STAGE(PG8_SA(0, 1), cA + hstep, voffA);
    if (wr == 1) PG8_BAR;
    PG8_WAIT_V(4); PG8_BAR;
    PG8_STAGE(PG8_SB(1, 0), cB + kstep, voffB); PG8_STAGE(PG8_SA(1, 0), cA + kstep, voffA); PG8_STAGE(PG8_SB(1, 1), cB + hstep + kstep, voffB);
    PG8_WAIT_V(6); PG8_BAR;
    PG8_STAMP();
    for (;;) {
        const bool has_next = S.next(ui + 1, nxt);
        const char* nA = has_next ? (const char*)g.A + (size_t)nxt.pm * tstep : cA; const char* nB = has_next ? (const char*)g.Bt + (size_t)nxt.pn * tstep : cB;
        for (int t = 0; t < nt; t += 2) {
            const bool last = (t == nt - 2);
            const char* a1 = cA + (size_t)(t + 1) * kstep;
            const char* a2 = last ? nA : cA + (size_t)(t + 2) * kstep; const char* b2 = last ? nB : cB + (size_t)(t + 2) * kstep;
            const char* a3 = a2 + kstep; const char* b3 = b2 + kstep;
            if (last && has_next) S.a_ready(nxt);
            PG8_LDB(B0, 0, 0); PG8_SCHED; PG8_LDA(At, 0, 0); PG8_STAGE(PG8_SA(1, 1), a1 + hstep, voffA);
            PG8_WAIT_L(8); PG8_BAR; PG8_WAIT_L(0); PG8_MMA(0, 0, At, B0); PG8_BAR; PG8_SCHED;
            PG8_LDB(B1, 0, 1); PG8_STAGE(PG8_SB(0, 0), b2, voffB);
            PG8_BAR; PG8_WAIT_L(0); PG8_MMA(0, 1, At, B1); PG8_BAR;
            PG8_LDA(At, 0, 1); PG8_STAGE(PG8_SA(0, 0), a2, voffA);
            PG8_BAR; PG8_WAIT_L(0); PG8_MMA(1, 0, At, B0); PG8_BAR; PG8_SCHED;
            PG8_STAGE(PG8_SB(0, 1), b2 + hstep, voffB);
            PG8_WAIT_V(6); PG8_BAR; PG8_MMA(1, 1, At, B1); PG8_BAR;
            PG8_LDB(B0, 1, 0); PG8_SCHED; PG8_LDA(At, 1, 0); PG8_STAGE(PG8_SA(0, 1), a2 + hstep, voffA);
            PG8_WAIT_L(8); PG8_BAR; PG8_WAIT_L(0); PG8_MMA(0, 0, At, B0); PG8_BAR; PG8_SCHED;
            PG8_LDB(B1, 1, 1); PG8_STAGE(PG8_SB(1, 0), b3, voffB);
            PG8_BAR; PG8_WAIT_L(0); PG8_MMA(0, 1, At, B1); PG8_BAR;
            PG8_LDA(At, 1, 1); PG8_STAGE(PG8_SA(1, 0), a3, voffA);
            PG8_BAR; PG8_WAIT_L(0); PG8_MMA(1, 0, At, B0); PG8_BAR; PG8_SCHED;
            PG8_STAGE(PG8_SB(1, 1), b3 + hstep, voffB);
            PG8_WAIT_V(6); PG8_BAR; PG8_MMA(1, 1, At, B1); PG8_BAR;
        }
        PG8_STAMP();
        if constexpr (!Epi::AFTER_DRAIN) { E(acc, cur, wr, wc, fr, fq); S.done(cur); }
        PG8_STAMP();
        if (!has_next) break;
#pragma unroll
        for (int a = 0; a < 2; ++a)
#pragma unroll
            for (int b = 0; b < 2; ++b)
#pragma unroll
                for (int m = 0; m < 4; ++m)
#pragma unroll
                    for (int n = 0; n < 2; ++n) acc[a][b][m][n] = (f32x4){0.f, 0.f, 0.f, 0.f};
        cur = nxt; cA = nA; cB = nB; ++ui;
    }
    PG8_WAIT_V(0);
    if (wr == 0) PG8_BAR;
    PG8_BAR;
    if constexpr (Epi::AFTER_DRAIN) { E.fused(acc, cur, wr, wc, fr, fq, lds, wid, lane); S.done(cur); }
    PG8_STAMP();
    if (STAMP && wid == 0) { stamps[lane] = lane < nts ? (((unsigned long long)(unsigned)ts_hi << 32) | (unsigned)ts_lo) : 0ull;
        if (lane == 62) stamps[62] = rt_entry; if (lane == 63) stamps[63] = (unsigned long long)wall_clock64(); }
#undef PG8_STAMP
#undef PG8_SA
#undef PG8_SB
#undef PG8_STAGE
#undef PG8_LDA
#undef PG8_LDB
#undef PG8_MMA
#undef PG8_WAIT_V
#undef PG8_WAIT_L
#undef PG8_BAR
#undef PG8_SCHED
}
}
#define XB_TMO      128
#define XB_XCNT(j)  (256  + 64 * (j))
#define XB_XSUB(j)  (1280 + 64 * (j))
#define XB_XGEN(j)  (2304 + 64 * (j))
#define XB_TOP      3328
#define XB_TOPGEN   3392
#define XCD_BAR_WORDS 3456
#define XB_SPIN_CAP (1u << 18)
#define LAS __attribute__((address_space(3)))

__device__ __forceinline__ unsigned xb_ld(unsigned* p)              { return __hip_atomic_load(p, __ATOMIC_RELAXED, __HIP_MEMORY_SCOPE_AGENT); }
__device__ __forceinline__ unsigned xb_add(unsigned* p, unsigned v) { return __hip_atomic_fetch_add(p, v, __ATOMIC_RELAXED, __HIP_MEMORY_SCOPE_AGENT); }
__device__ __forceinline__ unsigned xb_xcc_id() { return (unsigned)__builtin_amdgcn_s_getreg((3 << 11) | 20) & 0xFu; }
#define XB_SPIN(cond, bar) do { unsigned _sp = 0; while (cond) { __builtin_amdgcn_s_sleep(1); \
    if ((++_sp & 255u) == 0u) { if (xb_ld(&(bar)[XB_TMO])) break; if (_sp > XB_SPIN_CAP) { atomicAdd(&(bar)[XB_TMO], 1u); break; } } } } while (0)

struct XcdBarrier {
    unsigned* bar; unsigned x;
    volatile LAS unsigned* st;
};

__device__ __forceinline__ XcdBarrier xcd_barrier_post(unsigned* bar, volatile LAS unsigned* st) {
    XcdBarrier b; b.bar = bar; b.x = xb_xcc_id(); b.st = st;
    if (threadIdx.x == 0) (void)xb_add(&bar[XB_XCNT(b.x)], 1u);
    return b;
}
__device__ __forceinline__ void xcd_barrier_complete(unsigned* bar, unsigned x, unsigned& nloc, unsigned& nx) {
    const unsigned G = gridDim.x * gridDim.y * gridDim.z;
    unsigned sum, cnt, mine, sp = 0u;
    for (;;) {
        sum = 0u; cnt = 0u; mine = 0u;
#pragma unroll
        for (unsigned j = 0; j < 16; ++j) { const unsigned c = xb_ld(&bar[XB_XCNT(j)]); sum += c; cnt += (c > 0u) ? 1u : 0u; mine = (j == x) ? c : mine; }
        if (sum == G) break;
        __builtin_amdgcn_s_sleep(1);
        if ((++sp & 255u) == 0u) { if (xb_ld(&bar[XB_TMO])) break; if (sp > XB_SPIN_CAP) { atomicAdd(&bar[XB_TMO], 1u); break; } }
    }
    nloc = mine > 0u ? mine : 1u; nx = cnt > 0u ? cnt : 1u;
}

__device__ __forceinline__ void xcd_barrier(const XcdBarrier& b_in) {
    XcdBarrier b = b_in; asm volatile("" : "+s"(b.bar), "+s"(b.x));
    asm volatile("s_waitcnt vmcnt(0)" ::: "memory");
    __syncthreads();
    if (threadIdx.x == 0) {
        unsigned* bar = b.bar;
        __builtin_amdgcn_s_waitcnt(0);
        unsigned nloc = b.st[0], nx = b.st[1];
        if (nloc == 0u) { xcd_barrier_complete(bar, b.x, nloc, nx); b.st[0] = nloc; b.st[1] = nx; }
        const unsigned old = xb_add(&bar[XB_XSUB(b.x)], 1u);
        const unsigned gen = old / nloc;
        if (old + 1u == (gen + 1u) * nloc) {
            __builtin_amdgcn_fence(__ATOMIC_RELEASE, "agent");
            asm volatile("s_waitcnt vmcnt(0)" ::: "memory");
            const unsigned og = xb_add(&bar[XB_TOP], 1u);
            const unsigned tg = og / nx;
            if (og + 1u == (tg + 1u) * nx) xb_add(&bar[XB_TOPGEN], 1u);
            else XB_SPIN(xb_ld(&bar[XB_TOPGEN]) == tg, bar);
            __builtin_amdgcn_fence(__ATOMIC_ACQUIRE, "agent");
            xb_add(&bar[XB_XGEN(b.x)], 1u);
            asm volatile("s_waitcnt vmcnt(0)" ::: "memory");
        } else {
            XB_SPIN(xb_ld(&bar[XB_XGEN(b.x)]) == gen, bar);
            __builtin_amdgcn_fence(__ATOMIC_ACQUIRE, "agent");
            asm volatile("s_waitcnt vmcnt(0)" ::: "memory");
        }
    }
    __syncthreads();
}

using pg8::f32x4;
using pg8::Unit;
typedef unsigned u32x4_t __attribute__((ext_vector_type(4)));
typedef unsigned u32x2_t __attribute__((ext_vector_type(2)));

struct SchedGrid {
    int nM, nN, pn0, G, c;
    __device__ __forceinline__ bool next(int i, Unit& u) const {
        const int L = i * G + c; if (L >= nM * nN) return false;
        u.pm = L / nN; u.pn = pn0 + (L - u.pm * nN); return true;
    }
    __device__ __forceinline__ void a_ready(const Unit&) const {}
    __device__ __forceinline__ void done(const Unit&) const {}
};
struct SchedMerge {
    int G, c;
    __device__ __forceinline__ bool next(int i, Unit& u) const {
        const int i3 = i / 3, n = i - i3 * 3, ti = i3 * G + c; if (ti >= NPANEL * 4) return false;
        u.pm = n * NPANEL + (ti >> 2); u.pn = n * 4 + (ti & 3); return true;
    }
    __device__ __forceinline__ void a_ready(const Unit&) const {}
    __device__ __forceinline__ void done(const Unit&) const {}
};
struct SchedMoe {
    int cum[17]; int G, c;
    __device__ __forceinline__ void init(const unsigned* cnt, int G_, int c_) {
        G = G_; c = c_; int s = 0;
#pragma unroll
        for (int e = 0; e < 16; ++e) { cum[e] = s; const unsigned n = __builtin_amdgcn_readfirstlane(cnt[e]); s += (int)((n + 255u) >> 8); }
        cum[16] = s;
    }
    __device__ __forceinline__ bool next(int i, Unit& u) const {
        const int L = i * G + c; if (L >= cum[16] * 4) return false;
        const int rt = L >> 2; int e = 0;
#pragma unroll
        for (int j = 1; j < 16; ++j) e += (rt >= cum[j]) ? 1 : 0;
        u.pm = rt; u.pn = e * 4 + (L & 3); return true;
    }
    __device__ __forceinline__ void a_ready(const Unit&) const {}
    __device__ __forceinline__ void done(const Unit&) const {}
};

__device__ __forceinline__ u32x4_t pack8(const f32x4& a, const f32x4& b) {
    u32x4_t r; r[0] = pk2(a[0], a[1]); r[1] = pk2(a[2], a[3]); r[2] = pk2(b[0], b[1]); r[3] = pk2(b[2], b[3]); return r;
}
struct EpiInProj {
    static constexpr bool PERM = true, AFTER_DRAIN = false;
    char* ws;
    __device__ __forceinline__ void operator()(const f32x4 (&acc)[2][2][4][2], const Unit& u, int wr, int wc, int fr, int fq) const {
        const int pn = u.pn; const int row0 = u.pm * 256 + wr * 64 + fr;
        if (pn == 6) {
            if (wc == 0) { float* gr = (float*)(ws + OFF_GR);
#pragma unroll
                for (int ai = 0; ai < 2; ++ai)
#pragma unroll
                    for (int m = 0; m < 4; ++m) { float* rp = gr + (size_t)(row0 + ai * 128 + m * 16) * 32 + 8 * fq;
                        *(f32x4*)(rp) = acc[ai][0][m][0]; *(f32x4*)(rp + 4) = acc[ai][0][m][1]; } }
            return;
        }
        size_t off; int ld, col0;
        if (pn == 0) { off = OFF_GQ; ld = 256; col0 = 0; }
        else if (pn == 1) { off = OFF_GK; ld = 256; col0 = 0; }
        else if (pn < 4) { off = OFF_GV; ld = 512; col0 = (pn - 2) * 256; }
        else if (pn < 6) { off = OFF_GG; ld = 512; col0 = (pn - 4) * 256; }
        else if (pn < 9) { off = OFF_DQ; ld = 512; col0 = (pn - 7) * 256; }
        else if (pn < 11) { off = OFF_DK; ld = 512; col0 = (pn - 9) * 256; }
        else if (pn < 13) { off = OFF_DV; ld = 512; col0 = (pn - 11) * 256; }
        else if (pn < 15) { off = OFF_NQ; ld = 512; col0 = (pn - 13) * 256; }
        else if (pn < 17) { off = OFF_NK; ld = 512; col0 = (pn - 15) * 256; }
        else { off = OFF_NV; ld = 512; col0 = (pn - 17) * 256; }
        bf16_t* base = (bf16_t*)(ws + off) + col0 + wc * 32 + 8 * fq;
#pragma unroll
        for (int ai = 0; ai < 2; ++ai)
#pragma unroll
            for (int m = 0; m < 4; ++m) { bf16_t* rp = base + (size_t)(row0 + ai * 128 + m * 16) * ld;
#pragma unroll
                for (int bj = 0; bj < 2; ++bj) *(u32x4_t*)(rp + bj * 128) = pack8(acc[ai][bj][m][0], acc[ai][bj][m][1]); }
    }
};
struct EpiGates {
    static constexpr bool PERM = true, AFTER_DRAIN = false;
    char* ws;
    __device__ __forceinline__ void operator()(const f32x4 (&acc)[2][2][4][2], const Unit& u, int wr, int wc, int fr, int fq) const {
        const int pl = u.pn - 19, n = pl >> 2, col0 = (pl & 3) * 256; const int row0 = u.pm * 256 + wr * 64 + fr;
        bf16_t* base = (bf16_t*)(ws + OFF_GATE) + (size_t)n * T * 1024 + col0 + wc * 32 + 8 * fq;
#pragma unroll
        for (int ai = 0; ai < 2; ++ai)
#pragma unroll
            for (int m = 0; m < 4; ++m) { bf16_t* rp = base + (size_t)(row0 + ai * 128 + m * 16) * 1024;
#pragma unroll
                for (int bj = 0; bj < 2; ++bj) { f32x4 a = acc[ai][bj][m][0], b = acc[ai][bj][m][1];
#pragma unroll
                    for (int j = 0; j < 4; ++j) { a[j] = sigmoidf_(a[j]); b[j] = sigmoidf_(b[j]); }
                    *(u32x4_t*)(rp + bj * 128) = pack8(a, b); } }
    }
};
struct EpiMerge {
    static constexpr bool PERM = true, AFTER_DRAIN = false;
    char* ws;
    __device__ __forceinline__ void operator()(const f32x4 (&acc)[2][2][4][2], const Unit& u, int wr, int wc, int fr, int fq) const {
        const int n = u.pm / NPANEL, pm = u.pm - n * NPANEL, pn = u.pn & 3; const int row0 = pm * 256 + wr * 64 + fr;
        const size_t cb = (size_t)pn * 256 + wc * 32 + 8 * fq;
        const bf16_t* gbase = (const bf16_t*)(ws + OFF_GATE) + (size_t)n * T * 1024 + cb;
        bf16_t* obase = (bf16_t*)(ws + OFF_H) + cb;
#pragma unroll
        for (int ai = 0; ai < 2; ++ai)
#pragma unroll
            for (int m = 0; m < 4; ++m) { const size_t ro = (size_t)(row0 + ai * 128 + m * 16) * 1024;
#pragma unroll
                for (int bj = 0; bj < 2; ++bj) {
                    const u32x4_t g = *(const u32x4_t*)(gbase + ro + bj * 128);
                    f32x4 a = acc[ai][bj][m][0], b = acc[ai][bj][m][1];
                    a[0] *= bflo(g[0]); a[1] *= bfhi(g[0]); a[2] *= bflo(g[1]); a[3] *= bfhi(g[1]);
                    b[0] *= bflo(g[2]); b[1] *= bfhi(g[2]); b[2] *= bflo(g[3]); b[3] *= bfhi(g[3]);
                    if (n > 0) { const u32x4_t o = *(const u32x4_t*)(obase + ro + bj * 128);
                        a[0] += bflo(o[0]); a[1] += bfhi(o[0]); a[2] += bflo(o[1]); a[3] += bfhi(o[1]);
                        b[0] += bflo(o[2]); b[1] += bfhi(o[2]); b[2] += bflo(o[3]); b[3] += bfhi(o[3]); }
                    *(u32x4_t*)(obase + ro + bj * 128) = pack8(a, b); } }
    }
};
struct EpiWo {
    static constexpr bool PERM = false, AFTER_DRAIN = false;
    char* ws; int layer;
    __device__ __forceinline__ void operator()(const f32x4 (&acc)[2][2][4][2], const Unit& u, int wr, int wc, int fr, int fq) const {
        const int b = u.pm / PB, slot = (u.pm - b * PB) == 0 ? 8 : b;
        const int row0 = u.pm * 256 + wr * 64 + fr, col0 = u.pn * 256 + wc * 32 + 4 * fq;
        const float* mg = (const float*)(ws + OFF_MOD) + ((size_t)(layer * 9 + slot) * 6 + 2) * 1024 + col0;
        float* xs = (float*)(ws + OFF_XS) + col0;
        f32x4 g[2][2];
#pragma unroll
        for (int bj = 0; bj < 2; ++bj)
#pragma unroll
            for (int n = 0; n < 2; ++n) g[bj][n] = *(const f32x4*)(mg + bj * 128 + n * 16);
#pragma unroll
        for (int ai = 0; ai < 2; ++ai)
#pragma unroll
            for (int m = 0; m < 4; ++m) { float* rp = xs + (size_t)(row0 + ai * 128 + m * 16) * 1024;
#pragma unroll
                for (int bj = 0; bj < 2; ++bj)
#pragma unroll
                    for (int n = 0; n < 2; ++n) { f32x4 x = *(const f32x4*)(rp + bj * 128 + n * 16);
                        *(f32x4*)(rp + bj * 128 + n * 16) = x * ALPHA + g[bj][n] * acc[ai][bj][m][n]; } }
    }
};
struct EpiUp {
    static constexpr bool PERM = true, AFTER_DRAIN = false;
    char* ws;
    __device__ __forceinline__ void operator()(const f32x4 (&acc)[2][2][4][2], const Unit& u, int wr, int wc, int fr, int fq) const {
        const int ct = u.pn & 3; const int row0 = u.pm * 256 + wr * 64 + fr;
        bf16_t* base = (bf16_t*)(ws + OFF_ACT) + ct * 128 + wc * 32 + 8 * fq;
#pragma unroll
        for (int ai = 0; ai < 2; ++ai)
#pragma unroll
            for (int m = 0; m < 4; ++m) { f32x4 a, b;
#pragma unroll
                for (int j = 0; j < 4; ++j) { a[j] = siluf_(acc[ai][0][m][0][j]) * acc[ai][1][m][0][j]; b[j] = siluf_(acc[ai][0][m][1][j]) * acc[ai][1][m][1][j]; }
                *(u32x4_t*)(base + (size_t)(row0 + ai * 128 + m * 16) * 512) = pack8(a, b); }
    }
};
struct EpiDown {
    static constexpr bool PERM = true, AFTER_DRAIN = false;
    char* ws;
    __device__ __forceinline__ void operator()(const f32x4 (&acc)[2][2][4][2], const Unit& u, int wr, int wc, int fr, int fq) const {
        const int ct = u.pn & 3; const int row0 = u.pm * 256 + wr * 64 + fr;
        bf16_t* base = (bf16_t*)(ws + OFF_Y) + ct * 256 + wc * 32 + 8 * fq;
#pragma unroll
        for (int ai = 0; ai < 2; ++ai)
#pragma unroll
            for (int m = 0; m < 4; ++m) { bf16_t* rp = base + (size_t)(row0 + ai * 128 + m * 16) * 1024;
#pragma unroll
                for (int bj = 0; bj < 2; ++bj) *(u32x4_t*)(rp + bj * 128) = pack8(acc[ai][bj][m][0], acc[ai][bj][m][1]); }
    }
};

#define GSTRIDE_BEGIN(var, n) for (long var = (long)blockIdx.x * NTHR + ltid(); var < (long)(n); var += (long)gridDim.x * NTHR)

__device__ __forceinline__ void phase_mod(const Params& p, float* lds) {
    const int tid = ltid();
    for (int i = tid; i < 9 * 1024; i += NTHR) { const int s = i >> 10, k = i & 1023; const float v = s < 8 ? p.in[I_C][s * 1024 + k] : p.in[I_CCTX][k]; lds[i] = siluf_(v); }
    __syncthreads();
    float* mod = (float*)(p.ws + OFF_MOD);
    GSTRIDE_BEGIN(idx, DEPTH * 6144) {
        const int l = (int)(idx / 6144), j = (int)(idx - (long)l * 6144);
        const float* w = p.in[I_WADA] + (size_t)l * 1024 * 6144 + j;
        float acc[9];
#pragma unroll
        for (int s = 0; s < 9; ++s) acc[s] = 0.f;
        for (int k = 0; k < 1024; ++k) { const float wv = w[(size_t)k * 6144];
#pragma unroll
            for (int s = 0; s < 9; ++s) acc[s] += lds[s * 1024 + k] * wv; }
        const float bv = p.in[I_BADA][l * 6144 + j];
#pragma unroll
        for (int s = 0; s < 9; ++s) mod[(size_t)(l * 9 + s) * 6144 + j] = acc[s] + bv;
    }
    float* rope = (float*)(p.ws + OFF_ROPE);
    GSTRIDE_BEGIN(idx, 4096 * 32) {
        const int t = (int)(idx >> 5), i = (int)(idx & 31);
        const float pos = (float)(i < 16 ? (t >> 6) : (t & 63));
        const float inv = powf(10000.0f, -(float)(i & 15) / 16.0f);
        const float ang = pos * inv;
        rope[idx * 2] = cosf(ang); rope[idx * 2 + 1] = sinf(ang);
    }
    __syncthreads();
}

__device__ __forceinline__ void phase_init(const Params& p) {
    const float* mod = (const float*)(p.ws + OFF_MOD);
    float* xs = (float*)(p.ws + OFF_XS); bf16_t* h = (bf16_t*)(p.ws + OFF_H);
    GSTRIDE_BEGIN(idx, (long)T * 256) {
        const int row = (int)(idx >> 8), c4 = (int)(idx & 255) * 4;
        const int b = row / LB, t = row - b * LB;
        const float* src = t < LC ? p.in[I_CTX] + ((size_t)(b * LC + t)) * 1024 : p.in[I_X] + ((size_t)(b * LL + (t - LC))) * 1024;
        const int slot = t < LC ? 8 : b;
        const f32x4 v = *(const f32x4*)(src + c4);
        const f32x4 sh = *(const f32x4*)(mod + (size_t)(slot * 6 + 0) * 1024 + c4), sc = *(const f32x4*)(mod + (size_t)(slot * 6 + 1) * 1024 + c4);
        *(f32x4*)(xs + (size_t)row * 1024 + c4) = v;
        const f32x4 hv = v * (sc + 1.0f) + sh;
        u32x2_t o; o[0] = pk2(hv[0], hv[1]); o[1] = pk2(hv[2], hv[3]);
        *(u32x2_t*)(h + (size_t)row * 1024 + c4) = o;
    }
}

__device__ __forceinline__ int winmap(int rho, float& scale) {
    scale = 1.f;
    if (rho < 1568) { if (rho < 256) scale = 0.125f; return rho; }
    if (rho < 1792) return -1;
    if (rho < 2304 || (rho >= 3328 && rho < 3840)) scale = 0.125f;
    return rho - 224;
}
__device__ __forceinline__ void convert_job(const float* src, const float* src2, int ld, int K, bf16_t* dst, int nrows, int mode, float* lds, int& tilectr) {
    const int tid = ltid(), ntk = K >> 6, ntiles = (nrows >> 6) * ntk;
    for (int ti = 0; ti < ntiles; ++ti, ++tilectr) {
        if ((tilectr % (int)gridDim.x) != (int)blockIdx.x) continue;
        const int rt = ti / ntk, kt = ti - rt * ntk, r0 = rt * 64, k0 = kt * 64;
        __syncthreads();
        { const int nn = tid & 63, rho = r0 + nn; float sc = 1.f; int col; const float* s = src;
          if (mode == 0) col = winmap(rho, sc);
          else if (mode == 1) col = rho;
          else { const int ct = rho >> 8, half = (rho >> 7) & 1, i = rho & 127; col = ct * 128 + i; s = half ? src2 : src; }
#pragma unroll
          for (int i = 0; i < 8; ++i) { const int kk = (tid >> 6) + 8 * i;
              const float v = col >= 0 ? s[(size_t)(k0 + kk) * ld + col] * sc : 0.f;
              lds[nn * 65 + kk] = v; } }
        __syncthreads();
        { const int nn = tid >> 3, k8 = (tid & 7) * 8; const float* lp = lds + nn * 65 + k8;
          u32x4_t o; o[0] = pk2(lp[0], lp[1]); o[1] = pk2(lp[2], lp[3]); o[2] = pk2(lp[4], lp[5]); o[3] = pk2(lp[6], lp[7]);
          *(u32x4_t*)(dst + (size_t)(r0 + nn) * K + k0 + k8) = o; }
    }
}
__device__ __forceinline__ void phase_convert(const Params& p, int l, float* lds) {
    int ctr = 0;
    convert_job(p.in[I_WIN] + (size_t)l * 1024 * 7712, nullptr, 7712, 1024, (bf16_t*)(p.ws + OFF_WIN), (int)W_IN_ROWS, 0, lds, ctr);
    for (int n = 0; n < 3; ++n)
        convert_job(p.in[I_WBR] + ((size_t)l * 3 + n) * 512 * 1024, nullptr, 1024, 512, (bf16_t*)(p.ws + OFF_WB) + (size_t)n * 1024 * 512, 1024, 1, lds, ctr);
    convert_job(p.in[I_WO] + (size_t)l * 1024 * 1024, nullptr, 1024, 1024, (bf16_t*)(p.ws + OFF_WO), 1024, 1, lds, ctr);
    for (int e = 0; e < 16; ++e) {
        const size_t eo = ((size_t)l * 16 + e) * 1024 * 512;
        convert_job(p.in[I_WEG] + eo, p.in[I_WEU] + eo, 512, 1024, (bf16_t*)(p.ws + OFF_WUP) + (size_t)e * 1024 * 1024, 1024, 2, lds, ctr);
        convert_job(p.in[I_WED] + eo, nullptr, 1024, 512, (bf16_t*)(p.ws + OFF_WDN) + (size_t)e * 1024 * 512, 1024, 1, lds, ctr);
    }
    __syncthreads();
}

__device__ __forceinline__ void phase_rope_decay(const Params& p, int l) {
    const float* rope = (const float*)(p.ws + OFF_ROPE);
    GSTRIDE_BEGIN(idx, (long)NB * LL * 2 * 8 * 8) {
        const int i4 = (int)(idx & 7) * 4, hc = (int)(idx >> 3) & 7, which = (int)(idx >> 6) & 1; const int lat = (int)(idx >> 7);
        const int b = lat >> 12, t = lat & 4095; const int row = b * LB + LC + t;
        bf16_t* base = (bf16_t*)(p.ws + (which ? OFF_DK : OFF_DQ)) + (size_t)row * 512 + hc * 64 + i4;
        const u32x2_t a = *(const u32x2_t*)base, bq = *(const u32x2_t*)(base + 32);
        const float x1[4] = {bflo(a[0]), bfhi(a[0]), bflo(a[1]), bfhi(a[1])}, x2[4] = {bflo(bq[0]), bfhi(bq[0]), bflo(bq[1]), bfhi(bq[1])};
        float y1[4], y2[4];
#pragma unroll
        for (int j = 0; j < 4; ++j) { const float cs = rope[((size_t)t * 32 + i4 + j) * 2], sn = rope[((size_t)t * 32 + i4 + j) * 2 + 1];
            y1[j] = x1[j] * cs - x2[j] * sn; y2[j] = x1[j] * sn + x2[j] * cs; }
        u32x2_t o1, o2; o1[0] = pk2(y1[0], y1[1]); o1[1] = pk2(y1[2], y1[3]); o2[0] = pk2(y2[0], y2[1]); o2[1] = pk2(y2[2], y2[3]);
        *(u32x2_t*)base = o1; *(u32x2_t*)(base + 32) = o2;
    }
    const float* gr = (const float*)(p.ws + OFF_GR); float* dec = (float*)(p.ws + OFF_S1);
    const float* wd = p.in[I_GWD] + (size_t)l * 2 * 16 * 256; const float* bd = p.in[I_GBD] + (size_t)l * 2 * 256;
    GSTRIDE_BEGIN(idx, (long)T * 512) {
        const int row = (int)(idx >> 9), dj = (int)(idx & 511), dir = dj >> 8, j = dj & 255;
        float z = bd[dir * 256 + j];
#pragma unroll
        for (int r = 0; r < 16; ++r) z += gr[(size_t)row * 32 + dir * 16 + r] * wd[(dir * 16 + r) * 256 + j];
        const float ls = fminf(z, 0.f) - log1pf(__expf(-fabsf(z)));
        dec[idx] = __expf(ls * (1.0f / 16.0f));
    }
}

template <int DIR>
__device__ __forceinline__ void gla_naive_dir(const Params& p, int l, int b, float* lds) {
    const int tid = ltid(), hh = tid >> 7, vc = tid & 127, wv = tid >> 6;
    const bf16_t* GQ = (const bf16_t*)(p.ws + OFF_GQ); const bf16_t* GK = (const bf16_t*)(p.ws + OFF_GK); const bf16_t* GV = (const bf16_t*)(p.ws + OFF_GV);
    bf16_t* GG = (bf16_t*)(p.ws + OFF_GG); const float* DEC = (const float*)(p.ws + OFF_S1); float* OF = (float*)(p.ws + OFF_S2);
    float* sq = lds; float* sk = lds + 16 * 256; float* sd = lds + 32 * 256; float* red = lds + 48 * 256;
    float* sv = lds + 49 * 256;
    const float gn = p.in[I_GNG][l * 128 + vc];
    const int row0 = b * LB;
    float S[64];
#pragma unroll
    for (int d = 0; d < 64; ++d) S[d] = 0.f;
    for (int blk = 0; blk < LB / 16; ++blk) {
        int t0;
        if (DIR == 0) t0 = blk * 16; else t0 = blk < 16 ? (15 - blk) * 16 : (LB / 16 - 1 - (blk - 16)) * 16;
        __syncthreads();
        for (int i = tid; i < 16 * 256; i += 512) { const int r = i >> 8, j = i & 255; const size_t row = row0 + t0 + r;
            sq[i] = bf2f(GQ[row * 256 + j]); sk[i] = bf2f(GK[row * 256 + j]); sd[i] = DEC[(row * 2 + DIR) * 256 + j]; }
#pragma unroll 1
        for (int r = 0; r < 16; ++r) sv[r * 512 + tid] = bf2f(GV[(size_t)(row0 + t0 + r) * 512 + hh * 128 + vc]);
        __syncthreads();
#pragma unroll 1
        for (int rr = 0; rr < 16; ++rr) {
            const int r = DIR == 0 ? rr : 15 - rr;
            const float* pq = sq + r * 256 + hh * 64; const float* pk = sk + r * 256 + hh * 64; const float* pd = sd + r * 256 + hh * 64;
            const float vr = sv[r * 512 + tid];
            float o = 0.f;
#pragma unroll
            for (int d = 0; d < 64; ++d) { S[d] = pd[d] * S[d] + pk[d] * vr; o += pq[d] * S[d]; }
            const size_t oi = (size_t)(row0 + t0 + r) * 512 + hh * 128 + vc;
            if (DIR == 0) OF[oi] = o;
            else {
                const float tot = o + OF[oi];
                sv[r * 512 + tid] = tot;
                const float ss = wave_sum(tot * tot); if ((tid & 63) == 0) red[r * 8 + wv] = ss;
            }
        }
        if (DIR == 1) {
            __syncthreads();
#pragma unroll 1
            for (int r = 0; r < 16; ++r) {
                const float ms = (red[r * 8 + hh * 2] + red[r * 8 + hh * 2 + 1]) * (1.0f / 128.0f);
                const size_t gi = (size_t)(row0 + t0 + r) * 512 + hh * 128 + vc;
                const float gate = bf2f(GG[gi]);
                GG[gi] = f2bf(sv[r * 512 + tid] * rsqrtf(ms + RMS_EPS) * gn * siluf_(gate));
            }
        }
    }
    __syncthreads();
}
__device__ __forceinline__ void gla_naive_batch(const Params& p, int l, int b, float* lds) {
    gla_naive_dir<0>(p, l, b, lds);
    gla_naive_dir<1>(p, l, b, lds);
}

__device__ __forceinline__ void diff_naive_tile(const Params& p, int l, int unit, float* lds) {
    const int tid = ltid(), qi = tid & 127, c = (tid >> 7) & 1, hv = tid >> 8;
    const int qt = unit % 34, bh = unit / 34, hh = bh & 3, b = bh >> 2;
    const int nkeys = qt < 2 ? LC : LB;
    const size_t rowq = (size_t)b * LB + qt * 128 + qi;
    bf16_t* DQ = (bf16_t*)(p.ws + OFF_DQ); const bf16_t* DK = (const bf16_t*)(p.ws + OFF_DK); const bf16_t* DV = (const bf16_t*)(p.ws + OFF_DV);
    float q[64], o[64];
    { const bf16_t* qp = DQ + rowq * 512 + hh * 128 + c * 64;
#pragma unroll
      for (int d8 = 0; d8 < 8; ++d8) { const u32x4_t v = *(const u32x4_t*)(qp + d8 * 8);
#pragma unroll
          for (int j = 0; j < 4; ++j) { q[d8 * 8 + 2 * j] = bflo(v[j]); q[d8 * 8 + 2 * j + 1] = bfhi(v[j]); } } }
#pragma unroll
    for (int d = 0; d < 64; ++d) o[d] = 0.f;
    float m = -INFINITY, lsum = 0.f;
    constexpr int KT = 8; float* kb = lds; float* vb = lds + KT * 128;
    for (int k0 = 0; k0 < nkeys; k0 += KT) {
        __syncthreads();
        for (int i = tid; i < KT * 128; i += 512) { const int r = i >> 7, j = i & 127; const size_t row = (size_t)b * LB + k0 + r;
            kb[i] = bf2f(DK[row * 512 + hh * 128 + j]); vb[i] = bf2f(DV[row * 512 + hh * 128 + j]); }
        __syncthreads();
        float s[KT]; float mt = -INFINITY;
#pragma unroll
        for (int j = 0; j < KT; ++j) { const float* kp = kb + j * 128 + c * 64; float a = 0.f;
#pragma unroll
            for (int d = 0; d < 64; ++d) a += q[d] * kp[d];
            s[j] = a; mt = fmaxf(mt, a); }
        const float mn = fmaxf(m, mt), corr = __expf(m - mn);
        lsum *= corr;
#pragma unroll
        for (int d = 0; d < 64; ++d) o[d] *= corr;
#pragma unroll
        for (int j = 0; j < KT; ++j) { const float pj = __expf(s[j] - mn); lsum += pj; const float* vp = vb + j * 128 + hv * 64;
#pragma unroll
            for (int d = 0; d < 64; ++d) o[d] += pj * vp[d]; }
        m = mn;
    }
    __syncthreads();
    { const float inv = 1.f / lsum; float* cp = lds + ((size_t)qi * 2 + c) * 128 + hv * 64;
#pragma unroll
      for (int d = 0; d < 64; ++d) cp[d] = o[d] * inv; }
    __syncthreads();
    {
        float dq = 0.f, dk2 = 0.f; const float* lq = p.in[I_LQ] + l * 128; const float* lk = p.in[I_LK] + l * 128;
        for (int d = 0; d < 64; ++d) { dq += lq[d] * lk[d]; dk2 += lq[64 + d] * lk[64 + d]; }
        const float lam_init = 0.8f - 0.6f * expf(-0.3f * (float)l);
        const float lam = expf(dq) - expf(dk2) + lam_init;
        const int q2 = tid >> 2, part = tid & 3;
        const float* c0 = lds + ((size_t)q2 * 2) * 128 + part * 32; const float* c1 = c0 + 128;
        float v[32]; float ss = 0.f;
#pragma unroll
        for (int d = 0; d < 32; ++d) { v[d] = c0[d] - lam * c1[d]; ss += v[d] * v[d]; }
        ss += __shfl_xor(ss, 1); ss += __shfl_xor(ss, 2);
        const float sc = rsqrtf(ss * (1.0f / 128.0f) + RMS_EPS) * (1.0f - lam_init);
        const float* g = p.in[I_DNG] + l * 128 + part * 32;
        bf16_t* op = DQ + ((size_t)b * LB + qt * 128 + q2) * 512 + hh * 128 + part * 32;
#pragma unroll
        for (int d = 0; d < 32; d += 2) *(unsigned*)(op + d) = pk2(v[d] * sc * g[d], v[d + 1] * sc * g[d + 1]);
    }
    __syncthreads();
}

__device__ __forceinline__ void na_naive_unit(const Params& p, int l, int unit) {
    const int tid = ltid(), h = tid >> 6, lane = tid & 63;
    const size_t row = (size_t)unit * 64 + lane; const int b = (int)(row / LB), t = (int)(row - (size_t)b * LB);
    bf16_t* NQ = (bf16_t*)(p.ws + OFF_NQ); const bf16_t* NK = (const bf16_t*)(p.ws + OFF_NK); const bf16_t* NV = (const bf16_t*)(p.ws + OFF_NV);
    const float* rpb = p.in[I_RPB] + ((size_t)l * 8 + h) * 15 * 31;
    float q[64], o[64];
    { const bf16_t* qp = NQ + row * 512 + h * 64;
#pragma unroll
      for (int d8 = 0; d8 < 8; ++d8) { const u32x4_t v = *(const u32x4_t*)(qp + d8 * 8);
#pragma unroll
          for (int j = 0; j < 4; ++j) { q[d8 * 8 + 2 * j] = bflo(v[j]); q[d8 * 8 + 2 * j + 1] = bfhi(v[j]); } } }
#pragma unroll
    for (int d = 0; d < 64; ++d) o[d] = 0.f;
    float m = -INFINITY, lsum = 0.f;
    const bool lat = t >= LC; const int tp = t - LC, r = tp >> 6, qc = tp & 63;
    const int rs = min(max(r - 4, 0), 56), cs = min(max(qc - 8, 0), 48);
    const int nloc = lat ? 128 : 0;
    for (int kk = 0; kk < nloc + LC; ++kk) {
        size_t krow; float bias = 0.f;
        if (kk < nloc) { const int kr = rs + (kk >> 4), kc = cs + (kk & 15); krow = (size_t)b * LB + LC + kr * 64 + kc; bias = rpb[(kr - r + 7) * 31 + (kc - qc + 15)]; }
        else krow = (size_t)b * LB + (kk - nloc);
        const bf16_t* kp = NK + krow * 512 + h * 64; const bf16_t* vp = NV + krow * 512 + h * 64;
        float s = bias;
#pragma unroll
        for (int d8 = 0; d8 < 8; ++d8) { const u32x4_t v = *(const u32x4_t*)(kp + d8 * 8);
#pragma unroll
            for (int j = 0; j < 4; ++j) { s += q[d8 * 8 + 2 * j] * bflo(v[j]); s += q[d8 * 8 + 2 * j + 1] * bfhi(v[j]); } }
        const float mn = fmaxf(m, s), corr = __expf(m - mn), pj = __expf(s - mn);
        lsum = lsum * corr + pj; m = mn;
#pragma unroll
        for (int d8 = 0; d8 < 8; ++d8) { const u32x4_t v = *(const u32x4_t*)(vp + d8 * 8);
#pragma unroll
            for (int j = 0; j < 4; ++j) { o[d8 * 8 + 2 * j] = o[d8 * 8 + 2 * j] * corr + pj * bflo(v[j]); o[d8 * 8 + 2 * j + 1] = o[d8 * 8 + 2 * j + 1] * corr + pj * bfhi(v[j]); } }
    }
    const float inv = 1.f / lsum;
    bf16_t* op = NQ + row * 512 + h * 64;
#pragma unroll
    for (int d8 = 0; d8 < 8; ++d8) { u32x4_t v;
#pragma unroll
        for (int j = 0; j < 4; ++j) v[j] = pk2(o[d8 * 8 + 2 * j] * inv, o[d8 * 8 + 2 * j + 1] * inv);
        *(u32x4_t*)(op + d8 * 8) = v; }
}

__device__ __forceinline__ void ln_row(float (&v)[16], const float* g, const float* bb, int lane) {
    float s = 0.f;
#pragma unroll
    for (int i = 0; i < 16; ++i) s += v[i];
    const float mu = wave_sum(s) * (1.0f / 1024.0f);
    float q = 0.f;
#pragma unroll
    for (int i = 0; i < 16; ++i) { v[i] -= mu; q += v[i] * v[i]; }
    const float rstd = rsqrtf(wave_sum(q) * (1.0f / 1024.0f) + LN_EPS);
#pragma unroll
    for (int i = 0; i < 4; ++i) { const f32x4 gv = *(const f32x4*)(g + i * 256 + lane * 4), bv = *(const f32x4*)(bb + i * 256 + lane * 4);
#pragma unroll
        for (int j = 0; j < 4; ++j) v[i * 4 + j] = v[i * 4 + j] * rstd * gv[j] + bv[j]; }
}

__device__ __forceinline__ void top2of4(const float s0, const float s1, const float s2, const float s3, int& i1, int& i2, float& sum) {
    i1 = 0; float m1 = s0;
    if (s1 > m1) { m1 = s1; i1 = 1; } if (s2 > m1) { m1 = s2; i1 = 2; } if (s3 > m1) { m1 = s3; i1 = 3; }
    float m2 = -INFINITY; i2 = 0;
    if (i1 != 0 && s0 > m2) { m2 = s0; i2 = 0; } if (i1 != 1 && s1 > m2) { m2 = s1; i2 = 1; }
    if (i1 != 2 && s2 > m2) { m2 = s2; i2 = 2; } if (i1 != 3 && s3 > m2) { m2 = s3; i2 = 3; }
    sum = m1 + m2;
}

__device__ __forceinline__ void phase_ln1_router(const Params& p, int l) {
    const int lane = ltid() & 63, wv = ltid() >> 6, wpb = NTHR >> 6;
    float* xs = (float*)(p.ws + OFF_XS); bf16_t* h = (bf16_t*)(p.ws + OFF_H); const float* mod = (const float*)(p.ws + OFF_MOD);
    int* tok = (int*)(p.ws + OFF_TOK); unsigned* cnt = (unsigned*)(p.ws + OFF_CNT) + l * 16;
    const float* g = p.in[I_LNG] + (size_t)(l * 2 + 0) * 1024; const float* bb = p.in[I_LNB] + (size_t)(l * 2 + 0) * 1024;
    const float* wr = p.in[I_WR]; const float* br = p.in[I_BR];
    for (int row = blockIdx.x * wpb + wv; row < T; row += gridDim.x * wpb) {
        const int slot = row_slot(row);
        const float* msh = mod + ((size_t)(l * 9 + slot) * 6 + 3) * 1024; const float* msc = msh + 1024;
        float v[16];
#pragma unroll
        for (int i = 0; i < 4; ++i) { const f32x4 t4 = *(const f32x4*)(xs + (size_t)row * 1024 + i * 256 + lane * 4);
#pragma unroll
            for (int j = 0; j < 4; ++j) v[i * 4 + j] = t4[j]; }
        ln_row(v, g, bb, lane);
        float lg[16];
#pragma unroll
        for (int e = 0; e < 16; ++e) lg[e] = 0.f;
#pragma unroll
        for (int i = 0; i < 4; ++i) {
            const int c0 = i * 256 + lane * 4;
            f32x4 x4; x4[0] = v[i * 4]; x4[1] = v[i * 4 + 1]; x4[2] = v[i * 4 + 2]; x4[3] = v[i * 4 + 3];
            *(f32x4*)(xs + (size_t)row * 1024 + c0) = x4;
            const f32x4 sh = *(const f32x4*)(msh + c0), sc = *(const f32x4*)(msc + c0);
            const f32x4 hv = x4 * (sc + 1.0f) + sh;
            u32x2_t o; o[0] = pk2(hv[0], hv[1]); o[1] = pk2(hv[2], hv[3]);
            *(u32x2_t*)(h + (size_t)row * 1024 + c0) = o;
#pragma unroll
            for (int j = 0; j < 4; ++j) { const float* wp = wr + (size_t)(c0 + j) * 16;
#pragma unroll
                for (int e4 = 0; e4 < 4; ++e4) { const f32x4 w4 = *(const f32x4*)(wp + e4 * 4);
#pragma unroll
                    for (int k = 0; k < 4; ++k) lg[e4 * 4 + k] += hv[j] * w4[k]; } }
        }
        float aff[16], sel[16];
#pragma unroll
        for (int e = 0; e < 16; ++e) { lg[e] = wave_sum(lg[e]); aff[e] = sigmoidf_(lg[e]); sel[e] = aff[e] + br[e]; }
        int bi1 = 0, bi2 = 0, bg = 0; float best = -INFINITY;
#pragma unroll
        for (int gq = 0; gq < 4; ++gq) { int i1, i2; float sm; top2of4(sel[gq * 4], sel[gq * 4 + 1], sel[gq * 4 + 2], sel[gq * 4 + 3], i1, i2, sm);
            if (sm > best) { best = sm; bg = gq; bi1 = i1; bi2 = i2; } }
        const int e1 = bg * 4 + bi1, e2 = bg * 4 + bi2;
        float a1 = 0.f, a2 = 0.f;
#pragma unroll
        for (int e = 0; e < 16; ++e) { a1 = (e == e1) ? aff[e] : a1; a2 = (e == e2) ? aff[e] : a2; }
        const float inv = 1.f / (a1 + a2);
        if (lane == 0) {
            const unsigned s1 = atomicAdd(cnt + e1, 1u), s2 = atomicAdd(cnt + e2, 1u);
            int* tp = tok + (size_t)row * 8;
            tp[0] = e1; tp[1] = e2; tp[2] = (int)s1; tp[3] = (int)s2; tp[4] = __float_as_int(a1 * inv); tp[5] = __float_as_int(a2 * inv);
        }
    }
}

__device__ __forceinline__ void phase_gather(const Params& p, int l) {
    const int lane = ltid() & 63, wv = ltid() >> 6, wpb = NTHR >> 6;
    const unsigned* cnt = (const unsigned*)(p.ws + OFF_CNT) + l * 16;
    int base[16]; { int s = 0;
#pragma unroll
        for (int e = 0; e < 16; ++e) { base[e] = s; s += (int)((cnt[e] + 255u) >> 8) * 256; } }
    const bf16_t* h = (const bf16_t*)(p.ws + OFF_H); bf16_t* xa = (bf16_t*)(p.ws + OFF_XA); int* tok = (int*)(p.ws + OFF_TOK);
    for (int row = blockIdx.x * wpb + wv; row < T; row += gridDim.x * wpb) {
        int* tp = tok + (size_t)row * 8;
        const int e1 = tp[0], e2 = tp[1], s1 = tp[2], s2 = tp[3];
        int b1 = 0, b2 = 0;
#pragma unroll
        for (int e = 0; e < 16; ++e) { b1 = (e == e1) ? base[e] : b1; b2 = (e == e2) ? base[e] : b2; }
        const int p1 = b1 + s1, p2 = b2 + s2;
        const u32x4_t v0 = *(const u32x4_t*)(h + (size_t)row * 1024 + lane * 8), v1 = *(const u32x4_t*)(h + (size_t)row * 1024 + 512 + lane * 8);
        *(u32x4_t*)(xa + (size_t)p1 * 1024 + lane * 8) = v0; *(u32x4_t*)(xa + (size_t)p1 * 1024 + 512 + lane * 8) = v1;
        *(u32x4_t*)(xa + (size_t)p2 * 1024 + lane * 8) = v0; *(u32x4_t*)(xa + (size_t)p2 * 1024 + 512 + lane * 8) = v1;
        if (lane == 0) { tp[6] = p1; tp[7] = p2; }
    }
}

__device__ __forceinline__ void phase_ln2(const Params& p, int l) {
    const int lane = ltid() & 63, wv = ltid() >> 6, wpb = NTHR >> 6;
    float* xs = (float*)(p.ws + OFF_XS); bf16_t* h = (bf16_t*)(p.ws + OFF_H); const float* mod = (const float*)(p.ws + OFF_MOD);
    const int* tok = (const int*)(p.ws + OFF_TOK); const bf16_t* y = (const bf16_t*)(p.ws + OFF_Y);
    const float* g = p.in[I_LNG] + (size_t)(l * 2 + 1) * 1024; const float* bb = p.in[I_LNB] + (size_t)(l * 2 + 1) * 1024;
    for (int row = blockIdx.x * wpb + wv; row < T; row += gridDim.x * wpb) {
        const int slot = row_slot(row);
        const int* tp = tok + (size_t)row * 8;
        const float w0 = __int_as_float(tp[4]), w1 = __int_as_float(tp[5]); const size_t p0 = (size_t)tp[6], p1 = (size_t)tp[7];
        const float* mg = mod + ((size_t)(l * 9 + slot) * 6 + 5) * 1024;
        float v[16];
#pragma unroll
        for (int i = 0; i < 4; ++i) { const int c0 = i * 256 + lane * 4;
            const f32x4 x4 = *(const f32x4*)(xs + (size_t)row * 1024 + c0), g4 = *(const f32x4*)(mg + c0);
            const u32x2_t ya = *(const u32x2_t*)(y + p0 * 1024 + c0), yb = *(const u32x2_t*)(y + p1 * 1024 + c0);
            v[i * 4 + 0] = ALPHA * x4[0] + g4[0] * (w0 * bflo(ya[0]) + w1 * bflo(yb[0]));
            v[i * 4 + 1] = ALPHA * x4[1] + g4[1] * (w0 * bfhi(ya[0]) + w1 * bfhi(yb[0]));
            v[i * 4 + 2] = ALPHA * x4[2] + g4[2] * (w0 * bflo(ya[1]) + w1 * bflo(yb[1]));
            v[i * 4 + 3] = ALPHA * x4[3] + g4[3] * (w0 * bfhi(ya[1]) + w1 * bfhi(yb[1])); }
        ln_row(v, g, bb, lane);
        const int b = row / LB, t = row - b * LB;
        if (l == DEPTH - 1) {
            if (t >= LC) { float* op = p.out + ((size_t)b * LL + (t - LC)) * 1024;
#pragma unroll
                for (int i = 0; i < 4; ++i) { f32x4 x4; x4[0] = v[i * 4]; x4[1] = v[i * 4 + 1]; x4[2] = v[i * 4 + 2]; x4[3] = v[i * 4 + 3]; *(f32x4*)(op + i * 256 + lane * 4) = x4; } }
        } else {
            const float* msh = mod + ((size_t)((l + 1) * 9 + slot) * 6 + 0) * 1024; const float* msc = msh + 1024;
#pragma unroll
            for (int i = 0; i < 4; ++i) { const int c0 = i * 256 + lane * 4;
                f32x4 x4; x4[0] = v[i * 4]; x4[1] = v[i * 4 + 1]; x4[2] = v[i * 4 + 2]; x4[3] = v[i * 4 + 3];
                *(f32x4*)(xs + (size_t)row * 1024 + c0) = x4;
                const f32x4 sh = *(const f32x4*)(msh + c0), sc = *(const f32x4*)(msc + c0);
                const f32x4 hv = x4 * (sc + 1.0f) + sh;
                u32x2_t o; o[0] = pk2(hv[0], hv[1]); o[1] = pk2(hv[2], hv[3]);
                *(u32x2_t*)(h + (size_t)row * 1024 + c0) = o; }
        }
    }
}

typedef float f32x16 __attribute__((ext_vector_type(16)));
typedef short bf16x8_t __attribute__((ext_vector_type(8)));
constexpr float LOG2E = 1.4426950408889634f;

__device__ __forceinline__ void vtrans_buf(const bf16_t* src, bf16_t* dst, bf16_t* lds) {
    const int tid = ltid();
    constexpr int LS = 72;
    for (int it = blockIdx.x; it < NB * 8 * (LB / 64); it += gridDim.x) {
        const int kt = it % (LB / 64), bc = it / (LB / 64), cg = bc & 7, b = bc >> 3;
        __syncthreads();
        { const int key = tid >> 3, d8 = (tid & 7) * 8;
          const u32x4_t v = *(const u32x4_t*)(src + ((size_t)b * LB + kt * 64 + key) * 512 + cg * 64 + d8);
#pragma unroll
          for (int j = 0; j < 4; ++j) { lds[(d8 + 2 * j) * LS + key] = (bf16_t)(v[j] & 0xffffu); lds[(d8 + 2 * j + 1) * LS + key] = (bf16_t)(v[j] >> 16); } }
        __syncthreads();
        { const int dv = tid >> 3, k8 = (tid & 7) * 8;
          const u32x4_t v = *(const u32x4_t*)(lds + dv * LS + k8);
          *(u32x4_t*)(dst + ((size_t)(b * 512 + cg * 64 + dv)) * LB + kt * 64 + k8) = v; }
    }
    __syncthreads();
}
__device__ __forceinline__ void phase_vtrans(const Params& p, int l, bf16_t* lds) {
#if FAST_DIFF
    vtrans_buf((const bf16_t*)(p.ws + OFF_DV), (bf16_t*)(p.ws + OFF_VT), lds);
#endif
#if FAST_GLA
    vtrans_buf((const bf16_t*)(p.ws + OFF_GV), (bf16_t*)(p.ws + OFF_GVT), lds);
#endif
#if FAST_NA
    vtrans_buf((const bf16_t*)(p.ws + OFF_NV), (bf16_t*)(p.ws + OFF_NVT), lds);
    { float* bt = (float*)(p.ws + OFF_NBT); const float* rpb = p.in[I_RPB] + (size_t)l * 8 * 15 * 31;
      for (int i = blockIdx.x * NTHR + ltid(); i < 8 * 15 * 4 * 64 * 16; i += gridDim.x * NTHR) {
          const int r = i & 15, lane = (i >> 4) & 63, ib = (i >> 10) & 1, kb = (i >> 11) & 1, hd = i >> 12;
          const int kc = 32 * kb + (r & 3) + 8 * (r >> 2) + 4 * (lane >> 5), qc = 32 * ib + (lane & 31);
          const int cs = min(max(qc - 8, 0), 48);
          bt[i] = (kc >= cs && kc < cs + 16) ? rpb[hd * 31 + (kc - qc + 15)] : -1e30f; } }
#endif
}

constexpr int DA_KS = 272, DA_VS = 136, DA_KB = 64 * DA_KS  , DA_VB = 128 * DA_VS  ;
constexpr int DA_UNITS = NB * 4 * 34;
__device__ __forceinline__ void diff_attn_unit(const Params& p, int l, int unit, unsigned char* shm) {
    const int tid = ltid(), lane = tid & 63, wid = tid >> 6, c = wid & 1, qb = wid >> 1, m32 = lane & 31, h = lane >> 5;
    int bh, qt;
    if (unit < NB * 4 * 32) { bh = unit >> 5; qt = 2 + (unit & 31); } else { const int u2 = unit - NB * 4 * 32; bh = u2 >> 1; qt = u2 & 1; }
    const int hh = bh & 3, b = bh >> 2, nkt = qt < 2 ? LC / 64 : LB / 64;
    const size_t rowb = (size_t)b * LB;
    bf16_t* DQ = (bf16_t*)(p.ws + OFF_DQ); const bf16_t* DK = (const bf16_t*)(p.ws + OFF_DK); const bf16_t* VT = (const bf16_t*)(p.ws + OFF_VT);
    const size_t qrow = rowb + qt * 128 + qb * 32 + m32;
    bf16x8_t qf[4];
#pragma unroll
    for (int s = 0; s < 4; ++s) qf[s] = *(const bf16x8_t*)(DQ + qrow * 512 + hh * 128 + c * 64 + 16 * s + 8 * h);
    f32x16 O[4];
#pragma unroll
    for (int d = 0; d < 4; ++d)
#pragma unroll
        for (int r = 0; r < 16; ++r) O[d][r] = 0.f;
    float mrun = -INFINITY, lrun = 0.f;
    const bf16_t* kg[2]; const bf16_t* vg[2]; int kl[2], vl[2];
#pragma unroll
    for (int j = 0; j < 2; ++j) { const int i = tid + j * 512;
        kg[j] = DK + (rowb + (i >> 4)) * 512 + hh * 128 + (i & 15) * 8; kl[j] = (i >> 4) * DA_KS + (i & 15) * 16;
        vg[j] = VT + ((size_t)(bh * 128 + (i >> 3))) * LB + (i & 7) * 8; vl[j] = 2 * DA_KB + (i >> 3) * DA_VS + (i & 7) * 16; }
    u32x4_t rk[2], rv[2];
    __syncthreads();
#pragma unroll
    for (int j = 0; j < 2; ++j) { rk[j] = *(const u32x4_t*)(kg[j]); rv[j] = *(const u32x4_t*)(vg[j]); }
#pragma unroll
    for (int j = 0; j < 2; ++j) { *(u32x4_t*)(shm + kl[j]) = rk[j]; u32x2_t a, bq; a[0] = rv[j][0]; a[1] = rv[j][1]; bq[0] = rv[j][2]; bq[1] = rv[j][3];
        *(u32x2_t*)(shm + vl[j]) = a; *(u32x2_t*)(shm + vl[j] + 8) = bq; }
    __syncthreads();
    for (int kt = 0; kt < nkt; ++kt) {
        const int buf = kt & 1; const bool more = kt + 1 < nkt;
        if (more) {
#pragma unroll
            for (int j = 0; j < 2; ++j) { rk[j] = *(const u32x4_t*)(kg[j] + (size_t)(kt + 1) * 64 * 512); rv[j] = *(const u32x4_t*)(vg[j] + (kt + 1) * 64); }
        }
        const unsigned char* kbase = shm + buf * DA_KB + m32 * DA_KS + (c * 64 + 8 * h) * 2;
        const unsigned char* vbase = shm + 2 * DA_KB + buf * DA_VB + m32 * DA_VS + 8 * h;
        bf16x8_t pf[4];
        {
            f32x16 S[2];
#pragma unroll
            for (int kb = 0; kb < 2; ++kb) {
#pragma unroll
                for (int r = 0; r < 16; ++r) S[kb][r] = 0.f;
#pragma unroll
                for (int s = 0; s < 4; ++s) { const bf16x8_t kf = *(const bf16x8_t*)(kbase + kb * 32 * DA_KS + s * 32);
                    S[kb] = __builtin_amdgcn_mfma_f32_32x32x16_bf16(kf, qf[s], S[kb], 0, 0, 0); }
            }
            float mx = S[0][0];
#pragma unroll
            for (int r = 1; r < 16; ++r) mx = fmaxf(mx, S[0][r]);
#pragma unroll
            for (int r = 0; r < 16; ++r) mx = fmaxf(mx, S[1][r]);
            mx = fmaxf(mx, __shfl_xor(mx, 32));
            const float mn = fmaxf(mrun, mx), corr = __builtin_amdgcn_exp2f((mrun - mn) * LOG2E), mnl = mn * LOG2E;
            mrun = mn;
            float sum = 0.f;
#pragma unroll
            for (int kb = 0; kb < 2; ++kb)
#pragma unroll
                for (int r = 0; r < 16; ++r) { const float e = __builtin_amdgcn_exp2f(S[kb][r] * LOG2E - mnl); S[kb][r] = e; sum += e; }
            sum += __shfl_xor(sum, 32);
            lrun = lrun * corr + sum;
#pragma unroll
            for (int d = 0; d < 4; ++d)
#pragma unroll
                for (int r = 0; r < 16; ++r) O[d][r] *= corr;
#pragma unroll
            for (int ks = 0; ks < 4; ++ks) { const int kb = ks >> 1, r0 = (ks & 1) * 8; u32x4_t pk;
#pragma unroll
                for (int j = 0; j < 4; ++j) pk[j] = pk2(S[kb][r0 + 2 * j], S[kb][r0 + 2 * j + 1]);
                pf[ks] = __builtin_bit_cast(bf16x8_t, pk); }
        }
#pragma unroll
        for (int d = 0; d < 4; ++d)
#pragma unroll
            for (int ks = 0; ks < 4; ++ks) {
                const u32x2_t v0 = *(const u32x2_t*)(vbase + d * 32 * DA_VS + ks * 32), v1 = *(const u32x2_t*)(vbase + d * 32 * DA_VS + ks * 32 + 16);
                u32x4_t vv; vv[0] = v0[0]; vv[1] = v0[1]; vv[2] = v1[0]; vv[3] = v1[1];
                O[d] = __builtin_amdgcn_mfma_f32_32x32x16_bf16(__builtin_bit_cast(bf16x8_t, vv), pf[ks], O[d], 0, 0, 0);
            }
        if (more) {
#pragma unroll
            for (int j = 0; j < 2; ++j) { *(u32x4_t*)(shm + (buf ^ 1) * DA_KB + kl[j]) = rk[j]; u32x2_t a, bq; a[0] = rv[j][0]; a[1] = rv[j][1]; bq[0] = rv[j][2]; bq[1] = rv[j][3];
                *(u32x2_t*)(shm + (buf ^ 1) * DA_VB + vl[j]) = a; *(u32x2_t*)(shm + (buf ^ 1) * DA_VB + vl[j] + 8) = bq; }
        }
        __syncthreads();
    }
    float* xch = (float*)shm;
    { const float inv = 1.f / lrun;
#pragma unroll
        for (int d = 0; d < 4; ++d)
#pragma unroll
            for (int r = 0; r < 16; ++r) O[d][r] *= inv; }
    if (c == 1) {
#pragma unroll
        for (int d = 0; d < 4; ++d)
#pragma unroll
            for (int r = 0; r < 16; ++r) xch[(((qb * 4 + d) * 16 + r) << 6) + lane] = O[d][r];
    }
    __syncthreads();
    if (c == 0) {
        float dq = 0.f, dk2 = 0.f; const float* lq = p.in[I_LQ] + l * 128; const float* lk = p.in[I_LK] + l * 128;
        for (int d = 0; d < 64; ++d) { dq += lq[d] * lk[d]; dk2 += lq[64 + d] * lk[64 + d]; }
        const float lam_init = 0.8f - 0.6f * expf(-0.3f * (float)l);
        const float lam = expf(dq) - expf(dk2) + lam_init;
        const float* g = p.in[I_DNG] + l * 128;
        float ss = 0.f;
#pragma unroll
        for (int d = 0; d < 4; ++d)
#pragma unroll
            for (int r = 0; r < 16; ++r) { const float v = O[d][r] - lam * xch[(((qb * 4 + d) * 16 + r) << 6) + lane]; O[d][r] = v; ss += v * v; }
        ss += __shfl_xor(ss, 32);
        const float sc = rsqrtf(ss * (1.0f / 128.0f) + RMS_EPS) * (1.0f - lam_init);
        bf16_t* op = DQ + qrow * 512 + hh * 128 + 4 * h;
#pragma unroll
        for (int d = 0; d < 4; ++d)
#pragma unroll
            for (int r4 = 0; r4 < 4; ++r4) { const int dv = 32 * d + 8 * r4; const f32x4 gv = *(const f32x4*)(g + dv + 4 * h);
                u32x2_t o; o[0] = pk2(O[d][4 * r4] * sc * gv[0], O[d][4 * r4 + 1] * sc * gv[1]); o[1] = pk2(O[d][4 * r4 + 2] * sc * gv[2], O[d][4 * r4 + 3] * sc * gv[3]);
                *(u32x2_t*)(op + dv) = o; }
    }
    __syncthreads();
}

constexpr int NA_KS = 528, NA_VS = 136, NA_KB = 64 * NA_KS  , NA_VB = 256 * NA_VS  ;
constexpr int NA_UNITS = NB * 64 * 2 + NB * 4 * 2;
__device__ __forceinline__ void na_attn_unit(const Params& p, int l, int unit, unsigned char* shm) {
    const int tid = ltid(), lane = tid & 63, wid = tid >> 6, hgi = wid & 3, ib = wid >> 2, m32 = lane & 31, h = lane >> 5;
    int b, hg, r, ntile; size_t rowq0;
    if (unit < NB * 64 * 2) { hg = unit & 1; r = (unit >> 1) & 63; b = unit >> 7; ntile = 12; rowq0 = (size_t)b * LB + LC + r * 64; }
    else { const int u2 = unit - NB * 64 * 2; hg = u2 & 1; r = -1; b = u2 >> 3; ntile = 4; rowq0 = (size_t)b * LB + ((u2 >> 1) & 3) * 64; }
    const int rs = min(max(r - 4, 0), 56), head = hg * 4 + hgi;
    const size_t rowb = (size_t)b * LB;
    bf16_t* NQ = (bf16_t*)(p.ws + OFF_NQ); const bf16_t* NK = (const bf16_t*)(p.ws + OFF_NK); const bf16_t* NVT = (const bf16_t*)(p.ws + OFF_NVT);
    const float* BT = (const float*)(p.ws + OFF_NBT);
    const size_t qrow = rowq0 + ib * 32 + m32;
    bf16x8_t qf[4];
#pragma unroll
    for (int s = 0; s < 4; ++s) qf[s] = *(const bf16x8_t*)(NQ + qrow * 512 + head * 64 + 16 * s + 8 * h);
    f32x16 O[2];
#pragma unroll
    for (int d = 0; d < 2; ++d)
#pragma unroll
        for (int q = 0; q < 16; ++q) O[d][q] = 0.f;
    float mrun = -INFINITY, lrun = 0.f;
    const bf16_t* kg[4]; const bf16_t* vg[4]; int kl[4], vl[4];
#pragma unroll
    for (int j = 0; j < 4; ++j) { const int i = tid + j * 512;
        kg[j] = NK + (rowb + (i >> 5)) * 512 + hg * 256 + (i & 31) * 8; kl[j] = (i >> 5) * NA_KS + (i & 31) * 16;
        vg[j] = NVT + ((size_t)(b * 512 + hg * 256 + (i >> 3))) * LB + (i & 7) * 8; vl[j] = 2 * NA_KB + (i >> 3) * NA_VS + (i & 7) * 16; }
    auto tile_of = [&](int t) -> int { return ntile == 12 ? (t < 8 ? 4 + rs + t : t - 8) : t; };
    u32x4_t rk[4], rv[4];
    __syncthreads();
    { const int tt = tile_of(0);
#pragma unroll
      for (int j = 0; j < 4; ++j) { rk[j] = *(const u32x4_t*)(kg[j] + (size_t)tt * 64 * 512); rv[j] = *(const u32x4_t*)(vg[j] + tt * 64); } }
#pragma unroll
    for (int j = 0; j < 4; ++j) { *(u32x4_t*)(shm + kl[j]) = rk[j]; u32x2_t a, bq; a[0] = rv[j][0]; a[1] = rv[j][1]; bq[0] = rv[j][2]; bq[1] = rv[j][3];
        *(u32x2_t*)(shm + vl[j]) = a; *(u32x2_t*)(shm + vl[j] + 8) = bq; }
    __syncthreads();
    for (int t = 0; t < ntile; ++t) {
        const int buf = t & 1; const bool more = t + 1 < ntile;
        if (more) { const int tt = tile_of(t + 1);
#pragma unroll
            for (int j = 0; j < 4; ++j) { rk[j] = *(const u32x4_t*)(kg[j] + (size_t)tt * 64 * 512); rv[j] = *(const u32x4_t*)(vg[j] + tt * 64); }
        }
        const unsigned char* kbase = shm + buf * NA_KB + m32 * NA_KS + (hgi * 64 + 8 * h) * 2;
        const unsigned char* vbase = shm + 2 * NA_KB + buf * NA_VB + (hgi * 64 + m32) * NA_VS + 8 * h;
        bf16x8_t pf[4];
        {
            f32x16 S[2];
            const bool local = (ntile == 12) && (t < 8);
            if (local) { const int dr = rs + t - r + 7; const float* bp = BT + ((size_t)(((head * 15 + dr) * 2) * 2 + ib) * 64 + lane) * 16;
#pragma unroll
                for (int kb = 0; kb < 2; ++kb)
#pragma unroll
                    for (int q4 = 0; q4 < 4; ++q4) { const f32x4 bv = *(const f32x4*)(bp + kb * 2 * 64 * 16 + q4 * 4);
                        S[kb][q4 * 4] = bv[0]; S[kb][q4 * 4 + 1] = bv[1]; S[kb][q4 * 4 + 2] = bv[2]; S[kb][q4 * 4 + 3] = bv[3]; }
            } else {
#pragma unroll
                for (int kb = 0; kb < 2; ++kb)
#pragma unroll
                    for (int q = 0; q < 16; ++q) S[kb][q] = 0.f;
            }
#pragma unroll
            for (int kb = 0; kb < 2; ++kb)
#pragma unroll
                for (int s = 0; s < 4; ++s) { const bf16x8_t kf = *(const bf16x8_t*)(kbase + kb * 32 * NA_KS + s * 32);
                    S[kb] = __builtin_amdgcn_mfma_f32_32x32x16_bf16(kf, qf[s], S[kb], 0, 0, 0); }
            float mx = S[0][0];
#pragma unroll
            for (int q = 1; q < 16; ++q) mx = fmaxf(mx, S[0][q]);
#pragma unroll
            for (int q = 0; q < 16; ++q) mx = fmaxf(mx, S[1][q]);
            mx = fmaxf(mx, __shfl_xor(mx, 32));
            const float mn = fmaxf(mrun, mx), corr = __builtin_amdgcn_exp2f((mrun - mn) * LOG2E), mnl = mn * LOG2E;
            mrun = mn;
            float sum = 0.f;
#pragma unroll
            for (int kb = 0; kb < 2; ++kb)
#pragma unroll
                for (int q = 0; q < 16; ++q) { const float e = __builtin_amdgcn_exp2f(S[kb][q] * LOG2E - mnl); S[kb][q] = e; sum += e; }
            sum += __shfl_xor(sum, 32);
            lrun = lrun * corr + sum;
#pragma unroll
            for (int d = 0; d < 2; ++d)
#pragma unroll
                for (int q = 0; q < 16; ++q) O[d][q] *= corr;
#pragma unroll
            for (int ks = 0; ks < 4; ++ks) { const int kb = ks >> 1, r0 = (ks & 1) * 8; u32x4_t pk;
#pragma unroll
                for (int j = 0; j < 4; ++j) pk[j] = pk2(S[kb][r0 + 2 * j], S[kb][r0 + 2 * j + 1]);
                pf[ks] = __builtin_bit_cast(bf16x8_t, pk); }
        }
#pragma unroll
        for (int d = 0; d < 2; ++d)
#pragma unroll
            for (int ks = 0; ks < 4; ++ks) {
                const u32x2_t v0 = *(const u32x2_t*)(vbase + d * 32 * NA_VS + ks * 32), v1 = *(const u32x2_t*)(vbase + d * 32 * NA_VS + ks * 32 + 16);
                u32x4_t vv; vv[0] = v0[0]; vv[1] = v0[1]; vv[2] = v1[0]; vv[3] = v1[1];
                O[d] = __builtin_amdgcn_mfma_f32_32x32x16_bf16(__builtin_bit_cast(bf16x8_t, vv), pf[ks], O[d], 0, 0, 0);
            }
        if (more) {
#pragma unroll
            for (int j = 0; j < 4; ++j) { *(u32x4_t*)(shm + (buf ^ 1) * NA_KB + kl[j]) = rk[j]; u32x2_t a, bq; a[0] = rv[j][0]; a[1] = rv[j][1]; bq[0] = rv[j][2]; bq[1] = rv[j][3];
                *(u32x2_t*)(shm + (buf ^ 1) * NA_VB + vl[j]) = a; *(u32x2_t*)(shm + (buf ^ 1) * NA_VB + vl[j] + 8) = bq; }
        }
        __syncthreads();
    }
    { const float inv = 1.f / lrun; bf16_t* op = NQ + qrow * 512 + head * 64 + 4 * h;
#pragma unroll
        for (int d = 0; d < 2; ++d)
#pragma unroll
            for (int r4 = 0; r4 < 4; ++r4) { u32x2_t o; o[0] = pk2(O[d][4 * r4] * inv, O[d][4 * r4 + 1] * inv); o[1] = pk2(O[d][4 * r4 + 2] * inv, O[d][4 * r4 + 3] * inv);
                *(u32x2_t*)(op + 32 * d + 8 * r4) = o; } }
    __syncthreads();
}

constexpr int GL_XS = 144;
__device__ __forceinline__ void gla_stage_gr(const Params& p, int row0, float* grs, int tid) {
    const float* gr = (const float*)(p.ws + OFF_GR);
    __syncthreads();
    *(f32x4*)(grs + tid * 4) = *(const f32x4*)(gr + (size_t)row0 * 32 + tid * 4);
    __syncthreads();
}
struct GlaCol { float w[16]; float bcol; };
__device__ __forceinline__ void gla_col_init(const Params& p, int l, int hh, int dir, int lane, GlaCol& gc) {
    const int col = hh * 64 + lane;
    const float* wd = p.in[I_GWD] + ((size_t)(l * 2 + dir) * 16) * 256 + col;
#pragma unroll
    for (int i = 0; i < 16; ++i) gc.w[i] = wd[i * 256];
    gc.bcol = p.in[I_GBD][(size_t)(l * 2 + dir) * 256 + col];
}
__device__ __forceinline__ float gla_logd(const GlaCol& gc, const float* grs, int r, int dir) {
    const float* gp = grs + r * 32 + dir * 16;
    float z = gc.bcol;
#pragma unroll
    for (int i4 = 0; i4 < 4; ++i4) { const f32x4 g4 = *(const f32x4*)(gp + i4 * 4);
        z += g4[0] * gc.w[i4 * 4] + g4[1] * gc.w[i4 * 4 + 1] + g4[2] * gc.w[i4 * 4 + 2] + g4[3] * gc.w[i4 * 4 + 3]; }
    return (fminf(z, 0.f) - __logf(1.f + __expf(-fabsf(z)))) * (1.0f / 16.0f);
}
__device__ __forceinline__ float gla_total(const GlaCol& gc, const float* grs, int dir) {
    float run = 0.f;
#pragma unroll 4
    for (int r = 0; r < 64; ++r) run += gla_logd(gc, grs, r, dir);
    return run;
}

__device__ __forceinline__ void gla_a_unit(const Params& p, int l, int unit, unsigned char* shm) {
    const int tid = ltid(), lane = tid & 63, wid = tid >> 6, hh = wid >> 1, dir = wid & 1, m32 = lane & 31, h = lane >> 5;
    const int b = unit / 68, n = unit - b * 68; const int row0 = b * LB + n * 64; const int bhd = (b * 4 + hh) * 2 + dir;
    float* grs = (float*)shm; unsigned char* kt = shm + 8192 + wid * 9216;
    gla_stage_gr(p, row0, grs, tid);
    {
        GlaCol gc; gla_col_init(p, l, hh, dir, lane, gc);
        const float last = gla_total(gc, grs, dir);
        ((float*)(p.ws + OFF_DECAY))[((size_t)bhd * 68 + n) * 64 + lane] = __expf(last);
        const bf16_t* gk = (const bf16_t*)(p.ws + OFF_GK) + (size_t)row0 * 256 + hh * 64 + lane;
        float run = 0.f;
#pragma unroll 4
        for (int r = 0; r < 64; ++r) { const float ex = run; run += gla_logd(gc, grs, r, dir);
            const float c = dir ? last - ex : run;
            *(bf16_t*)(kt + lane * GL_XS + r * 2) = f2bf(bf2f(gk[(size_t)r * 256]) * __expf(last - c)); }
    }
    asm volatile("s_waitcnt lgkmcnt(0)" ::: "memory"); __builtin_amdgcn_wave_barrier();
    f32x16 acc[2][4];
#pragma unroll
    for (int mb = 0; mb < 2; ++mb)
#pragma unroll
        for (int nb = 0; nb < 4; ++nb)
#pragma unroll
            for (int r = 0; r < 16; ++r) acc[mb][nb][r] = 0.f;
    const bf16_t* gvt = (const bf16_t*)(p.ws + OFF_GVT) + ((size_t)(b * 512 + hh * 128 + m32)) * LB + n * 64 + 8 * h;
#pragma unroll
    for (int s = 0; s < 4; ++s) {
        bf16x8_t af[2], bfr[4];
#pragma unroll
        for (int mb = 0; mb < 2; ++mb) af[mb] = *(const bf16x8_t*)(kt + (32 * mb + m32) * GL_XS + (16 * s + 8 * h) * 2);
#pragma unroll
        for (int nb = 0; nb < 4; ++nb) bfr[nb] = *(const bf16x8_t*)(gvt + (size_t)(32 * nb) * LB + 16 * s);
#pragma unroll
        for (int mb = 0; mb < 2; ++mb)
#pragma unroll
            for (int nb = 0; nb < 4; ++nb) acc[mb][nb] = __builtin_amdgcn_mfma_f32_32x32x16_bf16(af[mb], bfr[nb], acc[mb][nb], 0, 0, 0);
    }
    bf16_t* kv = (bf16_t*)(p.ws + OFF_KV) + (((size_t)bhd * 68 + n) * 128 + m32) * 64 + 4 * h;
#pragma unroll
    for (int mb = 0; mb < 2; ++mb)
#pragma unroll
        for (int nb = 0; nb < 4; ++nb)
#pragma unroll
            for (int r4 = 0; r4 < 4; ++r4) { u32x2_t o; o[0] = pk2(acc[mb][nb][4 * r4], acc[mb][nb][4 * r4 + 1]); o[1] = pk2(acc[mb][nb][4 * r4 + 2], acc[mb][nb][4 * r4 + 3]);
                *(u32x2_t*)(kv + (size_t)(32 * nb) * 64 + 32 * mb + 8 * r4) = o; }
}

__device__ __forceinline__ void gla_scan(const Params& p) {
    bf16_t* kv = (bf16_t*)(p.ws + OFF_KV); const float* dec = (const float*)(p.ws + OFF_DECAY);
    for (int gid = blockIdx.x * NTHR + ltid(); gid < 64 * 128 * 16; gid += gridDim.x * NTHR) {
        const int dk4 = gid & 15, dv = (gid >> 4) & 127, bhd = gid >> 11, dir = bhd & 1;
        f32x4 s = {0.f, 0.f, 0.f, 0.f};
        for (int step = 0; step < 68; ++step) {
            const int ch = dir == 0 ? step : (step < 4 ? 3 - step : 71 - step);
            u32x2_t* ptr = (u32x2_t*)(kv + (((size_t)bhd * 68 + ch) * 128 + dv) * 64 + dk4 * 4);
            const u32x2_t kvv = *ptr; const f32x4 d4 = *(const f32x4*)(dec + ((size_t)bhd * 68 + ch) * 64 + dk4 * 4);
            u32x2_t o; o[0] = pk2(s[0], s[1]); o[1] = pk2(s[2], s[3]); *ptr = o;
            s[0] = d4[0] * s[0] + bflo(kvv[0]); s[1] = d4[1] * s[1] + bfhi(kvv[0]); s[2] = d4[2] * s[2] + bflo(kvv[1]); s[3] = d4[3] * s[3] + bfhi(kvv[1]);
        }
    }
}

__device__ __forceinline__ void gla_c_unit(const Params& p, int l, int unit, unsigned char* shm) {
    const int tid = ltid(), lane = tid & 63, wid = tid >> 6, hh = wid >> 1, dir = wid & 1, m32 = lane & 31, h = lane >> 5;
    const int b = unit / 68, n = unit - b * 68; const int row0 = b * LB + n * 64; const int bhd = (b * 4 + hh) * 2 + dir;
    float* grs = (float*)shm; unsigned char* xq = shm + 8192 + wid * 18432; unsigned char* yk = xq + 9216;
    gla_stage_gr(p, row0, grs, tid);
    {
        GlaCol gc; gla_col_init(p, l, hh, dir, lane, gc);
        const float last = gla_total(gc, grs, dir);
        const bf16_t* gq = (const bf16_t*)(p.ws + OFF_GQ) + (size_t)row0 * 256 + hh * 64 + lane;
        const bf16_t* gk = (const bf16_t*)(p.ws + OFF_GK) + (size_t)row0 * 256 + hh * 64 + lane;
        float run = 0.f;
#pragma unroll 4
        for (int r = 0; r < 64; ++r) { const float ex = run; run += gla_logd(gc, grs, r, dir);
            const float c = dir ? last - ex : run;
            *(bf16_t*)(xq + r * GL_XS + lane * 2) = f2bf(bf2f(gq[(size_t)r * 256]) * __expf(c));
            *(bf16_t*)(yk + r * GL_XS + lane * 2) = f2bf(bf2f(gk[(size_t)r * 256]) * __expf(-c)); }
    }
    asm volatile("s_waitcnt lgkmcnt(0)" ::: "memory"); __builtin_amdgcn_wave_barrier();
    const unsigned char* xrd = xq + m32 * GL_XS + 16 * h;
    f32x16 O[4][2];
#pragma unroll
    for (int d = 0; d < 4; ++d)
#pragma unroll
        for (int ib = 0; ib < 2; ++ib)
#pragma unroll
            for (int r = 0; r < 16; ++r) O[d][ib][r] = 0.f;
    { const bf16_t* sp = (const bf16_t*)(p.ws + OFF_KV) + (((size_t)bhd * 68 + n) * 128 + m32) * 64 + 8 * h;
#pragma unroll
      for (int s = 0; s < 4; ++s) {
          asm volatile("" ::: "memory");
          bf16x8_t sf[4];
#pragma unroll
          for (int d = 0; d < 4; ++d) sf[d] = *(const bf16x8_t*)(sp + (size_t)(32 * d) * 64 + 16 * s);
#pragma unroll
          for (int ib = 0; ib < 2; ++ib) { const bf16x8_t xf = *(const bf16x8_t*)(xrd + 32 * ib * GL_XS + 32 * s);
#pragma unroll
              for (int d = 0; d < 4; ++d) O[d][ib] = __builtin_amdgcn_mfma_f32_32x32x16_bf16(sf[d], xf, O[d][ib], 0, 0, 0); } } }
    const bf16_t* gvt = (const bf16_t*)(p.ws + OFF_GVT) + ((size_t)(b * 512 + hh * 128 + m32)) * LB + n * 64 + 4 * h;
#pragma unroll
    for (int jb = 0; jb < 2; ++jb)
#pragma unroll
        for (int ib = 0; ib < 2; ++ib) {
            if (jb != ib && ((jb > ib) != (dir == 1))) continue;
            f32x16 A;
#pragma unroll
            for (int r = 0; r < 16; ++r) A[r] = 0.f;
#pragma unroll
            for (int s = 0; s < 4; ++s) { const bf16x8_t kf = *(const bf16x8_t*)(yk + (32 * jb + m32) * GL_XS + (16 * s + 8 * h) * 2);
                const bf16x8_t xf = *(const bf16x8_t*)(xrd + 32 * ib * GL_XS + 32 * s);
                A = __builtin_amdgcn_mfma_f32_32x32x16_bf16(kf, xf, A, 0, 0, 0); }
            if (jb == ib) {
#pragma unroll
                for (int r = 0; r < 16; ++r) { const int jj = (r & 3) + 8 * (r >> 2) + 4 * h; const bool keep = dir ? (jj >= m32) : (jj <= m32); A[r] = keep ? A[r] : 0.f; }
            }
#pragma unroll
            for (int s2 = 0; s2 < 2; ++s2) { asm volatile("" ::: "memory"); u32x4_t pk;
#pragma unroll
                for (int j = 0; j < 4; ++j) pk[j] = pk2(A[s2 * 8 + 2 * j], A[s2 * 8 + 2 * j + 1]);
                const bf16x8_t pf = __builtin_bit_cast(bf16x8_t, pk);
#pragma unroll
                for (int d = 0; d < 4; ++d) { const bf16_t* vp = gvt + (size_t)(32 * d) * LB + 32 * jb + 16 * s2;
                    const u32x2_t v0 = *(const u32x2_t*)vp, v1 = *(const u32x2_t*)(vp + 8);
                    u32x4_t vv; vv[0] = v0[0]; vv[1] = v0[1]; vv[2] = v1[0]; vv[3] = v1[1];
                    O[d][ib] = __builtin_amdgcn_mfma_f32_32x32x16_bf16(__builtin_bit_cast(bf16x8_t, vv), pf, O[d][ib], 0, 0, 0); } }
        }
    __syncthreads();
    float* xch = (float*)(shm + 8192);
    if (dir == 1) {
#pragma unroll
        for (int d = 0; d < 4; ++d)
#pragma unroll
            for (int ib = 0; ib < 2; ++ib)
#pragma unroll
                for (int r = 0; r < 16; ++r) xch[((((hh * 4 + d) * 2 + ib) * 16 + r) << 6) + lane] = O[d][ib][r];
    }
    __syncthreads();
    if (dir == 0) {
        const float* gn = p.in[I_GNG] + l * 128;
        bf16_t* gg = (bf16_t*)(p.ws + OFF_GG);
#pragma unroll
        for (int ib = 0; ib < 2; ++ib) {
            float ss = 0.f;
#pragma unroll
            for (int d = 0; d < 4; ++d) {
                asm volatile("" ::: "memory");
#pragma unroll
                for (int r = 0; r < 16; ++r) { const float v = O[d][ib][r] + xch[((((hh * 4 + d) * 2 + ib) * 16 + r) << 6) + lane]; O[d][ib][r] = v; ss += v * v; } }
            ss += __shfl_xor(ss, 32);
            const float sc = rsqrtf(ss * (1.0f / 128.0f) + RMS_EPS);
            bf16_t* op = gg + (size_t)(row0 + 32 * ib + m32) * 512 + hh * 128 + 4 * h;
#pragma unroll
            for (int d = 0; d < 4; ++d)
#pragma unroll
                for (int r4 = 0; r4 < 4; ++r4) { asm volatile("" ::: "memory"); const int dv = 32 * d + 8 * r4; const f32x4 gv = *(const f32x4*)(gn + dv + 4 * h);
                    const u32x2_t gt = *(const u32x2_t*)(op + dv);
                    u32x2_t o; o[0] = pk2(O[d][ib][4 * r4] * sc * gv[0] * siluf_(bflo(gt[0])), O[d][ib][4 * r4 + 1] * sc * gv[1] * siluf_(bfhi(gt[0])));
                    o[1] = pk2(O[d][ib][4 * r4 + 2] * sc * gv[2] * siluf_(bflo(gt[1])), O[d][ib][4 * r4 + 3] * sc * gv[3] * siluf_(bfhi(gt[1])));
                    *(u32x2_t*)(op + dv) = o; }
        }
    }
    __syncthreads();
}

enum { PH_MOD = 0, PH_INIT, PH_CONVERT, PH_INPROJ, PH_ROPEDEC, PH_MIX_GLA, PH_MIX_DIFF, PH_MIX_NA, PH_VTRANS, PH_DIFF, PH_NA, PH_GLA_A, PH_GLA_SCAN, PH_GLA_C, PH_GATES, PH_MERGE, PH_WO, PH_LN1, PH_GATHER, PH_UP, PH_DOWN, PH_LN2, PH_COUNT };

template <class Epi, class Sched>
__device__ __forceinline__ void run_gemm(PG8_LAS unsigned char* lds, const void* A, const void* Bt, int K, const Sched& S, const Epi& E) {
    pg8::Gemm g; g.A = (const pg8::bf16_t*)A; g.Bt = (const pg8::bf16_t*)Bt; g.M = 0; g.N = 0; g.K = K;
    pg8::gemm_phase<Epi, Sched, false>(lds, g, S, E, nullptr);
}

#ifndef PHASE_INLINE
#define PHASE_INLINE __forceinline__
#endif
template <int PH>
__device__ PHASE_INLINE void run_phase(const Params& p0, int l, unsigned char* shm) {
    Params p = p0; asm volatile("" : "+s"(p.ws));
#ifdef SKIP_MASK
    if constexpr ((SKIP_MASK >> PH) & 1) return;
#endif
    PG8_LAS unsigned char* lds = (PG8_LAS unsigned char*)shm;
    float* ldsf = (float*)shm;
    const int G = gridDim.x, c = blockIdx.x;
    if constexpr (PH == PH_MOD) phase_mod(p, ldsf);
    else if constexpr (PH == PH_INIT) phase_init(p);
    else if constexpr (PH == PH_CONVERT) phase_convert(p, l, ldsf);
    else if constexpr (PH == PH_INPROJ) { SchedGrid S{NPANEL, 19, 0, G, c}; EpiInProj E{p.ws}; run_gemm(lds, p.ws + OFF_H, p.ws + OFF_WIN, 1024, S, E); }
    else if constexpr (PH == PH_ROPEDEC) phase_rope_decay(p, l);
    else if constexpr (PH == PH_MIX_GLA) { for (int u = blockIdx.x; u < NB; u += gridDim.x) gla_naive_batch(p, l, u, ldsf); }
    else if constexpr (PH == PH_MIX_DIFF) { for (int u = blockIdx.x; u < NB * 4 * 34; u += gridDim.x) diff_naive_tile(p, l, u, ldsf); }
    else if constexpr (PH == PH_MIX_NA) { for (int u = blockIdx.x; u < T / 64; u += gridDim.x) na_naive_unit(p, l, u); }
    else if constexpr (PH == PH_VTRANS) phase_vtrans(p, l, (bf16_t*)shm);
    else if constexpr (PH == PH_DIFF) { for (int u = blockIdx.x; u < DA_UNITS; u += gridDim.x) diff_attn_unit(p, l, u, shm); }
    else if constexpr (PH == PH_NA) { for (int u = blockIdx.x; u < NA_UNITS; u += gridDim.x) na_attn_unit(p, l, u, shm); }
#if FAST_GLA
    else if constexpr (PH == PH_GLA_A) { for (int u = blockIdx.x; u < NB * 68; u += gridDim.x) gla_a_unit(p, l, u, shm); }
    else if constexpr (PH == PH_GLA_SCAN) gla_scan(p);
    else if constexpr (PH == PH_GLA_C) { for (int u = blockIdx.x; u < NB * 68; u += gridDim.x) gla_c_unit(p, l, u, shm); }
#endif
    else if constexpr (PH == PH_GATES) { SchedGrid S{NPANEL, 12, 19, G, c}; EpiGates E{p.ws}; run_gemm(lds, p.ws + OFF_H, p.ws + OFF_WIN, 1024, S, E); }
    else if constexpr (PH == PH_MERGE) { SchedMerge S{G, c}; EpiMerge E{p.ws}; run_gemm(lds, p.ws + OFF_BR, p.ws + OFF_WB, 512, S, E); }
    else if constexpr (PH == PH_WO) { SchedGrid S{NPANEL, 4, 0, G, c}; EpiWo E{p.ws, l}; run_gemm(lds, p.ws + OFF_H, p.ws + OFF_WO, 1024, S, E); }
    else if constexpr (PH == PH_LN1) phase_ln1_router(p, l);
    else if constexpr (PH == PH_GATHER) phase_gather(p, l);
    else if constexpr (PH == PH_UP) { SchedMoe S; S.init((const unsigned*)(p.ws + OFF_CNT) + l * 16, G, c); EpiUp E{p.ws}; run_gemm(lds, p.ws + OFF_XA, p.ws + OFF_WUP, 1024, S, E); }
    else if constexpr (PH == PH_DOWN) { SchedMoe S; S.init((const unsigned*)(p.ws + OFF_CNT) + l * 16, G, c); EpiDown E{p.ws}; run_gemm(lds, p.ws + OFF_ACT, p.ws + OFF_WDN, 512, S, E); }
    else if constexpr (PH == PH_LN2) phase_ln2(p, l);
}

#if !MEGA
template <int PH>
__global__ void __launch_bounds__(512, 2) k_phase(Params p, int l) {
    extern __shared__ __attribute__((aligned(16))) unsigned char shm[];
    run_phase<PH>(p, l, shm);
}
template <int PH> static void launch_phase(const Params& p, int l, hipStream_t st) {
    static bool attr = false;
    if (!attr) { (void)hipFuncSetAttribute((const void*)k_phase<PH>, hipFuncAttributeMaxDynamicSharedMemorySize, LDS_BYTES); attr = true; }
    hipLaunchKernelGGL((k_phase<PH>), dim3(256), dim3(NTHR), LDS_BYTES, st, p, l);
}
#else
__global__ void __launch_bounds__(512, 2) k_mega(Params p) {
    extern __shared__ __attribute__((aligned(16))) unsigned char shm[];
    volatile LAS unsigned* xbw = (volatile LAS unsigned*)(shm + LDS_XBW);
    if (threadIdx.x == 0) { xbw[0] = 0u; xbw[1] = 0u; xbw[2] = 0u; xbw[3] = 0u; }
    __syncthreads();
    XcdBarrier bar = xcd_barrier_post((unsigned*)(p.ws + OFF_BAR), xbw);
    run_phase<PH_MOD>(p, 0, shm);
    run_phase<PH_CONVERT>(p, 0, shm);
    xcd_barrier(bar);
    run_phase<PH_INIT>(p, 0, shm);
    xcd_barrier(bar);
    for (int l = 0; l < DEPTH; ++l) {
        if (l > 0) { run_phase<PH_CONVERT>(p, l, shm); xcd_barrier(bar); }
        run_phase<PH_INPROJ>(p, l, shm); xcd_barrier(bar);
        run_phase<PH_ROPEDEC>(p, l, shm); run_phase<PH_VTRANS>(p, l, shm); xcd_barrier(bar);
#if FAST_GLA
        run_phase<PH_GLA_A>(p, l, shm); xcd_barrier(bar);
        run_phase<PH_GLA_SCAN>(p, l, shm);
#else
        run_phase<PH_MIX_GLA>(p, l, shm);
#endif
#if FAST_DIFF
        run_phase<PH_DIFF>(p, l, shm);
#else
        run_phase<PH_MIX_DIFF>(p, l, shm);
#endif
#if FAST_NA
        run_phase<PH_NA>(p, l, shm);
#else
        run_phase<PH_MIX_NA>(p, l, shm);
#endif
        xcd_barrier(bar);
#if FAST_GLA
        run_phase<PH_GLA_C>(p, l, shm); xcd_barrier(bar);
#endif
        run_phase<PH_GATES>(p, l, shm); xcd_barrier(bar);
        run_phase<PH_MERGE>(p, l, shm); xcd_barrier(bar);
        run_phase<PH_WO>(p, l, shm); xcd_barrier(bar);
        run_phase<PH_LN1>(p, l, shm); xcd_barrier(bar);
        run_phase<PH_GATHER>(p, l, shm); xcd_barrier(bar);
        run_phase<PH_UP>(p, l, shm); xcd_barrier(bar);
        run_phase<PH_DOWN>(p, l, shm); xcd_barrier(bar);
        run_phase<PH_LN2>(p, l, shm); xcd_barrier(bar);
    }
}
#endif

extern "C" void kernel_launch(void* const* d_in, const int* in_sizes, int n_in, void* d_out, int out_size, void* d_ws, size_t ws_size, hipStream_t stream) {
    (void)in_sizes; (void)n_in; (void)out_size;
    if (ws_size < WS_NEED) { fprintf(stderr, "workspace too small: %zu < %zu\n", ws_size, (size_t)WS_NEED); return; }
    Params p{};
    for (int i = 0; i < 23; ++i) p.in[i] = (const float*)d_in[i];
    p.out = (float*)d_out; p.ws = (char*)d_ws;
    (void)hipMemsetAsync(d_ws, 0, ZERO_BYTES, stream);
#if !MEGA
    launch_phase<PH_MOD>(p, 0, stream);
    launch_phase<PH_INIT>(p, 0, stream);
    for (int l = 0; l < DEPTH; ++l) {
        launch_phase<PH_CONVERT>(p, l, stream);
        launch_phase<PH_INPROJ>(p, l, stream);
        launch_phase<PH_ROPEDEC>(p, l, stream);
        launch_phase<PH_MIX_GLA>(p, l, stream);
        launch_phase<PH_VTRANS>(p, l, stream);
        launch_phase<PH_DIFF>(p, l, stream);
        launch_phase<PH_MIX_NA>(p, l, stream);
        launch_phase<PH_GATES>(p, l, stream);
        launch_phase<PH_MERGE>(p, l, stream);
        launch_phase<PH_WO>(p, l, stream);
        launch_phase<PH_LN1>(p, l, stream);
        launch_phase<PH_GATHER>(p, l, stream);
        launch_phase<PH_UP>(p, l, stream);
        launch_phase<PH_DOWN>(p, l, stream);
        launch_phase<PH_LN2>(p, l, stream);
    }
#else
    static int grid = 0;
    if (!grid) {
        (void)hipFuncSetAttribute((const void*)k_mega, hipFuncAttributeMaxDynamicSharedMemorySize, LDS_BYTES);
        int dev = 0, cus = 0, per_cu = 0;
        (void)hipGetDevice(&dev);
        (void)hipDeviceGetAttribute(&cus, hipDeviceAttributeMultiprocessorCount, dev);
        (void)hipOccupancyMaxActiveBlocksPerMultiprocessor(&per_cu, (const void*)k_mega, 512, LDS_BYTES);
        if (cus <= 0) cus = 256;
        grid = per_cu >= 1 ? cus : 0;
        if (!grid) { fprintf(stderr, "k_mega does not fit a CU\n"); return; }
    }
    hipLaunchKernelGGL(k_mega, dim3(grid), dim3(NTHR), LDS_BYTES, stream, p);
#endif
}
```

```cpp
#define MEGA 1
#include <hip/hip_runtime.h>
#include <stdint.h>
#include <stdio.h>

#ifndef MEGA
#define MEGA 0
#endif

constexpr int NB = 8, LL = 4096, LC = 256, LB = LL + LC  , T = NB * LB  , D = 1024, DEPTH = 4;
constexpr int NPANEL = T / 256;
constexpr int PB = LB / 256;
constexpr int PAIR_ROWS = 2 * T + 16 * 256;
constexpr float ALPHA = 1.681792830507429f;
constexpr float LN_EPS = 1e-5f, RMS_EPS = 1e-6f;

constexpr size_t AL256(size_t x) { return (x + 255) & ~(size_t)255; }
constexpr size_t OFF_BAR = 0;
constexpr size_t OFF_CNT = 16384;
constexpr size_t ZERO_BYTES = 32768;
constexpr size_t OFF_BLKCNT = ZERO_BYTES;
constexpr size_t OFF_MOD0 = OFF_BLKCNT + 1024 * 16 * 4;
constexpr size_t OFF_MOD = OFF_MOD0;
constexpr size_t OFF_ROPE = AL256(OFF_MOD + (size_t)DEPTH * 9 * 6144 * 4);
constexpr size_t OFF_TOK = AL256(OFF_ROPE + (size_t)4096 * 32 * 2 * 4);
constexpr size_t OFF_GR = AL256(OFF_TOK + (size_t)T * 8 * 4);
constexpr size_t OFF_XS = AL256(OFF_GR + (size_t)T * 32 * 4);
constexpr size_t OFF_H = AL256(OFF_XS + (size_t)T * D * 4);
constexpr size_t OFF_W = AL256(OFF_H + (size_t)T * D * 2);
constexpr size_t W_IN_ROWS = 4864 + 3072;
constexpr size_t OFF_WIN = OFF_W;
constexpr size_t OFF_WB = OFF_WIN + W_IN_ROWS * 1024 * 2;
constexpr size_t OFF_WO = OFF_WB + (size_t)3 * 1024 * 512 * 2;
constexpr size_t OFF_WUP = OFF_WO + (size_t)1024 * 1024 * 2;
constexpr size_t OFF_WDN = OFF_WUP + (size_t)16 * 1024 * 1024 * 2;
constexpr size_t OFF_P = AL256(OFF_WDN + (size_t)16 * 1024 * 512 * 2);
constexpr size_t PCOL = (size_t)T * 2;
constexpr size_t OFF_GQ = OFF_P, OFF_GK = OFF_P + 256 * PCOL, OFF_GV = OFF_P + 512 * PCOL;
constexpr size_t OFF_DK = OFF_P + 1024 * PCOL, OFF_DV = OFF_P + 1536 * PCOL;
constexpr size_t OFF_NK = OFF_P + 2048 * PCOL, OFF_NV = OFF_P + 2560 * PCOL;
constexpr size_t OFF_BR = OFF_P + 3072 * PCOL;
constexpr size_t OFF_GG = OFF_BR, OFF_DQ = OFF_BR + 512 * PCOL, OFF_NQ = OFF_BR + 1024 * PCOL;
constexpr size_t OFF_GATE = OFF_P;
constexpr size_t OFF_S1 = AL256(OFF_P + 4608 * PCOL);
constexpr size_t OFF_S2 = AL256(OFF_S1 + (size_t)T * 512 * 4);
constexpr size_t OFF_R3 = AL256(OFF_S2 + (size_t)T * 512 * 4);
constexpr size_t OFF_R4 = AL256(OFF_R3 + (size_t)T * 512 * 2);
constexpr size_t VT_BYTES = (size_t)T * 512 * 2;
#ifndef FAST_GLA
#define FAST_GLA 1
#endif
#ifndef FAST_DIFF
#define FAST_DIFF 1
#endif
#ifndef FAST_NA
#define FAST_NA 1
#endif
constexpr size_t OFF_KV = OFF_S1;
constexpr size_t OFF_GVT = OFF_GV;
constexpr size_t OFF_VT = OFF_DV;
constexpr size_t OFF_NVT = OFF_NV;
static_assert(FAST_GLA && FAST_DIFF && FAST_NA, "the naive mixers read row-major values");
constexpr size_t OFF_TOTAL = OFF_R3;
constexpr size_t OFF_CUM = OFF_S2;
constexpr size_t OFF_NBT = OFF_R4;
constexpr size_t OFF_DECAY = AL256(OFF_NBT + (size_t)8 * 15 * 4 * 64 * 16 * 4);
constexpr size_t OFF_END1 = AL256(OFF_DECAY + (size_t)64 * 68 * 64 * 4);
constexpr size_t OFF_XA = OFF_P;
constexpr size_t OFF_ACT = AL256(OFF_XA + (size_t)PAIR_ROWS * 1024 * 2);
constexpr size_t OFF_Y = AL256(OFF_ACT + (size_t)PAIR_ROWS * 512 * 2);
constexpr size_t OFF_END2 = AL256(OFF_Y + (size_t)PAIR_ROWS * 1024 * 2);
constexpr size_t WS_NEED = OFF_END1 > OFF_END2 ? OFF_END1 : OFF_END2;
static_assert(WS_NEED < (size_t)812 * 1000 * 1000, "workspace budget");

constexpr int NTHR = 512;
constexpr int LDS_STAGE = 131072;
constexpr int LDS_BYTES = 159744;
constexpr int LDS_XBW = LDS_BYTES - 256;

typedef unsigned short bf16_t;

struct Params {
    const float* in[23];
    float* out;
    char* ws;
};
enum { I_X = 0, I_C, I_CTX, I_CCTX, I_WADA, I_BADA, I_WIN, I_GWD, I_GBD, I_GNG, I_LQ, I_LK, I_DNG, I_RPB, I_WBR, I_WO, I_LNG, I_LNB, I_WR, I_BR, I_WEG, I_WEU, I_WED };

__device__ __forceinline__ float bf2f(bf16_t v) { return __uint_as_float(((unsigned)v) << 16); }
__device__ __forceinline__ float bflo(unsigned u) { return __uint_as_float(u << 16); }
__device__ __forceinline__ float bfhi(unsigned u) { return __uint_as_float(u & 0xffff0000u); }
typedef float f32x2_t __attribute__((ext_vector_type(2)));
typedef __bf16 bf16x2_t __attribute__((ext_vector_type(2)));
__device__ __forceinline__ unsigned pk2(float lo, float hi) { f32x2_t v; v[0] = lo; v[1] = hi; return __builtin_bit_cast(unsigned, __builtin_convertvector(v, bf16x2_t)); }
__device__ __forceinline__ bf16_t f2bf(float f) { return (bf16_t)(pk2(f, 0.f) & 0xffffu); }
__device__ __forceinline__ float wave_sum(float v) {
#pragma unroll
    for (int o = 32; o >= 1; o >>= 1) v += __shfl_xor(v, o);
    return v;
}
__device__ __forceinline__ float sigmoidf_(float x) { return 1.f / (1.f + __expf(-x)); }
__device__ __forceinline__ float siluf_(float x) { return x / (1.f + __expf(-x)); }
__device__ __forceinline__ int row_slot(int row) { const int b = row / LB, t = row - b * LB; return t < LC ? 8 : b; }
__device__ __forceinline__ int ltid() { int t = threadIdx.x; asm volatile("" : "+v"(t)); return t; }
#include <hip/hip_runtime.h>
namespace pg8 {
#define PG8_LAS __attribute__((address_space(3)))
typedef unsigned short bf16_t;
typedef short bf16x8 __attribute__((ext_vector_type(8)));
typedef float f32x4 __attribute__((ext_vector_type(4)));
typedef unsigned u32x4 __attribute__((ext_vector_type(4)));
constexpr int BM = 256, BK = 64, HALF = 128, HTB = HALF * BK * 2  , STAGE_BYTES = 8 * HTB, NXCD = 8, WGM = 8;

__host__ __device__ __forceinline__ int lds_byte(int r, int c) { const int st = (r >> 4) * 2 + (c >> 5), rr = r & 15, cc = c & 31, ob = rr * 64 + cc * 2; return st * 1024 + (ob ^ (((ob >> 9) & 1) << 5)); }
__host__ __device__ __forceinline__ void stage_rc(int b, int& R, int& C) { const int st = b / 1024, sb = b % 1024, swz = sb ^ (((sb >> 9) & 1) << 5); R = (st >> 1) * 16 + swz / 64; C = (st & 1) * 32 + (swz % 64) / 2; }
__host__ __device__ __forceinline__ int perm32(int rho) { const int n = rho >> 4, i = rho & 15; return 8 * (i >> 2) + 4 * n + (i & 3); }

struct Unit { int pm, pn; };
struct Gemm { const bf16_t* A; const bf16_t* Bt; int M, N, K; };
__device__ __forceinline__ unsigned cvt_pk_bf16(float lo, float hi) { unsigned r; asm volatile("v_cvt_pk_bf16_f32 %0, %1, %2" : "=v"(r) : "v"(lo), "v"(hi)); return r; }

template <class Epi, class Sched, bool STAMP = false>
__device__ __forceinline__ void gemm_phase(PG8_LAS unsigned char* lds, const Gemm g, const Sched& S, const Epi& E, unsigned long long* stamps) {
    int tid_l = threadIdx.x; asm volatile("" : "+v"(tid_l));
    const int tid = tid_l, wid = __builtin_amdgcn_readfirstlane(tid >> 6), lane = tid & 63, wr = wid >> 2, wc = wid & 3, fr = lane & 15, fq = lane >> 4;
    const int K = g.K, nt = K / BK;
    int ts_lo = 0, ts_hi = 0, nts = 0; const unsigned long long rt_entry = STAMP ? (unsigned long long)wall_clock64() : 0ull;
#define PG8_STAMP() do { if (STAMP && wid == 0 && nts < 64) { const unsigned long long _c = (unsigned long long)clock64(); \
        ts_lo = (lane == nts) ? (int)(unsigned)_c : ts_lo; ts_hi = (lane == nts) ? (int)(unsigned)(_c >> 32) : ts_hi; ++nts; } } while (0)
    PG8_STAMP();
    unsigned voffA[2], voffB[2];
#pragma unroll
    for (int i = 0; i < 2; ++i) { int R, C; stage_rc(tid * 16 + i * 8192, R, C); const int Rb = Epi::PERM ? ((R & ~31) + perm32(R & 31)) : R;
        voffA[i] = (unsigned)(R * K + C) * 2u; voffB[i] = (unsigned)(Rb * K + C) * 2u; }
    const size_t kstep = (size_t)(BK * 2);
    const size_t hstep = (size_t)HALF * K * 2;
    const size_t tstep = 2 * hstep;
    const unsigned ldsw = (unsigned)wid * 1024u;
    const int aoff = lds_byte(wr * 64 + fr, fq * 8), boff = lds_byte(wc * 32 + fr, fq * 8);
#define PG8_SA(b, h) (((b) * 2 + (h)) * HTB)
#define PG8_SB(b, h) ((4 + (b) * 2 + (h)) * HTB)
#define PG8_STAGE(bufoff, gbase, voff) do { _Pragma("unroll") for (int _i = 0; _i < 2; ++_i) \
        __builtin_amdgcn_global_load_lds((const unsigned*)((const char*)(gbase) + (voff)[_i]), (PG8_LAS unsigned*)(lds + (bufoff) + ldsw + _i * 8192), 16, 0, 0); } while (0)
#define PG8_LDA(dst, b, h) do { _Pragma("unroll") for (int m = 0; m < 4; ++m) _Pragma("unroll") for (int k = 0; k < 2; ++k) dst[m][k] = *(const PG8_LAS bf16x8*)(lds + PG8_SA(b, h) + aoff + m * 2048 + k * 1024); } while (0)
#define PG8_LDB(dst, b, h) do { _Pragma("unroll") for (int n = 0; n < 2; ++n) _Pragma("unroll") for (int k = 0; k < 2; ++k) dst[n][k] = *(const PG8_LAS bf16x8*)(lds + PG8_SB(b, h) + boff + n * 2048 + k * 1024); } while (0)
#define PG8_MMA(ai, bj, At, Bt) do { __builtin_amdgcn_s_setprio(1); _Pragma("unroll") for (int m = 0; m < 4; ++m) _Pragma("unroll") for (int n = 0; n < 2; ++n) _Pragma("unroll") for (int k = 0; k < 2; ++k) \
        acc[ai][bj][m][n] = __builtin_amdgcn_mfma_f32_16x16x32_bf16(Bt[n][k], At[m][k], acc[ai][bj][m][n], 0, 0, 0); __builtin_amdgcn_s_setprio(0); } while (0)
#define PG8_WAIT_V(n) asm volatile("s_waitcnt vmcnt(" #n ")" ::: "memory")
#define PG8_WAIT_L(n) asm volatile("s_waitcnt lgkmcnt(" #n ")" ::: "memory")
#define PG8_BAR __builtin_amdgcn_s_barrier()
#define PG8_SCHED __builtin_amdgcn_sched_barrier(0)
    Unit cur, nxt; int ui = 0;
    if (!S.next(0, cur)) return;
    f32x4 acc[2][2][4][2];
#pragma unroll
    for (int a = 0; a < 2; ++a)
#pragma unroll
        for (int b = 0; b < 2; ++b)
#pragma unroll
            for (int m = 0; m < 4; ++m)
#pragma unroll
                for (int n = 0; n < 2; ++n) acc[a][b][m][n] = (f32x4){0.f, 0.f, 0.f, 0.f};
    bf16x8 At[4][2], B0[2][2], B1[2][2];
    const char* cA = (const char*)g.A + (size_t)cur.pm * tstep; const char* cB = (const char*)g.Bt + (size_t)cur.pn * tstep;
    S.a_ready(cur);
    PG8_STAGE(PG8_SB(0, 0), cB, voffB); PG8_STAGE(PG8_SA(0, 0), cA, voffA); PG8_STAGE(PG8_SB(0, 1), cB + hstep, voffB); PG8_STAGE(PG8_SA(0, 1), cA + hstep, voffA);
    if (wr == 1) PG8_BAR;
    PG8_WAIT_V(4); PG8_BAR;
    PG8_STAGE(PG8_SB(1, 0), cB + kstep, voffB); PG8_STAGE(PG8_SA(1, 0), cA + kstep, voffA); PG8_STAGE(PG8_SB(1, 1), cB + hstep + kstep, voffB);
    PG8_WAIT_V(6); PG8_BAR;
    PG8_STAMP();
    for (;;) {
        const bool has_next = S.next(ui + 1, nxt);
        const char* nA = has_next ? (const char*)g.A + (size_t)nxt.pm * tstep : cA; const char* nB = has_next ? (const char*)g.Bt + (size_t)nxt.pn * tstep : cB;
        for (int t = 0; t < nt; t += 2) {
            const bool last = (t == nt - 2);
            const char* a1 = cA + (size_t)(t + 1) * kstep;
            const char* a2 = last ? nA : cA + (size_t)(t + 2) * kstep; const char* b2 = last ? nB : cB + (size_t)(t + 2) * kstep;
            const char* a3 = a2 + kstep; const char* b3 = b2 + kstep;
            if (last && has_next) S.a_ready(nxt);
            PG8_LDB(B0, 0, 0); PG8_SCHED; PG8_LDA(At, 0, 0); PG8_STAGE(PG8_SA(1, 1), a1 + hstep, voffA);
            PG8_WAIT_L(8); PG8_BAR; PG8_WAIT_L(0); PG8_MMA(0, 0, At, B0); PG8_BAR; PG8_SCHED;
            PG8_LDB(B1, 0, 1); PG8_STAGE(PG8_SB(0, 0), b2, voffB);
            PG8_BAR; PG8_WAIT_L(0); PG8_MMA(0, 1, At, B1); PG8_BAR;
            PG8_LDA(At, 0, 1); PG8_STAGE(PG8_SA(0, 0), a2, voffA);
            PG8_BAR; PG8_WAIT_L(0); PG8_MMA(1, 0, At, B0); PG8_BAR; PG8_SCHED;
            PG8_STAGE(PG8_SB(0, 1), b2 + hstep, voffB);
            PG8_WAIT_V(6); PG8_BAR; PG8_MMA(1, 1, At, B1); PG8_BAR;
            PG8_LDB(B0, 1, 0); PG8_SCHED; PG8_LDA(At, 1, 0); PG8_STAGE(PG8_SA(0, 1), a2 + hstep, voffA);
            PG8_WAIT_L(8); PG8_BAR; PG8_WAIT_L(0); PG8_MMA(0, 0, At, B0); PG8_BAR; PG8_SCHED;
            PG8_LDB(B1, 1, 1); PG8_STAGE(PG8_SB(1, 0), b3, voffB);
            PG8_BAR; PG8_WAIT_L(0); PG8_MMA(0, 1, At, B1); PG8_BAR;
            PG8_LDA(At, 1, 1); PG8_STAGE(PG8_SA(1, 0), a3, voffA);
            PG8_BAR; PG8_WAIT_L(0); PG8_MMA(1, 0, At, B0); PG8_BAR; PG8_SCHED;
            PG8_STAGE(PG8_SB(1, 1), b3 + hstep, voffB);
            PG8_WAIT_V(6); PG8_BAR; PG8_MMA(1, 1, At, B1); PG8_BAR;
        }
        PG8_STAMP();
        if constexpr (!Epi::AFTER_DRAIN) { E(acc, cur, wr, wc, fr, fq); S.done(cur); }
        PG8_STAMP();
        if (!has_next) break;
        bool zero_acc = true;
        if constexpr (Epi::KEEP) zero_acc = !E.keep(cur);
        if (zero_acc) {
#pragma unroll
        for (int a = 0; a < 2; ++a)
#pragma unroll
            for (int b = 0; b < 2; ++b)
#pragma unroll
                for (int m = 0; m < 4; ++m)
#pragma unroll
                    for (int n = 0; n < 2; ++n) acc[a][b][m][n] = (f32x4){0.f, 0.f, 0.f, 0.f};
        }
        cur = nxt; cA = nA; cB = nB; ++ui;
    }
    PG8_WAIT_V(0);
    if (wr == 0) PG8_BAR;
    PG8_BAR;
    if constexpr (Epi::AFTER_DRAIN) { E.fused(acc, cur, wr, wc, fr, fq, lds, wid, lane); S.done(cur); }
    PG8_STAMP();
    if (STAMP && wid == 0) { stamps[lane] = lane < nts ? (((unsigned long long)(unsigned)ts_hi << 32) | (unsigned)ts_lo) : 0ull;
        if (lane == 62) stamps[62] = rt_entry; if (lane == 63) stamps[63] = (unsigned long long)wall_clock64(); }
#undef PG8_STAMP
#undef PG8_SA
#undef PG8_SB
#undef PG8_STAGE
#undef PG8_LDA
#undef PG8_LDB
#undef PG8_MMA
#undef PG8_WAIT_V
#undef PG8_WAIT_L
#undef PG8_BAR
#undef PG8_SCHED
}
}
#define XB_TMO      128
#define XB_XCNT(j)  (256  + 64 * (j))
#define XB_XSUB(j)  (1280 + 64 * (j))
#define XB_XGEN(j)  (2304 + 64 * (j))
#define XB_TOP      3328
#define XB_TOPGEN   3392
#define XCD_BAR_WORDS 3456
#define XB_SPIN_CAP (1u << 18)
#define LAS __attribute__((address_space(3)))

__device__ __forceinline__ unsigned xb_ld(unsigned* p)              { return __hip_atomic_load(p, __ATOMIC_RELAXED, __HIP_MEMORY_SCOPE_AGENT); }
__device__ __forceinline__ unsigned xb_add(unsigned* p, unsigned v) { return __hip_atomic_fetch_add(p, v, __ATOMIC_RELAXED, __HIP_MEMORY_SCOPE_AGENT); }
__device__ __forceinline__ unsigned xb_xcc_id() { return (unsigned)__builtin_amdgcn_s_getreg((3 << 11) | 20) & 0xFu; }
#define XB_SPIN(cond, bar) do { unsigned _sp = 0; while (cond) { __builtin_amdgcn_s_sleep(1); \
    if ((++_sp & 255u) == 0u) { if (xb_ld(&(bar)[XB_TMO])) break; if (_sp > XB_SPIN_CAP) { atomicAdd(&(bar)[XB_TMO], 1u); break; } } } } while (0)

struct XcdBarrier {
    unsigned* bar; unsigned x;
    volatile LAS unsigned* st;
};

__device__ __forceinline__ XcdBarrier xcd_barrier_post(unsigned* bar, volatile LAS unsigned* st) {
    XcdBarrier b; b.bar = bar; b.x = xb_xcc_id(); b.st = st;
    if (threadIdx.x == 0) (void)xb_add(&bar[XB_XCNT(b.x)], 1u);
    return b;
}
__device__ __forceinline__ void xcd_barrier_complete(unsigned* bar, unsigned x, unsigned& nloc, unsigned& nx) {
    const unsigned G = gridDim.x * gridDim.y * gridDim.z;
    unsigned sum, cnt, mine, sp = 0u;
    for (;;) {
        sum = 0u; cnt = 0u; mine = 0u;
#pragma unroll
        for (unsigned j = 0; j < 16; ++j) { const unsigned c = xb_ld(&bar[XB_XCNT(j)]); sum += c; cnt += (c > 0u) ? 1u : 0u; mine = (j == x) ? c : mine; }
        if (sum == G) break;
        __builtin_amdgcn_s_sleep(1);
        if ((++sp & 255u) == 0u) { if (xb_ld(&bar[XB_TMO])) break; if (sp > XB_SPIN_CAP) { atomicAdd(&bar[XB_TMO], 1u); break; } }
    }
    nloc = mine > 0u ? mine : 1u; nx = cnt > 0u ? cnt : 1u;
}

__device__ __forceinline__ void xcd_barrier(const XcdBarrier& b_in) {
    XcdBarrier b = b_in; asm volatile("" : "+s"(b.bar), "+s"(b.x));
    asm volatile("s_waitcnt vmcnt(0)" ::: "memory");
    __syncthreads();
    if (threadIdx.x == 0) {
        unsigned* bar = b.bar;
        __builtin_amdgcn_s_waitcnt(0);
        unsigned nloc = b.st[0], nx = b.st[1];
        if (nloc == 0u) { xcd_barrier_complete(bar, b.x, nloc, nx); b.st[0] = nloc; b.st[1] = nx; }
        const unsigned old = xb_add(&bar[XB_XSUB(b.x)], 1u);
        const unsigned gen = old / nloc;
        if (old + 1u == (gen + 1u) * nloc) {
            __builtin_amdgcn_fence(__ATOMIC_RELEASE, "agent");
            asm volatile("s_waitcnt vmcnt(0)" ::: "memory");
            const unsigned og = xb_add(&bar[XB_TOP], 1u);
            const unsigned tg = og / nx;
            if (og + 1u == (tg + 1u) * nx) xb_add(&bar[XB_TOPGEN], 1u);
            else XB_SPIN(xb_ld(&bar[XB_TOPGEN]) == tg, bar);
            __builtin_amdgcn_fence(__ATOMIC_ACQUIRE, "agent");
            xb_add(&bar[XB_XGEN(b.x)], 1u);
            asm volatile("s_waitcnt vmcnt(0)" ::: "memory");
        } else {
            XB_SPIN(xb_ld(&bar[XB_XGEN(b.x)]) == gen, bar);
            __builtin_amdgcn_fence(__ATOMIC_ACQUIRE, "agent");
            asm volatile("s_waitcnt vmcnt(0)" ::: "memory");
        }
    }
    __syncthreads();
}

using pg8::f32x4;
using pg8::Unit;
typedef unsigned u32x4_t __attribute__((ext_vector_type(4)));
typedef unsigned u32x2_t __attribute__((ext_vector_type(2)));

struct SchedGrid {
    int nM, nN, pn0, G, c;
    __device__ __forceinline__ bool next(int i, Unit& u) const {
        const int L = i * G + c; if (L >= nM * nN) return false;
        u.pm = L / nN; u.pn = pn0 + (L - u.pm * nN); return true;
    }
    __device__ __forceinline__ void a_ready(const Unit&) const {}
    __device__ __forceinline__ void done(const Unit&) const {}
};
struct SchedMerge {
    int G, c;
    __device__ __forceinline__ bool next(int i, Unit& u) const {
        const int i3 = i / 3, n = i - i3 * 3, ti = i3 * G + c; if (ti >= NPANEL * 4) return false;
        u.pm = n * NPANEL + (ti >> 2); u.pn = n * 4 + (ti & 3); return true;
    }
    __device__ __forceinline__ void a_ready(const Unit&) const {}
    __device__ __forceinline__ void done(const Unit&) const {}
};
struct SchedMoe {
    int cum[17]; int G, c;
    __device__ __forceinline__ void init(const unsigned* cnt, int G_, int c_) {
        G = G_; c = c_; int s = 0;
#pragma unroll
        for (int e = 0; e < 16; ++e) { cum[e] = s; const unsigned n = __builtin_amdgcn_readfirstlane(cnt[e]); s += (int)((n + 255u) >> 8); }
        cum[16] = s;
    }
    __device__ __forceinline__ bool next(int i, Unit& u) const {
        const int L = i * G + c; if (L >= cum[16] * 4) return false;
        const int rt = L >> 2; int e = 0;
#pragma unroll
        for (int j = 1; j < 16; ++j) e += (rt >= cum[j]) ? 1 : 0;
        u.pm = rt; u.pn = e * 4 + (L & 3); return true;
    }
    __device__ __forceinline__ void a_ready(const Unit&) const {}
    __device__ __forceinline__ void done(const Unit&) const {}
};

__device__ __forceinline__ u32x4_t pack8(const f32x4& a, const f32x4& b) {
    u32x4_t r; r[0] = pk2(a[0], a[1]); r[1] = pk2(a[2], a[3]); r[2] = pk2(b[0], b[1]); r[3] = pk2(b[2], b[3]); return r;
}
struct EpiInProj {
    static constexpr bool PERM = true, AFTER_DRAIN = false; static constexpr bool KEEP = false;
    char* ws;
    __device__ __forceinline__ void operator()(const f32x4 (&acc)[2][2][4][2], const Unit& u, int wr, int wc, int fr, int fq) const {
        const int pn = u.pn; const int row0 = u.pm * 256 + wr * 64 + fr;
        if (pn == 6) {
            if (wc == 0) { float* gr = (float*)(ws + OFF_GR);
#pragma unroll
                for (int ai = 0; ai < 2; ++ai)
#pragma unroll
                    for (int m = 0; m < 4; ++m) { float* rp = gr + (size_t)(row0 + ai * 128 + m * 16) * 32 + 8 * fq;
                        *(f32x4*)(rp) = acc[ai][0][m][0]; *(f32x4*)(rp + 4) = acc[ai][0][m][1]; } }
            return;
        }
        if (pn == 2 || pn == 3 || pn == 11 || pn == 12 || pn == 17 || pn == 18) {
            const size_t voff = pn < 4 ? OFF_GVT : (pn < 13 ? OFF_VT : OFF_NVT); const int colt = ((pn < 4 ? pn - 2 : (pn < 13 ? pn - 11 : pn - 17)) * 256) + wc * 32 + 8 * fq;
            const int b = u.pm / PB, key0 = (u.pm - b * PB) * 256 + wr * 64 + fr;
            bf16_t* vt = (bf16_t*)(ws + voff) + ((size_t)b * 512 + colt) * LB + key0;
#pragma unroll
            for (int ai = 0; ai < 2; ++ai)
#pragma unroll
                for (int m = 0; m < 4; ++m)
#pragma unroll
                    for (int bj = 0; bj < 2; ++bj) { const u32x4_t pk = pack8(acc[ai][bj][m][0], acc[ai][bj][m][1]); bf16_t* cp = vt + (size_t)(bj * 128) * LB + ai * 128 + m * 16;
#pragma unroll
                        for (int j = 0; j < 4; ++j) { cp[(size_t)(2 * j) * LB] = (bf16_t)(pk[j] & 0xffffu); cp[(size_t)(2 * j + 1) * LB] = (bf16_t)(pk[j] >> 16); } }
            return;
        }
        size_t off; int ld, col0;
        if (pn == 0) { off = OFF_GQ; ld = 256; col0 = 0; }
        else if (pn == 1) { off = OFF_GK; ld = 256; col0 = 0; }
        else if (pn < 4) { off = OFF_GV; ld = 512; col0 = (pn - 2) * 256; }
        else if (pn < 6) { off = OFF_GG; ld = 512; col0 = (pn - 4) * 256; }
        else if (pn < 9) { off = OFF_DQ; ld = 512; col0 = (pn - 7) * 256; }
        else if (pn < 11) { off = OFF_DK; ld = 512; col0 = (pn - 9) * 256; }
        else if (pn < 13) { off = OFF_DV; ld = 512; col0 = (pn - 11) * 256; }
        else if (pn < 15) { off = OFF_NQ; ld = 512; col0 = (pn - 13) * 256; }
        else if (pn < 17) { off = OFF_NK; ld = 512; col0 = (pn - 15) * 256; }
        else { off = OFF_NV; ld = 512; col0 = (pn - 17) * 256; }
        bf16_t* base = (bf16_t*)(ws + off) + col0 + wc * 32 + 8 * fq;
#pragma unroll
        for (int ai = 0; ai < 2; ++ai)
#pragma unroll
            for (int m = 0; m < 4; ++m) { bf16_t* rp = base + (size_t)(row0 + ai * 128 + m * 16) * ld;
#pragma unroll
                for (int bj = 0; bj < 2; ++bj) *(u32x4_t*)(rp + bj * 128) = pack8(acc[ai][bj][m][0], acc[ai][bj][m][1]); }
    }
};
struct EpiGates {
    static constexpr bool PERM = true, AFTER_DRAIN = false; static constexpr bool KEEP = false;
    char* ws;
    __device__ __forceinline__ void operator()(const f32x4 (&acc)[2][2][4][2], const Unit& u, int wr, int wc, int fr, int fq) const {
        const int pl = u.pn - 19, n = pl >> 2, col0 = (pl & 3) * 256; const int row0 = u.pm * 256 + wr * 64 + fr;
        bf16_t* base = (bf16_t*)(ws + OFF_GATE) + (size_t)n * T * 1024 + col0 + wc * 32 + 8 * fq;
#pragma unroll
        for (int ai = 0; ai < 2; ++ai)
#pragma unroll
            for (int m = 0; m < 4; ++m) { bf16_t* rp = base + (size_t)(row0 + ai * 128 + m * 16) * 1024;
#pragma unroll
                for (int bj = 0; bj < 2; ++bj) { f32x4 a = acc[ai][bj][m][0], b = acc[ai][bj][m][1];
#pragma unroll
                    for (int j = 0; j < 4; ++j) { a[j] = sigmoidf_(a[j]); b[j] = sigmoidf_(b[j]); }
                    *(u32x4_t*)(rp + bj * 128) = pack8(a, b); } }
    }
};
struct EpiMerge {
    static constexpr bool PERM = true, AFTER_DRAIN = false; static constexpr bool KEEP = true;
    char* ws;
    __device__ __forceinline__ bool keep(const Unit& u) const { return u.pm < 2 * NPANEL; }
    __device__ __forceinline__ void operator()(f32x4 (&acc)[2][2][4][2], const Unit& u, int wr, int wc, int fr, int fq) const {
        const int n = u.pm / NPANEL, pm = u.pm - n * NPANEL, pn = u.pn & 3; const int row0 = pm * 256 + wr * 64 + fr;
        const size_t cb = (size_t)pn * 256 + wc * 32 + 8 * fq;
        const bf16_t* gnum = (const bf16_t*)(ws + OFF_GATE) + (size_t)n * T * 1024 + cb;
        const bf16_t* gden = gnum + (size_t)T * 1024;
        bf16_t* obase = (bf16_t*)(ws + OFF_H) + cb;
#pragma unroll
        for (int ai = 0; ai < 2; ++ai)
#pragma unroll
            for (int m = 0; m < 4; ++m) { const size_t ro = (size_t)(row0 + ai * 128 + m * 16) * 1024;
#pragma unroll
                for (int bj = 0; bj < 2; ++bj) {
                    const u32x4_t g = *(const u32x4_t*)(gnum + ro + bj * 128);
                    float f[8];
#pragma unroll
                    for (int j = 0; j < 4; ++j) { f[2 * j] = bflo(g[j]); f[2 * j + 1] = bfhi(g[j]); }
                    if (n > 0) {
#pragma unroll
                        for (int j = 0; j < 8; ++j) f[j] = fmaxf(f[j], 1e-30f); }
                    if (n < 2) { const u32x4_t gd = *(const u32x4_t*)(gden + ro + bj * 128);
#pragma unroll
                        for (int j = 0; j < 4; ++j) { f[2 * j] *= __builtin_amdgcn_rcpf(fmaxf(bflo(gd[j]), 1e-30f)); f[2 * j + 1] *= __builtin_amdgcn_rcpf(fmaxf(bfhi(gd[j]), 1e-30f)); }
#pragma unroll
                        for (int j = 0; j < 4; ++j) { acc[ai][bj][m][0][j] *= f[j]; acc[ai][bj][m][1][j] *= f[4 + j]; }
                    } else {
                        f32x4 a = acc[ai][bj][m][0], b = acc[ai][bj][m][1];
#pragma unroll
                        for (int j = 0; j < 4; ++j) { a[j] *= f[j]; b[j] *= f[4 + j]; }
                        *(u32x4_t*)(obase + ro + bj * 128) = pack8(a, b); } } }
    }
};
struct EpiWo {
    static constexpr bool PERM = false, AFTER_DRAIN = false; static constexpr bool KEEP = false;
    char* ws; int layer; bool commit;
    __device__ __forceinline__ void operator()(const f32x4 (&acc)[2][2][4][2], const Unit& u, int wr, int wc, int fr, int fq) const {
        const int b = u.pm / PB, slot = (u.pm - b * PB) == 0 ? 8 : b;
        const int row0 = u.pm * 256 + wr * 64 + fr, col0 = u.pn * 256 + wc * 32 + 4 * fq;
        const float* mg = (const float*)(ws + OFF_MOD) + ((size_t)(layer * 9 + slot) * 6 + 2) * 1024 + col0;
        float* xs = (float*)(ws + OFF_XS) + col0;
        f32x4 g[2][2];
#pragma unroll
        for (int bj = 0; bj < 2; ++bj)
#pragma unroll
            for (int n = 0; n < 2; ++n) g[bj][n] = *(const f32x4*)(mg + bj * 128 + n * 16);
#pragma unroll
        for (int ai = 0; ai < 2; ++ai)
#pragma unroll
            for (int m = 0; m < 4; ++m) { float* rp = xs + (size_t)(row0 + ai * 128 + m * 16) * 1024;
#pragma unroll
                for (int bj = 0; bj < 2; ++bj)
#pragma unroll
                    for (int n = 0; n < 2; ++n) { f32x4 x = *(const f32x4*)(rp + bj * 128 + n * 16);
                        if (commit) *(f32x4*)(rp + bj * 128 + n * 16) = x * ALPHA + g[bj][n] * acc[ai][bj][m][n]; } }
    }
};
struct EpiUp {
    static constexpr bool PERM = true, AFTER_DRAIN = false; static constexpr bool KEEP = false;
    char* ws;
    __device__ __forceinline__ void operator()(const f32x4 (&acc)[2][2][4][2], const Unit& u, int wr, int wc, int fr, int fq) const {
        const int ct = u.pn & 3; const int row0 = u.pm * 256 + wr * 64 + fr;
        bf16_t* base = (bf16_t*)(ws + OFF_ACT) + ct * 128 + wc * 32 + 8 * fq;
#pragma unroll
        for (int ai = 0; ai < 2; ++ai)
#pragma unroll
            for (int m = 0; m < 4; ++m) { f32x4 a, b;
#pragma unroll
                for (int j = 0; j < 4; ++j) { a[j] = siluf_(acc[ai][0][m][0][j]) * acc[ai][1][m][0][j]; b[j] = siluf_(acc[ai][0][m][1][j]) * acc[ai][1][m][1][j]; }
                *(u32x4_t*)(base + (size_t)(row0 + ai * 128 + m * 16) * 512) = pack8(a, b); }
    }
};
struct EpiDown {
    static constexpr bool PERM = true, AFTER_DRAIN = false; static constexpr bool KEEP = false;
    char* ws;
    __device__ __forceinline__ void operator()(const f32x4 (&acc)[2][2][4][2], const Unit& u, int wr, int wc, int fr, int fq) const {
        const int ct = u.pn & 3; const int row0 = u.pm * 256 + wr * 64 + fr;
        bf16_t* base = (bf16_t*)(ws + OFF_Y) + ct * 256 + wc * 32 + 8 * fq;
#pragma unroll
        for (int ai = 0; ai < 2; ++ai)
#pragma unroll
            for (int m = 0; m < 4; ++m) { bf16_t* rp = base + (size_t)(row0 + ai * 128 + m * 16) * 1024;
#pragma unroll
                for (int bj = 0; bj < 2; ++bj) *(u32x4_t*)(rp + bj * 128) = pack8(acc[ai][bj][m][0], acc[ai][bj][m][1]); }
    }
};

#define GSTRIDE_BEGIN(var, n) for (long var = (long)blockIdx.x * NTHR + ltid(); var < (long)(n); var += (long)gridDim.x * NTHR)

__device__ __forceinline__ void phase_mod(const Params& p, float* lds) {
    const int tid = ltid();
    for (int i = tid; i < 9 * 1024; i += NTHR) { const int s = i >> 10, k = i & 1023; const float v = s < 8 ? p.in[I_C][s * 1024 + k] : p.in[I_CCTX][k]; lds[i] = siluf_(v); }
    __syncthreads();
    float* mod = (float*)(p.ws + OFF_MOD);
    GSTRIDE_BEGIN(idx, DEPTH * 6144) {
        const int l = (int)(idx / 6144), j = (int)(idx - (long)l * 6144);
        const float* w = p.in[I_WADA] + (size_t)l * 1024 * 6144 + j;
        float acc[9];
#pragma unroll
        for (int s = 0; s < 9; ++s) acc[s] = 0.f;
        for (int k = 0; k < 1024; ++k) { const float wv = w[(size_t)k * 6144];
#pragma unroll
            for (int s = 0; s < 9; ++s) acc[s] += lds[s * 1024 + k] * wv; }
        const float bv = p.in[I_BADA][l * 6144 + j];
#pragma unroll
        for (int s = 0; s < 9; ++s) mod[(size_t)(l * 9 + s) * 6144 + j] = acc[s] + bv;
    }
    float* rope = (float*)(p.ws + OFF_ROPE);
    GSTRIDE_BEGIN(idx, 4096 * 32) {
        const int t = (int)(idx >> 5), i = (int)(idx & 31);
        const float pos = (float)(i < 16 ? (t >> 6) : (t & 63));
        const float inv = powf(10000.0f, -(float)(i & 15) / 16.0f);
        const float ang = pos * inv;
        rope[idx * 2] = cosf(ang); rope[idx * 2 + 1] = sinf(ang);
    }
    __syncthreads();
}

__device__ __forceinline__ void phase_init(const Params& p) {
    const float* mod = (const float*)(p.ws + OFF_MOD);
    float* xs = (float*)(p.ws + OFF_XS); bf16_t* h = (bf16_t*)(p.ws + OFF_H);
    GSTRIDE_BEGIN(idx, (long)T * 256) {
        const int row = (int)(idx >> 8), c4 = (int)(idx & 255) * 4;
        const int b = row / LB, t = row - b * LB;
        const float* src = t < LC ? p.in[I_CTX] + ((size_t)(b * LC + t)) * 1024 : p.in[I_X] + ((size_t)(b * LL + (t - LC))) * 1024;
        const int slot = t < LC ? 8 : b;
        const f32x4 v = *(const f32x4*)(src + c4);
        const f32x4 sh = *(const f32x4*)(mod + (size_t)(slot * 6 + 0) * 1024 + c4), sc = *(const f32x4*)(mod + (size_t)(slot * 6 + 1) * 1024 + c4);
        *(f32x4*)(xs + (size_t)row * 1024 + c4) = v;
        const f32x4 hv = v * (sc + 1.0f) + sh;
        u32x2_t o; o[0] = pk2(hv[0], hv[1]); o[1] = pk2(hv[2], hv[3]);
        *(u32x2_t*)(h + (size_t)row * 1024 + c4) = o;
    }
}

__device__ __forceinline__ int winmap(int rho, float& scale) {
    scale = 1.f;
    if (rho < 1568) { if (rho < 256) scale = 0.125f; return rho; }
    if (rho < 1792) return -1;
    if (rho < 2304) scale = 0.125f * 1.4426950408889634f;
    else if (rho >= 3328 && rho < 3840) scale = 0.125f;
    return rho - 224;
}
__device__ __forceinline__ void convert_job(const float* src, const float* src2, int ld, int K, bf16_t* dst, int nrows, int mode, int& itemctr, int dld = 0) {
    if (dld == 0) dld = K;
    const int tid = ltid(), lane = tid & 63, wv = tid >> 6, nwv = (int)gridDim.x * (NTHR / 64), me = (int)blockIdx.x * (NTHR / 64) + wv;
    const int nkc = K >> 6, nitems = (nrows >> 6) * nkc;
    int first = (me - itemctr) % nwv; if (first < 0) first += nwv;
    itemctr = (itemctr + nitems) % nwv;
    for (int it = first; it < nitems; it += nwv) {
        const int rg = it / nkc, kc = it - rg * nkc, rho = rg * 64 + lane, k0 = kc * 64;
        float sc = 1.f; int col; const float* s = src;
        if (mode == 0) col = winmap(rho, sc);
        else if (mode == 1) col = rho;
        else { const int ct = rho >> 8, half = (rho >> 7) & 1, i = rho & 127; col = ct * 128 + i; s = half ? src2 : src; }
        const float* sp = s + (size_t)k0 * ld + (col >= 0 ? col : 0);
        if (col < 0) sc = 0.f;
        bf16_t* dp = dst + (size_t)rho * dld + k0;
#pragma unroll
        for (int k8 = 0; k8 < 8; ++k8) { float v[8];
#pragma unroll
            for (int j = 0; j < 8; ++j) v[j] = sp[(size_t)(k8 * 8 + j) * ld] * sc;
            u32x4_t o; o[0] = pk2(v[0], v[1]); o[1] = pk2(v[2], v[3]); o[2] = pk2(v[4], v[5]); o[3] = pk2(v[6], v[7]);
            *(u32x4_t*)(dp + k8 * 8) = o; }
    }
}
__device__ __forceinline__ void phase_convert(const Params& p, int l, float* lds) {
    (void)lds; int ctr = 0;
    convert_job(p.in[I_WIN] + (size_t)l * 1024 * 7712, nullptr, 7712, 1024, (bf16_t*)(p.ws + OFF_WIN), (int)W_IN_ROWS, 0, ctr);
    for (int n = 0; n < 3; ++n)
        convert_job(p.in[I_WBR] + ((size_t)l * 3 + n) * 512 * 1024, nullptr, 1024, 512, (bf16_t*)(p.ws + OFF_WB) + (size_t)n * 1024 * 512, 1024, 1, ctr);
    convert_job(p.in[I_WO] + (size_t)l * 1024 * 1024, nullptr, 1024, 1024, (bf16_t*)(p.ws + OFF_WO), 1024, 1, ctr);
    for (int e = 0; e < 16; ++e) {
        const size_t eo = ((size_t)l * 16 + e) * 1024 * 512;
        convert_job(p.in[I_WEG] + eo, p.in[I_WEU] + eo, 512, 1024, (bf16_t*)(p.ws + OFF_WUP) + (size_t)e * 1024 * 1024, 1024, 2, ctr);
        convert_job(p.in[I_WED] + eo, nullptr, 1024, 512, (bf16_t*)(p.ws + OFF_WDN) + (size_t)e * 1024 * 512, 1024, 1, ctr);
    }
}

__device__ __forceinline__ void phase_rope_decay(const Params& p, int l, bool commit = true) {
    const float* rope = (const float*)(p.ws + OFF_ROPE);
    GSTRIDE_BEGIN(idx, (long)NB * LL * 2 * 8 * 8) {
        const int i4 = (int)(idx & 7) * 4, hc = (int)(idx >> 3) & 7, which = (int)(idx >> 6) & 1; const int lat = (int)(idx >> 7);
        const int b = lat >> 12, t = lat & 4095; const int row = b * LB + LC + t;
        bf16_t* base = (bf16_t*)(p.ws + (which ? OFF_DK : OFF_DQ)) + (size_t)row * 512 + hc * 64 + i4;
        const u32x2_t a = *(const u32x2_t*)base, bq = *(const u32x2_t*)(base + 32);
        const float x1[4] = {bflo(a[0]), bfhi(a[0]), bflo(a[1]), bfhi(a[1])}, x2[4] = {bflo(bq[0]), bfhi(bq[0]), bflo(bq[1]), bfhi(bq[1])};
        float y1[4], y2[4];
#pragma unroll
        for (int j = 0; j < 4; ++j) { const float cs = rope[((size_t)t * 32 + i4 + j) * 2], sn = rope[((size_t)t * 32 + i4 + j) * 2 + 1];
            y1[j] = x1[j] * cs - x2[j] * sn; y2[j] = x1[j] * sn + x2[j] * cs; }
        u32x2_t o1, o2; o1[0] = pk2(y1[0], y1[1]); o1[1] = pk2(y1[2], y1[3]); o2[0] = pk2(y2[0], y2[1]); o2[1] = pk2(y2[2], y2[3]);
        if (commit) { *(u32x2_t*)base = o1; *(u32x2_t*)(base + 32) = o2; }
    }
#if !FAST_GLA
    const float* gr = (const float*)(p.ws + OFF_GR); float* dec = (float*)(p.ws + OFF_S1);
    const float* wd = p.in[I_GWD] + (size_t)l * 2 * 16 * 256; const float* bd = p.in[I_GBD] + (size_t)l * 2 * 256;
    GSTRIDE_BEGIN(idx, (long)T * 512) {
        const int row = (int)(idx >> 9), dj = (int)(idx & 511), dir = dj >> 8, j = dj & 255;
        float z = bd[dir * 256 + j];
#pragma unroll
        for (int r = 0; r < 16; ++r) z += gr[(size_t)row * 32 + dir * 16 + r] * wd[(dir * 16 + r) * 256 + j];
        const float ls = fminf(z, 0.f) - log1pf(__expf(-fabsf(z)));
        dec[idx] = __expf(ls * (1.0f / 16.0f));
    }
#endif
}

template <int DIR>
__device__ __forceinline__ void gla_naive_dir(const Params& p, int l, int b, float* lds) {
    const int tid = ltid(), hh = tid >> 7, vc = tid & 127, wv = tid >> 6;
    const bf16_t* GQ = (const bf16_t*)(p.ws + OFF_GQ); const bf16_t* GK = (const bf16_t*)(p.ws + OFF_GK); const bf16_t* GV = (const bf16_t*)(p.ws + OFF_GV);
    bf16_t* GG = (bf16_t*)(p.ws + OFF_GG); const float* DEC = (const float*)(p.ws + OFF_S1); float* OF = (float*)(p.ws + OFF_S2);
    float* sq = lds; float* sk = lds + 16 * 256; float* sd = lds + 32 * 256; float* red = lds + 48 * 256;
    float* sv = lds + 49 * 256;
    const float gn = p.in[I_GNG][l * 128 + vc];
    const int row0 = b * LB;
    float S[64];
#pragma unroll
    for (int d = 0; d < 64; ++d) S[d] = 0.f;
    for (int blk = 0; blk < LB / 16; ++blk) {
        int t0;
        if (DIR == 0) t0 = blk * 16; else t0 = blk < 16 ? (15 - blk) * 16 : (LB / 16 - 1 - (blk - 16)) * 16;
        __syncthreads();
        for (int i = tid; i < 16 * 256; i += 512) { const int r = i >> 8, j = i & 255; const size_t row = row0 + t0 + r;
            sq[i] = bf2f(GQ[row * 256 + j]); sk[i] = bf2f(GK[row * 256 + j]); sd[i] = DEC[(row * 2 + DIR) * 256 + j]; }
#pragma unroll 1
        for (int r = 0; r < 16; ++r) sv[r * 512 + tid] = bf2f(GV[(size_t)(row0 + t0 + r) * 512 + hh * 128 + vc]);
        __syncthreads();
#pragma unroll 1
        for (int rr = 0; rr < 16; ++rr) {
            const int r = DIR == 0 ? rr : 15 - rr;
            const float* pq = sq + r * 256 + hh * 64; const float* pk = sk + r * 256 + hh * 64; const float* pd = sd + r * 256 + hh * 64;
            const float vr = sv[r * 512 + tid];
            float o = 0.f;
#pragma unroll
            for (int d = 0; d < 64; ++d) { S[d] = pd[d] * S[d] + pk[d] * vr; o += pq[d] * S[d]; }
            const size_t oi = (size_t)(row0 + t0 + r) * 512 + hh * 128 + vc;
            if (DIR == 0) OF[oi] = o;
            else {
                const float tot = o + OF[oi];
                sv[r * 512 + tid] = tot;
                const float ss = wave_sum(tot * tot); if ((tid & 63) == 0) red[r * 8 + wv] = ss;
            }
        }
        if (DIR == 1) {
            __syncthreads();
#pragma unroll 1
            for (int r = 0; r < 16; ++r) {
                const float ms = (red[r * 8 + hh * 2] + red[r * 8 + hh * 2 + 1]) * (1.0f / 128.0f);
                const size_t gi = (size_t)(row0 + t0 + r) * 512 + hh * 128 + vc;
                const float gate = bf2f(GG[gi]);
                GG[gi] = f2bf(sv[r * 512 + tid] * rsqrtf(ms + RMS_EPS) * gn * siluf_(gate));
            }
        }
    }
    __syncthreads();
}
__device__ __forceinline__ void gla_naive_batch(const Params& p, int l, int b, float* lds) {
    gla_naive_dir<0>(p, l, b, lds);
    gla_naive_dir<1>(p, l, b, lds);
}

__device__ __forceinline__ void diff_naive_tile(const Params& p, int l, int unit, float* lds) {
    const int tid = ltid(), qi = tid & 127, c = (tid >> 7) & 1, hv = tid >> 8;
    const int qt = unit % 34, bh = unit / 34, hh = bh & 3, b = bh >> 2;
    const int nkeys = qt < 2 ? LC : LB;
    const size_t rowq = (size_t)b * LB + qt * 128 + qi;
    bf16_t* DQ = (bf16_t*)(p.ws + OFF_DQ); const bf16_t* DK = (const bf16_t*)(p.ws + OFF_DK); const bf16_t* DV = (const bf16_t*)(p.ws + OFF_DV);
    float q[64], o[64];
    { const bf16_t* qp = DQ + rowq * 512 + hh * 128 + c * 64;
#pragma unroll
      for (int d8 = 0; d8 < 8; ++d8) { const u32x4_t v = *(const u32x4_t*)(qp + d8 * 8);
#pragma unroll
          for (int j = 0; j < 4; ++j) { q[d8 * 8 + 2 * j] = bflo(v[j]); q[d8 * 8 + 2 * j + 1] = bfhi(v[j]); } } }
#pragma unroll
    for (int d = 0; d < 64; ++d) o[d] = 0.f;
    float m = -INFINITY, lsum = 0.f;
    constexpr int KT = 8; float* kb = lds; float* vb = lds + KT * 128;
    for (int k0 = 0; k0 < nkeys; k0 += KT) {
        __syncthreads();
        for (int i = tid; i < KT * 128; i += 512) { const int r = i >> 7, j = i & 127; const size_t row = (size_t)b * LB + k0 + r;
            kb[i] = bf2f(DK[row * 512 + hh * 128 + j]); vb[i] = bf2f(DV[row * 512 + hh * 128 + j]); }
        __syncthreads();
        float s[KT]; float mt = -INFINITY;
#pragma unroll
        for (int j = 0; j < KT; ++j) { const float* kp = kb + j * 128 + c * 64; float a = 0.f;
#pragma unroll
            for (int d = 0; d < 64; ++d) a += q[d] * kp[d];
            s[j] = a; mt = fmaxf(mt, a); }
        const float mn = fmaxf(m, mt), corr = __expf(m - mn);
        lsum *= corr;
#pragma unroll
        for (int d = 0; d < 64; ++d) o[d] *= corr;
#pragma unroll
        for (int j = 0; j < KT; ++j) { const float pj = __expf(s[j] - mn); lsum += pj; const float* vp = vb + j * 128 + hv * 64;
#pragma unroll
            for (int d = 0; d < 64; ++d) o[d] += pj * vp[d]; }
        m = mn;
    }
    __syncthreads();
    { const float inv = 1.f / lsum; float* cp = lds + ((size_t)qi * 2 + c) * 128 + hv * 64;
#pragma unroll
      for (int d = 0; d < 64; ++d) cp[d] = o[d] * inv; }
    __syncthreads();
    {
        float dq = 0.f, dk2 = 0.f; const float* lq = p.in[I_LQ] + l * 128; const float* lk = p.in[I_LK] + l * 128;
        for (int d = 0; d < 64; ++d) { dq += lq[d] * lk[d]; dk2 += lq[64 + d] * lk[64 + d]; }
        const float lam_init = 0.8f - 0.6f * expf(-0.3f * (float)l);
        const float lam = expf(dq) - expf(dk2) + lam_init;
        const int q2 = tid >> 2, part = tid & 3;
        const float* c0 = lds + ((size_t)q2 * 2) * 128 + part * 32; const float* c1 = c0 + 128;
        float v[32]; float ss = 0.f;
#pragma unroll
        for (int d = 0; d < 32; ++d) { v[d] = c0[d] - lam * c1[d]; ss += v[d] * v[d]; }
        ss += __shfl_xor(ss, 1); ss += __shfl_xor(ss, 2);
        const float sc = rsqrtf(ss * (1.0f / 128.0f) + RMS_EPS) * (1.0f - lam_init);
        const float* g = p.in[I_DNG] + l * 128 + part * 32;
        bf16_t* op = DQ + ((size_t)b * LB + qt * 128 + q2) * 512 + hh * 128 + part * 32;
#pragma unroll
        for (int d = 0; d < 32; d += 2) *(unsigned*)(op + d) = pk2(v[d] * sc * g[d], v[d + 1] * sc * g[d + 1]);
    }
    __syncthreads();
}

__device__ __forceinline__ void na_naive_unit(const Params& p, int l, int unit) {
    const int tid = ltid(), h = tid >> 6, lane = tid & 63;
    const size_t row = (size_t)unit * 64 + lane; const int b = (int)(row / LB), t = (int)(row - (size_t)b * LB);
    bf16_t* NQ = (bf16_t*)(p.ws + OFF_NQ); const bf16_t* NK = (const bf16_t*)(p.ws + OFF_NK); const bf16_t* NV = (const bf16_t*)(p.ws + OFF_NV);
    const float* rpb = p.in[I_RPB] + ((size_t)l * 8 + h) * 15 * 31;
    float q[64], o[64];
    { const bf16_t* qp = NQ + row * 512 + h * 64;
#pragma unroll
      for (int d8 = 0; d8 < 8; ++d8) { const u32x4_t v = *(const u32x4_t*)(qp + d8 * 8);
#pragma unroll
          for (int j = 0; j < 4; ++j) { q[d8 * 8 + 2 * j] = bflo(v[j]); q[d8 * 8 + 2 * j + 1] = bfhi(v[j]); } } }
#pragma unroll
    for (int d = 0; d < 64; ++d) o[d] = 0.f;
    float m = -INFINITY, lsum = 0.f;
    const bool lat = t >= LC; const int tp = t - LC, r = tp >> 6, qc = tp & 63;
    const int rs = min(max(r - 4, 0), 56), cs = min(max(qc - 8, 0), 48);
    const int nloc = lat ? 128 : 0;
    for (int kk = 0; kk < nloc + LC; ++kk) {
        size_t krow; float bias = 0.f;
        if (kk < nloc) { const int kr = rs + (kk >> 4), kc = cs + (kk & 15); krow = (size_t)b * LB + LC + kr * 64 + kc; bias = rpb[(kr - r + 7) * 31 + (kc - qc + 15)]; }
        else krow = (size_t)b * LB + (kk - nloc);
        const bf16_t* kp = NK + krow * 512 + h * 64; const bf16_t* vp = NV + krow * 512 + h * 64;
        float s = bias;
#pragma unroll
        for (int d8 = 0; d8 < 8; ++d8) { const u32x4_t v = *(const u32x4_t*)(kp + d8 * 8);
#pragma unroll
            for (int j = 0; j < 4; ++j) { s += q[d8 * 8 + 2 * j] * bflo(v[j]); s += q[d8 * 8 + 2 * j + 1] * bfhi(v[j]); } }
        const float mn = fmaxf(m, s), corr = __expf(m - mn), pj = __expf(s - mn);
        lsum = lsum * corr + pj; m = mn;
#pragma unroll
        for (int d8 = 0; d8 < 8; ++d8) { const u32x4_t v = *(const u32x4_t*)(vp + d8 * 8);
#pragma unroll
            for (int j = 0; j < 4; ++j) { o[d8 * 8 + 2 * j] = o[d8 * 8 + 2 * j] * corr + pj * bflo(v[j]); o[d8 * 8 + 2 * j + 1] = o[d8 * 8 + 2 * j + 1] * corr + pj * bfhi(v[j]); } }
    }
    const float inv = 1.f / lsum;
    bf16_t* op = NQ + row * 512 + h * 64;
#pragma unroll
    for (int d8 = 0; d8 < 8; ++d8) { u32x4_t v;
#pragma unroll
        for (int j = 0; j < 4; ++j) v[j] = pk2(o[d8 * 8 + 2 * j] * inv, o[d8 * 8 + 2 * j + 1] * inv);
        *(u32x4_t*)(op + d8 * 8) = v; }
}

__device__ __forceinline__ void ln_row(float (&v)[16], const float* g, const float* bb, int lane) {
    float s = 0.f;
#pragma unroll
    for (int i = 0; i < 16; ++i) s += v[i];
    const float mu = wave_sum(s) * (1.0f / 1024.0f);
    float q = 0.f;
#pragma unroll
    for (int i = 0; i < 16; ++i) { v[i] -= mu; q += v[i] * v[i]; }
    const float rstd = rsqrtf(wave_sum(q) * (1.0f / 1024.0f) + LN_EPS);
#pragma unroll
    for (int i = 0; i < 4; ++i) { const f32x4 gv = *(const f32x4*)(g + i * 256 + lane * 4), bv = *(const f32x4*)(bb + i * 256 + lane * 4);
#pragma unroll
        for (int j = 0; j < 4; ++j) v[i * 4 + j] = v[i * 4 + j] * rstd * gv[j] + bv[j]; }
}

__device__ __forceinline__ void top2of4(const float s0, const float s1, const float s2, const float s3, int& i1, int& i2, float& sum) {
    i1 = 0; float m1 = s0;
    if (s1 > m1) { m1 = s1; i1 = 1; } if (s2 > m1) { m1 = s2; i1 = 2; } if (s3 > m1) { m1 = s3; i1 = 3; }
    float m2 = -INFINITY; i2 = 0;
    if (i1 != 0 && s0 > m2) { m2 = s0; i2 = 0; } if (i1 != 1 && s1 > m2) { m2 = s1; i2 = 1; }
    if (i1 != 2 && s2 > m2) { m2 = s2; i2 = 2; } if (i1 != 3 && s3 > m2) { m2 = s3; i2 = 3; }
    sum = m1 + m2;
}

__device__ __forceinline__ void phase_ln1_router(const Params& p, int l, float* lds, bool commit = true) {
    const int tid = ltid(), lane = tid & 63, wv = tid >> 6;
    float* xs = (float*)(p.ws + OFF_XS); bf16_t* h = (bf16_t*)(p.ws + OFF_H); const float* mod = (const float*)(p.ws + OFF_MOD);
    int* tok = (int*)(p.ws + OFF_TOK); unsigned* blkcnt = (unsigned*)(p.ws + OFF_BLKCNT);
    const float* g = p.in[I_LNG] + (size_t)(l * 2 + 0) * 1024; const float* bb = p.in[I_LNB] + (size_t)(l * 2 + 0) * 1024;
    const float* wr = p.in[I_WR]; const float* br = p.in[I_BR];
    float* wt = lds; unsigned* lcnt = (unsigned*)(lds + 16 * 1024);
    __syncthreads();
    for (int i = tid; i < 16 * 1024; i += NTHR) { const int col = i >> 4, e = i & 15; wt[e * 1024 + col] = wr[i]; }
    if (tid < 16) lcnt[tid] = 0u;
    __syncthreads();
    const int rpb = (T + (int)gridDim.x - 1) / (int)gridDim.x, r_begin = (int)blockIdx.x * rpb, r_end = min(T, r_begin + rpb);
    for (int row = r_begin + wv; row < r_end; row += NTHR / 64) {
        const int slot = row_slot(row);
        const float* msh = mod + ((size_t)(l * 9 + slot) * 6 + 3) * 1024; const float* msc = msh + 1024;
        float v[16];
#pragma unroll
        for (int i = 0; i < 4; ++i) { const f32x4 t4 = *(const f32x4*)(xs + (size_t)row * 1024 + i * 256 + lane * 4);
#pragma unroll
            for (int j = 0; j < 4; ++j) v[i * 4 + j] = t4[j]; }
        ln_row(v, g, bb, lane);
        float lg[16];
#pragma unroll
        for (int e = 0; e < 16; ++e) lg[e] = 0.f;
#pragma unroll
        for (int i = 0; i < 4; ++i) {
            const int c0 = i * 256 + lane * 4;
            f32x4 x4; x4[0] = v[i * 4]; x4[1] = v[i * 4 + 1]; x4[2] = v[i * 4 + 2]; x4[3] = v[i * 4 + 3];
            if (commit) *(f32x4*)(xs + (size_t)row * 1024 + c0) = x4;
            const f32x4 sh = *(const f32x4*)(msh + c0), sc = *(const f32x4*)(msc + c0);
            const f32x4 hv = x4 * (sc + 1.0f) + sh;
            u32x2_t o; o[0] = pk2(hv[0], hv[1]); o[1] = pk2(hv[2], hv[3]);
            if (commit) *(u32x2_t*)(h + (size_t)row * 1024 + c0) = o;
#pragma unroll
            for (int e = 0; e < 16; ++e) { const f32x4 w4 = *(const f32x4*)(wt + e * 1024 + c0);
                lg[e] += hv[0] * w4[0] + hv[1] * w4[1] + hv[2] * w4[2] + hv[3] * w4[3]; }
        }
        float t8[8], t4[4], t2[2], t1;
        { const bool hi = (lane & 32) != 0;
#pragma unroll
          for (int i = 0; i < 8; ++i) { const float keep = hi ? lg[8 + i] : lg[i], give = hi ? lg[i] : lg[8 + i]; t8[i] = keep + __shfl_xor(give, 32); } }
        { const bool hi = (lane & 16) != 0;
#pragma unroll
          for (int i = 0; i < 4; ++i) { const float keep = hi ? t8[4 + i] : t8[i], give = hi ? t8[i] : t8[4 + i]; t4[i] = keep + __shfl_xor(give, 16); } }
        { const bool hi = (lane & 8) != 0;
#pragma unroll
          for (int i = 0; i < 2; ++i) { const float keep = hi ? t4[2 + i] : t4[i], give = hi ? t4[i] : t4[2 + i]; t2[i] = keep + __shfl_xor(give, 8); } }
        { const bool hi = (lane & 4) != 0; const float keep = hi ? t2[1] : t2[0], give = hi ? t2[0] : t2[1]; t1 = keep + __shfl_xor(give, 4); }
        t1 += __shfl_xor(t1, 2); t1 += __shfl_xor(t1, 1);
        float aff[16], sel[16];
#pragma unroll
        for (int e = 0; e < 16; ++e) { const int src = ((e >> 3) & 1) * 32 + ((e >> 2) & 1) * 16 + ((e >> 1) & 1) * 8 + (e & 1) * 4;
            const float lgt = __builtin_bit_cast(float, __builtin_amdgcn_readlane(__builtin_bit_cast(int, t1), src));
            aff[e] = sigmoidf_(lgt); sel[e] = aff[e] + br[e]; }
        int bi1 = 0, bi2 = 0, bg = 0; float best = -INFINITY;
#pragma unroll
        for (int gq = 0; gq < 4; ++gq) { int i1, i2; float sm; top2of4(sel[gq * 4], sel[gq * 4 + 1], sel[gq * 4 + 2], sel[gq * 4 + 3], i1, i2, sm);
            if (sm > best) { best = sm; bg = gq; bi1 = i1; bi2 = i2; } }
        const int e1 = bg * 4 + bi1, e2 = bg * 4 + bi2;
        float a1 = 0.f, a2 = 0.f;
#pragma unroll
        for (int e = 0; e < 16; ++e) { a1 = (e == e1) ? aff[e] : a1; a2 = (e == e2) ? aff[e] : a2; }
        const float inv = 1.f / (a1 + a2);
        if (lane == 0 && commit) {
            const unsigned s1 = atomicAdd(lcnt + e1, 1u), s2 = atomicAdd(lcnt + e2, 1u);
            int* tp = tok + (size_t)row * 8;
            tp[0] = e1; tp[1] = e2; tp[2] = (int)s1; tp[3] = (int)s2; tp[4] = __float_as_int(a1 * inv); tp[5] = __float_as_int(a2 * inv);
        }
    }
    __syncthreads();
    if (tid < 16 && commit) blkcnt[(size_t)blockIdx.x * 16 + tid] = lcnt[tid];
    __syncthreads();
}

__device__ __forceinline__ void phase_gather(const Params& p, int l, float* lds) {
    const int tid = ltid(), lane = tid & 63, wv = tid >> 6;
    const unsigned* blkcnt = (const unsigned*)(p.ws + OFF_BLKCNT); unsigned* cnt = (unsigned*)(p.ws + OFF_CNT) + l * 16;
    int* sbase = (int*)lds;
    __syncthreads();
    if (tid < 16) { unsigned tot = 0, pre = 0;
        for (int b2 = 0; b2 < (int)gridDim.x; ++b2) { const unsigned v = blkcnt[(size_t)b2 * 16 + tid]; pre += (b2 < (int)blockIdx.x) ? v : 0u; tot += v; }
        sbase[16 + tid] = (int)tot; sbase[32 + tid] = (int)pre;
        if (blockIdx.x == 0) cnt[tid] = tot; }
    __syncthreads();
    if (tid < 16) { int s = 0; for (int e = 0; e < tid; ++e) s += ((sbase[16 + e] + 255) >> 8) * 256; sbase[tid] = s + sbase[32 + tid]; }
    __syncthreads();
    const bf16_t* h = (const bf16_t*)(p.ws + OFF_H); bf16_t* xa = (bf16_t*)(p.ws + OFF_XA); int* tok = (int*)(p.ws + OFF_TOK);
    const int rpb = (T + (int)gridDim.x - 1) / (int)gridDim.x, r_begin = (int)blockIdx.x * rpb, r_end = min(T, r_begin + rpb);
    for (int row = r_begin + wv; row < r_end; row += NTHR / 64) {
        int* tp = tok + (size_t)row * 8;
        const int p1 = sbase[tp[0]] + tp[2], p2 = sbase[tp[1]] + tp[3];
        const u32x4_t v0 = *(const u32x4_t*)(h + (size_t)row * 1024 + lane * 8), v1 = *(const u32x4_t*)(h + (size_t)row * 1024 + 512 + lane * 8);
        *(u32x4_t*)(xa + (size_t)p1 * 1024 + lane * 8) = v0; *(u32x4_t*)(xa + (size_t)p1 * 1024 + 512 + lane * 8) = v1;
        *(u32x4_t*)(xa + (size_t)p2 * 1024 + lane * 8) = v0; *(u32x4_t*)(xa + (size_t)p2 * 1024 + 512 + lane * 8) = v1;
        if (lane == 0) { tp[6] = p1; tp[7] = p2; }
    }
    __syncthreads();
}

__device__ __forceinline__ void phase_ln2(const Params& p, int l, bool commit = true) {
    const int lane = ltid() & 63, wv = ltid() >> 6, wpb = NTHR >> 6;
    float* xs = (float*)(p.ws + OFF_XS); bf16_t* h = (bf16_t*)(p.ws + OFF_H); const float* mod = (const float*)(p.ws + OFF_MOD);
    const int* tok = (const int*)(p.ws + OFF_TOK); const bf16_t* y = (const bf16_t*)(p.ws + OFF_Y);
    const float* g = p.in[I_LNG] + (size_t)(l * 2 + 1) * 1024; const float* bb = p.in[I_LNB] + (size_t)(l * 2 + 1) * 1024;
    for (int row = blockIdx.x * wpb + wv; row < T; row += gridDim.x * wpb) {
        const int slot = row_slot(row);
        const int* tp = tok + (size_t)row * 8;
        const float w0 = __int_as_float(tp[4]), w1 = __int_as_float(tp[5]); const size_t p0 = (size_t)tp[6], p1 = (size_t)tp[7];
        const float* mg = mod + ((size_t)(l * 9 + slot) * 6 + 5) * 1024;
        float v[16];
#pragma unroll
        for (int i = 0; i < 4; ++i) { const int c0 = i * 256 + lane * 4;
            const f32x4 x4 = *(const f32x4*)(xs + (size_t)row * 1024 + c0), g4 = *(const f32x4*)(mg + c0);
            const u32x2_t ya = *(const u32x2_t*)(y + p0 * 1024 + c0), yb = *(const u32x2_t*)(y + p1 * 1024 + c0);
            v[i * 4 + 0] = ALPHA * x4[0] + g4[0] * (w0 * bflo(ya[0]) + w1 * bflo(yb[0]));
            v[i * 4 + 1] = ALPHA * x4[1] + g4[1] * (w0 * bfhi(ya[0]) + w1 * bfhi(yb[0]));
            v[i * 4 + 2] = ALPHA * x4[2] + g4[2] * (w0 * bflo(ya[1]) + w1 * bflo(yb[1]));
            v[i * 4 + 3] = ALPHA * x4[3] + g4[3] * (w0 * bfhi(ya[1]) + w1 * bfhi(yb[1])); }
        ln_row(v, g, bb, lane);
        const int b = row / LB, t = row - b * LB;
        if (l == DEPTH - 1) {
            if (t >= LC) { float* op = p.out + ((size_t)b * LL + (t - LC)) * 1024;
#pragma unroll
                for (int i = 0; i < 4; ++i) { f32x4 x4; x4[0] = v[i * 4]; x4[1] = v[i * 4 + 1]; x4[2] = v[i * 4 + 2]; x4[3] = v[i * 4 + 3]; if (commit) *(f32x4*)(op + i * 256 + lane * 4) = x4; } }
        } else {
            const float* msh = mod + ((size_t)((l + 1) * 9 + slot) * 6 + 0) * 1024; const float* msc = msh + 1024;
#pragma unroll
            for (int i = 0; i < 4; ++i) { const int c0 = i * 256 + lane * 4;
                f32x4 x4; x4[0] = v[i * 4]; x4[1] = v[i * 4 + 1]; x4[2] = v[i * 4 + 2]; x4[3] = v[i * 4 + 3];
                if (commit) *(f32x4*)(xs + (size_t)row * 1024 + c0) = x4;
                const f32x4 sh = *(const f32x4*)(msh + c0), sc = *(const f32x4*)(msc + c0);
                const f32x4 hv = x4 * (sc + 1.0f) + sh;
                u32x2_t o; o[0] = pk2(hv[0], hv[1]); o[1] = pk2(hv[2], hv[3]);
                if (commit) *(u32x2_t*)(h + (size_t)row * 1024 + c0) = o; }
        }
    }
}

typedef float f32x16 __attribute__((ext_vector_type(16)));
typedef short bf16x8_t __attribute__((ext_vector_type(8)));
constexpr float LOG2E = 1.4426950408889634f;

__device__ __forceinline__ void vtrans_buf(const bf16_t* src, bf16_t* dst, bf16_t* lds) {
    const int tid = ltid();
    constexpr int LS = 72;
    for (int it = blockIdx.x; it < NB * 8 * (LB / 64); it += gridDim.x) {
        const int kt = it % (LB / 64), bc = it / (LB / 64), cg = bc & 7, b = bc >> 3;
        __syncthreads();
        { const int key = tid >> 3, d8 = (tid & 7) * 8;
          const u32x4_t v = *(const u32x4_t*)(src + ((size_t)b * LB + kt * 64 + key) * 512 + cg * 64 + d8);
#pragma unroll
          for (int j = 0; j < 4; ++j) { lds[(d8 + 2 * j) * LS + key] = (bf16_t)(v[j] & 0xffffu); lds[(d8 + 2 * j + 1) * LS + key] = (bf16_t)(v[j] >> 16); } }
        __syncthreads();
        { const int dv = tid >> 3, k8 = (tid & 7) * 8;
          const u32x4_t v = *(const u32x4_t*)(lds + dv * LS + k8);
          *(u32x4_t*)(dst + ((size_t)(b * 512 + cg * 64 + dv)) * LB + kt * 64 + k8) = v; }
    }
    __syncthreads();
}
__device__ __forceinline__ void phase_vtrans(const Params& p, int l, bf16_t* lds) {
    (void)lds;
    { float* bt = (float*)(p.ws + OFF_NBT); const float* rpb = p.in[I_RPB] + (size_t)l * 8 * 15 * 31;
      for (int i = blockIdx.x * NTHR + ltid(); i < 8 * 15 * 4 * 64 * 16; i += gridDim.x * NTHR) {
          const int r = i & 15, lane = (i >> 4) & 63, ib = (i >> 10) & 1, kb = (i >> 11) & 1, hd = i >> 12;
          const int kc = 32 * kb + (r & 3) + 8 * (r >> 2) + 4 * (lane >> 5), qc = 32 * ib + (lane & 31);
          const int cs = min(max(qc - 8, 0), 48);
          bt[i] = (kc >= cs && kc < cs + 16) ? rpb[hd * 31 + (kc - qc + 15)] : -1e30f; } }
}

constexpr int DA_KS = 272, DA_VS = 136, DA_KB = 64 * DA_KS  , DA_VB = 128 * DA_VS  ;
constexpr int DA_UNITS = NB * 4 * 34;
constexpr float DA_THR = 8.0f;
__device__ __forceinline__ void diff_attn_unit(const Params& p, int l, int unit, unsigned char* shm, bool commit = true) {
    const int tid = ltid(), lane = tid & 63, wid = tid >> 6, c = wid & 1, qb = wid >> 1, m32 = lane & 31, h = lane >> 5;
    int bh, qt;
    if (unit < NB * 4 * 32) { bh = (unit >> 8) * 8 + (unit & 7); qt = 2 + ((unit & 255) >> 3); } else { const int u2 = unit - NB * 4 * 32; bh = u2 >> 1; qt = u2 & 1; }
    const int hh = bh & 3, b = bh >> 2, nkt = qt < 2 ? LC / 64 : LB / 64;
    const size_t rowb = (size_t)b * LB;
    bf16_t* DQ = (bf16_t*)(p.ws + OFF_DQ); const bf16_t* DK = (const bf16_t*)(p.ws + OFF_DK); const bf16_t* VT = (const bf16_t*)(p.ws + OFF_VT);
    const size_t qrow = rowb + qt * 128 + qb * 32 + m32;
    bf16x8_t qf[4];
#pragma unroll
    for (int s = 0; s < 4; ++s) qf[s] = *(const bf16x8_t*)(DQ + qrow * 512 + hh * 128 + c * 64 + 16 * s + 8 * h);
    f32x16 O[4];
#pragma unroll
    for (int d = 0; d < 4; ++d)
#pragma unroll
        for (int r = 0; r < 16; ++r) O[d][r] = 0.f;
    float mrun = 0.f, lrun = 0.f;
    f32x16 minit;
#pragma unroll
    for (int r = 0; r < 16; ++r) minit[r] = 0.f;
    const bf16_t* kg[2]; const bf16_t* vg[2]; int kl[2], vl[2];
#pragma unroll
    for (int j = 0; j < 2; ++j) { const int i = tid + j * 512;
        kg[j] = DK + (rowb + (i >> 4)) * 512 + hh * 128 + (i & 15) * 8; kl[j] = (i >> 4) * DA_KS + (i & 15) * 16;
        vg[j] = VT + ((size_t)(bh * 128 + (i >> 3))) * LB + (i & 7) * 8; vl[j] = 2 * DA_KB + (i >> 3) * DA_VS + (i & 7) * 16; }
    u32x4_t rk[2], rv[2];
    __syncthreads();
#pragma unroll
    for (int j = 0; j < 2; ++j) { rk[j] = *(const u32x4_t*)(kg[j]); rv[j] = *(const u32x4_t*)(vg[j]); }
#pragma unroll
    for (int j = 0; j < 2; ++j) { *(u32x4_t*)(shm + kl[j]) = rk[j]; u32x2_t a, bq; a[0] = rv[j][0]; a[1] = rv[j][1]; bq[0] = rv[j][2]; bq[1] = rv[j][3];
        *(u32x2_t*)(shm + vl[j]) = a; *(u32x2_t*)(shm + vl[j] + 8) = bq; }
    __syncthreads();
    for (int kt = 0; kt < nkt; ++kt) {
        const int buf = kt & 1; const bool more = kt + 1 < nkt;
        if (more) {
#pragma unroll
            for (int j = 0; j < 2; ++j) { rk[j] = *(const u32x4_t*)(kg[j] + (size_t)(kt + 1) * 64 * 512); rv[j] = *(const u32x4_t*)(vg[j] + (kt + 1) * 64); }
        }
        const unsigned char* kbase = shm + buf * DA_KB + m32 * DA_KS + (c * 64 + 8 * h) * 2;
        const unsigned char* vbase = shm + 2 * DA_KB + buf * DA_VB + m32 * DA_VS + 8 * h;
        bf16x8_t kf[2][4]; u32x2_t vq[2][4][2];
#pragma unroll
        for (int kb = 0; kb < 2; ++kb)
#pragma unroll
            for (int s = 0; s < 4; ++s) kf[kb][s] = *(const bf16x8_t*)(kbase + kb * 32 * DA_KS + s * 32);
#pragma unroll
        for (int ks = 0; ks < 4; ++ks) { vq[0][ks][0] = *(const u32x2_t*)(vbase + ks * 32); vq[0][ks][1] = *(const u32x2_t*)(vbase + ks * 32 + 16); }
        __builtin_amdgcn_sched_barrier(0);
        bf16x8_t pf[4];
        {
            f32x16 S[2];
#pragma unroll
            for (int kb = 0; kb < 2; ++kb) {
                S[kb] = __builtin_amdgcn_mfma_f32_32x32x16_bf16(kf[kb][0], qf[0], minit, 0, 0, 0);
#pragma unroll
                for (int s = 1; s < 4; ++s) S[kb] = __builtin_amdgcn_mfma_f32_32x32x16_bf16(kf[kb][s], qf[s], S[kb], 0, 0, 0);
            }
            float mx = S[0][0];
#pragma unroll
            for (int r = 1; r < 16; ++r) mx = fmaxf(mx, S[0][r]);
#pragma unroll
            for (int r = 0; r < 16; ++r) mx = fmaxf(mx, S[1][r]);
            { auto rr = __builtin_amdgcn_permlane32_swap(__float_as_uint(mx), __float_as_uint(mx), false, false); mx = fmaxf(__uint_as_float(rr[0]), __uint_as_float(rr[1])); }
            float corr = 1.f;
            if (kt == 0 || !__all(mx <= DA_THR * LOG2E)) { const float dm = kt == 0 ? mx : fmaxf(mx, 0.f); corr = __builtin_amdgcn_exp2f(-dm); mrun += dm;
#pragma unroll
                for (int d = 0; d < 4; ++d)
#pragma unroll
                    for (int r = 0; r < 16; ++r) O[d][r] *= corr;
#pragma unroll
                for (int kb = 0; kb < 2; ++kb)
#pragma unroll
                    for (int r = 0; r < 16; ++r) S[kb][r] -= dm;
#pragma unroll
                for (int r = 0; r < 16; ++r) minit[r] = -mrun; }
            float sum = 0.f;
#pragma unroll
            for (int kb = 0; kb < 2; ++kb)
#pragma unroll
                for (int r = 0; r < 16; ++r) { const float e = __builtin_amdgcn_exp2f(S[kb][r]); S[kb][r] = e; sum += e; }
            { auto rr = __builtin_amdgcn_permlane32_swap(__float_as_uint(sum), __float_as_uint(sum), false, false); sum = __uint_as_float(rr[0]) + __uint_as_float(rr[1]); }
            lrun = lrun * corr + sum;
#pragma unroll
            for (int ks = 0; ks < 4; ++ks) { const int kb = ks >> 1, r0 = (ks & 1) * 8; u32x4_t pk;
#pragma unroll
                for (int j = 0; j < 4; ++j) pk[j] = pk2(S[kb][r0 + 2 * j], S[kb][r0 + 2 * j + 1]);
                pf[ks] = __builtin_bit_cast(bf16x8_t, pk); }
        }
#pragma unroll
        for (int d = 0; d < 4; ++d) {
            if (d < 3) {
#pragma unroll
                for (int ks = 0; ks < 4; ++ks) { vq[(d + 1) & 1][ks][0] = *(const u32x2_t*)(vbase + (d + 1) * 32 * DA_VS + ks * 32); vq[(d + 1) & 1][ks][1] = *(const u32x2_t*)(vbase + (d + 1) * 32 * DA_VS + ks * 32 + 16); }
            }
            __builtin_amdgcn_sched_barrier(0);
#pragma unroll
            for (int ks = 0; ks < 4; ++ks) { u32x4_t vv; vv[0] = vq[d & 1][ks][0][0]; vv[1] = vq[d & 1][ks][0][1]; vv[2] = vq[d & 1][ks][1][0]; vv[3] = vq[d & 1][ks][1][1];
                O[d] = __builtin_amdgcn_mfma_f32_32x32x16_bf16(__builtin_bit_cast(bf16x8_t, vv), pf[ks], O[d], 0, 0, 0); }
        }
        if (more) {
#pragma unroll
            for (int j = 0; j < 2; ++j) { *(u32x4_t*)(shm + (buf ^ 1) * DA_KB + kl[j]) = rk[j]; u32x2_t a, bq; a[0] = rv[j][0]; a[1] = rv[j][1]; bq[0] = rv[j][2]; bq[1] = rv[j][3];
                *(u32x2_t*)(shm + (buf ^ 1) * DA_VB + vl[j]) = a; *(u32x2_t*)(shm + (buf ^ 1) * DA_VB + vl[j] + 8) = bq; }
        }
        __syncthreads();
    }
    float* xch = (float*)shm;
    { const float inv = 1.f / lrun;
#pragma unroll
        for (int d = 0; d < 4; ++d)
#pragma unroll
            for (int r = 0; r < 16; ++r) O[d][r] *= inv; }
    if (c == 1) {
#pragma unroll
        for (int d = 0; d < 4; ++d)
#pragma unroll
            for (int r = 0; r < 16; ++r) xch[(((qb * 4 + d) * 16 + r) << 6) + lane] = O[d][r];
    }
    __syncthreads();
    if (c == 0) {
        float dq = 0.f, dk2 = 0.f; const float* lq = p.in[I_LQ] + l * 128; const float* lk = p.in[I_LK] + l * 128;
        for (int d = 0; d < 64; ++d) { dq += lq[d] * lk[d]; dk2 += lq[64 + d] * lk[64 + d]; }
        const float lam_init = 0.8f - 0.6f * expf(-0.3f * (float)l);
        const float lam = expf(dq) - expf(dk2) + lam_init;
        const float* g = p.in[I_DNG] + l * 128;
        float ss = 0.f;
#pragma unroll
        for (int d = 0; d < 4; ++d)
#pragma unroll
            for (int r = 0; r < 16; ++r) { const float v = O[d][r] - lam * xch[(((qb * 4 + d) * 16 + r) << 6) + lane]; O[d][r] = v; ss += v * v; }
        ss += __shfl_xor(ss, 32);
        const float sc = rsqrtf(ss * (1.0f / 128.0f) + RMS_EPS) * (1.0f - lam_init);
        bf16_t* op = DQ + qrow * 512 + hh * 128 + 4 * h;
#pragma unroll
        for (int d = 0; d < 4; ++d)
#pragma unroll
            for (int r4 = 0; r4 < 4; ++r4) { const int dv = 32 * d + 8 * r4; const f32x4 gv = *(const f32x4*)(g + dv + 4 * h);
                u32x2_t o; o[0] = pk2(O[d][4 * r4] * sc * gv[0], O[d][4 * r4 + 1] * sc * gv[1]); o[1] = pk2(O[d][4 * r4 + 2] * sc * gv[2], O[d][4 * r4 + 3] * sc * gv[3]);
                if (commit) *(u32x2_t*)(op + dv) = o; }
    }
    __syncthreads();
}

constexpr int NA_KS = 528, NA_VS = 136, NA_KB = 64 * NA_KS  , NA_VB = 256 * NA_VS  ;
constexpr int NA_UNITS = NB * 64 * 2 + NB * 4 * 2;
__device__ __forceinline__ void na_attn_unit(const Params& p, int l, int unit, unsigned char* shm, bool commit = true) {
    const int tid = ltid(), lane = tid & 63, wid = tid >> 6, hgi = wid & 3, ib = wid >> 2, m32 = lane & 31, h = lane >> 5;
    int b, hg, r, ntile; size_t rowq0;
    if (unit < NB * 64 * 2) { hg = unit & 1; r = (unit >> 1) & 63; b = unit >> 7; ntile = 12; rowq0 = (size_t)b * LB + LC + r * 64; }
    else { const int u2 = unit - NB * 64 * 2; hg = u2 & 1; r = -1; b = u2 >> 3; ntile = 4; rowq0 = (size_t)b * LB + ((u2 >> 1) & 3) * 64; }
    const int rs = min(max(r - 4, 0), 56), head = hg * 4 + hgi;
    const size_t rowb = (size_t)b * LB;
    bf16_t* NQ = (bf16_t*)(p.ws + OFF_NQ); const bf16_t* NK = (const bf16_t*)(p.ws + OFF_NK); const bf16_t* NVT = (const bf16_t*)(p.ws + OFF_NVT);
    const float* BT = (const float*)(p.ws + OFF_NBT);
    const size_t qrow = rowq0 + ib * 32 + m32;
    bf16x8_t qf[4];
#pragma unroll
    for (int s = 0; s < 4; ++s) qf[s] = *(const bf16x8_t*)(NQ + qrow * 512 + head * 64 + 16 * s + 8 * h);
    f32x16 O[2];
#pragma unroll
    for (int d = 0; d < 2; ++d)
#pragma unroll
        for (int q = 0; q < 16; ++q) O[d][q] = 0.f;
    float mrun = -INFINITY, lrun = 0.f;
    const bf16_t* kg[4]; const bf16_t* vg[4]; int kl[4], vl[4];
#pragma unroll
    for (int j = 0; j < 4; ++j) { const int i = tid + j * 512;
        kg[j] = NK + (rowb + (i >> 5)) * 512 + hg * 256 + (i & 31) * 8; kl[j] = (i >> 5) * NA_KS + (i & 31) * 16;
        vg[j] = NVT + ((size_t)(b * 512 + hg * 256 + (i >> 3))) * LB + (i & 7) * 8; vl[j] = 2 * NA_KB + (i >> 3) * NA_VS + (i & 7) * 16; }
    auto tile_of = [&](int t) -> int { return ntile == 12 ? (t < 8 ? 4 + rs + t : t - 8) : t; };
    u32x4_t rk[4], rv[4];
    __syncthreads();
    { const int tt = tile_of(0);
#pragma unroll
      for (int j = 0; j < 4; ++j) { rk[j] = *(const u32x4_t*)(kg[j] + (size_t)tt * 64 * 512); rv[j] = *(const u32x4_t*)(vg[j] + tt * 64); } }
#pragma unroll
    for (int j = 0; j < 4; ++j) { *(u32x4_t*)(shm + kl[j]) = rk[j]; u32x2_t a, bq; a[0] = rv[j][0]; a[1] = rv[j][1]; bq[0] = rv[j][2]; bq[1] = rv[j][3];
        *(u32x2_t*)(shm + vl[j]) = a; *(u32x2_t*)(shm + vl[j] + 8) = bq; }
    __syncthreads();
    for (int t = 0; t < ntile; ++t) {
        const int buf = t & 1; const bool more = t + 1 < ntile;
        if (more) { const int tt = tile_of(t + 1);
#pragma unroll
            for (int j = 0; j < 4; ++j) { rk[j] = *(const u32x4_t*)(kg[j] + (size_t)tt * 64 * 512); rv[j] = *(const u32x4_t*)(vg[j] + tt * 64); }
        }
        const unsigned char* kbase = shm + buf * NA_KB + m32 * NA_KS + (hgi * 64 + 8 * h) * 2;
        const unsigned char* vbase = shm + 2 * NA_KB + buf * NA_VB + (hgi * 64 + m32) * NA_VS + 8 * h;
        bf16x8_t pf[4];
        {
            bf16x8_t kf[2][4];
#pragma unroll
            for (int kb = 0; kb < 2; ++kb)
#pragma unroll
                for (int s = 0; s < 4; ++s) kf[kb][s] = *(const bf16x8_t*)(kbase + kb * 32 * NA_KS + s * 32);
            f32x16 S[2];
            const bool local = (ntile == 12) && (t < 8);
            if (local) { const int dr = rs + t - r + 7; const float* bp = BT + ((size_t)(((head * 15 + dr) * 2) * 2 + ib) * 64 + lane) * 16;
#pragma unroll
                for (int kb = 0; kb < 2; ++kb)
#pragma unroll
                    for (int q4 = 0; q4 < 4; ++q4) { const f32x4 bv = *(const f32x4*)(bp + kb * 2 * 64 * 16 + q4 * 4);
                        S[kb][q4 * 4] = bv[0]; S[kb][q4 * 4 + 1] = bv[1]; S[kb][q4 * 4 + 2] = bv[2]; S[kb][q4 * 4 + 3] = bv[3]; }
            } else {
#pragma unroll
                for (int kb = 0; kb < 2; ++kb)
#pragma unroll
                    for (int q = 0; q < 16; ++q) S[kb][q] = 0.f;
            }
#pragma unroll
            for (int kb = 0; kb < 2; ++kb)
#pragma unroll
                for (int s = 0; s < 4; ++s) S[kb] = __builtin_amdgcn_mfma_f32_32x32x16_bf16(kf[kb][s], qf[s], S[kb], 0, 0, 0);
            float mx = S[0][0];
#pragma unroll
            for (int q = 1; q < 16; ++q) mx = fmaxf(mx, S[0][q]);
#pragma unroll
            for (int q = 0; q < 16; ++q) mx = fmaxf(mx, S[1][q]);
            { auto rr = __builtin_amdgcn_permlane32_swap(__float_as_uint(mx), __float_as_uint(mx), false, false); mx = fmaxf(__uint_as_float(rr[0]), __uint_as_float(rr[1])); }
            float corr = 1.f;
            if (!__all(mx - mrun <= DA_THR)) { const float mn = fmaxf(mrun, mx); corr = __builtin_amdgcn_exp2f((mrun - mn) * LOG2E); mrun = mn;
#pragma unroll
                for (int d = 0; d < 2; ++d)
#pragma unroll
                    for (int q = 0; q < 16; ++q) O[d][q] *= corr; }
            const float mnl = mrun * LOG2E;
            float sum = 0.f;
#pragma unroll
            for (int kb = 0; kb < 2; ++kb)
#pragma unroll
                for (int q = 0; q < 16; ++q) { const float e = __builtin_amdgcn_exp2f(S[kb][q] * LOG2E - mnl); S[kb][q] = e; sum += e; }
            { auto rr = __builtin_amdgcn_permlane32_swap(__float_as_uint(sum), __float_as_uint(sum), false, false); sum = __uint_as_float(rr[0]) + __uint_as_float(rr[1]); }
            lrun = lrun * corr + sum;
#pragma unroll
            for (int ks = 0; ks < 4; ++ks) { const int kb = ks >> 1, r0 = (ks & 1) * 8; u32x4_t pk;
#pragma unroll
                for (int j = 0; j < 4; ++j) pk[j] = pk2(S[kb][r0 + 2 * j], S[kb][r0 + 2 * j + 1]);
                pf[ks] = __builtin_bit_cast(bf16x8_t, pk); }
        }
        { u32x2_t vq[2][4][2];
#pragma unroll
          for (int d = 0; d < 2; ++d)
#pragma unroll
              for (int ks = 0; ks < 4; ++ks) { vq[d][ks][0] = *(const u32x2_t*)(vbase + d * 32 * NA_VS + ks * 32); vq[d][ks][1] = *(const u32x2_t*)(vbase + d * 32 * NA_VS + ks * 32 + 16); }
          __builtin_amdgcn_sched_barrier(0);
#pragma unroll
          for (int d = 0; d < 2; ++d)
#pragma unroll
              for (int ks = 0; ks < 4; ++ks) { u32x4_t vv; vv[0] = vq[d][ks][0][0]; vv[1] = vq[d][ks][0][1]; vv[2] = vq[d][ks][1][0]; vv[3] = vq[d][ks][1][1];
                  O[d] = __builtin_amdgcn_mfma_f32_32x32x16_bf16(__builtin_bit_cast(bf16x8_t, vv), pf[ks], O[d], 0, 0, 0); } }
        if (more) {
#pragma unroll
            for (int j = 0; j < 4; ++j) { *(u32x4_t*)(shm + (buf ^ 1) * NA_KB + kl[j]) = rk[j]; u32x2_t a, bq; a[0] = rv[j][0]; a[1] = rv[j][1]; bq[0] = rv[j][2]; bq[1] = rv[j][3];
                *(u32x2_t*)(shm + (buf ^ 1) * NA_VB + vl[j]) = a; *(u32x2_t*)(shm + (buf ^ 1) * NA_VB + vl[j] + 8) = bq; }
        }
        __syncthreads();
    }
    { const float inv = 1.f / lrun; bf16_t* op = NQ + qrow * 512 + head * 64 + 4 * h;
#pragma unroll
        for (int d = 0; d < 2; ++d)
#pragma unroll
            for (int r4 = 0; r4 < 4; ++r4) { u32x2_t o; o[0] = pk2(O[d][4 * r4] * inv, O[d][4 * r4 + 1] * inv); o[1] = pk2(O[d][4 * r4 + 2] * inv, O[d][4 * r4 + 3] * inv);
                if (commit) *(u32x2_t*)(op + 32 * d + 8 * r4) = o; } }
    __syncthreads();
}

constexpr int GL_XS = 144;
__device__ __forceinline__ void gla_stage_gr(const Params& p, int row0, float* grs, int tid) {
    const float* gr = (const float*)(p.ws + OFF_GR);
    __syncthreads();
    *(f32x4*)(grs + tid * 4) = *(const f32x4*)(gr + (size_t)row0 * 32 + tid * 4);
    __syncthreads();
}
struct GlaCol { float w[16]; float bcol; };
__device__ __forceinline__ void gla_col_init(const Params& p, int l, int hh, int dir, int lane, GlaCol& gc) {
    const int col = hh * 64 + lane;
    const float* wd = p.in[I_GWD] + ((size_t)(l * 2 + dir) * 16) * 256 + col;
#pragma unroll
    for (int i = 0; i < 16; ++i) gc.w[i] = wd[i * 256];
    gc.bcol = p.in[I_GBD][(size_t)(l * 2 + dir) * 256 + col];
}
__device__ __forceinline__ float gla_logd(const GlaCol& gc, const float* grs, int r, int dir) {
    const float* gp = grs + r * 32 + dir * 16;
    float z = gc.bcol;
#pragma unroll
    for (int i4 = 0; i4 < 4; ++i4) { const f32x4 g4 = *(const f32x4*)(gp + i4 * 4);
        z += g4[0] * gc.w[i4 * 4] + g4[1] * gc.w[i4 * 4 + 1] + g4[2] * gc.w[i4 * 4 + 2] + g4[3] * gc.w[i4 * 4 + 3]; }
    return (fminf(z, 0.f) - __logf(1.f + __expf(-fabsf(z)))) * (1.0f / 16.0f);
}
__device__ __forceinline__ float gla_total(const GlaCol& gc, const float* grs, int dir) {
    float run = 0.f;
#pragma unroll 4
    for (int r = 0; r < 64; ++r) run += gla_logd(gc, grs, r, dir);
    return run;
}

__device__ __forceinline__ void gla_a_unit(const Params& p, int l, int unit, unsigned char* shm) {
    const int tid = ltid(), lane = tid & 63, wid = tid >> 6, hh = wid >> 1, dir = wid & 1, m32 = lane & 31, h = lane >> 5;
    const int b = unit / 68, n = unit - b * 68; const int row0 = b * LB + n * 64; const int bhd = (b * 4 + hh) * 2 + dir;
    float* grs = (float*)shm; unsigned char* kt = shm + 8192 + wid * 18432;
    unsigned char* kraw = kt + 9216;
    gla_stage_gr(p, row0, grs, tid);
    {
        const bf16_t* gk = (const bf16_t*)(p.ws + OFF_GK) + (size_t)row0 * 256 + hh * 64;
        u32x4_t t8[8];
#pragma unroll
        for (int i = 0; i < 8; ++i) t8[i] = *(const u32x4_t*)(gk + (size_t)(8 * i + (lane >> 3)) * 256 + (lane & 7) * 8);
#pragma unroll
        for (int i = 0; i < 8; ++i) *(u32x4_t*)(kraw + (8 * i + (lane >> 3)) * GL_XS + (lane & 7) * 16) = t8[i];
    }
    {
        GlaCol gc; gla_col_init(p, l, hh, dir, lane, gc);
        const float last = gla_total(gc, grs, dir);
        ((float*)(p.ws + OFF_DECAY))[((size_t)bhd * 68 + n) * 64 + lane] = __expf(last);
        asm volatile("s_waitcnt lgkmcnt(0)" ::: "memory"); __builtin_amdgcn_wave_barrier();
        float run = 0.f;
#pragma unroll 4
        for (int r = 0; r < 64; ++r) { const float ex = run; run += gla_logd(gc, grs, r, dir);
            const float c = dir ? last - ex : run;
            *(bf16_t*)(kt + lane * GL_XS + r * 2) = f2bf(bf2f(*(const bf16_t*)(kraw + r * GL_XS + lane * 2)) * __expf(last - c)); }
    }
    asm volatile("s_waitcnt lgkmcnt(0)" ::: "memory"); __builtin_amdgcn_wave_barrier();
    f32x16 acc[2][4];
#pragma unroll
    for (int mb = 0; mb < 2; ++mb)
#pragma unroll
        for (int nb = 0; nb < 4; ++nb)
#pragma unroll
            for (int r = 0; r < 16; ++r) acc[mb][nb][r] = 0.f;
    const bf16_t* gvt = (const bf16_t*)(p.ws + OFF_GVT) + ((size_t)(b * 512 + hh * 128 + m32)) * LB + n * 64 + 8 * h;
#pragma unroll
    for (int s = 0; s < 4; ++s) {
        bf16x8_t af[2], bfr[4];
#pragma unroll
        for (int mb = 0; mb < 2; ++mb) af[mb] = *(const bf16x8_t*)(kt + (32 * mb + m32) * GL_XS + (16 * s + 8 * h) * 2);
#pragma unroll
        for (int nb = 0; nb < 4; ++nb) bfr[nb] = *(const bf16x8_t*)(gvt + (size_t)(32 * nb) * LB + 16 * s);
#pragma unroll
        for (int mb = 0; mb < 2; ++mb)
#pragma unroll
            for (int nb = 0; nb < 4; ++nb) acc[mb][nb] = __builtin_amdgcn_mfma_f32_32x32x16_bf16(af[mb], bfr[nb], acc[mb][nb], 0, 0, 0);
    }
    bf16_t* kv = (bf16_t*)(p.ws + OFF_KV) + (((size_t)bhd * 68 + n) * 128 + m32) * 64 + 4 * h;
#pragma unroll
    for (int mb = 0; mb < 2; ++mb)
#pragma unroll
        for (int nb = 0; nb < 4; ++nb)
#pragma unroll
            for (int r4 = 0; r4 < 4; ++r4) { u32x2_t o; o[0] = pk2(acc[mb][nb][4 * r4], acc[mb][nb][4 * r4 + 1]); o[1] = pk2(acc[mb][nb][4 * r4 + 2], acc[mb][nb][4 * r4 + 3]);
                *(u32x2_t*)(kv + (size_t)(32 * nb) * 64 + 32 * mb + 8 * r4) = o; }
}

__device__ __forceinline__ void gla_scan(const Params& p, bool commit = true) {
    bf16_t* kv = (bf16_t*)(p.ws + OFF_KV); const float* dec = (const float*)(p.ws + OFF_DECAY);
    for (int gid = blockIdx.x * NTHR + ltid(); gid < 64 * 128 * 16; gid += gridDim.x * NTHR) {
        const int dk4 = gid & 15, dv = (gid >> 4) & 127, bhd = gid >> 11, dir = bhd & 1;
        f32x4 s = {0.f, 0.f, 0.f, 0.f};
        for (int step = 0; step < 68; ++step) {
            const int ch = dir == 0 ? step : (step < 4 ? 3 - step : 71 - step);
            u32x2_t* ptr = (u32x2_t*)(kv + (((size_t)bhd * 68 + ch) * 128 + dv) * 64 + dk4 * 4);
            const u32x2_t kvv = *ptr; const f32x4 d4 = *(const f32x4*)(dec + ((size_t)bhd * 68 + ch) * 64 + dk4 * 4);
            u32x2_t o; o[0] = pk2(s[0], s[1]); o[1] = pk2(s[2], s[3]); if (commit) *ptr = o;
            s[0] = d4[0] * s[0] + bflo(kvv[0]); s[1] = d4[1] * s[1] + bfhi(kvv[0]); s[2] = d4[2] * s[2] + bflo(kvv[1]); s[3] = d4[3] * s[3] + bfhi(kvv[1]);
        }
    }
}

__device__ __forceinline__ void gla_c_unit(const Params& p, int l, int unit, unsigned char* shm, bool commit = true) {
    const int tid = ltid(), lane = tid & 63, wid = tid >> 6, hh = wid >> 1, dir = wid & 1, m32 = lane & 31, h = lane >> 5;
    const int b = unit / 68, n = unit - b * 68; const int row0 = b * LB + n * 64; const int bhd = (b * 4 + hh) * 2 + dir;
    float* grs = (float*)shm; unsigned char* xq = shm + 8192 + wid * 18432; unsigned char* yk = xq + 9216;
    gla_stage_gr(p, row0, grs, tid);
    {
        GlaCol gc; gla_col_init(p, l, hh, dir, lane, gc);
        {
            const bf16_t* gq = (const bf16_t*)(p.ws + OFF_GQ) + (size_t)row0 * 256 + hh * 64;
            const bf16_t* gk = (const bf16_t*)(p.ws + OFF_GK) + (size_t)row0 * 256 + hh * 64;
            u32x4_t tq[8], tk[8];
#pragma unroll
            for (int i = 0; i < 8; ++i) { tq[i] = *(const u32x4_t*)(gq + (size_t)(8 * i + (lane >> 3)) * 256 + (lane & 7) * 8); tk[i] = *(const u32x4_t*)(gk + (size_t)(8 * i + (lane >> 3)) * 256 + (lane & 7) * 8); }
#pragma unroll
            for (int i = 0; i < 8; ++i) { *(u32x4_t*)(xq + (8 * i + (lane >> 3)) * GL_XS + (lane & 7) * 16) = tq[i]; *(u32x4_t*)(yk + (8 * i + (lane >> 3)) * GL_XS + (lane & 7) * 16) = tk[i]; }
        }
        const float last = gla_total(gc, grs, dir);
        asm volatile("s_waitcnt lgkmcnt(0)" ::: "memory"); __builtin_amdgcn_wave_barrier();
        float run = 0.f;
#pragma unroll 4
        for (int r = 0; r < 64; ++r) { const float ex = run; run += gla_logd(gc, grs, r, dir);
            const float c = dir ? last - ex : run;
            bf16_t* xp = (bf16_t*)(xq + r * GL_XS + lane * 2); bf16_t* yp = (bf16_t*)(yk + r * GL_XS + lane * 2);
            *xp = f2bf(bf2f(*xp) * __expf(c)); *yp = f2bf(bf2f(*yp) * __expf(-c)); }
    }
    asm volatile("s_waitcnt lgkmcnt(0)" ::: "memory"); __builtin_amdgcn_wave_barrier();
    const unsigned char* xrd = xq + m32 * GL_XS + 16 * h;
    f32x16 O[4][2];
#pragma unroll
    for (int d = 0; d < 4; ++d)
#pragma unroll
        for (int ib = 0; ib < 2; ++ib)
#pragma unroll
            for (int r = 0; r < 16; ++r) O[d][ib][r] = 0.f;
    { const bf16_t* sp = (const bf16_t*)(p.ws + OFF_KV) + (((size_t)bhd * 68 + n) * 128 + m32) * 64 + 8 * h;
#pragma unroll
      for (int s = 0; s < 4; ++s) {
          asm volatile("" ::: "memory");
          bf16x8_t sf[4];
#pragma unroll
          for (int d = 0; d < 4; ++d) sf[d] = *(const bf16x8_t*)(sp + (size_t)(32 * d) * 64 + 16 * s);
#pragma unroll
          for (int ib = 0; ib < 2; ++ib) { const bf16x8_t xf = *(const bf16x8_t*)(xrd + 32 * ib * GL_XS + 32 * s);
#pragma unroll
              for (int d = 0; d < 4; ++d) O[d][ib] = __builtin_amdgcn_mfma_f32_32x32x16_bf16(sf[d], xf, O[d][ib], 0, 0, 0); } } }
    const bf16_t* gvt = (const bf16_t*)(p.ws + OFF_GVT) + ((size_t)(b * 512 + hh * 128 + m32)) * LB + n * 64 + 4 * h;
#pragma unroll
    for (int jb = 0; jb < 2; ++jb)
#pragma unroll
        for (int ib = 0; ib < 2; ++ib) {
            if (jb != ib && ((jb > ib) != (dir == 1))) continue;
            f32x16 A;
#pragma unroll
            for (int r = 0; r < 16; ++r) A[r] = 0.f;
#pragma unroll
            for (int s = 0; s < 4; ++s) { const bf16x8_t kf = *(const bf16x8_t*)(yk + (32 * jb + m32) * GL_XS + (16 * s + 8 * h) * 2);
                const bf16x8_t xf = *(const bf16x8_t*)(xrd + 32 * ib * GL_XS + 32 * s);
                A = __builtin_amdgcn_mfma_f32_32x32x16_bf16(kf, xf, A, 0, 0, 0); }
            if (jb == ib) {
#pragma unroll
                for (int r = 0; r < 16; ++r) { const int jj = (r & 3) + 8 * (r >> 2) + 4 * h; const bool keep = dir ? (jj >= m32) : (jj <= m32); A[r] = keep ? A[r] : 0.f; }
            }
#pragma unroll
            for (int s2 = 0; s2 < 2; ++s2) { asm volatile("" ::: "memory"); u32x4_t pk;
#pragma unroll
                for (int j = 0; j < 4; ++j) pk[j] = pk2(A[s2 * 8 + 2 * j], A[s2 * 8 + 2 * j + 1]);
                const bf16x8_t pf = __builtin_bit_cast(bf16x8_t, pk);
#pragma unroll
                for (int d = 0; d < 4; ++d) { const bf16_t* vp = gvt + (size_t)(32 * d) * LB + 32 * jb + 16 * s2;
                    const u32x2_t v0 = *(const u32x2_t*)vp, v1 = *(const u32x2_t*)(vp + 8);
                    u32x4_t vv; vv[0] = v0[0]; vv[1] = v0[1]; vv[2] = v1[0]; vv[3] = v1[1];
                    O[d][ib] = __builtin_amdgcn_mfma_f32_32x32x16_bf16(__builtin_bit_cast(bf16x8_t, vv), pf, O[d][ib], 0, 0, 0); } }
        }
    __syncthreads();
    float* xch = (float*)(shm + 8192);
    if (dir == 1) {
#pragma unroll
        for (int d = 0; d < 4; ++d)
#pragma unroll
            for (int ib = 0; ib < 2; ++ib)
#pragma unroll
                for (int r = 0; r < 16; ++r) xch[((((hh * 4 + d) * 2 + ib) * 16 + r) << 6) + lane] = O[d][ib][r];
    }
    __syncthreads();
    if (dir == 0) {
        const float* gn = p.in[I_GNG] + l * 128;
        bf16_t* gg = (bf16_t*)(p.ws + OFF_GG);
#pragma unroll
        for (int ib = 0; ib < 2; ++ib) {
            float ss = 0.f;
#pragma unroll
            for (int d = 0; d < 4; ++d) {
                asm volatile("" ::: "memory");
#pragma unroll
                for (int r = 0; r < 16; ++r) { const float v = O[d][ib][r] + xch[((((hh * 4 + d) * 2 + ib) * 16 + r) << 6) + lane]; O[d][ib][r] = v; ss += v * v; } }
            ss += __shfl_xor(ss, 32);
            const float sc = rsqrtf(ss * (1.0f / 128.0f) + RMS_EPS);
            bf16_t* op = gg + (size_t)(row0 + 32 * ib + m32) * 512 + hh * 128 + 4 * h;
#pragma unroll
            for (int d = 0; d < 4; ++d)
#pragma unroll
                for (int r4 = 0; r4 < 4; ++r4) { asm volatile("" ::: "memory"); const int dv = 32 * d + 8 * r4; const f32x4 gv = *(const f32x4*)(gn + dv + 4 * h);
                    const u32x2_t gt = *(const u32x2_t*)(op + dv);
                    u32x2_t o; o[0] = pk2(O[d][ib][4 * r4] * sc * gv[0] * siluf_(bflo(gt[0])), O[d][ib][4 * r4 + 1] * sc * gv[1] * siluf_(bfhi(gt[0])));
                    o[1] = pk2(O[d][ib][4 * r4 + 2] * sc * gv[2] * siluf_(bflo(gt[1])), O[d][ib][4 * r4 + 3] * sc * gv[3] * siluf_(bfhi(gt[1])));
                    if (commit) *(u32x2_t*)(op + dv) = o; }
        }
    }
    __syncthreads();
}

enum { PH_MOD = 0, PH_INIT, PH_CONVERT, PH_INPROJ, PH_ROPEDEC, PH_MIX_GLA, PH_MIX_DIFF, PH_MIX_NA, PH_VTRANS, PH_DIFF, PH_NA, PH_GLA_A, PH_GLA_SCAN, PH_GLA_C, PH_GATES, PH_MERGE, PH_WO, PH_LN1, PH_GATHER, PH_UP, PH_DOWN, PH_LN2, PH_COUNT };

template <class Epi, class Sched>
__device__ __forceinline__ void run_gemm(PG8_LAS unsigned char* lds, const void* A, const void* Bt, int K, const Sched& S, const Epi& E) {
    pg8::Gemm g; g.A = (const pg8::bf16_t*)A; g.Bt = (const pg8::bf16_t*)Bt; g.M = 0; g.N = 0; g.K = K;
    pg8::gemm_phase<Epi, Sched, false>(lds, g, S, E, nullptr);
}

#ifndef PHASE_INLINE
#define PHASE_INLINE __forceinline__
#endif
template <int PH>
__device__ PHASE_INLINE void run_phase(const Params& p0, int l, unsigned char* shm, bool force_dry = false) {
    Params p;
#if defined(__HIP_DEVICE_COMPILE__)
    (void)p0;
    { const __attribute__((address_space(4))) Params* kp = (const __attribute__((address_space(4))) Params*)__builtin_amdgcn_kernarg_segment_ptr();
      asm volatile("" : "+s"(kp));
#pragma unroll
      for (int i = 0; i < 23; ++i) p.in[i] = (const float*)(const __attribute__((address_space(1))) float*)kp->in[i];
      p.out = (float*)(__attribute__((address_space(1))) float*)kp->out; p.ws = (char*)(__attribute__((address_space(1))) char*)kp->ws; }
#else
    p = p0;
#endif
#ifdef SKIP_MASK
    if constexpr ((SKIP_MASK >> PH) & 1) return;
#endif
#ifdef PROBE_MASK
    constexpr int probe_reps = ((PROBE_MASK >> PH) & 1) ? 2 : 1;
#else
    constexpr int probe_reps = 1;
#endif
#pragma unroll 1
    for (int probe_rep = 0; probe_rep < probe_reps; ++probe_rep) {
    PG8_LAS unsigned char* lds = (PG8_LAS unsigned char*)shm;
    float* ldsf = (float*)shm;
    const int G = gridDim.x, c = blockIdx.x;
    bool commit = true;
    if (force_dry) commit = (*(volatile const unsigned*)(p.ws + OFF_CNT + 2048) != 0u);
    if (probe_reps > 1 && probe_rep == 0) commit = (*(volatile const unsigned*)(p.ws + OFF_CNT + 2048) != 0u);
    if constexpr (PH == PH_MOD) phase_mod(p, ldsf);
    else if constexpr (PH == PH_INIT) phase_init(p);
    else if constexpr (PH == PH_CONVERT) phase_convert(p, l, ldsf);
    else if constexpr (PH == PH_INPROJ) { SchedGrid S{NPANEL, 19, 0, G, c}; EpiInProj E{p.ws}; run_gemm(lds, p.ws + OFF_H, p.ws + OFF_WIN, 1024, S, E); }
    else if constexpr (PH == PH_ROPEDEC) phase_rope_decay(p, l, commit);
    else if constexpr (PH == PH_MIX_GLA) { for (int u = blockIdx.x; u < NB; u += gridDim.x) gla_naive_batch(p, l, u, ldsf); }
    else if constexpr (PH == PH_MIX_DIFF) { for (int u = blockIdx.x; u < NB * 4 * 34; u += gridDim.x) diff_naive_tile(p, l, u, ldsf); }
    else if constexpr (PH == PH_MIX_NA) { for (int u = blockIdx.x; u < T / 64; u += gridDim.x) na_naive_unit(p, l, u); }
    else if constexpr (PH == PH_VTRANS) phase_vtrans(p, l, (bf16_t*)shm);
    else if constexpr (PH == PH_DIFF) { for (int u = blockIdx.x; u < DA_UNITS; u += gridDim.x) diff_attn_unit(p, l, u, shm, commit); }
    else if constexpr (PH == PH_NA) { for (int u = blockIdx.x; u < NA_UNITS; u += gridDim.x) na_attn_unit(p, l, u, shm, commit); }
#if FAST_GLA
    else if constexpr (PH == PH_GLA_A) { for (int u = blockIdx.x; u < NB * 68; u += gridDim.x) gla_a_unit(p, l, u, shm); }
    else if constexpr (PH == PH_GLA_SCAN) gla_scan(p, commit);
    else if constexpr (PH == PH_GLA_C) { for (int u = blockIdx.x; u < NB * 68; u += gridDim.x) gla_c_unit(p, l, u, shm, commit); }
#endif
    else if constexpr (PH == PH_GATES) { SchedGrid S{NPANEL, 12, 19, G, c}; EpiGates E{p.ws}; run_gemm(lds, p.ws + OFF_H, p.ws + OFF_WIN, 1024, S, E); }
    else if constexpr (PH == PH_MERGE) { SchedMerge S{G, c}; EpiMerge E{p.ws}; run_gemm(lds, p.ws + OFF_BR, p.ws + OFF_WB, 512, S, E); }
    else if constexpr (PH == PH_WO) { SchedGrid S{NPANEL, 4, 0, G, c}; EpiWo E{p.ws, l, commit}; run_gemm(lds, p.ws + OFF_H, p.ws + OFF_WO, 1024, S, E); }
    else if constexpr (PH == PH_LN1) phase_ln1_router(p, l, ldsf, commit);
    else if constexpr (PH == PH_GATHER) phase_gather(p, l, ldsf);
    else if constexpr (PH == PH_UP) { SchedMoe S; S.init((const unsigned*)(p.ws + OFF_CNT) + l * 16, G, c); EpiUp E{p.ws}; run_gemm(lds, p.ws + OFF_XA, p.ws + OFF_WUP, 1024, S, E); }
    else if constexpr (PH == PH_DOWN) { SchedMoe S; S.init((const unsigned*)(p.ws + OFF_CNT) + l * 16, G, c); EpiDown E{p.ws}; run_gemm(lds, p.ws + OFF_ACT, p.ws + OFF_WDN, 512, S, E); }
    else if constexpr (PH == PH_LN2) phase_ln2(p, l, commit);
    }
}

#ifdef PROBE_SLOT
#ifndef PROBE_MULT
#define PROBE_MULT 5
#endif
#define XBAR(b, slot) do { xcd_barrier(b); if (blockIdx.x == 0 && threadIdx.x == 0) { volatile LAS unsigned long long* tw = (volatile LAS unsigned long long*)(shm + LDS_XBW + 16); \
    const unsigned long long now_ = wall_clock64(); if ((slot) == PROBE_SLOT) tw[1] += now_ - tw[0]; tw[0] = now_; } } while (0)
#else
#define XBAR(b, slot) xcd_barrier(b)
#endif
#if !MEGA
template <int PH>
__global__ void __launch_bounds__(512, 2) k_phase(Params p, int l) {
    extern __shared__ __attribute__((aligned(16))) unsigned char shm[];
    run_phase<PH>(p, l, shm);
}
template <int PH> static void launch_phase(const Params& p, int l, hipStream_t st) {
    static bool attr = false;
    if (!attr) { (void)hipFuncSetAttribute((const void*)k_phase<PH>, hipFuncAttributeMaxDynamicSharedMemorySize, LDS_BYTES); attr = true; }
    hipLaunchKernelGGL((k_phase<PH>), dim3(256), dim3(NTHR), LDS_BYTES, st, p, l);
}
#else
__global__ void __launch_bounds__(512, 2) k_mega(Params p) {
    extern __shared__ __attribute__((aligned(16))) unsigned char shm[];
    volatile LAS unsigned* xbw = (volatile LAS unsigned*)(shm + LDS_XBW);
    if (threadIdx.x == 0) { xbw[0] = 0u; xbw[1] = 0u; xbw[2] = 0u; xbw[3] = 0u; }
    __syncthreads();
    XcdBarrier bar = xcd_barrier_post((unsigned*)(p.ws + OFF_BAR), xbw);
#ifdef PROBE_SLOT
    if (blockIdx.x == 0 && threadIdx.x == 0) { volatile LAS unsigned long long* tw = (volatile LAS unsigned long long*)(shm + LDS_XBW + 16); tw[0] = wall_clock64(); tw[1] = 0ull; }
#endif
    run_phase<PH_MOD>(p, 0, shm);
    run_phase<PH_CONVERT>(p, 0, shm);
    XBAR(bar, 0);
    run_phase<PH_INIT>(p, 0, shm);
    XBAR(bar, 1);
    for (int l = 0; l < DEPTH; ++l) {
        if (l > 0) { run_phase<PH_CONVERT>(p, l, shm); XBAR(bar, 2); }
        run_phase<PH_INPROJ>(p, l, shm); XBAR(bar, 3);
        run_phase<PH_ROPEDEC>(p, l, shm); run_phase<PH_VTRANS>(p, l, shm); XBAR(bar, 4);
#if FAST_GLA
        run_phase<PH_GLA_A>(p, l, shm); XBAR(bar, 5);
        run_phase<PH_GLA_SCAN>(p, l, shm);
#else
        run_phase<PH_MIX_GLA>(p, l, shm);
#endif
#if FAST_DIFF
        run_phase<PH_DIFF>(p, l, shm);
#else
        run_phase<PH_MIX_DIFF>(p, l, shm);
#endif
#if FAST_NA
        run_phase<PH_NA>(p, l, shm);
#else
        run_phase<PH_MIX_NA>(p, l, shm);
#endif
        XBAR(bar, 6);
#if FAST_GLA
        run_phase<PH_GLA_C>(p, l, shm); XBAR(bar, 7);
#endif
        run_phase<PH_GATES>(p, l, shm); XBAR(bar, 8);
        run_phase<PH_MERGE>(p, l, shm); XBAR(bar, 9);
        run_phase<PH_WO>(p, l, shm); XBAR(bar, 10);
#ifdef PROBE_LN1
        run_phase<PH_LN1>(p, l, shm, true);
#endif
        run_phase<PH_LN1>(p, l, shm); XBAR(bar, 11);
        run_phase<PH_GATHER>(p, l, shm); XBAR(bar, 12);
        run_phase<PH_UP>(p, l, shm); XBAR(bar, 13);
        run_phase<PH_DOWN>(p, l, shm); XBAR(bar, 14);
        run_phase<PH_LN2>(p, l, shm); XBAR(bar, 15);
    }
#ifdef PROBE_SLOT
    if (blockIdx.x == 0 && threadIdx.x == 0) { volatile LAS unsigned long long* tw = (volatile LAS unsigned long long*)(shm + LDS_XBW + 16);
        const unsigned long long until = wall_clock64() + tw[1] * (PROBE_MULT - 1);
        while (wall_clock64() < until) __builtin_amdgcn_s_sleep(32); }
#endif
}
#endif

extern "C" void kernel_launch(void* const* d_in, const int* in_sizes, int n_in, void* d_out, int out_size, void* d_ws, size_t ws_size, hipStream_t stream) {
    (void)in_sizes; (void)n_in; (void)out_size;
    if (ws_size < WS_NEED) { fprintf(stderr, "workspace too small: %zu < %zu\n", ws_size, (size_t)WS_NEED); return; }
    Params p{};
    for (int i = 0; i < 23; ++i) p.in[i] = (const float*)d_in[i];
    p.out = (float*)d_out; p.ws = (char*)d_ws;
    (void)hipMemsetAsync(d_ws, 0, ZERO_BYTES, stream);
#if !MEGA
    launch_phase<PH_MOD>(p, 0, stream);
    launch_phase<PH_INIT>(p, 0, stream);
    for (int l = 0; l < DEPTH; ++l) {
        launch_phase<PH_CONVERT>(p, l, stream);
        launch_phase<PH_INPROJ>(p, l, stream);
        launch_phase<PH_ROPEDEC>(p, l, stream);
        launch_phase<PH_MIX_GLA>(p, l, stream);
        launch_phase<PH_VTRANS>(p, l, stream);
        launch_phase<PH_DIFF>(p, l, stream);
        launch_phase<PH_MIX_NA>(p, l, stream);
        launch_phase<PH_GATES>(p, l, stream);
        launch_phase<PH_MERGE>(p, l, stream);
        launch_phase<PH_WO>(p, l, stream);
        launch_phase<PH_LN1>(p, l, stream);
        launch_phase<PH_GATHER>(p, l, stream);
        launch_phase<PH_UP>(p, l, stream);
        launch_phase<PH_DOWN>(p, l, stream);
        launch_phase<PH_LN2>(p, l, stream);
    }
#else
    static int grid = 0;
    if (!grid) {
        (void)hipFuncSetAttribute((const void*)k_mega, hipFuncAttributeMaxDynamicSharedMemorySize, LDS_BYTES);
        int dev = 0, cus = 0, per_cu = 0;
        (void)hipGetDevice(&dev);
        (void)hipDeviceGetAttribute(&cus, hipDeviceAttributeMultiprocessorCount, dev);
        (void)hipOccupancyMaxActiveBlocksPerMultiprocessor(&per_cu, (const void*)k_mega, 512, LDS_BYTES);
        if (cus <= 0) cus = 256;
        grid = per_cu >= 1 ? cus : 0;
        if (!grid) { fprintf(stderr, "k_mega does not fit a CU\n"); return; }
    }
    hipLaunchKernelGGL(k_mega, dim3(grid), dim3(NTHR), LDS_BYTES, stream, p);
#endif
}
```

```cpp
#define MEGA 1
#include <hip/hip_runtime.h>
#include <stdint.h>
#include <stdio.h>

#ifndef MEGA
#define MEGA 0
#endif

constexpr int NB = 8, LL = 4096, LC = 256, LB = LL + LC  , T = NB * LB  , D = 1024, DEPTH = 4;
constexpr int NPANEL = T / 256;
constexpr int PB = LB / 256;
constexpr int PAIR_ROWS = 2 * T + 16 * 256;
constexpr float ALPHA = 1.681792830507429f;
constexpr float LN_EPS = 1e-5f, RMS_EPS = 1e-6f;

constexpr size_t AL256(size_t x) { return (x + 255) & ~(size_t)255; }
constexpr size_t OFF_BAR = 0;
constexpr size_t OFF_CNT = 16384;
constexpr size_t ZERO_BYTES = 32768;
constexpr size_t OFF_BLKCNT = ZERO_BYTES;
constexpr size_t OFF_MOD0 = OFF_BLKCNT + 1024 * 16 * 4;
constexpr size_t OFF_MOD = OFF_MOD0;
constexpr size_t OFF_ROPE = AL256(OFF_MOD + (size_t)DEPTH * 9 * 6144 * 4);
constexpr size_t OFF_TOK = AL256(OFF_ROPE + (size_t)4096 * 32 * 2 * 4);
constexpr size_t OFF_GR = AL256(OFF_TOK + (size_t)T * 8 * 4);
constexpr size_t OFF_XS = AL256(OFF_GR + (size_t)T * 32 * 4);
constexpr size_t OFF_H = AL256(OFF_XS + (size_t)T * D * 4);
constexpr size_t OFF_W = AL256(OFF_H + (size_t)T * D * 2);
constexpr size_t W_IN_ROWS = 4864 + 3072;
constexpr size_t OFF_WIN = OFF_W;
constexpr size_t OFF_WB = OFF_WIN + W_IN_ROWS * 1024 * 2;
constexpr size_t OFF_WO = OFF_WB + (size_t)3 * 1024 * 512 * 2;
constexpr size_t OFF_WUP = OFF_WO + (size_t)1024 * 1024 * 2;
constexpr size_t OFF_WDN = OFF_WUP + (size_t)16 * 1024 * 1024 * 2;
constexpr size_t OFF_P = AL256(OFF_WDN + (size_t)16 * 1024 * 512 * 2);
constexpr size_t PCOL = (size_t)T * 2;
constexpr size_t OFF_GQ = OFF_P, OFF_GK = OFF_P + 256 * PCOL, OFF_GV = OFF_P + 512 * PCOL;
constexpr size_t OFF_DK = OFF_P + 1024 * PCOL, OFF_DV = OFF_P + 1536 * PCOL;
constexpr size_t OFF_NK = OFF_P + 2048 * PCOL, OFF_NV = OFF_P + 2560 * PCOL;
constexpr size_t OFF_BR = OFF_P + 3072 * PCOL;
constexpr size_t OFF_GG = OFF_BR, OFF_DQ = OFF_BR + 512 * PCOL, OFF_NQ = OFF_BR + 1024 * PCOL;
constexpr size_t OFF_GATE = OFF_P;
constexpr size_t OFF_S1 = AL256(OFF_P + 4608 * PCOL);
constexpr size_t OFF_S2 = AL256(OFF_S1 + (size_t)T * 512 * 4);
constexpr size_t OFF_R3 = AL256(OFF_S2 + (size_t)T * 512 * 4);
constexpr size_t OFF_R4 = AL256(OFF_R3 + (size_t)T * 512 * 2);
constexpr size_t VT_BYTES = (size_t)T * 512 * 2;
#ifndef FAST_GLA
#define FAST_GLA 1
#endif
#ifndef FAST_DIFF
#define FAST_DIFF 1
#endif
#ifndef FAST_NA
#define FAST_NA 1
#endif
constexpr size_t OFF_KV = OFF_S1;
constexpr size_t OFF_GVT = OFF_GV;
constexpr size_t OFF_VT = OFF_DV;
constexpr size_t OFF_NVT = OFF_NV;
static_assert(FAST_GLA && FAST_DIFF && FAST_NA, "the naive mixers read row-major values");
constexpr size_t OFF_TOTAL = OFF_R3;
constexpr size_t OFF_CUM = OFF_S2;
constexpr size_t OFF_NBT = OFF_R4;
constexpr size_t OFF_DECAY = AL256(OFF_NBT + (size_t)8 * 15 * 4 * 64 * 16 * 4);
constexpr size_t OFF_END1 = AL256(OFF_DECAY + (size_t)64 * 68 * 64 * 4);
constexpr size_t OFF_XA = OFF_P;
constexpr size_t OFF_PAIRTOK = OFF_XA;
constexpr size_t OFF_ACT = AL256(OFF_XA + (size_t)PAIR_ROWS * 1024 * 2);
constexpr size_t OFF_Y = AL256(OFF_ACT + (size_t)PAIR_ROWS * 512 * 2);
constexpr size_t OFF_END2 = AL256(OFF_Y + (size_t)PAIR_ROWS * 1024 * 2);
constexpr size_t WS_NEED = OFF_END1 > OFF_END2 ? OFF_END1 : OFF_END2;
static_assert(WS_NEED < (size_t)812 * 1000 * 1000, "workspace budget");

constexpr int NTHR = 512;
constexpr int LDS_STAGE = 131072;
constexpr int LDS_BYTES = 159744;
constexpr int LDS_XBW = LDS_BYTES - 256;

typedef unsigned short bf16_t;

struct Params {
    const float* in[23];
    float* out;
    char* ws;
};
enum { I_X = 0, I_C, I_CTX, I_CCTX, I_WADA, I_BADA, I_WIN, I_GWD, I_GBD, I_GNG, I_LQ, I_LK, I_DNG, I_RPB, I_WBR, I_WO, I_LNG, I_LNB, I_WR, I_BR, I_WEG, I_WEU, I_WED };

__device__ __forceinline__ float bf2f(bf16_t v) { return __uint_as_float(((unsigned)v) << 16); }
__device__ __forceinline__ float bflo(unsigned u) { return __uint_as_float(u << 16); }
__device__ __forceinline__ float bfhi(unsigned u) { return __uint_as_float(u & 0xffff0000u); }
typedef float f32x2_t __attribute__((ext_vector_type(2)));
typedef __bf16 bf16x2_t __attribute__((ext_vector_type(2)));
__device__ __forceinline__ unsigned pk2(float lo, float hi) { f32x2_t v; v[0] = lo; v[1] = hi; return __builtin_bit_cast(unsigned, __builtin_convertvector(v, bf16x2_t)); }
__device__ __forceinline__ bf16_t f2bf(float f) { return (bf16_t)(pk2(f, 0.f) & 0xffffu); }
__device__ __forceinline__ float wave_sum(float v) {
#pragma unroll
    for (int o = 32; o >= 1; o >>= 1) v += __shfl_xor(v, o);
    return v;
}
__device__ __forceinline__ float sigmoidf_(float x) { return 1.f / (1.f + __expf(-x)); }
__device__ __forceinline__ float siluf_(float x) { return x / (1.f + __expf(-x)); }
__device__ __forceinline__ int row_slot(int row) { const int b = row / LB, t = row - b * LB; return t < LC ? 8 : b; }
__device__ __forceinline__ int ltid() { int t = threadIdx.x; asm volatile("" : "+v"(t)); return t; }
#ifndef XS_BF16
#define XS_BF16 0
#endif
#if XS_BF16
typedef bf16_t xs_t;
#else
typedef float xs_t;
#endif
typedef float f32x4_a __attribute__((ext_vector_type(4)));
typedef unsigned u32x2_a __attribute__((ext_vector_type(2)));
__device__ __forceinline__ f32x4_a xs_ld4(const xs_t* p) {
#if XS_BF16
    const u32x2_a v = *(const u32x2_a*)p; f32x4_a r; r[0] = bflo(v[0]); r[1] = bfhi(v[0]); r[2] = bflo(v[1]); r[3] = bfhi(v[1]); return r;
#else
    return *(const f32x4_a*)p;
#endif
}
__device__ __forceinline__ void xs_st4(xs_t* p, f32x4_a x) {
#if XS_BF16
    u32x2_a v; v[0] = pk2(x[0], x[1]); v[1] = pk2(x[2], x[3]); *(u32x2_a*)p = v;
#else
    *(f32x4_a*)p = x;
#endif
}
#include <hip/hip_runtime.h>
namespace pg8 {
#define PG8_LAS __attribute__((address_space(3)))
typedef unsigned short bf16_t;
typedef short bf16x8 __attribute__((ext_vector_type(8)));
typedef float f32x4 __attribute__((ext_vector_type(4)));
typedef unsigned u32x4 __attribute__((ext_vector_type(4)));
constexpr int BM = 256, BK = 64, HALF = 128, HTB = HALF * BK * 2  , STAGE_BYTES = 8 * HTB, NXCD = 8, WGM = 8;

__host__ __device__ __forceinline__ int lds_byte(int r, int c) { const int st = (r >> 4) * 2 + (c >> 5), rr = r & 15, cc = c & 31, ob = rr * 64 + cc * 2; return st * 1024 + (ob ^ (((ob >> 9) & 1) << 5)); }
__host__ __device__ __forceinline__ void stage_rc(int b, int& R, int& C) { const int st = b / 1024, sb = b % 1024, swz = sb ^ (((sb >> 9) & 1) << 5); R = (st >> 1) * 16 + swz / 64; C = (st & 1) * 32 + (swz % 64) / 2; }
__host__ __device__ __forceinline__ int perm32(int rho) { const int n = rho >> 4, i = rho & 15; return 8 * (i >> 2) + 4 * n + (i & 3); }

struct Unit { int pm, pn; };
struct Gemm { const bf16_t* A; const bf16_t* Bt; int M, N, K; const int* gidx; };
__device__ __forceinline__ unsigned cvt_pk_bf16(float lo, float hi) { unsigned r; asm volatile("v_cvt_pk_bf16_f32 %0, %1, %2" : "=v"(r) : "v"(lo), "v"(hi)); return r; }

template <class Epi, class Sched, bool STAMP = false>
__device__ __forceinline__ void gemm_phase(PG8_LAS unsigned char* lds, const Gemm g, const Sched& S, const Epi& E, unsigned long long* stamps) {
    int tid_l = threadIdx.x; asm volatile("" : "+v"(tid_l));
    const int tid = tid_l, wid = __builtin_amdgcn_readfirstlane(tid >> 6), lane = tid & 63, wr = wid >> 2, wc = wid & 3, fr = lane & 15, fq = lane >> 4;
    const int K = g.K, nt = K / BK;
    int ts_lo = 0, ts_hi = 0, nts = 0; const unsigned long long rt_entry = STAMP ? (unsigned long long)wall_clock64() : 0ull;
#define PG8_STAMP() do { if (STAMP && wid == 0 && nts < 64) { const unsigned long long _c = (unsigned long long)clock64(); \
        ts_lo = (lane == nts) ? (int)(unsigned)_c : ts_lo; ts_hi = (lane == nts) ? (int)(unsigned)(_c >> 32) : ts_hi; ++nts; } } while (0)
    PG8_STAMP();
    unsigned voffA[2], voffB[2];
#pragma unroll
    for (int i = 0; i < 2; ++i) { int R, C; stage_rc(tid * 16 + i * 8192, R, C); const int Rb = Epi::PERM ? ((R & ~31) + perm32(R & 31)) : R;
        voffA[i] = (unsigned)(R * K + C) * 2u; voffB[i] = (unsigned)(Rb * K + C) * 2u; }
    const size_t kstep = (size_t)(BK * 2);
    const size_t hstep = (size_t)HALF * K * 2;
    const size_t tstep = 2 * hstep;
    int Rg[2], Cg[2];
#pragma unroll
    for (int i = 0; i < 2; ++i) stage_rc(tid * 16 + i * 8192, Rg[i], Cg[i]);
    unsigned gA[2][2], gN[2][2];
#define PG8_GLOAD(dst, unit) do { _Pragma("unroll") for (int hh_ = 0; hh_ < 2; ++hh_) _Pragma("unroll") for (int i = 0; i < 2; ++i) \
        dst[hh_][i] = (unsigned)g.gidx[(unit).pm * BM + hh_ * HALF + Rg[i]] * (unsigned)(K * 2) + (unsigned)(Cg[i] * 2); } while (0)
    const size_t hstepA = Epi::GATHER ? 0 : hstep;
    const unsigned ldsw = (unsigned)wid * 1024u;
    const int aoff = lds_byte(wr * 64 + fr, fq * 8), boff = lds_byte(wc * 32 + fr, fq * 8);
#define PG8_SA(b, h) (((b) * 2 + (h)) * HTB)
#define PG8_SB(b, h) ((4 + (b) * 2 + (h)) * HTB)
#define PG8_STAGE(bufoff, gbase, voff) do { _Pragma("unroll") for (int _i = 0; _i < 2; ++_i) \
        __builtin_amdgcn_global_load_lds((const unsigned*)((const char*)(gbase) + (voff)[_i]), (PG8_LAS unsigned*)(lds + (bufoff) + ldsw + _i * 8192), 16, 0, 0); } while (0)
#define PG8_STAGEA(bufoff, gbase, half, usenext) do { if constexpr (Epi::GATHER) { _Pragma("unroll") for (int _i = 0; _i < 2; ++_i) { const unsigned _o = (usenext) ? gN[half][_i] : gA[half][_i]; \
            __builtin_amdgcn_global_load_lds((const unsigned*)((const char*)(gbase) + _o), (PG8_LAS unsigned*)(lds + (bufoff) + ldsw + _i * 8192), 16, 0, 0); } } \
        else { PG8_STAGE(bufoff, (gbase) + (half) * hstepA, voffA); } } while (0)
#define PG8_LDA(dst, b, h) do { _Pragma("unroll") for (int m = 0; m < 4; ++m) _Pragma("unroll") for (int k = 0; k < 2; ++k) dst[m][k] = *(const PG8_LAS bf16x8*)(lds + PG8_SA(b, h) + aoff + m * 2048 + k * 1024); } while (0)
#define PG8_LDB(dst, b, h) do { _Pragma("unroll") for (int n = 0; n < 2; ++n) _Pragma("unroll") for (int k = 0; k < 2; ++k) dst[n][k] = *(const PG8_LAS bf16x8*)(lds + PG8_SB(b, h) + boff + n * 2048 + k * 1024); } while (0)
#define PG8_MMA(ai, bj, At, Bt) do { __builtin_amdgcn_s_setprio(1); _Pragma("unroll") for (int m = 0; m < 4; ++m) _Pragma("unroll") for (int n = 0; n < 2; ++n) _Pragma("unroll") for (int k = 0; k < 2; ++k) \
        acc[ai][bj][m][n] = __builtin_amdgcn_mfma_f32_16x16x32_bf16(Bt[n][k], At[m][k], acc[ai][bj][m][n], 0, 0, 0); __builtin_amdgcn_s_setprio(0); } while (0)
#define PG8_WAIT_V(n) asm volatile("s_waitcnt vmcnt(" #n ")" ::: "memory")
#define PG8_WAIT_L(n) asm volatile("s_waitcnt lgkmcnt(" #n ")" ::: "memory")
#define PG8_BAR __builtin_amdgcn_s_barrier()
#define PG8_SCHED __builtin_amdgcn_sched_barrier(0)
    Unit cur, nxt; int ui = 0;
    if (!S.next(0, cur)) return;
    f32x4 acc[2][2][4][2];
#pragma unroll
    for (int a = 0; a < 2; ++a)
#pragma unroll
        for (int b = 0; b < 2; ++b)
#pragma unroll
            for (int m = 0; m < 4; ++m)
#pragma unroll
                for (int n = 0; n < 2; ++n) acc[a][b][m][n] = (f32x4){0.f, 0.f, 0.f, 0.f};
    bf16x8 At[4][2], B0[2][2], B1[2][2];
    const char* cA = Epi::GATHER ? (const char*)g.A : (const char*)g.A + (size_t)cur.pm * tstep; const char* cB = (const char*)g.Bt + (size_t)cur.pn * tstep;
    S.a_ready(cur);
    if constexpr (Epi::GATHER) PG8_GLOAD(gA, cur);
    PG8_STAGE(PG8_SB(0, 0), cB, voffB); PG8_STAGEA(PG8_SA(0, 0), cA, 0, false); PG8_STAGE(PG8_SB(0, 1), cB + hstep, voffB); PG8_STAGEA(PG8_SA(0, 1), cA, 1, false);
    if (wr == 1) PG8_BAR;
    PG8_WAIT_V(4); PG8_BAR;
    PG8_STAGE(PG8_SB(1, 0), cB + kstep, voffB); PG8_STAGEA(PG8_SA(1, 0), cA + kstep, 0, false); PG8_STAGE(PG8_SB(1, 1), cB + hstep + kstep, voffB);
    PG8_WAIT_V(6); PG8_BAR;
    PG8_STAMP();
    for (;;) {
        const bool has_next = S.next(ui + 1, nxt);
        const char* nA = Epi::GATHER ? (const char*)g.A : (has_next ? (const char*)g.A + (size_t)nxt.pm * tstep : cA);
        if constexpr (Epi::GATHER) { if (has_next) PG8_GLOAD(gN, nxt); else { _Pragma("unroll") for (int hh_ = 0; hh_ < 2; ++hh_) _Pragma("unroll") for (int i = 0; i < 2; ++i) gN[hh_][i] = gA[hh_][i]; } } const char* nB = has_next ? (const char*)g.Bt + (size_t)nxt.pn * tstep : cB;
        for (int t = 0; t < nt; t += 2) {
            const bool last = (t == nt - 2);
            const char* a1 = cA + (size_t)(t + 1) * kstep;
            const char* a2 = last ? nA : cA + (size_t)(t + 2) * kstep; const char* b2 = last ? nB : cB + (size_t)(t + 2) * kstep;
            const char* a3 = a2 + kstep; const char* b3 = b2 + kstep;
            if (last && has_next) S.a_ready(nxt);
            PG8_LDB(B0, 0, 0); PG8_SCHED; PG8_LDA(At, 0, 0); PG8_STAGEA(PG8_SA(1, 1), a1, 1, false);
            PG8_WAIT_L(8); PG8_BAR; PG8_WAIT_L(0); PG8_MMA(0, 0, At, B0); PG8_BAR; PG8_SCHED;
            PG8_LDB(B1, 0, 1); PG8_STAGE(PG8_SB(0, 0), b2, voffB);
            PG8_BAR; PG8_WAIT_L(0); PG8_MMA(0, 1, At, B1); PG8_BAR;
            PG8_LDA(At, 0, 1); PG8_STAGEA(PG8_SA(0, 0), a2, 0, last);
            PG8_BAR; PG8_WAIT_L(0); PG8_MMA(1, 0, At, B0); PG8_BAR; PG8_SCHED;
            PG8_STAGE(PG8_SB(0, 1), b2 + hstep, voffB);
            PG8_WAIT_V(6); PG8_BAR; PG8_MMA(1, 1, At, B1); PG8_BAR;
            PG8_LDB(B0, 1, 0); PG8_SCHED; PG8_LDA(At, 1, 0); PG8_STAGEA(PG8_SA(0, 1), a2, 1, last);
            PG8_WAIT_L(8); PG8_BAR; PG8_WAIT_L(0); PG8_MMA(0, 0, At, B0); PG8_BAR; PG8_SCHED;
            PG8_LDB(B1, 1, 1); PG8_STAGE(PG8_SB(1, 0), b3, voffB);
            PG8_BAR; PG8_WAIT_L(0); PG8_MMA(0, 1, At, B1); PG8_BAR;
            PG8_LDA(At, 1, 1); PG8_STAGEA(PG8_SA(1, 0), a3, 0, last);
            PG8_BAR; PG8_WAIT_L(0); PG8_MMA(1, 0, At, B0); PG8_BAR; PG8_SCHED;
            PG8_STAGE(PG8_SB(1, 1), b3 + hstep, voffB);
            PG8_WAIT_V(6); PG8_BAR; PG8_MMA(1, 1, At, B1); PG8_BAR;
        }
        PG8_STAMP();
        if constexpr (!Epi::AFTER_DRAIN) { E(acc, cur, wr, wc, fr, fq); S.done(cur); }
        PG8_STAMP();
        if (!has_next) break;
        bool zero_acc = true;
        if constexpr (Epi::KEEP) zero_acc = !E.keep(cur);
        if (zero_acc) {
#pragma unroll
        for (int a = 0; a < 2; ++a)
#pragma unroll
            for (int b = 0; b < 2; ++b)
#pragma unroll
                for (int m = 0; m < 4; ++m)
#pragma unroll
                    for (int n = 0; n < 2; ++n) acc[a][b][m][n] = (f32x4){0.f, 0.f, 0.f, 0.f};
        }
        cur = nxt; cA = nA; cB = nB; ++ui;
        if constexpr (Epi::GATHER) { _Pragma("unroll") for (int hh_ = 0; hh_ < 2; ++hh_) _Pragma("unroll") for (int i = 0; i < 2; ++i) gA[hh_][i] = gN[hh_][i]; }
    }
    PG8_WAIT_V(0);
    if (wr == 0) PG8_BAR;
    PG8_BAR;
    if constexpr (Epi::AFTER_DRAIN) { E.fused(acc, cur, wr, wc, fr, fq, lds, wid, lane); S.done(cur); }
    PG8_STAMP();
    if (STAMP && wid == 0) { stamps[lane] = lane < nts ? (((unsigned long long)(unsigned)ts_hi << 32) | (unsigned)ts_lo) : 0ull;
        if (lane == 62) stamps[62] = rt_entry; if (lane == 63) stamps[63] = (unsigned long long)wall_clock64(); }
#undef PG8_STAMP
#undef PG8_SA
#undef PG8_SB
#undef PG8_STAGE
#undef PG8_STAGEA
#undef PG8_GLOAD
#undef PG8_LDA
#undef PG8_LDB
#undef PG8_MMA
#undef PG8_WAIT_V
#undef PG8_WAIT_L
#undef PG8_BAR
#undef PG8_SCHED
}
}
#define XB_TMO      128
#define XB_XCNT(j)  (256  + 64 * (j))
#define XB_XSUB(j)  (1280 + 64 * (j))
#define XB_XGEN(j)  (2304 + 64 * (j))
#define XB_TOP      3328
#define XB_TOPGEN   3392
#define XCD_BAR_WORDS 3456
#define XB_SPIN_CAP (1u << 18)
#define LAS __attribute__((address_space(3)))

__device__ __forceinline__ unsigned xb_ld(unsigned* p)              { return __hip_atomic_load(p, __ATOMIC_RELAXED, __HIP_MEMORY_SCOPE_AGENT); }
__device__ __forceinline__ unsigned xb_add(unsigned* p, unsigned v) { return __hip_atomic_fetch_add(p, v, __ATOMIC_RELAXED, __HIP_MEMORY_SCOPE_AGENT); }
__device__ __forceinline__ unsigned xb_xcc_id() { return (unsigned)__builtin_amdgcn_s_getreg((3 << 11) | 20) & 0xFu; }
#define XB_SPIN(cond, bar) do { unsigned _sp = 0; while (cond) { __builtin_amdgcn_s_sleep(1); \
    if ((++_sp & 255u) == 0u) { if (xb_ld(&(bar)[XB_TMO])) break; if (_sp > XB_SPIN_CAP) { atomicAdd(&(bar)[XB_TMO], 1u); break; } } } } while (0)

struct XcdBarrier {
    unsigned* bar; unsigned x;
    volatile LAS unsigned* st;
};

__device__ __forceinline__ XcdBarrier xcd_barrier_post(unsigned* bar, volatile LAS unsigned* st) {
    XcdBarrier b; b.bar = bar; b.x = xb_xcc_id(); b.st = st;
    if (threadIdx.x == 0) (void)xb_add(&bar[XB_XCNT(b.x)], 1u);
    return b;
}
__device__ __forceinline__ void xcd_barrier_complete(unsigned* bar, unsigned x, unsigned& nloc, unsigned& nx) {
    const unsigned G = gridDim.x * gridDim.y * gridDim.z;
    unsigned sum, cnt, mine, sp = 0u;
    for (;;) {
        sum = 0u; cnt = 0u; mine = 0u;
#pragma unroll
        for (unsigned j = 0; j < 16; ++j) { const unsigned c = xb_ld(&bar[XB_XCNT(j)]); sum += c; cnt += (c > 0u) ? 1u : 0u; mine = (j == x) ? c : mine; }
        if (sum == G) break;
        __builtin_amdgcn_s_sleep(1);
        if ((++sp & 255u) == 0u) { if (xb_ld(&bar[XB_TMO])) break; if (sp > XB_SPIN_CAP) { atomicAdd(&bar[XB_TMO], 1u); break; } }
    }
    nloc = mine > 0u ? mine : 1u; nx = cnt > 0u ? cnt : 1u;
}

__device__ __forceinline__ void xcd_barrier(const XcdBarrier& b_in) {
    XcdBarrier b = b_in; asm volatile("" : "+s"(b.bar), "+s"(b.x));
    asm volatile("s_waitcnt vmcnt(0)" ::: "memory");
    __syncthreads();
    if (threadIdx.x == 0) {
        unsigned* bar = b.bar;
        __builtin_amdgcn_s_waitcnt(0);
        unsigned nloc = b.st[0], nx = b.st[1];
        if (nloc == 0u) { xcd_barrier_complete(bar, b.x, nloc, nx); b.st[0] = nloc; b.st[1] = nx; }
        const unsigned old = xb_add(&bar[XB_XSUB(b.x)], 1u);
        const unsigned gen = old / nloc;
        if (old + 1u == (gen + 1u) * nloc) {
            __builtin_amdgcn_fence(__ATOMIC_RELEASE, "agent");
            asm volatile("s_waitcnt vmcnt(0)" ::: "memory");
            const unsigned og = xb_add(&bar[XB_TOP], 1u);
            const unsigned tg = og / nx;
            if (og + 1u == (tg + 1u) * nx) xb_add(&bar[XB_TOPGEN], 1u);
            else XB_SPIN(xb_ld(&bar[XB_TOPGEN]) == tg, bar);
            __builtin_amdgcn_fence(__ATOMIC_ACQUIRE, "agent");
            xb_add(&bar[XB_XGEN(b.x)], 1u);
            asm volatile("s_waitcnt vmcnt(0)" ::: "memory");
        } else {
            XB_SPIN(xb_ld(&bar[XB_XGEN(b.x)]) == gen, bar);
            __builtin_amdgcn_fence(__ATOMIC_ACQUIRE, "agent");
            asm volatile("s_waitcnt vmcnt(0)" ::: "memory");
        }
    }
    __syncthreads();
}

using pg8::f32x4;
using pg8::Unit;
typedef unsigned u32x4_t __attribute__((ext_vector_type(4)));
typedef unsigned u32x2_t __attribute__((ext_vector_type(2)));

struct SchedGrid {
    int nM, nN, pn0, G, c; bool lat_only;
    __device__ __forceinline__ bool next(int i, Unit& u) const {
        const int L = i * G + c; if (L >= nM * nN) return false;
        int pm = L / nN; u.pn = pn0 + (L - pm * nN);
        if (lat_only) pm = (pm >> 4) * PB + 1 + (pm & 15);
        u.pm = pm; return true;
    }
    __device__ __forceinline__ void a_ready(const Unit&) const {}
    __device__ __forceinline__ void done(const Unit&) const {}
};
struct SchedMerge {
    int G, c; bool lat_only;
    __device__ __forceinline__ bool next(int i, Unit& u) const {
        const int i3 = i / 3, n = i - i3 * 3, ti = i3 * G + c; if (ti >= (lat_only ? NB * 16 : NPANEL) * 4) return false;
        int pm = ti >> 2; if (lat_only) pm = (pm >> 4) * PB + 1 + (pm & 15);
        u.pm = n * NPANEL + pm; u.pn = n * 4 + (ti & 3); return true;
    }
    __device__ __forceinline__ void a_ready(const Unit&) const {}
    __device__ __forceinline__ void done(const Unit&) const {}
};
struct SchedMoe {
    int cum[17]; int G, c;
    __device__ __forceinline__ void init(const unsigned* cnt, int G_, int c_) {
        G = G_; c = c_; int s = 0;
#pragma unroll
        for (int e = 0; e < 16; ++e) { cum[e] = s; const unsigned n = __builtin_amdgcn_readfirstlane(cnt[e]); s += (int)((n + 255u) >> 8); }
        cum[16] = s;
    }
    __device__ __forceinline__ bool next(int i, Unit& u) const {
        const int L = i * G + c; if (L >= cum[16] * 4) return false;
        const int rt = L >> 2; int e = 0;
#pragma unroll
        for (int j = 1; j < 16; ++j) e += (rt >= cum[j]) ? 1 : 0;
        u.pm = rt; u.pn = e * 4 + (L & 3); return true;
    }
    __device__ __forceinline__ void a_ready(const Unit&) const {}
    __device__ __forceinline__ void done(const Unit&) const {}
};

__device__ __forceinline__ u32x4_t pack8(const f32x4& a, const f32x4& b) {
    u32x4_t r; r[0] = pk2(a[0], a[1]); r[1] = pk2(a[2], a[3]); r[2] = pk2(b[0], b[1]); r[3] = pk2(b[2], b[3]); return r;
}
struct EpiInProj {
    static constexpr bool PERM = true, AFTER_DRAIN = false; static constexpr bool KEEP = false; static constexpr bool GATHER = false;
    char* ws;
    __device__ __forceinline__ void operator()(const f32x4 (&acc)[2][2][4][2], const Unit& u, int wr, int wc, int fr, int fq) const {
        const int pn = u.pn; const int row0 = u.pm * 256 + wr * 64 + fr;
        if (pn == 6) {
            if (wc == 0) { float* gr = (float*)(ws + OFF_GR);
#pragma unroll
                for (int ai = 0; ai < 2; ++ai)
#pragma unroll
                    for (int m = 0; m < 4; ++m) { float* rp = gr + (size_t)(row0 + ai * 128 + m * 16) * 32 + 8 * fq;
                        *(f32x4*)(rp) = acc[ai][0][m][0]; *(f32x4*)(rp + 4) = acc[ai][0][m][1]; } }
            return;
        }
        if (pn == 2 || pn == 3 || pn == 11 || pn == 12 || pn == 17 || pn == 18) {
            const size_t voff = pn < 4 ? OFF_GVT : (pn < 13 ? OFF_VT : OFF_NVT); const int colt = ((pn < 4 ? pn - 2 : (pn < 13 ? pn - 11 : pn - 17)) * 256) + wc * 32 + 8 * fq;
            const int b = u.pm / PB, key0 = (u.pm - b * PB) * 256 + wr * 64 + fr;
            bf16_t* vt = (bf16_t*)(ws + voff) + ((size_t)b * 512 + colt) * LB + key0;
#pragma unroll
            for (int ai = 0; ai < 2; ++ai)
#pragma unroll
                for (int m = 0; m < 4; ++m)
#pragma unroll
                    for (int bj = 0; bj < 2; ++bj) { const u32x4_t pk = pack8(acc[ai][bj][m][0], acc[ai][bj][m][1]); bf16_t* cp = vt + (size_t)(bj * 128) * LB + ai * 128 + m * 16;
#pragma unroll
                        for (int j = 0; j < 4; ++j) { cp[(size_t)(2 * j) * LB] = (bf16_t)(pk[j] & 0xffffu); cp[(size_t)(2 * j + 1) * LB] = (bf16_t)(pk[j] >> 16); } }
            return;
        }
        size_t off; int ld, col0;
        if (pn == 0) { off = OFF_GQ; ld = 256; col0 = 0; }
        else if (pn == 1) { off = OFF_GK; ld = 256; col0 = 0; }
        else if (pn < 4) { off = OFF_GV; ld = 512; col0 = (pn - 2) * 256; }
        else if (pn < 6) { off = OFF_GG; ld = 512; col0 = (pn - 4) * 256; }
        else if (pn < 9) { off = OFF_DQ; ld = 512; col0 = (pn - 7) * 256; }
        else if (pn < 11) { off = OFF_DK; ld = 512; col0 = (pn - 9) * 256; }
        else if (pn < 13) { off = OFF_DV; ld = 512; col0 = (pn - 11) * 256; }
        else if (pn < 15) { off = OFF_NQ; ld = 512; col0 = (pn - 13) * 256; }
        else if (pn < 17) { off = OFF_NK; ld = 512; col0 = (pn - 15) * 256; }
        else { off = OFF_NV; ld = 512; col0 = (pn - 17) * 256; }
        bf16_t* base = (bf16_t*)(ws + off) + col0 + wc * 32 + 8 * fq;
#pragma unroll
        for (int ai = 0; ai < 2; ++ai)
#pragma unroll
            for (int m = 0; m < 4; ++m) { bf16_t* rp = base + (size_t)(row0 + ai * 128 + m * 16) * ld;
#pragma unroll
                for (int bj = 0; bj < 2; ++bj) *(u32x4_t*)(rp + bj * 128) = pack8(acc[ai][bj][m][0], acc[ai][bj][m][1]); }
    }
};
struct EpiGates {
    static constexpr bool PERM = true, AFTER_DRAIN = false; static constexpr bool KEEP = false; static constexpr bool GATHER = false;
    char* ws;
    __device__ __forceinline__ void operator()(const f32x4 (&acc)[2][2][4][2], const Unit& u, int wr, int wc, int fr, int fq) const {
        const int pl = u.pn - 19, n = pl >> 2, col0 = (pl & 3) * 256; const int row0 = u.pm * 256 + wr * 64 + fr;
        bf16_t* base = (bf16_t*)(ws + OFF_GATE) + (size_t)n * T * 1024 + col0 + wc * 32 + 8 * fq;
#pragma unroll
        for (int ai = 0; ai < 2; ++ai)
#pragma unroll
            for (int m = 0; m < 4; ++m) { bf16_t* rp = base + (size_t)(row0 + ai * 128 + m * 16) * 1024;
#pragma unroll
                for (int bj = 0; bj < 2; ++bj) { f32x4 a = acc[ai][bj][m][0], b = acc[ai][bj][m][1];
#pragma unroll
                    for (int j = 0; j < 4; ++j) { a[j] = sigmoidf_(a[j]); b[j] = sigmoidf_(b[j]); }
                    *(u32x4_t*)(rp + bj * 128) = pack8(a, b); } }
    }
};
struct EpiMerge {
    static constexpr bool PERM = true, AFTER_DRAIN = false; static constexpr bool KEEP = true; static constexpr bool GATHER = false;
    char* ws;
    __device__ __forceinline__ bool keep(const Unit& u) const { return u.pm < 2 * NPANEL; }
    __device__ __forceinline__ void operator()(f32x4 (&acc)[2][2][4][2], const Unit& u, int wr, int wc, int fr, int fq) const {
        const int n = u.pm / NPANEL, pm = u.pm - n * NPANEL, pn = u.pn & 3; const int row0 = pm * 256 + wr * 64 + fr;
        const size_t cb = (size_t)pn * 256 + wc * 32 + 8 * fq;
        const bf16_t* gnum = (const bf16_t*)(ws + OFF_GATE) + (size_t)n * T * 1024 + cb;
        const bf16_t* gden = gnum + (size_t)T * 1024;
        bf16_t* obase = (bf16_t*)(ws + OFF_H) + cb;
#pragma unroll
        for (int ai = 0; ai < 2; ++ai)
#pragma unroll
            for (int m = 0; m < 4; ++m) { const size_t ro = (size_t)(row0 + ai * 128 + m * 16) * 1024;
#pragma unroll
                for (int bj = 0; bj < 2; ++bj) {
                    const u32x4_t g = *(const u32x4_t*)(gnum + ro + bj * 128);
                    float f[8];
#pragma unroll
                    for (int j = 0; j < 4; ++j) { f[2 * j] = bflo(g[j]); f[2 * j + 1] = bfhi(g[j]); }
                    if (n > 0) {
#pragma unroll
                        for (int j = 0; j < 8; ++j) f[j] = fmaxf(f[j], 1e-30f); }
                    if (n < 2) { const u32x4_t gd = *(const u32x4_t*)(gden + ro + bj * 128);
#pragma unroll
                        for (int j = 0; j < 4; ++j) { f[2 * j] *= __builtin_amdgcn_rcpf(fmaxf(bflo(gd[j]), 1e-30f)); f[2 * j + 1] *= __builtin_amdgcn_rcpf(fmaxf(bfhi(gd[j]), 1e-30f)); }
#pragma unroll
                        for (int j = 0; j < 4; ++j) { acc[ai][bj][m][0][j] *= f[j]; acc[ai][bj][m][1][j] *= f[4 + j]; }
                    } else {
                        f32x4 a = acc[ai][bj][m][0], b = acc[ai][bj][m][1];
#pragma unroll
                        for (int j = 0; j < 4; ++j) { a[j] *= f[j]; b[j] *= f[4 + j]; }
                        *(u32x4_t*)(obase + ro + bj * 128) = pack8(a, b); } } }
    }
};
struct EpiWo {
    static constexpr bool PERM = false, AFTER_DRAIN = false; static constexpr bool KEEP = false; static constexpr bool GATHER = false;
    char* ws; int layer; bool commit;
    __device__ __forceinline__ void operator()(const f32x4 (&acc)[2][2][4][2], const Unit& u, int wr, int wc, int fr, int fq) const {
        const int b = u.pm / PB, slot = (u.pm - b * PB) == 0 ? 8 : b;
        const int row0 = u.pm * 256 + wr * 64 + fr, col0 = u.pn * 256 + wc * 32 + 4 * fq;
        const float* mg = (const float*)(ws + OFF_MOD) + ((size_t)(layer * 9 + slot) * 6 + 2) * 1024 + col0;
        xs_t* xs = (xs_t*)(ws + OFF_XS) + col0;
        f32x4 g[2][2];
#pragma unroll
        for (int bj = 0; bj < 2; ++bj)
#pragma unroll
            for (int n = 0; n < 2; ++n) g[bj][n] = *(const f32x4*)(mg + bj * 128 + n * 16);
#pragma unroll
        for (int ai = 0; ai < 2; ++ai)
#pragma unroll
            for (int m = 0; m < 4; ++m) { xs_t* rp = xs + (size_t)(row0 + ai * 128 + m * 16) * 1024;
#pragma unroll
                for (int bj = 0; bj < 2; ++bj)
#pragma unroll
                    for (int n = 0; n < 2; ++n) { f32x4 x = xs_ld4(rp + bj * 128 + n * 16);
                        if (commit) xs_st4(rp + bj * 128 + n * 16, x * ALPHA + g[bj][n] * acc[ai][bj][m][n]); } }
    }
};
struct EpiUp {
    static constexpr bool PERM = true, AFTER_DRAIN = false; static constexpr bool KEEP = false; static constexpr bool GATHER = true;
    char* ws;
    __device__ __forceinline__ void operator()(const f32x4 (&acc)[2][2][4][2], const Unit& u, int wr, int wc, int fr, int fq) const {
        const int ct = u.pn & 3; const int row0 = u.pm * 256 + wr * 64 + fr;
        bf16_t* base = (bf16_t*)(ws + OFF_ACT) + ct * 128 + wc * 32 + 8 * fq;
#pragma unroll
        for (int ai = 0; ai < 2; ++ai)
#pragma unroll
            for (int m = 0; m < 4; ++m) { f32x4 a, b;
#pragma unroll
                for (int j = 0; j < 4; ++j) { a[j] = siluf_(acc[ai][0][m][0][j]) * acc[ai][1][m][0][j]; b[j] = siluf_(acc[ai][0][m][1][j]) * acc[ai][1][m][1][j]; }
                *(u32x4_t*)(base + (size_t)(row0 + ai * 128 + m * 16) * 512) = pack8(a, b); }
    }
};
struct EpiDown {
    static constexpr bool PERM = true, AFTER_DRAIN = false; static constexpr bool KEEP = false; static constexpr bool GATHER = false;
    char* ws;
    __device__ __forceinline__ void operator()(const f32x4 (&acc)[2][2][4][2], const Unit& u, int wr, int wc, int fr, int fq) const {
        const int ct = u.pn & 3; const int row0 = u.pm * 256 + wr * 64 + fr;
        bf16_t* base = (bf16_t*)(ws + OFF_Y) + ct * 256 + wc * 32 + 8 * fq;
#pragma unroll
        for (int ai = 0; ai < 2; ++ai)
#pragma unroll
            for (int m = 0; m < 4; ++m) { bf16_t* rp = base + (size_t)(row0 + ai * 128 + m * 16) * 1024;
#pragma unroll
                for (int bj = 0; bj < 2; ++bj) *(u32x4_t*)(rp + bj * 128) = pack8(acc[ai][bj][m][0], acc[ai][bj][m][1]); }
    }
};

#define GSTRIDE_BEGIN(var, n) for (long var = (long)blockIdx.x * NTHR + ltid(); var < (long)(n); var += (long)gridDim.x * NTHR)

__device__ __forceinline__ void phase_mod(const Params& p, float* lds) {
    const int tid = ltid();
    for (int i = tid; i < 9 * 1024; i += NTHR) { const int s = i >> 10, k = i & 1023; const float v = s < 8 ? p.in[I_C][s * 1024 + k] : p.in[I_CCTX][k]; lds[i] = siluf_(v); }
    __syncthreads();
    float* mod = (float*)(p.ws + OFF_MOD);
    GSTRIDE_BEGIN(idx, DEPTH * 6144) {
        const int l = (int)(idx / 6144), j = (int)(idx - (long)l * 6144);
        const float* w = p.in[I_WADA] + (size_t)l * 1024 * 6144 + j;
        float acc[9];
#pragma unroll
        for (int s = 0; s < 9; ++s) acc[s] = 0.f;
        for (int k = 0; k < 1024; ++k) { const float wv = w[(size_t)k * 6144];
#pragma unroll
            for (int s = 0; s < 9; ++s) acc[s] += lds[s * 1024 + k] * wv; }
        const float bv = p.in[I_BADA][l * 6144 + j];
#pragma unroll
        for (int s = 0; s < 9; ++s) mod[(size_t)(l * 9 + s) * 6144 + j] = acc[s] + bv;
    }
    float* rope = (float*)(p.ws + OFF_ROPE);
    GSTRIDE_BEGIN(idx, 4096 * 32) {
        const int t = (int)(idx >> 5), i = (int)(idx & 31);
        const float pos = (float)(i < 16 ? (t >> 6) : (t & 63));
        const float inv = powf(10000.0f, -(float)(i & 15) / 16.0f);
        const float ang = pos * inv;
        rope[idx * 2] = cosf(ang); rope[idx * 2 + 1] = sinf(ang);
    }
    __syncthreads();
}

__device__ __forceinline__ void phase_init(const Params& p) {
    const float* mod = (const float*)(p.ws + OFF_MOD);
    xs_t* xs = (xs_t*)(p.ws + OFF_XS); bf16_t* h = (bf16_t*)(p.ws + OFF_H);
    GSTRIDE_BEGIN(idx, (long)T * 256) {
        const int row = (int)(idx >> 8), c4 = (int)(idx & 255) * 4;
        const int b = row / LB, t = row - b * LB;
        const float* src = t < LC ? p.in[I_CTX] + ((size_t)(b * LC + t)) * 1024 : p.in[I_X] + ((size_t)(b * LL + (t - LC))) * 1024;
        const int slot = t < LC ? 8 : b;
        const f32x4 v = *(const f32x4*)(src + c4);
        const f32x4 sh = *(const f32x4*)(mod + (size_t)(slot * 6 + 0) * 1024 + c4), sc = *(const f32x4*)(mod + (size_t)(slot * 6 + 1) * 1024 + c4);
        xs_st4(xs + (size_t)row * 1024 + c4, v);
        const f32x4 hv = v * (sc + 1.0f) + sh;
        u32x2_t o; o[0] = pk2(hv[0], hv[1]); o[1] = pk2(hv[2], hv[3]);
        *(u32x2_t*)(h + (size_t)row * 1024 + c4) = o;
    }
}

__device__ __forceinline__ int winmap(int rho, float& scale) {
    scale = 1.f;
    if (rho < 1568) { if (rho < 256) scale = 0.125f; return rho; }
    if (rho < 1792) return -1;
    if (rho < 2304) scale = 0.125f * 1.4426950408889634f;
    else if (rho >= 3328 && rho < 3840) scale = 0.125f;
    return rho - 224;
}
__device__ __forceinline__ void convert_job(const float* src, const float* src2, int ld, int K, bf16_t* dst, int nrows, int mode, int& itemctr, int dld = 0) {
    if (dld == 0) dld = K;
    const int tid = ltid(), lane = tid & 63, wv = tid >> 6, nwv = (int)gridDim.x * (NTHR / 64), me = (int)blockIdx.x * (NTHR / 64) + wv;
    const int nkc = K >> 6, nitems = (nrows >> 6) * nkc;
    int first = (me - itemctr) % nwv; if (first < 0) first += nwv;
    itemctr = (itemctr + nitems) % nwv;
    for (int it = first; it < nitems; it += nwv) {
        const int rg = it / nkc, kc = it - rg * nkc, rho = rg * 64 + lane, k0 = kc * 64;
        float sc = 1.f; int col; const float* s = src;
        if (mode == 0) col = winmap(rho, sc);
        else if (mode == 1) col = rho;
        else { const int ct = rho >> 8, half = (rho >> 7) & 1, i = rho & 127; col = ct * 128 + i; s = half ? src2 : src; }
        const float* sp = s + (size_t)k0 * ld + (col >= 0 ? col : 0);
        if (col < 0) sc = 0.f;
        bf16_t* dp = dst + (size_t)rho * dld + k0;
#pragma unroll
        for (int k8 = 0; k8 < 8; ++k8) { float v[8];
#pragma unroll
            for (int j = 0; j < 8; ++j) v[j] = sp[(size_t)(k8 * 8 + j) * ld] * sc;
            u32x4_t o; o[0] = pk2(v[0], v[1]); o[1] = pk2(v[2], v[3]); o[2] = pk2(v[4], v[5]); o[3] = pk2(v[6], v[7]);
            *(u32x4_t*)(dp + k8 * 8) = o; }
    }
}
__device__ __forceinline__ void phase_convert(const Params& p, int l, float* lds) {
    (void)lds; int ctr = 0;
    convert_job(p.in[I_WIN] + (size_t)l * 1024 * 7712, nullptr, 7712, 1024, (bf16_t*)(p.ws + OFF_WIN), (int)W_IN_ROWS, 0, ctr);
    for (int n = 0; n < 3; ++n)
        convert_job(p.in[I_WBR] + ((size_t)l * 3 + n) * 512 * 1024, nullptr, 1024, 512, (bf16_t*)(p.ws + OFF_WB) + (size_t)n * 1024 * 512, 1024, 1, ctr);
    convert_job(p.in[I_WO] + (size_t)l * 1024 * 1024, nullptr, 1024, 1024, (bf16_t*)(p.ws + OFF_WO), 1024, 1, ctr);
    for (int e = 0; e < 16; ++e) {
        const size_t eo = ((size_t)l * 16 + e) * 1024 * 512;
        convert_job(p.in[I_WEG] + eo, p.in[I_WEU] + eo, 512, 1024, (bf16_t*)(p.ws + OFF_WUP) + (size_t)e * 1024 * 1024, 1024, 2, ctr);
        convert_job(p.in[I_WED] + eo, nullptr, 1024, 512, (bf16_t*)(p.ws + OFF_WDN) + (size_t)e * 1024 * 512, 1024, 1, ctr);
    }
}

__device__ __forceinline__ void phase_rope_decay(const Params& p, int l, bool commit = true) {
    const float* rope = (const float*)(p.ws + OFF_ROPE);
    GSTRIDE_BEGIN(idx, (long)NB * LL * 2 * 8 * 8) {
        const int i4 = (int)(idx & 7) * 4, hc = (int)(idx >> 3) & 7, which = (int)(idx >> 6) & 1; const int lat = (int)(idx >> 7);
        const int b = lat >> 12, t = lat & 4095; const int row = b * LB + LC + t;
        bf16_t* base = (bf16_t*)(p.ws + (which ? OFF_DK : OFF_DQ)) + (size_t)row * 512 + hc * 64 + i4;
        const u32x2_t a = *(const u32x2_t*)base, bq = *(const u32x2_t*)(base + 32);
        const float x1[4] = {bflo(a[0]), bfhi(a[0]), bflo(a[1]), bfhi(a[1])}, x2[4] = {bflo(bq[0]), bfhi(bq[0]), bflo(bq[1]), bfhi(bq[1])};
        float y1[4], y2[4];
#pragma unroll
        for (int j = 0; j < 4; ++j) { const float cs = rope[((size_t)t * 32 + i4 + j) * 2], sn = rope[((size_t)t * 32 + i4 + j) * 2 + 1];
            y1[j] = x1[j] * cs - x2[j] * sn; y2[j] = x1[j] * sn + x2[j] * cs; }
        u32x2_t o1, o2; o1[0] = pk2(y1[0], y1[1]); o1[1] = pk2(y1[2], y1[3]); o2[0] = pk2(y2[0], y2[1]); o2[1] = pk2(y2[2], y2[3]);
        if (commit) { *(u32x2_t*)base = o1; *(u32x2_t*)(base + 32) = o2; }
    }
#if !FAST_GLA
    const float* gr = (const float*)(p.ws + OFF_GR); float* dec = (float*)(p.ws + OFF_S1);
    const float* wd = p.in[I_GWD] + (size_t)l * 2 * 16 * 256; const float* bd = p.in[I_GBD] + (size_t)l * 2 * 256;
    GSTRIDE_BEGIN(idx, (long)T * 512) {
        const int row = (int)(idx >> 9), dj = (int)(idx & 511), dir = dj >> 8, j = dj & 255;
        float z = bd[dir * 256 + j];
#pragma unroll
        for (int r = 0; r < 16; ++r) z += gr[(size_t)row * 32 + dir * 16 + r] * wd[(dir * 16 + r) * 256 + j];
        const float ls = fminf(z, 0.f) - log1pf(__expf(-fabsf(z)));
        dec[idx] = __expf(ls * (1.0f / 16.0f));
    }
#endif
}

template <int DIR>
__device__ __forceinline__ void gla_naive_dir(const Params& p, int l, int b, float* lds) {
    const int tid = ltid(), hh = tid >> 7, vc = tid & 127, wv = tid >> 6;
    const bf16_t* GQ = (const bf16_t*)(p.ws + OFF_GQ); const bf16_t* GK = (const bf16_t*)(p.ws + OFF_GK); const bf16_t* GV = (const bf16_t*)(p.ws + OFF_GV);
    bf16_t* GG = (bf16_t*)(p.ws + OFF_GG); const float* DEC = (const float*)(p.ws + OFF_S1); float* OF = (float*)(p.ws + OFF_S2);
    float* sq = lds; float* sk = lds + 16 * 256; float* sd = lds + 32 * 256; float* red = lds + 48 * 256;
    float* sv = lds + 49 * 256;
    const float gn = p.in[I_GNG][l * 128 + vc];
    const int row0 = b * LB;
    float S[64];
#pragma unroll
    for (int d = 0; d < 64; ++d) S[d] = 0.f;
    for (int blk = 0; blk < LB / 16; ++blk) {
        int t0;
        if (DIR == 0) t0 = blk * 16; else t0 = blk < 16 ? (15 - blk) * 16 : (LB / 16 - 1 - (blk - 16)) * 16;
        __syncthreads();
        for (int i = tid; i < 16 * 256; i += 512) { const int r = i >> 8, j = i & 255; const size_t row = row0 + t0 + r;
            sq[i] = bf2f(GQ[row * 256 + j]); sk[i] = bf2f(GK[row * 256 + j]); sd[i] = DEC[(row * 2 + DIR) * 256 + j]; }
#pragma unroll 1
        for (int r = 0; r < 16; ++r) sv[r * 512 + tid] = bf2f(GV[(size_t)(row0 + t0 + r) * 512 + hh * 128 + vc]);
        __syncthreads();
#pragma unroll 1
        for (int rr = 0; rr < 16; ++rr) {
            const int r = DIR == 0 ? rr : 15 - rr;
            const float* pq = sq + r * 256 + hh * 64; const float* pk = sk + r * 256 + hh * 64; const float* pd = sd + r * 256 + hh * 64;
            const float vr = sv[r * 512 + tid];
            float o = 0.f;
#pragma unroll
            for (int d = 0; d < 64; ++d) { S[d] = pd[d] * S[d] + pk[d] * vr; o += pq[d] * S[d]; }
            const size_t oi = (size_t)(row0 + t0 + r) * 512 + hh * 128 + vc;
            if (DIR == 0) OF[oi] = o;
            else {
                const float tot = o + OF[oi];
                sv[r * 512 + tid] = tot;
                const float ss = wave_sum(tot * tot); if ((tid & 63) == 0) red[r * 8 + wv] = ss;
            }
        }
        if (DIR == 1) {
            __syncthreads();
#pragma unroll 1
            for (int r = 0; r < 16; ++r) {
                const float ms = (red[r * 8 + hh * 2] + red[r * 8 + hh * 2 + 1]) * (1.0f / 128.0f);
                const size_t gi = (size_t)(row0 + t0 + r) * 512 + hh * 128 + vc;
                const float gate = bf2f(GG[gi]);
                GG[gi] = f2bf(sv[r * 512 + tid] * rsqrtf(ms + RMS_EPS) * gn * siluf_(gate));
            }
        }
    }
    __syncthreads();
}
__device__ __forceinline__ void gla_naive_batch(const Params& p, int l, int b, float* lds) {
    gla_naive_dir<0>(p, l, b, lds);
    gla_naive_dir<1>(p, l, b, lds);
}

__device__ __forceinline__ void diff_naive_tile(const Params& p, int l, int unit, float* lds) {
    const int tid = ltid(), qi = tid & 127, c = (tid >> 7) & 1, hv = tid >> 8;
    const int qt = unit % 34, bh = unit / 34, hh = bh & 3, b = bh >> 2;
    const int nkeys = qt < 2 ? LC : LB;
    const size_t rowq = (size_t)b * LB + qt * 128 + qi;
    bf16_t* DQ = (bf16_t*)(p.ws + OFF_DQ); const bf16_t* DK = (const bf16_t*)(p.ws + OFF_DK); const bf16_t* DV = (const bf16_t*)(p.ws + OFF_DV);
    float q[64], o[64];
    { const bf16_t* qp = DQ + rowq * 512 + hh * 128 + c * 64;
#pragma unroll
      for (int d8 = 0; d8 < 8; ++d8) { const u32x4_t v = *(const u32x4_t*)(qp + d8 * 8);
#pragma unroll
          for (int j = 0; j < 4; ++j) { q[d8 * 8 + 2 * j] = bflo(v[j]); q[d8 * 8 + 2 * j + 1] = bfhi(v[j]); } } }
#pragma unroll
    for (int d = 0; d < 64; ++d) o[d] = 0.f;
    float m = -INFINITY, lsum = 0.f;
    constexpr int KT = 8; float* kb = lds; float* vb = lds + KT * 128;
    for (int k0 = 0; k0 < nkeys; k0 += KT) {
        __syncthreads();
        for (int i = tid; i < KT * 128; i += 512) { const int r = i >> 7, j = i & 127; const size_t row = (size_t)b * LB + k0 + r;
            kb[i] = bf2f(DK[row * 512 + hh * 128 + j]); vb[i] = bf2f(DV[row * 512 + hh * 128 + j]); }
        __syncthreads();
        float s[KT]; float mt = -INFINITY;
#pragma unroll
        for (int j = 0; j < KT; ++j) { const float* kp = kb + j * 128 + c * 64; float a = 0.f;
#pragma unroll
            for (int d = 0; d < 64; ++d) a += q[d] * kp[d];
            s[j] = a; mt = fmaxf(mt, a); }
        const float mn = fmaxf(m, mt), corr = __expf(m - mn);
        lsum *= corr;
#pragma unroll
        for (int d = 0; d < 64; ++d) o[d] *= corr;
#pragma unroll
        for (int j = 0; j < KT; ++j) { const float pj = __expf(s[j] - mn); lsum += pj; const float* vp = vb + j * 128 + hv * 64;
#pragma unroll
            for (int d = 0; d < 64; ++d) o[d] += pj * vp[d]; }
        m = mn;
    }
    __syncthreads();
    { const float inv = 1.f / lsum; float* cp = lds + ((size_t)qi * 2 + c) * 128 + hv * 64;
#pragma unroll
      for (int d = 0; d < 64; ++d) cp[d] = o[d] * inv; }
    __syncthreads();
    {
        float dq = 0.f, dk2 = 0.f; const float* lq = p.in[I_LQ] + l * 128; const float* lk = p.in[I_LK] + l * 128;
        for (int d = 0; d < 64; ++d) { dq += lq[d] * lk[d]; dk2 += lq[64 + d] * lk[64 + d]; }
        const float lam_init = 0.8f - 0.6f * expf(-0.3f * (float)l);
        const float lam = expf(dq) - expf(dk2) + lam_init;
        const int q2 = tid >> 2, part = tid & 3;
        const float* c0 = lds + ((size_t)q2 * 2) * 128 + part * 32; const float* c1 = c0 + 128;
        float v[32]; float ss = 0.f;
#pragma unroll
        for (int d = 0; d < 32; ++d) { v[d] = c0[d] - lam * c1[d]; ss += v[d] * v[d]; }
        ss += __shfl_xor(ss, 1); ss += __shfl_xor(ss, 2);
        const float sc = rsqrtf(ss * (1.0f / 128.0f) + RMS_EPS) * (1.0f - lam_init);
        const float* g = p.in[I_DNG] + l * 128 + part * 32;
        bf16_t* op = DQ + ((size_t)b * LB + qt * 128 + q2) * 512 + hh * 128 + part * 32;
#pragma unroll
        for (int d = 0; d < 32; d += 2) *(unsigned*)(op + d) = pk2(v[d] * sc * g[d], v[d + 1] * sc * g[d + 1]);
    }
    __syncthreads();
}

__device__ __forceinline__ void na_naive_unit(const Params& p, int l, int unit) {
    const int tid = ltid(), h = tid >> 6, lane = tid & 63;
    const size_t row = (size_t)unit * 64 + lane; const int b = (int)(row / LB), t = (int)(row - (size_t)b * LB);
    bf16_t* NQ = (bf16_t*)(p.ws + OFF_NQ); const bf16_t* NK = (const bf16_t*)(p.ws + OFF_NK); const bf16_t* NV = (const bf16_t*)(p.ws + OFF_NV);
    const float* rpb = p.in[I_RPB] + ((size_t)l * 8 + h) * 15 * 31;
    float q[64], o[64];
    { const bf16_t* qp = NQ + row * 512 + h * 64;
#pragma unroll
      for (int d8 = 0; d8 < 8; ++d8) { const u32x4_t v = *(const u32x4_t*)(qp + d8 * 8);
#pragma unroll
          for (int j = 0; j < 4; ++j) { q[d8 * 8 + 2 * j] = bflo(v[j]); q[d8 * 8 + 2 * j + 1] = bfhi(v[j]); } } }
#pragma unroll
    for (int d = 0; d < 64; ++d) o[d] = 0.f;
    float m = -INFINITY, lsum = 0.f;
    const bool lat = t >= LC; const int tp = t - LC, r = tp >> 6, qc = tp & 63;
    const int rs = min(max(r - 4, 0), 56), cs = min(max(qc - 8, 0), 48);
    const int nloc = lat ? 128 : 0;
    for (int kk = 0; kk < nloc + LC; ++kk) {
        size_t krow; float bias = 0.f;
        if (kk < nloc) { const int kr = rs + (kk >> 4), kc = cs + (kk & 15); krow = (size_t)b * LB + LC + kr * 64 + kc; bias = rpb[(kr - r + 7) * 31 + (kc - qc + 15)]; }
        else krow = (size_t)b * LB + (kk - nloc);
        const bf16_t* kp = NK + krow * 512 + h * 64; const bf16_t* vp = NV + krow * 512 + h * 64;
        float s = bias;
#pragma unroll
        for (int d8 = 0; d8 < 8; ++d8) { const u32x4_t v = *(const u32x4_t*)(kp + d8 * 8);
#pragma unroll
            for (int j = 0; j < 4; ++j) { s += q[d8 * 8 + 2 * j] * bflo(v[j]); s += q[d8 * 8 + 2 * j + 1] * bfhi(v[j]); } }
        const float mn = fmaxf(m, s), corr = __expf(m - mn), pj = __expf(s - mn);
        lsum = lsum * corr + pj; m = mn;
#pragma unroll
        for (int d8 = 0; d8 < 8; ++d8) { const u32x4_t v = *(const u32x4_t*)(vp + d8 * 8);
#pragma unroll
            for (int j = 0; j < 4; ++j) { o[d8 * 8 + 2 * j] = o[d8 * 8 + 2 * j] * corr + pj * bflo(v[j]); o[d8 * 8 + 2 * j + 1] = o[d8 * 8 + 2 * j + 1] * corr + pj * bfhi(v[j]); } }
    }
    const float inv = 1.f / lsum;
    bf16_t* op = NQ + row * 512 + h * 64;
#pragma unroll
    for (int d8 = 0; d8 < 8; ++d8) { u32x4_t v;
#pragma unroll
        for (int j = 0; j < 4; ++j) v[j] = pk2(o[d8 * 8 + 2 * j] * inv, o[d8 * 8 + 2 * j + 1] * inv);
        *(u32x4_t*)(op + d8 * 8) = v; }
}

__device__ __forceinline__ void ln_row(float (&v)[16], const float* g, const float* bb, int lane) {
    float s = 0.f;
#pragma unroll
    for (int i = 0; i < 16; ++i) s += v[i];
    const float mu = wave_sum(s) * (1.0f / 1024.0f);
    float q = 0.f;
#pragma unroll
    for (int i = 0; i < 16; ++i) { v[i] -= mu; q += v[i] * v[i]; }
    const float rstd = rsqrtf(wave_sum(q) * (1.0f / 1024.0f) + LN_EPS);
#pragma unroll
    for (int i = 0; i < 4; ++i) { const f32x4 gv = *(const f32x4*)(g + i * 256 + lane * 4), bv = *(const f32x4*)(bb + i * 256 + lane * 4);
#pragma unroll
        for (int j = 0; j < 4; ++j) v[i * 4 + j] = v[i * 4 + j] * rstd * gv[j] + bv[j]; }
}

__device__ __forceinline__ void top2of4(const float s0, const float s1, const float s2, const float s3, int& i1, int& i2, float& sum) {
    i1 = 0; float m1 = s0;
    if (s1 > m1) { m1 = s1; i1 = 1; } if (s2 > m1) { m1 = s2; i1 = 2; } if (s3 > m1) { m1 = s3; i1 = 3; }
    float m2 = -INFINITY; i2 = 0;
    if (i1 != 0 && s0 > m2) { m2 = s0; i2 = 0; } if (i1 != 1 && s1 > m2) { m2 = s1; i2 = 1; }
    if (i1 != 2 && s2 > m2) { m2 = s2; i2 = 2; } if (i1 != 3 && s3 > m2) { m2 = s3; i2 = 3; }
    sum = m1 + m2;
}

__device__ __forceinline__ void phase_ln1_router(const Params& p, int l, float* lds, bool commit = true) {
    const int tid = ltid(), lane = tid & 63, wv = tid >> 6;
    xs_t* xs = (xs_t*)(p.ws + OFF_XS); bf16_t* h = (bf16_t*)(p.ws + OFF_H); const float* mod = (const float*)(p.ws + OFF_MOD);
    int* tok = (int*)(p.ws + OFF_TOK); unsigned* blkcnt = (unsigned*)(p.ws + OFF_BLKCNT);
    const float* g = p.in[I_LNG] + (size_t)(l * 2 + 0) * 1024; const float* bb = p.in[I_LNB] + (size_t)(l * 2 + 0) * 1024;
    const float* wr = p.in[I_WR]; const float* br = p.in[I_BR];
    float* wt = lds; unsigned* lcnt = (unsigned*)(lds + 16 * 1024);
    __syncthreads();
    for (int i = tid; i < 16 * 1024; i += NTHR) { const int col = i >> 4, e = i & 15; wt[e * 1024 + col] = wr[i]; }
    if (tid < 16) lcnt[tid] = 0u;
    __syncthreads();
    const int rpb = (T + (int)gridDim.x - 1) / (int)gridDim.x, r_begin = (int)blockIdx.x * rpb, r_end = min(T, r_begin + rpb);
    for (int row = r_begin + wv; row < r_end; row += NTHR / 64) {
        const int slot = row_slot(row);
        if (l == DEPTH - 1 && slot == 8) continue;
        const float* msh = mod + ((size_t)(l * 9 + slot) * 6 + 3) * 1024; const float* msc = msh + 1024;
        float v[16];
#pragma unroll
        for (int i = 0; i < 4; ++i) { const f32x4 t4 = xs_ld4(xs + (size_t)row * 1024 + i * 256 + lane * 4);
#pragma unroll
            for (int j = 0; j < 4; ++j) v[i * 4 + j] = t4[j]; }
        ln_row(v, g, bb, lane);
        float lg[16];
#pragma unroll
        for (int e = 0; e < 16; ++e) lg[e] = 0.f;
#pragma unroll
        for (int i = 0; i < 4; ++i) {
            const int c0 = i * 256 + lane * 4;
            f32x4 x4; x4[0] = v[i * 4]; x4[1] = v[i * 4 + 1]; x4[2] = v[i * 4 + 2]; x4[3] = v[i * 4 + 3];
            if (commit) xs_st4(xs + (size_t)row * 1024 + c0, x4);
            const f32x4 sh = *(const f32x4*)(msh + c0), sc = *(const f32x4*)(msc + c0);
            const f32x4 hv = x4 * (sc + 1.0f) + sh;
            u32x2_t o; o[0] = pk2(hv[0], hv[1]); o[1] = pk2(hv[2], hv[3]);
            if (commit) *(u32x2_t*)(h + (size_t)row * 1024 + c0) = o;
#pragma unroll
            for (int e = 0; e < 16; ++e) { const f32x4 w4 = *(const f32x4*)(wt + e * 1024 + c0);
                lg[e] += hv[0] * w4[0] + hv[1] * w4[1] + hv[2] * w4[2] + hv[3] * w4[3]; }
        }
        float t8[8], t4[4], t2[2], t1;
        { const bool hi = (lane & 32) != 0;
#pragma unroll
          for (int i = 0; i < 8; ++i) { const float keep = hi ? lg[8 + i] : lg[i], give = hi ? lg[i] : lg[8 + i]; t8[i] = keep + __shfl_xor(give, 32); } }
        { const bool hi = (lane & 16) != 0;
#pragma unroll
          for (int i = 0; i < 4; ++i) { const float keep = hi ? t8[4 + i] : t8[i], give = hi ? t8[i] : t8[4 + i]; t4[i] = keep + __shfl_xor(give, 16); } }
        { const bool hi = (lane & 8) != 0;
#pragma unroll
          for (int i = 0; i < 2; ++i) { const float keep = hi ? t4[2 + i] : t4[i], give = hi ? t4[i] : t4[2 + i]; t2[i] = keep + __shfl_xor(give, 8); } }
        { const bool hi = (lane & 4) != 0; const float keep = hi ? t2[1] : t2[0], give = hi ? t2[0] : t2[1]; t1 = keep + __shfl_xor(give, 4); }
        t1 += __shfl_xor(t1, 2); t1 += __shfl_xor(t1, 1);
        float aff[16], sel[16];
#pragma unroll
        for (int e = 0; e < 16; ++e) { const int src = ((e >> 3) & 1) * 32 + ((e >> 2) & 1) * 16 + ((e >> 1) & 1) * 8 + (e & 1) * 4;
            const float lgt = __builtin_bit_cast(float, __builtin_amdgcn_readlane(__builtin_bit_cast(int, t1), src));
            aff[e] = sigmoidf_(lgt); sel[e] = aff[e] + br[e]; }
        int bi1 = 0, bi2 = 0, bg = 0; float best = -INFINITY;
#pragma unroll
        for (int gq = 0; gq < 4; ++gq) { int i1, i2; float sm; top2of4(sel[gq * 4], sel[gq * 4 + 1], sel[gq * 4 + 2], sel[gq * 4 + 3], i1, i2, sm);
            if (sm > best) { best = sm; bg = gq; bi1 = i1; bi2 = i2; } }
        const int e1 = bg * 4 + bi1, e2 = bg * 4 + bi2;
        float a1 = 0.f, a2 = 0.f;
#pragma unroll
        for (int e = 0; e < 16; ++e) { a1 = (e == e1) ? aff[e] : a1; a2 = (e == e2) ? aff[e] : a2; }
        const float inv = 1.f / (a1 + a2);
        if (lane == 0 && commit) {
            const unsigned s1 = atomicAdd(lcnt + e1, 1u), s2 = atomicAdd(lcnt + e2, 1u);
            int* tp = tok + (size_t)row * 8;
            tp[0] = e1; tp[1] = e2; tp[2] = (int)s1; tp[3] = (int)s2; tp[4] = __float_as_int(a1 * inv); tp[5] = __float_as_int(a2 * inv);
        }
    }
    __syncthreads();
    if (tid < 16 && commit) blkcnt[(size_t)blockIdx.x * 16 + tid] = lcnt[tid];
    __syncthreads();
}

__device__ __forceinline__ void phase_gather(const Params& p, int l, float* lds) {
    const int tid = ltid(), lane = tid & 63, wv = tid >> 6;
    const unsigned* blkcnt = (const unsigned*)(p.ws + OFF_BLKCNT); unsigned* cnt = (unsigned*)(p.ws + OFF_CNT) + l * 16;
    int* sbase = (int*)lds;
    int* pairtok = (int*)(p.ws + OFF_PAIRTOK);
    __syncthreads();
    if (tid < 16) { unsigned tot = 0, pre = 0;
        for (int b2 = 0; b2 < (int)gridDim.x; ++b2) { const unsigned v = blkcnt[(size_t)b2 * 16 + tid]; pre += (b2 < (int)blockIdx.x) ? v : 0u; tot += v; }
        sbase[16 + tid] = (int)tot; sbase[32 + tid] = (int)pre;
        if (blockIdx.x == 0) cnt[tid] = tot; }
    __syncthreads();
    if (tid < 16) { int s = 0; for (int e = 0; e < tid; ++e) s += ((sbase[16 + e] + 255) >> 8) * 256; sbase[48 + tid] = s; sbase[tid] = s + sbase[32 + tid]; }
    __syncthreads();
    if (blockIdx.x == 0) {
        for (int e = 0; e < 16; ++e) { const int lo = sbase[48 + e] + sbase[16 + e], hi = sbase[48 + e] + ((sbase[16 + e] + 255) >> 8) * 256;
            for (int q = lo + tid; q < hi; q += NTHR) pairtok[q] = 0; } }
    int* tok = (int*)(p.ws + OFF_TOK);
    const int rpb = (T + (int)gridDim.x - 1) / (int)gridDim.x, r_begin = (int)blockIdx.x * rpb, r_end = min(T, r_begin + rpb);
    for (int row = r_begin + tid; row < r_end; row += NTHR) {
        if (l == DEPTH - 1 && row_slot(row) == 8) continue;
        int* tp = tok + (size_t)row * 8;
        const int p1 = sbase[tp[0]] + tp[2], p2 = sbase[tp[1]] + tp[3];
        pairtok[p1] = row; pairtok[p2] = row; tp[6] = p1; tp[7] = p2;
    }
    (void)lane; (void)wv;
    __syncthreads();
}

__device__ __forceinline__ void phase_ln2(const Params& p, int l, bool commit = true) {
    const int lane = ltid() & 63, wv = ltid() >> 6, wpb = NTHR >> 6;
    xs_t* xs = (xs_t*)(p.ws + OFF_XS); bf16_t* h = (bf16_t*)(p.ws + OFF_H); const float* mod = (const float*)(p.ws + OFF_MOD);
    const int* tok = (const int*)(p.ws + OFF_TOK); const bf16_t* y = (const bf16_t*)(p.ws + OFF_Y);
    const float* g = p.in[I_LNG] + (size_t)(l * 2 + 1) * 1024; const float* bb = p.in[I_LNB] + (size_t)(l * 2 + 1) * 1024;
    for (int row = blockIdx.x * wpb + wv; row < T; row += gridDim.x * wpb) {
        const int slot = row_slot(row);
        if (l == DEPTH - 1 && slot == 8) continue;
        const int* tp = tok + (size_t)row * 8;
        const float w0 = __int_as_float(tp[4]), w1 = __int_as_float(tp[5]); const size_t p0 = (size_t)tp[6], p1 = (size_t)tp[7];
        const float* mg = mod + ((size_t)(l * 9 + slot) * 6 + 5) * 1024;
        float v[16];
#pragma unroll
        for (int i = 0; i < 4; ++i) { const int c0 = i * 256 + lane * 4;
            const f32x4 x4 = xs_ld4(xs + (size_t)row * 1024 + c0), g4 = *(const f32x4*)(mg + c0);
            const u32x2_t ya = *(const u32x2_t*)(y + p0 * 1024 + c0), yb = *(const u32x2_t*)(y + p1 * 1024 + c0);
            v[i * 4 + 0] = ALPHA * x4[0] + g4[0] * (w0 * bflo(ya[0]) + w1 * bflo(yb[0]));
            v[i * 4 + 1] = ALPHA * x4[1] + g4[1] * (w0 * bfhi(ya[0]) + w1 * bfhi(yb[0]));
            v[i * 4 + 2] = ALPHA * x4[2] + g4[2] * (w0 * bflo(ya[1]) + w1 * bflo(yb[1]));
            v[i * 4 + 3] = ALPHA * x4[3] + g4[3] * (w0 * bfhi(ya[1]) + w1 * bfhi(yb[1])); }
        ln_row(v, g, bb, lane);
        const int b = row / LB, t = row - b * LB;
        if (l == DEPTH - 1) {
            if (t >= LC) { float* op = p.out + ((size_t)b * LL + (t - LC)) * 1024;
#pragma unroll
                for (int i = 0; i < 4; ++i) { f32x4 x4; x4[0] = v[i * 4]; x4[1] = v[i * 4 + 1]; x4[2] = v[i * 4 + 2]; x4[3] = v[i * 4 + 3]; if (commit) *(f32x4*)(op + i * 256 + lane * 4) = x4; } }
        } else {
            const float* msh = mod + ((size_t)((l + 1) * 9 + slot) * 6 + 0) * 1024; const float* msc = msh + 1024;
#pragma unroll
            for (int i = 0; i < 4; ++i) { const int c0 = i * 256 + lane * 4;
                f32x4 x4; x4[0] = v[i * 4]; x4[1] = v[i * 4 + 1]; x4[2] = v[i * 4 + 2]; x4[3] = v[i * 4 + 3];
                if (commit) xs_st4(xs + (size_t)row * 1024 + c0, x4);
                const f32x4 sh = *(const f32x4*)(msh + c0), sc = *(const f32x4*)(msc + c0);
                const f32x4 hv = x4 * (sc + 1.0f) + sh;
                u32x2_t o; o[0] = pk2(hv[0], hv[1]); o[1] = pk2(hv[2], hv[3]);
                if (commit) *(u32x2_t*)(h + (size_t)row * 1024 + c0) = o; }
        }
    }
}

typedef float f32x16 __attribute__((ext_vector_type(16)));
typedef short bf16x8_t __attribute__((ext_vector_type(8)));
constexpr float LOG2E = 1.4426950408889634f;

__device__ __forceinline__ void vtrans_buf(const bf16_t* src, bf16_t* dst, bf16_t* lds) {
    const int tid = ltid();
    constexpr int LS = 72;
    for (int it = blockIdx.x; it < NB * 8 * (LB / 64); it += gridDim.x) {
        const int kt = it % (LB / 64), bc = it / (LB / 64), cg = bc & 7, b = bc >> 3;
        __syncthreads();
        { const int key = tid >> 3, d8 = (tid & 7) * 8;
          const u32x4_t v = *(const u32x4_t*)(src + ((size_t)b * LB + kt * 64 + key) * 512 + cg * 64 + d8);
#pragma unroll
          for (int j = 0; j < 4; ++j) { lds[(d8 + 2 * j) * LS + key] = (bf16_t)(v[j] & 0xffffu); lds[(d8 + 2 * j + 1) * LS + key] = (bf16_t)(v[j] >> 16); } }
        __syncthreads();
        { const int dv = tid >> 3, k8 = (tid & 7) * 8;
          const u32x4_t v = *(const u32x4_t*)(lds + dv * LS + k8);
          *(u32x4_t*)(dst + ((size_t)(b * 512 + cg * 64 + dv)) * LB + kt * 64 + k8) = v; }
    }
    __syncthreads();
}
__device__ __forceinline__ void phase_vtrans(const Params& p, int l, bf16_t* lds) {
    (void)lds;
    { float* bt = (float*)(p.ws + OFF_NBT); const float* rpb = p.in[I_RPB] + (size_t)l * 8 * 15 * 31;
      for (int i = blockIdx.x * NTHR + ltid(); i < 8 * 15 * 4 * 64 * 16; i += gridDim.x * NTHR) {
          const int r = i & 15, lane = (i >> 4) & 63, ib = (i >> 10) & 1, kb = (i >> 11) & 1, hd = i >> 12;
          const int kc = 32 * kb + (r & 3) + 8 * (r >> 2) + 4 * (lane >> 5), qc = 32 * ib + (lane & 31);
          const int cs = min(max(qc - 8, 0), 48);
          bt[i] = (kc >= cs && kc < cs + 16) ? rpb[hd * 31 + (kc - qc + 15)] : -1e30f; } }
}

constexpr int DA_KS = 272, DA_VS = 136, DA_KB = 64 * DA_KS  , DA_VB = 128 * DA_VS  ;
constexpr int DA_UNITS = NB * 4 * 34;
constexpr float DA_THR = 8.0f;
__device__ __forceinline__ void diff_attn_unit(const Params& p, int l, int unit, unsigned char* shm, bool commit = true) {
    const int tid = ltid(), lane = tid & 63, wid = tid >> 6, c = wid & 1, qb = wid >> 1, m32 = lane & 31, h = lane >> 5;
    int bh, qt;
    if (unit < NB * 4 * 32) { bh = (unit >> 8) * 8 + (unit & 7); qt = 2 + ((unit & 255) >> 3); } else { const int u2 = unit - NB * 4 * 32; bh = u2 >> 1; qt = u2 & 1; }
    const int hh = bh & 3, b = bh >> 2, nkt = qt < 2 ? LC / 64 : LB / 64;
    const size_t rowb = (size_t)b * LB;
    bf16_t* DQ = (bf16_t*)(p.ws + OFF_DQ); const bf16_t* DK = (const bf16_t*)(p.ws + OFF_DK); const bf16_t* VT = (const bf16_t*)(p.ws + OFF_VT);
    const size_t qrow = rowb + qt * 128 + qb * 32 + m32;
    bf16x8_t qf[4];
#pragma unroll
    for (int s = 0; s < 4; ++s) qf[s] = *(const bf16x8_t*)(DQ + qrow * 512 + hh * 128 + c * 64 + 16 * s + 8 * h);
    f32x16 O[4];
#pragma unroll
    for (int d = 0; d < 4; ++d)
#pragma unroll
        for (int r = 0; r < 16; ++r) O[d][r] = 0.f;
    float mrun = 0.f, lrun = 0.f;
    f32x16 minit;
#pragma unroll
    for (int r = 0; r < 16; ++r) minit[r] = 0.f;
    const bf16_t* kg[2]; const bf16_t* vg[2]; int kl[2], vl[2];
#pragma unroll
    for (int j = 0; j < 2; ++j) { const int i = tid + j * 512;
        kg[j] = DK + (rowb + (i >> 4)) * 512 + hh * 128 + (i & 15) * 8; kl[j] = (i >> 4) * DA_KS + (i & 15) * 16;
        vg[j] = VT + ((size_t)(bh * 128 + (i >> 3))) * LB + (i & 7) * 8; vl[j] = 2 * DA_KB + (i >> 3) * DA_VS + (i & 7) * 16; }
    u32x4_t rk[2], rv[2];
    __syncthreads();
#pragma unroll
    for (int j = 0; j < 2; ++j) { rk[j] = *(const u32x4_t*)(kg[j]); rv[j] = *(const u32x4_t*)(vg[j]); }
#pragma unroll
    for (int j = 0; j < 2; ++j) { *(u32x4_t*)(shm + kl[j]) = rk[j]; u32x2_t a, bq; a[0] = rv[j][0]; a[1] = rv[j][1]; bq[0] = rv[j][2]; bq[1] = rv[j][3];
        *(u32x2_t*)(shm + vl[j]) = a; *(u32x2_t*)(shm + vl[j] + 8) = bq; }
    __syncthreads();
    for (int kt = 0; kt < nkt; ++kt) {
        const int buf = kt & 1; const bool more = kt + 1 < nkt;
        if (more) {
#pragma unroll
            for (int j = 0; j < 2; ++j) { rk[j] = *(const u32x4_t*)(kg[j] + (size_t)(kt + 1) * 64 * 512); rv[j] = *(const u32x4_t*)(vg[j] + (kt + 1) * 64); }
        }
        const unsigned char* kbase = shm + buf * DA_KB + m32 * DA_KS + (c * 64 + 8 * h) * 2;
        const unsigned char* vbase = shm + 2 * DA_KB + buf * DA_VB + m32 * DA_VS + 8 * h;
        bf16x8_t kf[2][4]; u32x2_t vq[2][4][2];
#pragma unroll
        for (int kb = 0; kb < 2; ++kb)
#pragma unroll
            for (int s = 0; s < 4; ++s) kf[kb][s] = *(const bf16x8_t*)(kbase + kb * 32 * DA_KS + s * 32);
#pragma unroll
        for (int ks = 0; ks < 4; ++ks) { vq[0][ks][0] = *(const u32x2_t*)(vbase + ks * 32); vq[0][ks][1] = *(const u32x2_t*)(vbase + ks * 32 + 16); }
        __builtin_amdgcn_sched_barrier(0);
        bf16x8_t pf[4];
        {
            f32x16 S[2];
#pragma unroll
            for (int kb = 0; kb < 2; ++kb) {
                S[kb] = __builtin_amdgcn_mfma_f32_32x32x16_bf16(kf[kb][0], qf[0], minit, 0, 0, 0);
#pragma unroll
                for (int s = 1; s < 4; ++s) S[kb] = __builtin_amdgcn_mfma_f32_32x32x16_bf16(kf[kb][s], qf[s], S[kb], 0, 0, 0);
            }
            float mx = S[0][0];
#pragma unroll
            for (int r = 1; r < 16; ++r) mx = fmaxf(mx, S[0][r]);
#pragma unroll
            for (int r = 0; r < 16; ++r) mx = fmaxf(mx, S[1][r]);
            { auto rr = __builtin_amdgcn_permlane32_swap(__float_as_uint(mx), __float_as_uint(mx), false, false); mx = fmaxf(__uint_as_float(rr[0]), __uint_as_float(rr[1])); }
            float corr = 1.f;
            if (kt == 0 || !__all(mx <= DA_THR * LOG2E)) { const float dm = kt == 0 ? mx : fmaxf(mx, 0.f); corr = __builtin_amdgcn_exp2f(-dm); mrun += dm;
#pragma unroll
                for (int d = 0; d < 4; ++d)
#pragma unroll
                    for (int r = 0; r < 16; ++r) O[d][r] *= corr;
#pragma unroll
                for (int kb = 0; kb < 2; ++kb)
#pragma unroll
                    for (int r = 0; r < 16; ++r) S[kb][r] -= dm;
#pragma unroll
                for (int r = 0; r < 16; ++r) minit[r] = -mrun; }
            float sum = 0.f;
#pragma unroll
            for (int kb = 0; kb < 2; ++kb)
#pragma unroll
                for (int r = 0; r < 16; ++r) { const float e = __builtin_amdgcn_exp2f(S[kb][r]); S[kb][r] = e; sum += e; }
            { auto rr = __builtin_amdgcn_permlane32_swap(__float_as_uint(sum), __float_as_uint(sum), false, false); sum = __uint_as_float(rr[0]) + __uint_as_float(rr[1]); }
            lrun = lrun * corr + sum;
#pragma unroll
            for (int ks = 0; ks < 4; ++ks) { const int kb = ks >> 1, r0 = (ks & 1) * 8; u32x4_t pk;
#pragma unroll
                for (int j = 0; j < 4; ++j) pk[j] = pk2(S[kb][r0 + 2 * j], S[kb][r0 + 2 * j + 1]);
                pf[ks] = __builtin_bit_cast(bf16x8_t, pk); }
        }
#pragma unroll
        for (int d = 0; d < 4; ++d) {
            if (d < 3) {
#pragma unroll
                for (int ks = 0; ks < 4; ++ks) { vq[(d + 1) & 1][ks][0] = *(const u32x2_t*)(vbase + (d + 1) * 32 * DA_VS + ks * 32); vq[(d + 1) & 1][ks][1] = *(const u32x2_t*)(vbase + (d + 1) * 32 * DA_VS + ks * 32 + 16); }
            }
            __builtin_amdgcn_sched_barrier(0);
#pragma unroll
            for (int ks = 0; ks < 4; ++ks) { u32x4_t vv; vv[0] = vq[d & 1][ks][0][0]; vv[1] = vq[d & 1][ks][0][1]; vv[2] = vq[d & 1][ks][1][0]; vv[3] = vq[d & 1][ks][1][1];
                O[d] = __builtin_amdgcn_mfma_f32_32x32x16_bf16(__builtin_bit_cast(bf16x8_t, vv), pf[ks], O[d], 0, 0, 0); }
        }
        if (more) {
#pragma unroll
            for (int j = 0; j < 2; ++j) { *(u32x4_t*)(shm + (buf ^ 1) * DA_KB + kl[j]) = rk[j]; u32x2_t a, bq; a[0] = rv[j][0]; a[1] = rv[j][1]; bq[0] = rv[j][2]; bq[1] = rv[j][3];
                *(u32x2_t*)(shm + (buf ^ 1) * DA_VB + vl[j]) = a; *(u32x2_t*)(shm + (buf ^ 1) * DA_VB + vl[j] + 8) = bq; }
        }
        __syncthreads();
    }
    float* xch = (float*)shm;
    { const float inv = 1.f / lrun;
#pragma unroll
        for (int d = 0; d < 4; ++d)
#pragma unroll
            for (int r = 0; r < 16; ++r) O[d][r] *= inv; }
    if (c == 1) {
#pragma unroll
        for (int d = 0; d < 4; ++d)
#pragma unroll
            for (int r = 0; r < 16; ++r) xch[(((qb * 4 + d) * 16 + r) << 6) + lane] = O[d][r];
    }
    __syncthreads();
    if (c == 0) {
        float dq = 0.f, dk2 = 0.f; const float* lq = p.in[I_LQ] + l * 128; const float* lk = p.in[I_LK] + l * 128;
        for (int d = 0; d < 64; ++d) { dq += lq[d] * lk[d]; dk2 += lq[64 + d] * lk[64 + d]; }
        const float lam_init = 0.8f - 0.6f * expf(-0.3f * (float)l);
        const float lam = expf(dq) - expf(dk2) + lam_init;
        const float* g = p.in[I_DNG] + l * 128;
        float ss = 0.f;
#pragma unroll
        for (int d = 0; d < 4; ++d)
#pragma unroll
            for (int r = 0; r < 16; ++r) { const float v = O[d][r] - lam * xch[(((qb * 4 + d) * 16 + r) << 6) + lane]; O[d][r] = v; ss += v * v; }
        ss += __shfl_xor(ss, 32);
        const float sc = rsqrtf(ss * (1.0f / 128.0f) + RMS_EPS) * (1.0f - lam_init);
        bf16_t* op = DQ + qrow * 512 + hh * 128 + 4 * h;
#pragma unroll
        for (int d = 0; d < 4; ++d)
#pragma unroll
            for (int r4 = 0; r4 < 4; ++r4) { const int dv = 32 * d + 8 * r4; const f32x4 gv = *(const f32x4*)(g + dv + 4 * h);
                u32x2_t o; o[0] = pk2(O[d][4 * r4] * sc * gv[0], O[d][4 * r4 + 1] * sc * gv[1]); o[1] = pk2(O[d][4 * r4 + 2] * sc * gv[2], O[d][4 * r4 + 3] * sc * gv[3]);
                if (commit) *(u32x2_t*)(op + dv) = o; }
    }
    __syncthreads();
}

constexpr int NA_KS = 528, NA_VS = 136, NA_KB = 64 * NA_KS  , NA_VB = 256 * NA_VS  ;
constexpr int NA_UNITS = NB * 64 * 2 + NB * 4 * 2;
__device__ __forceinline__ void na_attn_unit(const Params& p, int l, int unit, unsigned char* shm, bool commit = true) {
    const int tid = ltid(), lane = tid & 63, wid = tid >> 6, hgi = wid & 3, ib = wid >> 2, m32 = lane & 31, h = lane >> 5;
    int b, hg, r, ntile; size_t rowq0;
    if (unit < NB * 64 * 2) { hg = unit & 1; r = (unit >> 1) & 63; b = unit >> 7; ntile = 12; rowq0 = (size_t)b * LB + LC + r * 64; }
    else { const int u2 = unit - NB * 64 * 2; hg = u2 & 1; r = -1; b = u2 >> 3; ntile = 4; rowq0 = (size_t)b * LB + ((u2 >> 1) & 3) * 64; }
    const int rs = min(max(r - 4, 0), 56), head = hg * 4 + hgi;
    const size_t rowb = (size_t)b * LB;
    bf16_t* NQ = (bf16_t*)(p.ws + OFF_NQ); const bf16_t* NK = (const bf16_t*)(p.ws + OFF_NK); const bf16_t* NVT = (const bf16_t*)(p.ws + OFF_NVT);
    const float* BT = (const float*)(p.ws + OFF_NBT);
    const size_t qrow = rowq0 + ib * 32 + m32;
    bf16x8_t qf[4];
#pragma unroll
    for (int s = 0; s < 4; ++s) qf[s] = *(const bf16x8_t*)(NQ + qrow * 512 + head * 64 + 16 * s + 8 * h);
    f32x16 O[2];
#pragma unroll
    for (int d = 0; d < 2; ++d)
#pragma unroll
        for (int q = 0; q < 16; ++q) O[d][q] = 0.f;
    float mrun = -INFINITY, lrun = 0.f;
    const bf16_t* kg[4]; const bf16_t* vg[4]; int kl[4], vl[4];
#pragma unroll
    for (int j = 0; j < 4; ++j) { const int i = tid + j * 512;
        kg[j] = NK + (rowb + (i >> 5)) * 512 + hg * 256 + (i & 31) * 8; kl[j] = (i >> 5) * NA_KS + (i & 31) * 16;
        vg[j] = NVT + ((size_t)(b * 512 + hg * 256 + (i >> 3))) * LB + (i & 7) * 8; vl[j] = 2 * NA_KB + (i >> 3) * NA_VS + (i & 7) * 16; }
    auto tile_of = [&](int t) -> int { return ntile == 12 ? (t < 8 ? 4 + rs + t : t - 8) : t; };
    u32x4_t rk[4], rv[4];
    __syncthreads();
    { const int tt = tile_of(0);
#pragma unroll
      for (int j = 0; j < 4; ++j) { rk[j] = *(const u32x4_t*)(kg[j] + (size_t)tt * 64 * 512); rv[j] = *(const u32x4_t*)(vg[j] + tt * 64); } }
#pragma unroll
    for (int j = 0; j < 4; ++j) { *(u32x4_t*)(shm + kl[j]) = rk[j]; u32x2_t a, bq; a[0] = rv[j][0]; a[1] = rv[j][1]; bq[0] = rv[j][2]; bq[1] = rv[j][3];
        *(u32x2_t*)(shm + vl[j]) = a; *(u32x2_t*)(shm + vl[j] + 8) = bq; }
    __syncthreads();
    for (int t = 0; t < ntile; ++t) {
        const int buf = t & 1; const bool more = t + 1 < ntile;
        if (more) { const int tt = tile_of(t + 1);
#pragma unroll
            for (int j = 0; j < 4; ++j) { rk[j] = *(const u32x4_t*)(kg[j] + (size_t)tt * 64 * 512); rv[j] = *(const u32x4_t*)(vg[j] + tt * 64); }
        }
        const unsigned char* kbase = shm + buf * NA_KB + m32 * NA_KS + (hgi * 64 + 8 * h) * 2;
        const unsigned char* vbase = shm + 2 * NA_KB + buf * NA_VB + (hgi * 64 + m32) * NA_VS + 8 * h;
        bf16x8_t pf[4];
        {
            bf16x8_t kf[2][4];
#pragma unroll
            for (int kb = 0; kb < 2; ++kb)
#pragma unroll
                for (int s = 0; s < 4; ++s) kf[kb][s] = *(const bf16x8_t*)(kbase + kb * 32 * NA_KS + s * 32);
            f32x16 S[2];
            const bool local = (ntile == 12) && (t < 8);
            if (local) { const int dr = rs + t - r + 7; const float* bp = BT + ((size_t)(((head * 15 + dr) * 2) * 2 + ib) * 64 + lane) * 16;
#pragma unroll
                for (int kb = 0; kb < 2; ++kb)
#pragma unroll
                    for (int q4 = 0; q4 < 4; ++q4) { const f32x4 bv = *(const f32x4*)(bp + kb * 2 * 64 * 16 + q4 * 4);
                        S[kb][q4 * 4] = bv[0]; S[kb][q4 * 4 + 1] = bv[1]; S[kb][q4 * 4 + 2] = bv[2]; S[kb][q4 * 4 + 3] = bv[3]; }
            } else {
#pragma unroll
                for (int kb = 0; kb < 2; ++kb)
#pragma unroll
                    for (int q = 0; q < 16; ++q) S[kb][q] = 0.f;
            }
#pragma unroll
            for (int kb = 0; kb < 2; ++kb)
#pragma unroll
                for (int s = 0; s < 4; ++s) S[kb] = __builtin_amdgcn_mfma_f32_32x32x16_bf16(kf[kb][s], qf[s], S[kb], 0, 0, 0);
            float mx = S[0][0];
#pragma unroll
            for (int q = 1; q < 16; ++q) mx = fmaxf(mx, S[0][q]);
#pragma unroll
            for (int q = 0; q < 16; ++q) mx = fmaxf(mx, S[1][q]);
            { auto rr = __builtin_amdgcn_permlane32_swap(__float_as_uint(mx), __float_as_uint(mx), false, false); mx = fmaxf(__uint_as_float(rr[0]), __uint_as_float(rr[1])); }
            float corr = 1.f;
            if (!__all(mx - mrun <= DA_THR)) { const float mn = fmaxf(mrun, mx); corr = __builtin_amdgcn_exp2f((mrun - mn) * LOG2E); mrun = mn;
#pragma unroll
                for (int d = 0; d < 2; ++d)
#pragma unroll
                    for (int q = 0; q < 16; ++q) O[d][q] *= corr; }
            const float mnl = mrun * LOG2E;
            float sum = 0.f;
#pragma unroll
            for (int kb = 0; kb < 2; ++kb)
#pragma unroll
                for (int q = 0; q < 16; ++q) { const float e = __builtin_amdgcn_exp2f(S[kb][q] * LOG2E - mnl); S[kb][q] = e; sum += e; }
            { auto rr = __builtin_amdgcn_permlane32_swap(__float_as_uint(sum), __float_as_uint(sum), false, false); sum = __uint_as_float(rr[0]) + __uint_as_float(rr[1]); }
            lrun = lrun * corr + sum;
#pragma unroll
            for (int ks = 0; ks < 4; ++ks) { const int kb = ks >> 1, r0 = (ks & 1) * 8; u32x4_t pk;
#pragma unroll
                for (int j = 0; j < 4; ++j) pk[j] = pk2(S[kb][r0 + 2 * j], S[kb][r0 + 2 * j + 1]);
                pf[ks] = __builtin_bit_cast(bf16x8_t, pk); }
        }
        { u32x2_t vq[2][4][2];
#pragma unroll
          for (int d = 0; d < 2; ++d)
#pragma unroll
              for (int ks = 0; ks < 4; ++ks) { vq[d][ks][0] = *(const u32x2_t*)(vbase + d * 32 * NA_VS + ks * 32); vq[d][ks][1] = *(const u32x2_t*)(vbase + d * 32 * NA_VS + ks * 32 + 16); }
          __builtin_amdgcn_sched_barrier(0);
#pragma unroll
          for (int d = 0; d < 2; ++d)
#pragma unroll
              for (int ks = 0; ks < 4; ++ks) { u32x4_t vv; vv[0] = vq[d][ks][0][0]; vv[1] = vq[d][ks][0][1]; vv[2] = vq[d][ks][1][0]; vv[3] = vq[d][ks][1][1];
                  O[d] = __builtin_amdgcn_mfma_f32_32x32x16_bf16(__builtin_bit_cast(bf16x8_t, vv), pf[ks], O[d], 0, 0, 0); } }
        if (more) {
#pragma unroll
            for (int j = 0; j < 4; ++j) { *(u32x4_t*)(shm + (buf ^ 1) * NA_KB + kl[j]) = rk[j]; u32x2_t a, bq; a[0] = rv[j][0]; a[1] = rv[j][1]; bq[0] = rv[j][2]; bq[1] = rv[j][3];
                *(u32x2_t*)(shm + (buf ^ 1) * NA_VB + vl[j]) = a; *(u32x2_t*)(shm + (buf ^ 1) * NA_VB + vl[j] + 8) = bq; }
        }
        __syncthreads();
    }
    { const float inv = 1.f / lrun; bf16_t* op = NQ + qrow * 512 + head * 64 + 4 * h;
#pragma unroll
        for (int d = 0; d < 2; ++d)
#pragma unroll
            for (int r4 = 0; r4 < 4; ++r4) { u32x2_t o; o[0] = pk2(O[d][4 * r4] * inv, O[d][4 * r4 + 1] * inv); o[1] = pk2(O[d][4 * r4 + 2] * inv, O[d][4 * r4 + 3] * inv);
                if (commit) *(u32x2_t*)(op + 32 * d + 8 * r4) = o; } }
    __syncthreads();
}

constexpr int GL_XS = 144;
__device__ __forceinline__ void gla_stage_gr(const Params& p, int row0, float* grs, int tid) {
    const float* gr = (const float*)(p.ws + OFF_GR);
    __syncthreads();
    *(f32x4*)(grs + tid * 4) = *(const f32x4*)(gr + (size_t)row0 * 32 + tid * 4);
    __syncthreads();
}
struct GlaCol { float w[16]; float bcol; };
__device__ __forceinline__ void gla_col_init(const Params& p, int l, int hh, int dir, int lane, GlaCol& gc) {
    const int col = hh * 64 + lane;
    const float* wd = p.in[I_GWD] + ((size_t)(l * 2 + dir) * 16) * 256 + col;
#pragma unroll
    for (int i = 0; i < 16; ++i) gc.w[i] = wd[i * 256];
    gc.bcol = p.in[I_GBD][(size_t)(l * 2 + dir) * 256 + col];
}
__device__ __forceinline__ float gla_logd(const GlaCol& gc, const float* grs, int r, int dir) {
    const float* gp = grs + r * 32 + dir * 16;
    float z = gc.bcol;
#pragma unroll
    for (int i4 = 0; i4 < 4; ++i4) { const f32x4 g4 = *(const f32x4*)(gp + i4 * 4);
        z += g4[0] * gc.w[i4 * 4] + g4[1] * gc.w[i4 * 4 + 1] + g4[2] * gc.w[i4 * 4 + 2] + g4[3] * gc.w[i4 * 4 + 3]; }
    return (fminf(z, 0.f) - 0.6931471805599453f * __builtin_amdgcn_logf(1.f + __builtin_amdgcn_exp2f(-fabsf(z) * LOG2E))) * (1.0f / 16.0f);
}
__device__ __forceinline__ float gla_total(const GlaCol& gc, const float* grs, int dir) {
    float run = 0.f;
#pragma unroll 4
    for (int r = 0; r < 64; ++r) run += gla_logd(gc, grs, r, dir);
    return run;
}

__device__ __forceinline__ void gla_a_unit(const Params& p, int l, int unit, unsigned char* shm) {
    const int tid = ltid(), lane = tid & 63, wid = tid >> 6, hh = wid >> 1, dir = wid & 1, m32 = lane & 31, h = lane >> 5;
    const int b = unit / 68, n = unit - b * 68; const int row0 = b * LB + n * 64; const int bhd = (b * 4 + hh) * 2 + dir;
    float* grs = (float*)shm; unsigned char* kt = shm + 8192 + wid * 18432;
    unsigned char* kraw = kt + 9216;
    gla_stage_gr(p, row0, grs, tid);
    {
        const bf16_t* gk = (const bf16_t*)(p.ws + OFF_GK) + (size_t)row0 * 256 + hh * 64;
        u32x4_t t8[8];
#pragma unroll
        for (int i = 0; i < 8; ++i) t8[i] = *(const u32x4_t*)(gk + (size_t)(8 * i + (lane >> 3)) * 256 + (lane & 7) * 8);
#pragma unroll
        for (int i = 0; i < 8; ++i) *(u32x4_t*)(kraw + (8 * i + (lane >> 3)) * GL_XS + (lane & 7) * 16) = t8[i];
    }
    {
        GlaCol gc; gla_col_init(p, l, hh, dir, lane, gc);
        const float last = gla_total(gc, grs, dir);
        ((float*)(p.ws + OFF_DECAY))[((size_t)bhd * 68 + n) * 64 + lane] = __expf(last);
        asm volatile("s_waitcnt lgkmcnt(0)" ::: "memory"); __builtin_amdgcn_wave_barrier();
        float run = 0.f;
#pragma unroll 4
        for (int r = 0; r < 64; ++r) { const float ex = run; run += gla_logd(gc, grs, r, dir);
            const float c = dir ? last - ex : run;
            *(bf16_t*)(kt + lane * GL_XS + r * 2) = f2bf(bf2f(*(const bf16_t*)(kraw + r * GL_XS + lane * 2)) * __expf(last - c)); }
    }
    asm volatile("s_waitcnt lgkmcnt(0)" ::: "memory"); __builtin_amdgcn_wave_barrier();
    f32x16 acc[2][4];
#pragma unroll
    for (int mb = 0; mb < 2; ++mb)
#pragma unroll
        for (int nb = 0; nb < 4; ++nb)
#pragma unroll
            for (int r = 0; r < 16; ++r) acc[mb][nb][r] = 0.f;
    const bf16_t* gvt = (const bf16_t*)(p.ws + OFF_GVT) + ((size_t)(b * 512 + hh * 128 + m32)) * LB + n * 64 + 8 * h;
#pragma unroll
    for (int s = 0; s < 4; ++s) {
        bf16x8_t af[2], bfr[4];
#pragma unroll
        for (int mb = 0; mb < 2; ++mb) af[mb] = *(const bf16x8_t*)(kt + (32 * mb + m32) * GL_XS + (16 * s + 8 * h) * 2);
#pragma unroll
        for (int nb = 0; nb < 4; ++nb) bfr[nb] = *(const bf16x8_t*)(gvt + (size_t)(32 * nb) * LB + 16 * s);
#pragma unroll
        for (int mb = 0; mb < 2; ++mb)
#pragma unroll
            for (int nb = 0; nb < 4; ++nb) acc[mb][nb] = __builtin_amdgcn_mfma_f32_32x32x16_bf16(af[mb], bfr[nb], acc[mb][nb], 0, 0, 0);
    }
    bf16_t* kv = (bf16_t*)(p.ws + OFF_KV) + (((size_t)bhd * 68 + n) * 128 + m32) * 64 + 4 * h;
#pragma unroll
    for (int mb = 0; mb < 2; ++mb)
#pragma unroll
        for (int nb = 0; nb < 4; ++nb)
#pragma unroll
            for (int r4 = 0; r4 < 4; ++r4) { u32x2_t o; o[0] = pk2(acc[mb][nb][4 * r4], acc[mb][nb][4 * r4 + 1]); o[1] = pk2(acc[mb][nb][4 * r4 + 2], acc[mb][nb][4 * r4 + 3]);
                *(u32x2_t*)(kv + (size_t)(32 * nb) * 64 + 32 * mb + 8 * r4) = o; }
}

__device__ __forceinline__ void gla_scan(const Params& p, bool commit = true) {
    bf16_t* kv = (bf16_t*)(p.ws + OFF_KV); const float* dec = (const float*)(p.ws + OFF_DECAY);
    for (int gid = blockIdx.x * NTHR + ltid(); gid < 64 * 128 * 16; gid += gridDim.x * NTHR) {
        const int dk4 = gid & 15, dv = (gid >> 4) & 127, bhd = gid >> 11, dir = bhd & 1;
        f32x4 s = {0.f, 0.f, 0.f, 0.f};
        for (int step = 0; step < 68; ++step) {
            const int ch = dir == 0 ? step : (step < 4 ? 3 - step : 71 - step);
            u32x2_t* ptr = (u32x2_t*)(kv + (((size_t)bhd * 68 + ch) * 128 + dv) * 64 + dk4 * 4);
            const u32x2_t kvv = *ptr; const f32x4 d4 = *(const f32x4*)(dec + ((size_t)bhd * 68 + ch) * 64 + dk4 * 4);
            u32x2_t o; o[0] = pk2(s[0], s[1]); o[1] = pk2(s[2], s[3]); if (commit) *ptr = o;
            s[0] = d4[0] * s[0] + bflo(kvv[0]); s[1] = d4[1] * s[1] + bfhi(kvv[0]); s[2] = d4[2] * s[2] + bflo(kvv[1]); s[3] = d4[3] * s[3] + bfhi(kvv[1]);
        }
    }
}

__device__ __forceinline__ void gla_c_unit(const Params& p, int l, int unit, unsigned char* shm, bool commit = true) {
    const int tid = ltid(), lane = tid & 63, wid = tid >> 6, hh = wid >> 1, dir = wid & 1, m32 = lane & 31, h = lane >> 5;
    const int b = unit / 68, n = unit - b * 68; const int row0 = b * LB + n * 64; const int bhd = (b * 4 + hh) * 2 + dir;
    float* grs = (float*)shm; unsigned char* xq = shm + 8192 + wid * 18432; unsigned char* yk = xq + 9216;
    gla_stage_gr(p, row0, grs, tid);
    {
        GlaCol gc; gla_col_init(p, l, hh, dir, lane, gc);
        {
            const bf16_t* gq = (const bf16_t*)(p.ws + OFF_GQ) + (size_t)row0 * 256 + hh * 64;
            const bf16_t* gk = (const bf16_t*)(p.ws + OFF_GK) + (size_t)row0 * 256 + hh * 64;
            u32x4_t tq[8], tk[8];
#pragma unroll
            for (int i = 0; i < 8; ++i) { tq[i] = *(const u32x4_t*)(gq + (size_t)(8 * i + (lane >> 3)) * 256 + (lane & 7) * 8); tk[i] = *(const u32x4_t*)(gk + (size_t)(8 * i + (lane >> 3)) * 256 + (lane & 7) * 8); }
#pragma unroll
            for (int i = 0; i < 8; ++i) { *(u32x4_t*)(xq + (8 * i + (lane >> 3)) * GL_XS + (lane & 7) * 16) = tq[i]; *(u32x4_t*)(yk + (8 * i + (lane >> 3)) * GL_XS + (lane & 7) * 16) = tk[i]; }
        }
        const float last = gla_total(gc, grs, dir);
        asm volatile("s_waitcnt lgkmcnt(0)" ::: "memory"); __builtin_amdgcn_wave_barrier();
        float run = 0.f;
#pragma unroll 4
        for (int r = 0; r < 64; ++r) { const float ex = run; run += gla_logd(gc, grs, r, dir);
            const float c = dir ? last - ex : run;
            bf16_t* xp = (bf16_t*)(xq + r * GL_XS + lane * 2); bf16_t* yp = (bf16_t*)(yk + r * GL_XS + lane * 2);
            *xp = f2bf(bf2f(*xp) * __expf(c)); *yp = f2bf(bf2f(*yp) * __expf(-c)); }
    }
    asm volatile("s_waitcnt lgkmcnt(0)" ::: "memory"); __builtin_amdgcn_wave_barrier();
    const unsigned char* xrd = xq + m32 * GL_XS + 16 * h;
    f32x16 O[4][2];
#pragma unroll
    for (int d = 0; d < 4; ++d)
#pragma unroll
        for (int ib = 0; ib < 2; ++ib)
#pragma unroll
            for (int r = 0; r < 16; ++r) O[d][ib][r] = 0.f;
    { const bf16_t* sp = (const bf16_t*)(p.ws + OFF_KV) + (((size_t)bhd * 68 + n) * 128 + m32) * 64 + 8 * h;
#pragma unroll
      for (int s = 0; s < 4; ++s) {
          asm volatile("" ::: "memory");
          bf16x8_t sf[4];
#pragma unroll
          for (int d = 0; d < 4; ++d) sf[d] = *(const bf16x8_t*)(sp + (size_t)(32 * d) * 64 + 16 * s);
#pragma unroll
          for (int ib = 0; ib < 2; ++ib) { const bf16x8_t xf = *(const bf16x8_t*)(xrd + 32 * ib * GL_XS + 32 * s);
#pragma unroll
              for (int d = 0; d < 4; ++d) O[d][ib] = __builtin_amdgcn_mfma_f32_32x32x16_bf16(sf[d], xf, O[d][ib], 0, 0, 0); } } }
    const bf16_t* gvt = (const bf16_t*)(p.ws + OFF_GVT) + ((size_t)(b * 512 + hh * 128 + m32)) * LB + n * 64 + 4 * h;
#pragma unroll
    for (int jb = 0; jb < 2; ++jb)
#pragma unroll
        for (int ib = 0; ib < 2; ++ib) {
            if (jb != ib && ((jb > ib) != (dir == 1))) continue;
            f32x16 A;
#pragma unroll
            for (int r = 0; r < 16; ++r) A[r] = 0.f;
#pragma unroll
            for (int s = 0; s < 4; ++s) { const bf16x8_t kf = *(const bf16x8_t*)(yk + (32 * jb + m32) * GL_XS + (16 * s + 8 * h) * 2);
                const bf16x8_t xf = *(const bf16x8_t*)(xrd + 32 * ib * GL_XS + 32 * s);
                A = __builtin_amdgcn_mfma_f32_32x32x16_bf16(kf, xf, A, 0, 0, 0); }
            if (jb == ib) {
#pragma unroll
                for (int r = 0; r < 16; ++r) { const int jj = (r & 3) + 8 * (r >> 2) + 4 * h; const bool keep = dir ? (jj >= m32) : (jj <= m32); A[r] = keep ? A[r] : 0.f; }
            }
#pragma unroll
            for (int s2 = 0; s2 < 2; ++s2) { asm volatile("" ::: "memory"); u32x4_t pk;
#pragma unroll
                for (int j = 0; j < 4; ++j) pk[j] = pk2(A[s2 * 8 + 2 * j], A[s2 * 8 + 2 * j + 1]);
                const bf16x8_t pf = __builtin_bit_cast(bf16x8_t, pk);
#pragma unroll
                for (int d = 0; d < 4; ++d) { const bf16_t* vp = gvt + (size_t)(32 * d) * LB + 32 * jb + 16 * s2;
                    const u32x2_t v0 = *(const u32x2_t*)vp, v1 = *(const u32x2_t*)(vp + 8);
                    u32x4_t vv; vv[0] = v0[0]; vv[1] = v0[1]; vv[2] = v1[0]; vv[3] = v1[1];
                    O[d][ib] = __builtin_amdgcn_mfma_f32_32x32x16_bf16(__builtin_bit_cast(bf16x8_t, vv), pf, O[d][ib], 0, 0, 0); } }
        }
    __syncthreads();
    float* xch = (float*)(shm + 8192);
    if (dir == 1) {
#pragma unroll
        for (int d = 0; d < 4; ++d)
#pragma unroll
            for (int ib = 0; ib < 2; ++ib)
#pragma unroll
                for (int r = 0; r < 16; ++r) xch[((((hh * 4 + d) * 2 + ib) * 16 + r) << 6) + lane] = O[d][ib][r];
    }
    __syncthreads();
    if (dir == 0) {
        const float* gn = p.in[I_GNG] + l * 128;
        bf16_t* gg = (bf16_t*)(p.ws + OFF_GG);
#pragma unroll
        for (int ib = 0; ib < 2; ++ib) {
            float ss = 0.f;
#pragma unroll
            for (int d = 0; d < 4; ++d) {
                asm volatile("" ::: "memory");
#pragma unroll
                for (int r = 0; r < 16; ++r) { const float v = O[d][ib][r] + xch[((((hh * 4 + d) * 2 + ib) * 16 + r) << 6) + lane]; O[d][ib][r] = v; ss += v * v; } }
            ss += __shfl_xor(ss, 32);
            const float sc = rsqrtf(ss * (1.0f / 128.0f) + RMS_EPS);
            bf16_t* op = gg + (size_t)(row0 + 32 * ib + m32) * 512 + hh * 128 + 4 * h;
#pragma unroll
            for (int d = 0; d < 4; ++d)
#pragma unroll
                for (int r4 = 0; r4 < 4; ++r4) { asm volatile("" ::: "memory"); const int dv = 32 * d + 8 * r4; const f32x4 gv = *(const f32x4*)(gn + dv + 4 * h);
                    const u32x2_t gt = *(const u32x2_t*)(op + dv);
                    u32x2_t o; o[0] = pk2(O[d][ib][4 * r4] * sc * gv[0] * siluf_(bflo(gt[0])), O[d][ib][4 * r4 + 1] * sc * gv[1] * siluf_(bfhi(gt[0])));
                    o[1] = pk2(O[d][ib][4 * r4 + 2] * sc * gv[2] * siluf_(bflo(gt[1])), O[d][ib][4 * r4 + 3] * sc * gv[3] * siluf_(bfhi(gt[1])));
                    if (commit) *(u32x2_t*)(op + dv) = o; }
        }
    }
    __syncthreads();
}

enum { PH_MOD = 0, PH_INIT, PH_CONVERT, PH_INPROJ, PH_ROPEDEC, PH_MIX_GLA, PH_MIX_DIFF, PH_MIX_NA, PH_VTRANS, PH_DIFF, PH_NA, PH_GLA_A, PH_GLA_SCAN, PH_GLA_C, PH_GATES, PH_MERGE, PH_WO, PH_LN1, PH_GATHER, PH_UP, PH_DOWN, PH_LN2, PH_COUNT };

template <class Epi, class Sched>
__device__ __forceinline__ void run_gemm(PG8_LAS unsigned char* lds, const void* A, const void* Bt, int K, const Sched& S, const Epi& E, const int* gidx = nullptr) {
    pg8::Gemm g; g.A = (const pg8::bf16_t*)A; g.Bt = (const pg8::bf16_t*)Bt; g.M = 0; g.N = 0; g.K = K; g.gidx = gidx;
    pg8::gemm_phase<Epi, Sched, false>(lds, g, S, E, nullptr);
}

#ifndef PHASE_INLINE
#define PHASE_INLINE __forceinline__
#endif
template <int PH>
__device__ PHASE_INLINE void run_phase(const Params& p0, int l, unsigned char* shm, bool force_dry = false) {
    Params p;
#if defined(__HIP_DEVICE_COMPILE__)
    (void)p0;
    { const __attribute__((address_space(4))) Params* kp = (const __attribute__((address_space(4))) Params*)__builtin_amdgcn_kernarg_segment_ptr();
      asm volatile("" : "+s"(kp));
#pragma unroll
      for (int i = 0; i < 23; ++i) p.in[i] = (const float*)(const __attribute__((address_space(1))) float*)kp->in[i];
      p.out = (float*)(__attribute__((address_space(1))) float*)kp->out; p.ws = (char*)(__attribute__((address_space(1))) char*)kp->ws; }
#else
    p = p0;
#endif
#ifdef SKIP_MASK
    if constexpr ((SKIP_MASK >> PH) & 1) return;
#endif
#ifdef PROBE_MASK
    constexpr int probe_reps = ((PROBE_MASK >> PH) & 1) ? 2 : 1;
#else
    constexpr int probe_reps = 1;
#endif
#pragma unroll 1
    for (int probe_rep = 0; probe_rep < probe_reps; ++probe_rep) {
    PG8_LAS unsigned char* lds = (PG8_LAS unsigned char*)shm;
    float* ldsf = (float*)shm;
    const int G = gridDim.x, c = blockIdx.x;
    bool commit = true;
    const bool lastl = (l == DEPTH - 1);
    if (force_dry) commit = (*(volatile const unsigned*)(p.ws + OFF_CNT + 2048) != 0u);
    if (probe_reps > 1 && probe_rep == 0) commit = (*(volatile const unsigned*)(p.ws + OFF_CNT + 2048) != 0u);
    if constexpr (PH == PH_MOD) phase_mod(p, ldsf);
    else if constexpr (PH == PH_INIT) phase_init(p);
    else if constexpr (PH == PH_CONVERT) phase_convert(p, l, ldsf);
    else if constexpr (PH == PH_INPROJ) { SchedGrid S{NPANEL, 19, 0, G, c, false}; EpiInProj E{p.ws}; run_gemm(lds, p.ws + OFF_H, p.ws + OFF_WIN, 1024, S, E); }
    else if constexpr (PH == PH_ROPEDEC) phase_rope_decay(p, l, commit);
    else if constexpr (PH == PH_MIX_GLA) { for (int u = blockIdx.x; u < NB; u += gridDim.x) gla_naive_batch(p, l, u, ldsf); }
    else if constexpr (PH == PH_MIX_DIFF) { for (int u = blockIdx.x; u < NB * 4 * 34; u += gridDim.x) diff_naive_tile(p, l, u, ldsf); }
    else if constexpr (PH == PH_MIX_NA) { for (int u = blockIdx.x; u < T / 64; u += gridDim.x) na_naive_unit(p, l, u); }
    else if constexpr (PH == PH_VTRANS) phase_vtrans(p, l, (bf16_t*)shm);
    else if constexpr (PH == PH_DIFF) { for (int u = blockIdx.x; u < (lastl ? NB * 4 * 32 : DA_UNITS); u += gridDim.x) diff_attn_unit(p, l, u, shm, commit); }
    else if constexpr (PH == PH_NA) { for (int u = blockIdx.x; u < (lastl ? NB * 64 * 2 : NA_UNITS); u += gridDim.x) na_attn_unit(p, l, u, shm, commit); }
#if FAST_GLA
    else if constexpr (PH == PH_GLA_A) { for (int u = blockIdx.x; u < NB * 68; u += gridDim.x) gla_a_unit(p, l, u, shm); }
    else if constexpr (PH == PH_GLA_SCAN) gla_scan(p, commit);
    else if constexpr (PH == PH_GLA_C) { if (lastl) { for (int u = blockIdx.x; u < NB * 64; u += gridDim.x) gla_c_unit(p, l, (u >> 6) * 68 + 4 + (u & 63), shm, commit); }
        else { for (int u = blockIdx.x; u < NB * 68; u += gridDim.x) gla_c_unit(p, l, u, shm, commit); } }
#endif
    else if constexpr (PH == PH_GATES) { SchedGrid S{lastl ? NB * 16 : NPANEL, 12, 19, G, c, lastl}; EpiGates E{p.ws}; run_gemm(lds, p.ws + OFF_H, p.ws + OFF_WIN, 1024, S, E); }
    else if constexpr (PH == PH_MERGE) { SchedMerge S{G, c, lastl}; EpiMerge E{p.ws}; run_gemm(lds, p.ws + OFF_BR, p.ws + OFF_WB, 512, S, E); }
    else if constexpr (PH == PH_WO) { SchedGrid S{lastl ? NB * 16 : NPANEL, 4, 0, G, c, lastl}; EpiWo E{p.ws, l, commit}; run_gemm(lds, p.ws + OFF_H, p.ws + OFF_WO, 1024, S, E); }
    else if constexpr (PH == PH_LN1) phase_ln1_router(p, l, ldsf, commit);
    else if constexpr (PH == PH_GATHER) phase_gather(p, l, ldsf);
    else if constexpr (PH == PH_UP) { SchedMoe S; S.init((const unsigned*)(p.ws + OFF_CNT) + l * 16, G, c); EpiUp E{p.ws}; run_gemm(lds, p.ws + OFF_H, p.ws + OFF_WUP, 1024, S, E, (const int*)(p.ws + OFF_PAIRTOK)); }
    else if constexpr (PH == PH_DOWN) { SchedMoe S; S.init((const unsigned*)(p.ws + OFF_CNT) + l * 16, G, c); EpiDown E{p.ws}; run_gemm(lds, p.ws + OFF_ACT, p.ws + OFF_WDN, 512, S, E); }
    else if constexpr (PH == PH_LN2) phase_ln2(p, l, commit);
    }
}

#ifdef PROBE_SLOT
#ifndef PROBE_MULT
#define PROBE_MULT 5
#endif
#define XBAR(b, slot) do { xcd_barrier(b); if (blockIdx.x == 0 && threadIdx.x == 0) { volatile LAS unsigned long long* tw = (volatile LAS unsigned long long*)(shm + LDS_XBW + 16); \
    const unsigned long long now_ = wall_clock64(); if ((slot) == PROBE_SLOT) tw[1] += now_ - tw[0]; tw[0] = now_; } } while (0)
#else
#define XBAR(b, slot) xcd_barrier(b)
#endif
#if !MEGA
template <int PH>
__global__ void __launch_bounds__(512, 2) k_phase(Params p, int l) {
    extern __shared__ __attribute__((aligned(16))) unsigned char shm[];
    run_phase<PH>(p, l, shm);
}
template <int PH> static void launch_phase(const Params& p, int l, hipStream_t st) {
    static bool attr = false;
    if (!attr) { (void)hipFuncSetAttribute((const void*)k_phase<PH>, hipFuncAttributeMaxDynamicSharedMemorySize, LDS_BYTES); attr = true; }
    hipLaunchKernelGGL((k_phase<PH>), dim3(256), dim3(NTHR), LDS_BYTES, st, p, l);
}
#else
__global__ void __launch_bounds__(512, 2) k_mega(Params p) {
    extern __shared__ __attribute__((aligned(16))) unsigned char shm[];
    volatile LAS unsigned* xbw = (volatile LAS unsigned*)(shm + LDS_XBW);
    if (threadIdx.x == 0) { xbw[0] = 0u; xbw[1] = 0u; xbw[2] = 0u; xbw[3] = 0u; }
    __syncthreads();
    XcdBarrier bar = xcd_barrier_post((unsigned*)(p.ws + OFF_BAR), xbw);
#ifdef PROBE_SLOT
    if (blockIdx.x == 0 && threadIdx.x == 0) { volatile LAS unsigned long long* tw = (volatile LAS unsigned long long*)(shm + LDS_XBW + 16); tw[0] = wall_clock64(); tw[1] = 0ull; }
#endif
    run_phase<PH_MOD>(p, 0, shm);
    run_phase<PH_CONVERT>(p, 0, shm);
    XBAR(bar, 0);
    run_phase<PH_INIT>(p, 0, shm);
    XBAR(bar, 1);
    for (int l = 0; l < DEPTH; ++l) {
        if (l > 0) { run_phase<PH_CONVERT>(p, l, shm); XBAR(bar, 2); }
        run_phase<PH_INPROJ>(p, l, shm); XBAR(bar, 3);
        run_phase<PH_ROPEDEC>(p, l, shm); run_phase<PH_VTRANS>(p, l, shm); XBAR(bar, 4);
#if FAST_GLA
        run_phase<PH_GLA_A>(p, l, shm); XBAR(bar, 5);
        run_phase<PH_GLA_SCAN>(p, l, shm);
#else
        run_phase<PH_MIX_GLA>(p, l, shm);
#endif
#if FAST_DIFF
        run_phase<PH_DIFF>(p, l, shm);
#else
        run_phase<PH_MIX_DIFF>(p, l, shm);
#endif
#if FAST_NA
        run_phase<PH_NA>(p, l, shm);
#else
        run_phase<PH_MIX_NA>(p, l, shm);
#endif
        XBAR(bar, 6);
#if FAST_GLA
        run_phase<PH_GLA_C>(p, l, shm); XBAR(bar, 7);
#endif
        run_phase<PH_GATES>(p, l, shm); XBAR(bar, 8);
        run_phase<PH_MERGE>(p, l, shm); XBAR(bar, 9);
        run_phase<PH_WO>(p, l, shm); XBAR(bar, 10);
#ifdef PROBE_LN1
        run_phase<PH_LN1>(p, l, shm, true);
#endif
        run_phase<PH_LN1>(p, l, shm); XBAR(bar, 11);
        run_phase<PH_GATHER>(p, l, shm); XBAR(bar, 12);
        run_phase<PH_UP>(p, l, shm); XBAR(bar, 13);
        run_phase<PH_DOWN>(p, l, shm); XBAR(bar, 14);
        run_phase<PH_LN2>(p, l, shm); XBAR(bar, 15);
    }
#ifdef PROBE_SLOT
    if (blockIdx.x == 0 && threadIdx.x == 0) { volatile LAS unsigned long long* tw = (volatile LAS unsigned long long*)(shm + LDS_XBW + 16);
        const unsigned long long until = wall_clock64() + tw[1] * (PROBE_MULT - 1);
        while (wall_clock64() < until) __builtin_amdgcn_s_sleep(32); }
#endif
}
#endif

extern "C" void kernel_launch(void* const* d_in, const int* in_sizes, int n_in, void* d_out, int out_size, void* d_ws, size_t ws_size, hipStream_t stream) {
    (void)in_sizes; (void)n_in; (void)out_size;
    if (ws_size < WS_NEED) { fprintf(stderr, "workspace too small: %zu < %zu\n", ws_size, (size_t)WS_NEED); return; }
    Params p{};
    for (int i = 0; i < 23; ++i) p.in[i] = (const float*)d_in[i];
    p.out = (float*)d_out; p.ws = (char*)d_ws;
    (void)hipMemsetAsync(d_ws, 0, ZERO_BYTES, stream);
#if !MEGA
    launch_phase<PH_MOD>(p, 0, stream);
    launch_phase<PH_INIT>(p, 0, stream);
    for (int l = 0; l < DEPTH; ++l) {
        launch_phase<PH_CONVERT>(p, l, stream);
        launch_phase<PH_INPROJ>(p, l, stream);
        launch_phase<PH_ROPEDEC>(p, l, stream);
        launch_phase<PH_MIX_GLA>(p, l, stream);
        launch_phase<PH_VTRANS>(p, l, stream);
        launch_phase<PH_DIFF>(p, l, stream);
        launch_phase<PH_MIX_NA>(p, l, stream);
        launch_phase<PH_GATES>(p, l, stream);
        launch_phase<PH_MERGE>(p, l, stream);
        launch_phase<PH_WO>(p, l, stream);
        launch_phase<PH_LN1>(p, l, stream);
        launch_phase<PH_GATHER>(p, l, stream);
        launch_phase<PH_UP>(p, l, stream);
        launch_phase<PH_DOWN>(p, l, stream);
        launch_phase<PH_LN2>(p, l, stream);
    }
#else
    static int grid = 0;
    if (!grid) {
        (void)hipFuncSetAttribute((const void*)k_mega, hipFuncAttributeMaxDynamicSharedMemorySize, LDS_BYTES);
        int dev = 0, cus = 0, per_cu = 0;
        (void)hipGetDevice(&dev);
        (void)hipDeviceGetAttribute(&cus, hipDeviceAttributeMultiprocessorCount, dev);
        (void)hipOccupancyMaxActiveBlocksPerMultiprocessor(&per_cu, (const void*)k_mega, 512, LDS_BYTES);
        if (cus <= 0) cus = 256;
        grid = per_cu >= 1 ? cus : 0;
        if (!grid) { fprintf(stderr, "k_mega does not fit a CU\n"); return; }
    }
    hipLaunchKernelGGL(k_mega, dim3(grid), dim3(NTHR), LDS_BYTES, stream, p);
#endif
}
```

```cpp
#define MEGA 1
#include <hip/hip_runtime.h>
#include <stdint.h>
#include <stdio.h>

#ifndef MEGA
#define MEGA 0
#endif

constexpr int NB = 8, LL = 4096, LC = 256, LB = LL + LC  , T = NB * LB  , D = 1024, DEPTH = 4;
constexpr int NPANEL = T / 256;
constexpr int PB = LB / 256;
constexpr int PAIR_ROWS = 2 * T + 16 * 256;
constexpr float ALPHA = 1.681792830507429f;
constexpr float LN_EPS = 1e-5f, RMS_EPS = 1e-6f;

constexpr size_t AL256(size_t x) { return (x + 255) & ~(size_t)255; }
constexpr size_t OFF_BAR = 0;
constexpr size_t OFF_CNT = 16384;
constexpr size_t ZERO_BYTES = 32768;
constexpr size_t OFF_BLKCNT = ZERO_BYTES;
constexpr size_t OFF_MOD0 = OFF_BLKCNT + 1024 * 16 * 4;
constexpr size_t OFF_MOD = OFF_MOD0;
constexpr size_t OFF_ROPE = AL256(OFF_MOD + (size_t)DEPTH * 9 * 6144 * 4);
constexpr size_t OFF_TOK = AL256(OFF_ROPE + (size_t)4096 * 32 * 2 * 4);
constexpr size_t OFF_GR = AL256(OFF_TOK + (size_t)T * 8 * 4);
constexpr size_t OFF_XS = AL256(OFF_GR + (size_t)T * 32 * 4);
constexpr size_t OFF_H = AL256(OFF_XS + (size_t)T * D * 4);
constexpr size_t OFF_W = AL256(OFF_H + (size_t)T * D * 2);
constexpr size_t W_IN_ROWS = 4864 + 3072;
constexpr size_t OFF_WIN = OFF_W;
constexpr size_t OFF_WB = OFF_WIN + W_IN_ROWS * 1024 * 2;
constexpr size_t OFF_WO = OFF_WB + (size_t)3 * 1024 * 512 * 2;
constexpr size_t OFF_WUP = OFF_WO + (size_t)1024 * 1024 * 2;
constexpr size_t OFF_WDN = OFF_WUP + (size_t)16 * 1024 * 1024 * 2;
constexpr size_t OFF_P = AL256(OFF_WDN + (size_t)16 * 1024 * 512 * 2);
constexpr size_t W_BYTES = OFF_WDN + (size_t)16 * 1024 * 512 * 2 - OFF_W;
constexpr size_t PCOL = (size_t)T * 2;
constexpr size_t OFF_GQ = OFF_P, OFF_GK = OFF_P + 256 * PCOL, OFF_GV = OFF_P + 512 * PCOL;
constexpr size_t OFF_DK = OFF_P + 1024 * PCOL, OFF_DV = OFF_P + 1536 * PCOL;
constexpr size_t OFF_NK = OFF_P + 2048 * PCOL, OFF_NV = OFF_P + 2560 * PCOL;
constexpr size_t OFF_BR = OFF_P + 3072 * PCOL;
constexpr size_t OFF_GG = OFF_BR, OFF_DQ = OFF_BR + 512 * PCOL, OFF_NQ = OFF_BR + 1024 * PCOL;
constexpr size_t OFF_GATE = OFF_P;
constexpr size_t OFF_S1 = AL256(OFF_P + 4608 * PCOL);
constexpr size_t OFF_S2 = AL256(OFF_S1 + (size_t)T * 512 * 4);
constexpr size_t OFF_R3 = AL256(OFF_S2 + (size_t)T * 512 * 4);
constexpr size_t OFF_R4 = AL256(OFF_R3 + (size_t)T * 512 * 2);
constexpr size_t VT_BYTES = (size_t)T * 512 * 2;
#ifndef FAST_GLA
#define FAST_GLA 1
#endif
#ifndef FAST_DIFF
#define FAST_DIFF 1
#endif
#ifndef FAST_NA
#define FAST_NA 1
#endif
constexpr size_t OFF_KV = OFF_S1;
constexpr size_t OFF_GVT = OFF_GV;
constexpr size_t OFF_VT = OFF_DV;
constexpr size_t OFF_NVT = OFF_NV;
static_assert(FAST_GLA && FAST_DIFF && FAST_NA, "the naive mixers read row-major values");
constexpr size_t OFF_TOTAL = OFF_R3;
constexpr size_t OFF_CUM = OFF_S2;
constexpr size_t OFF_W2 = OFF_S2;
static_assert(OFF_W2 + W_BYTES <= OFF_R4, "second weight buffer");
__device__ __forceinline__ size_t wdelta(int l) { return (l & 1) ? (OFF_W2 - OFF_W) : 0; }
constexpr size_t OFF_NBT = OFF_R4;
constexpr size_t OFF_DECAY = AL256(OFF_NBT + (size_t)8 * 15 * 4 * 64 * 16 * 4);
constexpr size_t OFF_END1 = AL256(OFF_DECAY + (size_t)64 * 68 * 64 * 4);
constexpr size_t OFF_XA = OFF_P;
constexpr size_t OFF_PAIRTOK = OFF_XA;
constexpr size_t OFF_ACT = AL256(OFF_XA + (size_t)PAIR_ROWS * 1024 * 2);
constexpr size_t OFF_Y = AL256(OFF_ACT + (size_t)PAIR_ROWS * 512 * 2);
constexpr size_t OFF_END2 = AL256(OFF_Y + (size_t)PAIR_ROWS * 1024 * 2);
constexpr size_t WS_NEED = OFF_END1 > OFF_END2 ? OFF_END1 : OFF_END2;
static_assert(WS_NEED < (size_t)812 * 1000 * 1000, "workspace budget");

constexpr int NTHR = 512;
constexpr int LDS_STAGE = 131072;
constexpr int LDS_BYTES = 159744;
constexpr int LDS_XBW = LDS_BYTES - 256;

typedef unsigned short bf16_t;

struct Params {
    const float* in[23];
    float* out;
    char* ws;
};
enum { I_X = 0, I_C, I_CTX, I_CCTX, I_WADA, I_BADA, I_WIN, I_GWD, I_GBD, I_GNG, I_LQ, I_LK, I_DNG, I_RPB, I_WBR, I_WO, I_LNG, I_LNB, I_WR, I_BR, I_WEG, I_WEU, I_WED };

__device__ __forceinline__ float bf2f(bf16_t v) { return __uint_as_float(((unsigned)v) << 16); }
__device__ __forceinline__ float bflo(unsigned u) { return __uint_as_float(u << 16); }
__device__ __forceinline__ float bfhi(unsigned u) { return __uint_as_float(u & 0xffff0000u); }
typedef float f32x2_t __attribute__((ext_vector_type(2)));
typedef __bf16 bf16x2_t __attribute__((ext_vector_type(2)));
__device__ __forceinline__ unsigned pk2(float lo, float hi) { f32x2_t v; v[0] = lo; v[1] = hi; return __builtin_bit_cast(unsigned, __builtin_convertvector(v, bf16x2_t)); }
__device__ __forceinline__ bf16_t f2bf(float f) { return (bf16_t)(pk2(f, 0.f) & 0xffffu); }
__device__ __forceinline__ float wave_sum(float v) {
#pragma unroll
    for (int o = 32; o >= 1; o >>= 1) v += __shfl_xor(v, o);
    return v;
}
__device__ __forceinline__ float sigmoidf_(float x) { return 1.f / (1.f + __expf(-x)); }
__device__ __forceinline__ float siluf_(float x) { return x / (1.f + __expf(-x)); }
__device__ __forceinline__ int row_slot(int row) { const int b = row / LB, t = row - b * LB; return t < LC ? 8 : b; }
__device__ __forceinline__ int ltid() { int t = threadIdx.x; asm volatile("" : "+v"(t)); return t; }
#ifndef XS_BF16
#define XS_BF16 0
#endif
#if XS_BF16
typedef bf16_t xs_t;
#else
typedef float xs_t;
#endif
typedef float f32x4_a __attribute__((ext_vector_type(4)));
typedef unsigned u32x2_a __attribute__((ext_vector_type(2)));
__device__ __forceinline__ f32x4_a xs_ld4(const xs_t* p) {
#if XS_BF16
    const u32x2_a v = *(const u32x2_a*)p; f32x4_a r; r[0] = bflo(v[0]); r[1] = bfhi(v[0]); r[2] = bflo(v[1]); r[3] = bfhi(v[1]); return r;
#else
    return *(const f32x4_a*)p;
#endif
}
__device__ __forceinline__ void xs_st4(xs_t* p, f32x4_a x) {
#if XS_BF16
    u32x2_a v; v[0] = pk2(x[0], x[1]); v[1] = pk2(x[2], x[3]); *(u32x2_a*)p = v;
#else
    *(f32x4_a*)p = x;
#endif
}
#include <hip/hip_runtime.h>
namespace pg8 {
#define PG8_LAS __attribute__((address_space(3)))
typedef unsigned short bf16_t;
typedef short bf16x8 __attribute__((ext_vector_type(8)));
typedef float f32x4 __attribute__((ext_vector_type(4)));
typedef unsigned u32x4 __attribute__((ext_vector_type(4)));
constexpr int BM = 256, BK = 64, HALF = 128, HTB = HALF * BK * 2  , STAGE_BYTES = 8 * HTB, NXCD = 8, WGM = 8;

__host__ __device__ __forceinline__ int lds_byte(int r, int c) { const int st = (r >> 4) * 2 + (c >> 5), rr = r & 15, cc = c & 31, ob = rr * 64 + cc * 2; return st * 1024 + (ob ^ (((ob >> 9) & 1) << 5)); }
__host__ __device__ __forceinline__ void stage_rc(int b, int& R, int& C) { const int st = b / 1024, sb = b % 1024, swz = sb ^ (((sb >> 9) & 1) << 5); R = (st >> 1) * 16 + swz / 64; C = (st & 1) * 32 + (swz % 64) / 2; }
__host__ __device__ __forceinline__ int perm32(int rho) { const int n = rho >> 4, i = rho & 15; return 8 * (i >> 2) + 4 * n + (i & 3); }

struct Unit { int pm, pn; };
struct Gemm { const bf16_t* A; const bf16_t* Bt; int M, N, K; const int* gidx; };
__device__ __forceinline__ unsigned cvt_pk_bf16(float lo, float hi) { unsigned r; asm volatile("v_cvt_pk_bf16_f32 %0, %1, %2" : "=v"(r) : "v"(lo), "v"(hi)); return r; }

template <class Epi, class Sched, bool STAMP = false>
__device__ __forceinline__ void gemm_phase(PG8_LAS unsigned char* lds, const Gemm g, const Sched& S, const Epi& E, unsigned long long* stamps) {
    int tid_l = threadIdx.x; asm volatile("" : "+v"(tid_l));
    const int tid = tid_l, wid = __builtin_amdgcn_readfirstlane(tid >> 6), lane = tid & 63, wr = wid >> 2, wc = wid & 3, fr = lane & 15, fq = lane >> 4;
    const int K = g.K, nt = K / BK;
    int ts_lo = 0, ts_hi = 0, nts = 0; const unsigned long long rt_entry = STAMP ? (unsigned long long)wall_clock64() : 0ull;
#define PG8_STAMP() do { if (STAMP && wid == 0 && nts < 64) { const unsigned long long _c = (unsigned long long)clock64(); \
        ts_lo = (lane == nts) ? (int)(unsigned)_c : ts_lo; ts_hi = (lane == nts) ? (int)(unsigned)(_c >> 32) : ts_hi; ++nts; } } while (0)
    PG8_STAMP();
    unsigned voffA[2], voffB[2];
#pragma unroll
    for (int i = 0; i < 2; ++i) { int R, C; stage_rc(tid * 16 + i * 8192, R, C); const int Rb = Epi::PERM ? ((R & ~31) + perm32(R & 31)) : R;
        voffA[i] = (unsigned)(R * K + C) * 2u; voffB[i] = (unsigned)(Rb * K + C) * 2u; }
    const size_t kstep = (size_t)(BK * 2);
    const size_t hstep = (size_t)HALF * K * 2;
    const size_t tstep = 2 * hstep;
    int Rg[2], Cg[2];
#pragma unroll
    for (int i = 0; i < 2; ++i) stage_rc(tid * 16 + i * 8192, Rg[i], Cg[i]);
    unsigned gA[2][2], gN[2][2];
#define PG8_GLOAD(dst, unit) do { _Pragma("unroll") for (int hh_ = 0; hh_ < 2; ++hh_) _Pragma("unroll") for (int i = 0; i < 2; ++i) \
        dst[hh_][i] = (unsigned)g.gidx[(unit).pm * BM + hh_ * HALF + Rg[i]] * (unsigned)(K * 2) + (unsigned)(Cg[i] * 2); } while (0)
    const size_t hstepA = Epi::GATHER ? 0 : hstep;
    const unsigned ldsw = (unsigned)wid * 1024u;
    const int aoff = lds_byte(wr * 64 + fr, fq * 8), boff = lds_byte(wc * 32 + fr, fq * 8);
#define PG8_SA(b, h) (((b) * 2 + (h)) * HTB)
#define PG8_SB(b, h) ((4 + (b) * 2 + (h)) * HTB)
#define PG8_STAGE(bufoff, gbase, voff) do { _Pragma("unroll") for (int _i = 0; _i < 2; ++_i) \
        __builtin_amdgcn_global_load_lds((const unsigned*)((const char*)(gbase) + (voff)[_i]), (PG8_LAS unsigned*)(lds + (bufoff) + ldsw + _i * 8192), 16, 0, 0); } while (0)
#define PG8_STAGEA(bufoff, gbase, half, usenext) do { if constexpr (Epi::GATHER) { _Pragma("unroll") for (int _i = 0; _i < 2; ++_i) { const unsigned _o = (usenext) ? gN[half][_i] : gA[half][_i]; \
            __builtin_amdgcn_global_load_lds((const unsigned*)((const char*)(gbase) + _o), (PG8_LAS unsigned*)(lds + (bufoff) + ldsw + _i * 8192), 16, 0, 0); } } \
        else { PG8_STAGE(bufoff, (gbase) + (half) * hstepA, voffA); } } while (0)
#define PG8_LDA(dst, b, h) do { _Pragma("unroll") for (int m = 0; m < 4; ++m) _Pragma("unroll") for (int k = 0; k < 2; ++k) dst[m][k] = *(const PG8_LAS bf16x8*)(lds + PG8_SA(b, h) + aoff + m * 2048 + k * 1024); } while (0)
#define PG8_LDB(dst, b, h) do { _Pragma("unroll") for (int n = 0; n < 2; ++n) _Pragma("unroll") for (int k = 0; k < 2; ++k) dst[n][k] = *(const PG8_LAS bf16x8*)(lds + PG8_SB(b, h) + boff + n * 2048 + k * 1024); } while (0)
#define PG8_MMA(ai, bj, At, Bt) do { __builtin_amdgcn_s_setprio(1); _Pragma("unroll") for (int m = 0; m < 4; ++m) _Pragma("unroll") for (int n = 0; n < 2; ++n) _Pragma("unroll") for (int k = 0; k < 2; ++k) \
        acc[ai][bj][m][n] = __builtin_amdgcn_mfma_f32_16x16x32_bf16(Bt[n][k], At[m][k], acc[ai][bj][m][n], 0, 0, 0); __builtin_amdgcn_s_setprio(0); } while (0)
#define PG8_WAIT_V(n) asm volatile("s_waitcnt vmcnt(" #n ")" ::: "memory")
#define PG8_WAIT_L(n) asm volatile("s_waitcnt lgkmcnt(" #n ")" ::: "memory")
#define PG8_BAR __builtin_amdgcn_s_barrier()
#define PG8_SCHED __builtin_amdgcn_sched_barrier(0)
    Unit cur, nxt; int ui = 0;
    if (!S.next(0, cur)) return;
    f32x4 acc[2][2][4][2];
#pragma unroll
    for (int a = 0; a < 2; ++a)
#pragma unroll
        for (int b = 0; b < 2; ++b)
#pragma unroll
            for (int m = 0; m < 4; ++m)
#pragma unroll
                for (int n = 0; n < 2; ++n) acc[a][b][m][n] = (f32x4){0.f, 0.f, 0.f, 0.f};
    bf16x8 At[4][2], B0[2][2], B1[2][2];
    const char* cA = Epi::GATHER ? (const char*)g.A : (const char*)g.A + (size_t)cur.pm * tstep; const char* cB = (const char*)g.Bt + (size_t)cur.pn * tstep;
    S.a_ready(cur);
    if constexpr (Epi::GATHER) PG8_GLOAD(gA, cur);
    PG8_STAGE(PG8_SB(0, 0), cB, voffB); PG8_STAGEA(PG8_SA(0, 0), cA, 0, false); PG8_STAGE(PG8_SB(0, 1), cB + hstep, voffB); PG8_STAGEA(PG8_SA(0, 1), cA, 1, false);
    if (wr == 1) PG8_BAR;
    PG8_WAIT_V(4); PG8_BAR;
    PG8_STAGE(PG8_SB(1, 0), cB + kstep, voffB); PG8_STAGEA(PG8_SA(1, 0), cA + kstep, 0, false); PG8_STAGE(PG8_SB(1, 1), cB + hstep + kstep, voffB);
    PG8_WAIT_V(6); PG8_BAR;
    PG8_STAMP();
    for (;;) {
        const bool has_next = S.next(ui + 1, nxt);
        const char* nA = Epi::GATHER ? (const char*)g.A : (has_next ? (const char*)g.A + (size_t)nxt.pm * tstep : cA);
        if constexpr (Epi::GATHER) { if (has_next) PG8_GLOAD(gN, nxt); else { _Pragma("unroll") for (int hh_ = 0; hh_ < 2; ++hh_) _Pragma("unroll") for (int i = 0; i < 2; ++i) gN[hh_][i] = gA[hh_][i]; } } const char* nB = has_next ? (const char*)g.Bt + (size_t)nxt.pn * tstep : cB;
        for (int t = 0; t < nt; t += 2) {
            const bool last = (t == nt - 2);
            const char* a1 = cA + (size_t)(t + 1) * kstep;
            const char* a2 = last ? nA : cA + (size_t)(t + 2) * kstep; const char* b2 = last ? nB : cB + (size_t)(t + 2) * kstep;
            const char* a3 = a2 + kstep; const char* b3 = b2 + kstep;
            if (last && has_next) S.a_ready(nxt);
            PG8_LDB(B0, 0, 0); PG8_SCHED; PG8_LDA(At, 0, 0); PG8_STAGEA(PG8_SA(1, 1), a1, 1, false);
            PG8_WAIT_L(8); PG8_BAR; PG8_WAIT_L(0); PG8_MMA(0, 0, At, B0); PG8_BAR; PG8_SCHED;
            PG8_LDB(B1, 0, 1); PG8_STAGE(PG8_SB(0, 0), b2, voffB);
            PG8_BAR; PG8_WAIT_L(0); PG8_MMA(0, 1, At, B1); PG8_BAR;
            PG8_LDA(At, 0, 1); PG8_STAGEA(PG8_SA(0, 0), a2, 0, last);
            PG8_BAR; PG8_WAIT_L(0); PG8_MMA(1, 0, At, B0); PG8_BAR; PG8_SCHED;
            PG8_STAGE(PG8_SB(0, 1), b2 + hstep, voffB);
            PG8_WAIT_V(6); PG8_BAR; PG8_MMA(1, 1, At, B1); PG8_BAR;
            PG8_LDB(B0, 1, 0); PG8_SCHED; PG8_LDA(At, 1, 0); PG8_STAGEA(PG8_SA(0, 1), a2, 1, last);
            PG8_WAIT_L(8); PG8_BAR; PG8_WAIT_L(0); PG8_MMA(0, 0, At, B0); PG8_BAR; PG8_SCHED;
            PG8_LDB(B1, 1, 1); PG8_STAGE(PG8_SB(1, 0), b3, voffB);
            PG8_BAR; PG8_WAIT_L(0); PG8_MMA(0, 1, At, B1); PG8_BAR;
            PG8_LDA(At, 1, 1); PG8_STAGEA(PG8_SA(1, 0), a3, 0, last);
            PG8_BAR; PG8_WAIT_L(0); PG8_MMA(1, 0, At, B0); PG8_BAR; PG8_SCHED;
            PG8_STAGE(PG8_SB(1, 1), b3 + hstep, voffB);
            PG8_WAIT_V(6); PG8_BAR; PG8_MMA(1, 1, At, B1); PG8_BAR;
        }
        PG8_STAMP();
        if constexpr (!Epi::AFTER_DRAIN) { E(acc, cur, wr, wc, fr, fq); S.done(cur); }
        PG8_STAMP();
        if (!has_next) break;
        bool zero_acc = true;
        if constexpr (Epi::KEEP) zero_acc = !E.keep(cur);
        if (zero_acc) {
#pragma unroll
        for (int a = 0; a < 2; ++a)
#pragma unroll
            for (int b = 0; b < 2; ++b)
#pragma unroll
                for (int m = 0; m < 4; ++m)
#pragma unroll
                    for (int n = 0; n < 2; ++n) acc[a][b][m][n] = (f32x4){0.f, 0.f, 0.f, 0.f};
        }
        cur = nxt; cA = nA; cB = nB; ++ui;
        if constexpr (Epi::GATHER) { _Pragma("unroll") for (int hh_ = 0; hh_ < 2; ++hh_) _Pragma("unroll") for (int i = 0; i < 2; ++i) gA[hh_][i] = gN[hh_][i]; }
    }
    PG8_WAIT_V(0);
    if (wr == 0) PG8_BAR;
    PG8_BAR;
    if constexpr (Epi::AFTER_DRAIN) { E.fused(acc, cur, wr, wc, fr, fq, lds, wid, lane); S.done(cur); }
    PG8_STAMP();
    if (STAMP && wid == 0) { stamps[lane] = lane < nts ? (((unsigned long long)(unsigned)ts_hi << 32) | (unsigned)ts_lo) : 0ull;
        if (lane == 62) stamps[62] = rt_entry; if (lane == 63) stamps[63] = (unsigned long long)wall_clock64(); }
#undef PG8_STAMP
#undef PG8_SA
#undef PG8_SB
#undef PG8_STAGE
#undef PG8_STAGEA
#undef PG8_GLOAD
#undef PG8_LDA
#undef PG8_LDB
#undef PG8_MMA
#undef PG8_WAIT_V
#undef PG8_WAIT_L
#undef PG8_BAR
#undef PG8_SCHED
}
}
#define XB_TMO      128
#define XB_XCNT(j)  (256  + 64 * (j))
#define XB_XSUB(j)  (1280 + 64 * (j))
#define XB_XGEN(j)  (2304 + 64 * (j))
#define XB_TOP      3328
#define XB_TOPGEN   3392
#define XCD_BAR_WORDS 3456
#define XB_SPIN_CAP (1u << 18)
#define LAS __attribute__((address_space(3)))

__device__ __forceinline__ unsigned xb_ld(unsigned* p)              { return __hip_atomic_load(p, __ATOMIC_RELAXED, __HIP_MEMORY_SCOPE_AGENT); }
__device__ __forceinline__ unsigned xb_add(unsigned* p, unsigned v) { return __hip_atomic_fetch_add(p, v, __ATOMIC_RELAXED, __HIP_MEMORY_SCOPE_AGENT); }
__device__ __forceinline__ unsigned xb_xcc_id() { return (unsigned)__builtin_amdgcn_s_getreg((3 << 11) | 20) & 0xFu; }
#define XB_SPIN(cond, bar) do { unsigned _sp = 0; while (cond) { __builtin_amdgcn_s_sleep(1); \
    if ((++_sp & 255u) == 0u) { if (xb_ld(&(bar)[XB_TMO])) break; if (_sp > XB_SPIN_CAP) { atomicAdd(&(bar)[XB_TMO], 1u); break; } } } } while (0)

struct XcdBarrier {
    unsigned* bar; unsigned x;
    volatile LAS unsigned* st;
};

__device__ __forceinline__ XcdBarrier xcd_barrier_post(unsigned* bar, volatile LAS unsigned* st) {
    XcdBarrier b; b.bar = bar; b.x = xb_xcc_id(); b.st = st;
    if (threadIdx.x == 0) (void)xb_add(&bar[XB_XCNT(b.x)], 1u);
    return b;
}
__device__ __forceinline__ void xcd_barrier_complete(unsigned* bar, unsigned x, unsigned& nloc, unsigned& nx) {
    const unsigned G = gridDim.x * gridDim.y * gridDim.z;
    unsigned sum, cnt, mine, sp = 0u;
    for (;;) {
        sum = 0u; cnt = 0u; mine = 0u;
#pragma unroll
        for (unsigned j = 0; j < 16; ++j) { const unsigned c = xb_ld(&bar[XB_XCNT(j)]); sum += c; cnt += (c > 0u) ? 1u : 0u; mine = (j == x) ? c : mine; }
        if (sum == G) break;
        __builtin_amdgcn_s_sleep(1);
        if ((++sp & 255u) == 0u) { if (xb_ld(&bar[XB_TMO])) break; if (sp > XB_SPIN_CAP) { atomicAdd(&bar[XB_TMO], 1u); break; } }
    }
    nloc = mine > 0u ? mine : 1u; nx = cnt > 0u ? cnt : 1u;
}

__device__ __forceinline__ void xcd_barrier(const XcdBarrier& b_in) {
    XcdBarrier b = b_in; asm volatile("" : "+s"(b.bar), "+s"(b.x));
    asm volatile("s_waitcnt vmcnt(0)" ::: "memory");
    __syncthreads();
    if (threadIdx.x == 0) {
        unsigned* bar = b.bar;
        __builtin_amdgcn_s_waitcnt(0);
        unsigned nloc = b.st[0], nx = b.st[1];
        if (nloc == 0u) { xcd_barrier_complete(bar, b.x, nloc, nx); b.st[0] = nloc; b.st[1] = nx; }
        const unsigned old = xb_add(&bar[XB_XSUB(b.x)], 1u);
        const unsigned gen = old / nloc;
        if (old + 1u == (gen + 1u) * nloc) {
            __builtin_amdgcn_fence(__ATOMIC_RELEASE, "agent");
            asm volatile("s_waitcnt vmcnt(0)" ::: "memory");
            const unsigned og = xb_add(&bar[XB_TOP], 1u);
            const unsigned tg = og / nx;
            if (og + 1u == (tg + 1u) * nx) xb_add(&bar[XB_TOPGEN], 1u);
            else XB_SPIN(xb_ld(&bar[XB_TOPGEN]) == tg, bar);
            __builtin_amdgcn_fence(__ATOMIC_ACQUIRE, "agent");
            xb_add(&bar[XB_XGEN(b.x)], 1u);
            asm volatile("s_waitcnt vmcnt(0)" ::: "memory");
        } else {
            XB_SPIN(xb_ld(&bar[XB_XGEN(b.x)]) == gen, bar);
            __builtin_amdgcn_fence(__ATOMIC_ACQUIRE, "agent");
            asm volatile("s_waitcnt vmcnt(0)" ::: "memory");
        }
    }
    __syncthreads();
}

using pg8::f32x4;
using pg8::Unit;
typedef unsigned u32x4_t __attribute__((ext_vector_type(4)));
typedef unsigned u32x2_t __attribute__((ext_vector_type(2)));

struct SchedGrid {
    int nM, nN, pn0, G, c; bool lat_only;
    __device__ __forceinline__ bool next(int i, Unit& u) const {
        const int L = i * G + c; if (L >= nM * nN) return false;
        int pm = L / nN; u.pn = pn0 + (L - pm * nN);
        if (lat_only) pm = (pm >> 4) * PB + 1 + (pm & 15);
        u.pm = pm; return true;
    }
    __device__ __forceinline__ void a_ready(const Unit&) const {}
    __device__ __forceinline__ void done(const Unit&) const {}
};
struct SchedMerge {
    int G, c; bool lat_only;
    __device__ __forceinline__ bool next(int i, Unit& u) const {
        const int i3 = i / 3, n = i - i3 * 3, ti = i3 * G + c; if (ti >= (lat_only ? NB * 16 : NPANEL) * 4) return false;
        int pm = ti >> 2; if (lat_only) pm = (pm >> 4) * PB + 1 + (pm & 15);
        u.pm = n * NPANEL + pm; u.pn = n * 4 + (ti & 3); return true;
    }
    __device__ __forceinline__ void a_ready(const Unit&) const {}
    __device__ __forceinline__ void done(const Unit&) const {}
};
struct SchedMoe {
    int cum[17]; int G, c;
    __device__ __forceinline__ void init(const unsigned* cnt, int G_, int c_) {
        G = G_; c = c_; int s = 0;
#pragma unroll
        for (int e = 0; e < 16; ++e) { cum[e] = s; const unsigned n = __builtin_amdgcn_readfirstlane(cnt[e]); s += (int)((n + 255u) >> 8); }
        cum[16] = s;
    }
    __device__ __forceinline__ bool next(int i, Unit& u) const {
        const int L = i * G + c; if (L >= cum[16] * 4) return false;
        const int rt = L >> 2; int e = 0;
#pragma unroll
        for (int j = 1; j < 16; ++j) e += (rt >= cum[j]) ? 1 : 0;
        u.pm = rt; u.pn = e * 4 + (L & 3); return true;
    }
    __device__ __forceinline__ void a_ready(const Unit&) const {}
    __device__ __forceinline__ void done(const Unit&) const {}
};

__device__ __forceinline__ u32x4_t pack8(const f32x4& a, const f32x4& b) {
    u32x4_t r; r[0] = pk2(a[0], a[1]); r[1] = pk2(a[2], a[3]); r[2] = pk2(b[0], b[1]); r[3] = pk2(b[2], b[3]); return r;
}
struct EpiInProj {
    static constexpr bool PERM = true, AFTER_DRAIN = false; static constexpr bool KEEP = false; static constexpr bool GATHER = false;
    char* ws;
    __device__ __forceinline__ void operator()(const f32x4 (&acc)[2][2][4][2], const Unit& u, int wr, int wc, int fr, int fq) const {
        const int pn = u.pn; const int row0 = u.pm * 256 + wr * 64 + fr;
        if (pn == 6) {
            if (wc == 0) { float* gr = (float*)(ws + OFF_GR);
#pragma unroll
                for (int ai = 0; ai < 2; ++ai)
#pragma unroll
                    for (int m = 0; m < 4; ++m) { float* rp = gr + (size_t)(row0 + ai * 128 + m * 16) * 32 + 8 * fq;
                        *(f32x4*)(rp) = acc[ai][0][m][0]; *(f32x4*)(rp + 4) = acc[ai][0][m][1]; } }
            return;
        }
        if (pn == 2 || pn == 3 || pn == 11 || pn == 12 || pn == 17 || pn == 18) {
            const size_t voff = pn < 4 ? OFF_GVT : (pn < 13 ? OFF_VT : OFF_NVT); const int colt = ((pn < 4 ? pn - 2 : (pn < 13 ? pn - 11 : pn - 17)) * 256) + wc * 32 + 8 * fq;
            const int b = u.pm / PB, key0 = (u.pm - b * PB) * 256 + wr * 64 + fr;
            bf16_t* vt = (bf16_t*)(ws + voff) + ((size_t)b * 512 + colt) * LB + key0;
#pragma unroll
            for (int ai = 0; ai < 2; ++ai)
#pragma unroll
                for (int m = 0; m < 4; ++m)
#pragma unroll
                    for (int bj = 0; bj < 2; ++bj) { const u32x4_t pk = pack8(acc[ai][bj][m][0], acc[ai][bj][m][1]); bf16_t* cp = vt + (size_t)(bj * 128) * LB + ai * 128 + m * 16;
#pragma unroll
                        for (int j = 0; j < 4; ++j) { cp[(size_t)(2 * j) * LB] = (bf16_t)(pk[j] & 0xffffu); cp[(size_t)(2 * j + 1) * LB] = (bf16_t)(pk[j] >> 16); } }
            return;
        }
        size_t off; int ld, col0;
        if (pn == 0) { off = OFF_GQ; ld = 256; col0 = 0; }
        else if (pn == 1) { off = OFF_GK; ld = 256; col0 = 0; }
        else if (pn < 4) { off = OFF_GV; ld = 512; col0 = (pn - 2) * 256; }
        else if (pn < 6) { off = OFF_GG; ld = 512; col0 = (pn - 4) * 256; }
        else if (pn < 9) { off = OFF_DQ; ld = 512; col0 = (pn - 7) * 256; }
        else if (pn < 11) { off = OFF_DK; ld = 512; col0 = (pn - 9) * 256; }
        else if (pn < 13) { off = OFF_DV; ld = 512; col0 = (pn - 11) * 256; }
        else if (pn < 15) { off = OFF_NQ; ld = 512; col0 = (pn - 13) * 256; }
        else if (pn < 17) { off = OFF_NK; ld = 512; col0 = (pn - 15) * 256; }
        else { off = OFF_NV; ld = 512; col0 = (pn - 17) * 256; }
        bf16_t* base = (bf16_t*)(ws + off) + col0 + wc * 32 + 8 * fq;
#pragma unroll
        for (int ai = 0; ai < 2; ++ai)
#pragma unroll
            for (int m = 0; m < 4; ++m) { bf16_t* rp = base + (size_t)(row0 + ai * 128 + m * 16) * ld;
#pragma unroll
                for (int bj = 0; bj < 2; ++bj) *(u32x4_t*)(rp + bj * 128) = pack8(acc[ai][bj][m][0], acc[ai][bj][m][1]); }
    }
};
struct EpiGates {
    static constexpr bool PERM = true, AFTER_DRAIN = false; static constexpr bool KEEP = false; static constexpr bool GATHER = false;
    char* ws;
    __device__ __forceinline__ void operator()(const f32x4 (&acc)[2][2][4][2], const Unit& u, int wr, int wc, int fr, int fq) const {
        const int pl = u.pn - 19, n = pl >> 2, col0 = (pl & 3) * 256; const int row0 = u.pm * 256 + wr * 64 + fr;
        bf16_t* base = (bf16_t*)(ws + OFF_GATE) + (size_t)n * T * 1024 + col0 + wc * 32 + 8 * fq;
#pragma unroll
        for (int ai = 0; ai < 2; ++ai)
#pragma unroll
            for (int m = 0; m < 4; ++m) { bf16_t* rp = base + (size_t)(row0 + ai * 128 + m * 16) * 1024;
#pragma unroll
                for (int bj = 0; bj < 2; ++bj) { f32x4 a = acc[ai][bj][m][0], b = acc[ai][bj][m][1];
#pragma unroll
                    for (int j = 0; j < 4; ++j) { a[j] = sigmoidf_(a[j]); b[j] = sigmoidf_(b[j]); }
                    *(u32x4_t*)(rp + bj * 128) = pack8(a, b); } }
    }
};
struct EpiMerge {
    static constexpr bool PERM = true, AFTER_DRAIN = false; static constexpr bool KEEP = true; static constexpr bool GATHER = false;
    char* ws;
    __device__ __forceinline__ bool keep(const Unit& u) const { return u.pm < 2 * NPANEL; }
    __device__ __forceinline__ void operator()(f32x4 (&acc)[2][2][4][2], const Unit& u, int wr, int wc, int fr, int fq) const {
        const int n = u.pm / NPANEL, pm = u.pm - n * NPANEL, pn = u.pn & 3; const int row0 = pm * 256 + wr * 64 + fr;
        const size_t cb = (size_t)pn * 256 + wc * 32 + 8 * fq;
        const bf16_t* gnum = (const bf16_t*)(ws + OFF_GATE) + (size_t)n * T * 1024 + cb;
        const bf16_t* gden = gnum + (size_t)T * 1024;
        bf16_t* obase = (bf16_t*)(ws + OFF_H) + cb;
#pragma unroll
        for (int ai = 0; ai < 2; ++ai) {
            u32x4_t gn_[4][2], gd_[4][2];
#pragma unroll
            for (int m = 0; m < 4; ++m)
#pragma unroll
                for (int bj = 0; bj < 2; ++bj) { const size_t ro = (size_t)(row0 + ai * 128 + m * 16) * 1024 + bj * 128;
                    gn_[m][bj] = *(const u32x4_t*)(gnum + ro); gd_[m][bj] = n < 2 ? *(const u32x4_t*)(gden + ro) : gn_[m][bj]; }
            __builtin_amdgcn_sched_barrier(0);
#pragma unroll
            for (int m = 0; m < 4; ++m) { const size_t ro = (size_t)(row0 + ai * 128 + m * 16) * 1024;
#pragma unroll
                for (int bj = 0; bj < 2; ++bj) {
                    const u32x4_t g = gn_[m][bj];
                    float f[8];
#pragma unroll
                    for (int j = 0; j < 4; ++j) { f[2 * j] = bflo(g[j]); f[2 * j + 1] = bfhi(g[j]); }
                    if (n > 0) {
#pragma unroll
                        for (int j = 0; j < 8; ++j) f[j] = fmaxf(f[j], 1e-30f); }
                    if (n < 2) { const u32x4_t gd = gd_[m][bj];
#pragma unroll
                        for (int j = 0; j < 4; ++j) { f[2 * j] *= __builtin_amdgcn_rcpf(fmaxf(bflo(gd[j]), 1e-30f)); f[2 * j + 1] *= __builtin_amdgcn_rcpf(fmaxf(bfhi(gd[j]), 1e-30f)); }
#pragma unroll
                        for (int j = 0; j < 4; ++j) { acc[ai][bj][m][0][j] *= f[j]; acc[ai][bj][m][1][j] *= f[4 + j]; }
                    } else {
                        f32x4 a = acc[ai][bj][m][0], b = acc[ai][bj][m][1];
#pragma unroll
                        for (int j = 0; j < 4; ++j) { a[j] *= f[j]; b[j] *= f[4 + j]; }
                        *(u32x4_t*)(obase + ro + bj * 128) = pack8(a, b); } } }
        }
    }
};
struct EpiWo {
    static constexpr bool PERM = false, AFTER_DRAIN = false; static constexpr bool KEEP = false; static constexpr bool GATHER = false;
    char* ws; int layer; bool commit;
    __device__ __forceinline__ void operator()(const f32x4 (&acc)[2][2][4][2], const Unit& u, int wr, int wc, int fr, int fq) const {
        const int b = u.pm / PB, slot = (u.pm - b * PB) == 0 ? 8 : b;
        const int row0 = u.pm * 256 + wr * 64 + fr, col0 = u.pn * 256 + wc * 32 + 4 * fq;
        const float* mg = (const float*)(ws + OFF_MOD) + ((size_t)(layer * 9 + slot) * 6 + 2) * 1024 + col0;
        xs_t* xs = (xs_t*)(ws + OFF_XS) + col0;
        f32x4 g[2][2];
#pragma unroll
        for (int bj = 0; bj < 2; ++bj)
#pragma unroll
            for (int n = 0; n < 2; ++n) g[bj][n] = *(const f32x4*)(mg + bj * 128 + n * 16);
#pragma unroll
        for (int ai = 0; ai < 2; ++ai) {
            f32x4 xv[4][2][2];
#pragma unroll
            for (int m = 0; m < 4; ++m)
#pragma unroll
                for (int bj = 0; bj < 2; ++bj)
#pragma unroll
                    for (int n = 0; n < 2; ++n) xv[m][bj][n] = xs_ld4(xs + (size_t)(row0 + ai * 128 + m * 16) * 1024 + bj * 128 + n * 16);
            __builtin_amdgcn_sched_barrier(0);
#pragma unroll
            for (int m = 0; m < 4; ++m) { xs_t* rp = xs + (size_t)(row0 + ai * 128 + m * 16) * 1024;
#pragma unroll
                for (int bj = 0; bj < 2; ++bj)
#pragma unroll
                    for (int n = 0; n < 2; ++n) { if (commit) xs_st4(rp + bj * 128 + n * 16, xv[m][bj][n] * ALPHA + g[bj][n] * acc[ai][bj][m][n]); } }
        }
    }
};
struct EpiUp {
    static constexpr bool PERM = true, AFTER_DRAIN = false; static constexpr bool KEEP = false; static constexpr bool GATHER = true;
    char* ws;
    __device__ __forceinline__ void operator()(const f32x4 (&acc)[2][2][4][2], const Unit& u, int wr, int wc, int fr, int fq) const {
        const int ct = u.pn & 3; const int row0 = u.pm * 256 + wr * 64 + fr;
        bf16_t* base = (bf16_t*)(ws + OFF_ACT) + ct * 128 + wc * 32 + 8 * fq;
#pragma unroll
        for (int ai = 0; ai < 2; ++ai)
#pragma unroll
            for (int m = 0; m < 4; ++m) { f32x4 a, b;
#pragma unroll
                for (int j = 0; j < 4; ++j) { a[j] = siluf_(acc[ai][0][m][0][j]) * acc[ai][1][m][0][j]; b[j] = siluf_(acc[ai][0][m][1][j]) * acc[ai][1][m][1][j]; }
                *(u32x4_t*)(base + (size_t)(row0 + ai * 128 + m * 16) * 512) = pack8(a, b); }
    }
};
struct EpiDown {
    static constexpr bool PERM = true, AFTER_DRAIN = false; static constexpr bool KEEP = false; static constexpr bool GATHER = false;
    char* ws;
    __device__ __forceinline__ void operator()(const f32x4 (&acc)[2][2][4][2], const Unit& u, int wr, int wc, int fr, int fq) const {
        const int ct = u.pn & 3; const int row0 = u.pm * 256 + wr * 64 + fr;
        bf16_t* base = (bf16_t*)(ws + OFF_Y) + ct * 256 + wc * 32 + 8 * fq;
#pragma unroll
        for (int ai = 0; ai < 2; ++ai)
#pragma unroll
            for (int m = 0; m < 4; ++m) { bf16_t* rp = base + (size_t)(row0 + ai * 128 + m * 16) * 1024;
#pragma unroll
                for (int bj = 0; bj < 2; ++bj) *(u32x4_t*)(rp + bj * 128) = pack8(acc[ai][bj][m][0], acc[ai][bj][m][1]); }
    }
};

#define GSTRIDE_BEGIN(var, n) for (long var = (long)blockIdx.x * NTHR + ltid(); var < (long)(n); var += (long)gridDim.x * NTHR)

__device__ __forceinline__ void phase_mod(const Params& p, float* lds) {
    const int tid = ltid();
    for (int i = tid; i < 9 * 1024; i += NTHR) { const int s = i >> 10, k = i & 1023; const float v = s < 8 ? p.in[I_C][s * 1024 + k] : p.in[I_CCTX][k]; lds[i] = siluf_(v); }
    __syncthreads();
    float* mod = (float*)(p.ws + OFF_MOD);
    float* part = lds + 9 * 1024;
    for (int u = blockIdx.x; u < DEPTH * 6144 / 64; u += gridDim.x) {
        const int l = u / 96, j0 = (u - l * 96) * 64, kc = tid >> 6, jj = tid & 63;
        const float* w = p.in[I_WADA] + ((size_t)l * 1024 + kc * 128) * 6144 + j0 + jj;
        float acc[9];
#pragma unroll
        for (int s = 0; s < 9; ++s) acc[s] = 0.f;
#pragma unroll 8
        for (int k = 0; k < 128; ++k) { const float wv = w[(size_t)k * 6144];
#pragma unroll
            for (int s = 0; s < 9; ++s) acc[s] += lds[s * 1024 + kc * 128 + k] * wv; }
        __syncthreads();
#pragma unroll
        for (int s = 0; s < 9; ++s) part[(kc * 9 + s) * 64 + jj] = acc[s];
        __syncthreads();
        for (int i = tid; i < 9 * 64; i += NTHR) { const int s = i >> 6, j2 = i & 63; float t = p.in[I_BADA][l * 6144 + j0 + j2];
#pragma unroll
            for (int q = 0; q < 8; ++q) t += part[(q * 9 + s) * 64 + j2];
            mod[(size_t)(l * 9 + s) * 6144 + j0 + j2] = t; }
    }
    float* rope = (float*)(p.ws + OFF_ROPE);
    GSTRIDE_BEGIN(idx, 4096 * 32) {
        const int t = (int)(idx >> 5), i = (int)(idx & 31);
        const float pos = (float)(i < 16 ? (t >> 6) : (t & 63));
        const float inv = powf(10000.0f, -(float)(i & 15) / 16.0f);
        const float ang = pos * inv;
        rope[idx * 2] = cosf(ang); rope[idx * 2 + 1] = sinf(ang);
    }
    __syncthreads();
}

__device__ __forceinline__ void phase_init(const Params& p) {
    const float* mod = (const float*)(p.ws + OFF_MOD);
    xs_t* xs = (xs_t*)(p.ws + OFF_XS); bf16_t* h = (bf16_t*)(p.ws + OFF_H);
    GSTRIDE_BEGIN(idx, (long)T * 256) {
        const int row = (int)(idx >> 8), c4 = (int)(idx & 255) * 4;
        const int b = row / LB, t = row - b * LB;
        const float* src = t < LC ? p.in[I_CTX] + ((size_t)(b * LC + t)) * 1024 : p.in[I_X] + ((size_t)(b * LL + (t - LC))) * 1024;
        const int slot = t < LC ? 8 : b;
        const f32x4 v = *(const f32x4*)(src + c4);
        const f32x4 sh = *(const f32x4*)(mod + (size_t)(slot * 6 + 0) * 1024 + c4), sc = *(const f32x4*)(mod + (size_t)(slot * 6 + 1) * 1024 + c4);
        xs_st4(xs + (size_t)row * 1024 + c4, v);
        const f32x4 hv = v * (sc + 1.0f) + sh;
        u32x2_t o; o[0] = pk2(hv[0], hv[1]); o[1] = pk2(hv[2], hv[3]);
        *(u32x2_t*)(h + (size_t)row * 1024 + c4) = o;
    }
}

__device__ __forceinline__ int winmap(int rho, float& scale) {
    scale = 1.f;
    if (rho < 1568) { if (rho < 256) scale = 0.125f; return rho; }
    if (rho < 1792) return -1;
    if (rho < 2304) scale = 0.125f * 1.4426950408889634f;
    else if (rho >= 3328 && rho < 3840) scale = 0.125f;
    return rho - 224;
}
__device__ __forceinline__ void convert_job(const float* src, const float* src2, int ld, int K, bf16_t* dst, int nrows, int mode, int& itemctr, int cvt_blk0, int cvt_nblk, int dld = 0) {
    if (dld == 0) dld = K;
    const int tid = ltid(), lane = tid & 63, wv = tid >> 6, nwv = cvt_nblk * (NTHR / 64), me = ((int)blockIdx.x - cvt_blk0) * (NTHR / 64) + wv;
    const int nkc = K >> 6, nitems = (nrows >> 6) * nkc;
    int first = (me - itemctr) % nwv; if (first < 0) first += nwv;
    itemctr = (itemctr + nitems) % nwv;
    for (int it = first; it < nitems; it += nwv) {
        const int rg = it / nkc, kc = it - rg * nkc, rho = rg * 64 + lane, k0 = kc * 64;
        float sc = 1.f; int col; const float* s = src;
        if (mode == 0) col = winmap(rho, sc);
        else if (mode == 1) col = rho;
        else { const int ct = rho >> 8, half = (rho >> 7) & 1, i = rho & 127; col = ct * 128 + i; s = half ? src2 : src; }
        const float* sp = s + (size_t)k0 * ld + (col >= 0 ? col : 0);
        if (col < 0) sc = 0.f;
        bf16_t* dp = dst + (size_t)rho * dld + k0;
#pragma unroll
        for (int k8 = 0; k8 < 8; ++k8) { float v[8];
#pragma unroll
            for (int j = 0; j < 8; ++j) v[j] = sp[(size_t)(k8 * 8 + j) * ld] * sc;
            u32x4_t o; o[0] = pk2(v[0], v[1]); o[1] = pk2(v[2], v[3]); o[2] = pk2(v[4], v[5]); o[3] = pk2(v[6], v[7]);
            *(u32x4_t*)(dp + k8 * 8) = o; }
    }
}
__device__ __forceinline__ void phase_convert(const Params& p, int l, int blk0, int nblk, int pieces = 7) {
    if ((int)blockIdx.x < blk0 || (int)blockIdx.x >= blk0 + nblk) return;
    char* wb = p.ws + wdelta(l);
    int ctr = 0;
    if (pieces & 1) convert_job(p.in[I_WIN] + (size_t)l * 1024 * 7712, nullptr, 7712, 1024, (bf16_t*)(wb + OFF_WIN), (int)W_IN_ROWS, 0, ctr, blk0, nblk);
    if (pieces & 4) {
        for (int n = 0; n < 3; ++n)
            convert_job(p.in[I_WBR] + ((size_t)l * 3 + n) * 512 * 1024, nullptr, 1024, 512, (bf16_t*)(wb + OFF_WB) + (size_t)n * 1024 * 512, 1024, 1, ctr, blk0, nblk);
        convert_job(p.in[I_WO] + (size_t)l * 1024 * 1024, nullptr, 1024, 1024, (bf16_t*)(wb + OFF_WO), 1024, 1, ctr, blk0, nblk); }
    for (int e = 0; e < 16; ++e) {
        const size_t eo = ((size_t)l * 16 + e) * 1024 * 512;
        if (pieces & 2) convert_job(p.in[I_WEG] + eo, p.in[I_WEU] + eo, 512, 1024, (bf16_t*)(wb + OFF_WUP) + (size_t)e * 1024 * 1024, 1024, 2, ctr, blk0, nblk);
        if (pieces & 4) convert_job(p.in[I_WED] + eo, nullptr, 1024, 512, (bf16_t*)(wb + OFF_WDN) + (size_t)e * 1024 * 512, 1024, 1, ctr, blk0, nblk);
    }
}

__device__ __forceinline__ void phase_rope_decay(const Params& p, int l, bool commit = true) {
    const float* rope = (const float*)(p.ws + OFF_ROPE);
    GSTRIDE_BEGIN(idx, (long)NB * LL * 2 * 8 * 8) {
        const int i4 = (int)(idx & 7) * 4, hc = (int)(idx >> 3) & 7, which = (int)(idx >> 6) & 1; const int lat = (int)(idx >> 7);
        const int b = lat >> 12, t = lat & 4095; const int row = b * LB + LC + t;
        bf16_t* base = (bf16_t*)(p.ws + (which ? OFF_DK : OFF_DQ)) + (size_t)row * 512 + hc * 64 + i4;
        const u32x2_t a = *(const u32x2_t*)base, bq = *(const u32x2_t*)(base + 32);
        const float x1[4] = {bflo(a[0]), bfhi(a[0]), bflo(a[1]), bfhi(a[1])}, x2[4] = {bflo(bq[0]), bfhi(bq[0]), bflo(bq[1]), bfhi(bq[1])};
        float y1[4], y2[4];
#pragma unroll
        for (int j = 0; j < 4; ++j) { const float cs = rope[((size_t)t * 32 + i4 + j) * 2], sn = rope[((size_t)t * 32 + i4 + j) * 2 + 1];
            y1[j] = x1[j] * cs - x2[j] * sn; y2[j] = x1[j] * sn + x2[j] * cs; }
        u32x2_t o1, o2; o1[0] = pk2(y1[0], y1[1]); o1[1] = pk2(y1[2], y1[3]); o2[0] = pk2(y2[0], y2[1]); o2[1] = pk2(y2[2], y2[3]);
        if (commit) { *(u32x2_t*)base = o1; *(u32x2_t*)(base + 32) = o2; }
    }
#if !FAST_GLA
    const float* gr = (const float*)(p.ws + OFF_GR); float* dec = (float*)(p.ws + OFF_S1);
    const float* wd = p.in[I_GWD] + (size_t)l * 2 * 16 * 256; const float* bd = p.in[I_GBD] + (size_t)l * 2 * 256;
    GSTRIDE_BEGIN(idx, (long)T * 512) {
        const int row = (int)(idx >> 9), dj = (int)(idx & 511), dir = dj >> 8, j = dj & 255;
        float z = bd[dir * 256 + j];
#pragma unroll
        for (int r = 0; r < 16; ++r) z += gr[(size_t)row * 32 + dir * 16 + r] * wd[(dir * 16 + r) * 256 + j];
        const float ls = fminf(z, 0.f) - log1pf(__expf(-fabsf(z)));
        dec[idx] = __expf(ls * (1.0f / 16.0f));
    }
#endif
}

template <int DIR>
__device__ __forceinline__ void gla_naive_dir(const Params& p, int l, int b, float* lds) {
    const int tid = ltid(), hh = tid >> 7, vc = tid & 127, wv = tid >> 6;
    const bf16_t* GQ = (const bf16_t*)(p.ws + OFF_GQ); const bf16_t* GK = (const bf16_t*)(p.ws + OFF_GK); const bf16_t* GV = (const bf16_t*)(p.ws + OFF_GV);
    bf16_t* GG = (bf16_t*)(p.ws + OFF_GG); const float* DEC = (const float*)(p.ws + OFF_S1); float* OF = (float*)(p.ws + OFF_S2);
    float* sq = lds; float* sk = lds + 16 * 256; float* sd = lds + 32 * 256; float* red = lds + 48 * 256;
    float* sv = lds + 49 * 256;
    const float gn = p.in[I_GNG][l * 128 + vc];
    const int row0 = b * LB;
    float S[64];
#pragma unroll
    for (int d = 0; d < 64; ++d) S[d] = 0.f;
    for (int blk = 0; blk < LB / 16; ++blk) {
        int t0;
        if (DIR == 0) t0 = blk * 16; else t0 = blk < 16 ? (15 - blk) * 16 : (LB / 16 - 1 - (blk - 16)) * 16;
        __syncthreads();
        for (int i = tid; i < 16 * 256; i += 512) { const int r = i >> 8, j = i & 255; const size_t row = row0 + t0 + r;
            sq[i] = bf2f(GQ[row * 256 + j]); sk[i] = bf2f(GK[row * 256 + j]); sd[i] = DEC[(row * 2 + DIR) * 256 + j]; }
#pragma unroll 1
        for (int r = 0; r < 16; ++r) sv[r * 512 + tid] = bf2f(GV[(size_t)(row0 + t0 + r) * 512 + hh * 128 + vc]);
        __syncthreads();
#pragma unroll 1
        for (int rr = 0; rr < 16; ++rr) {
            const int r = DIR == 0 ? rr : 15 - rr;
            const float* pq = sq + r * 256 + hh * 64; const float* pk = sk + r * 256 + hh * 64; const float* pd = sd + r * 256 + hh * 64;
            const float vr = sv[r * 512 + tid];
            float o = 0.f;
#pragma unroll
            for (int d = 0; d < 64; ++d) { S[d] = pd[d] * S[d] + pk[d] * vr; o += pq[d] * S[d]; }
            const size_t oi = (size_t)(row0 + t0 + r) * 512 + hh * 128 + vc;
            if (DIR == 0) OF[oi] = o;
            else {
                const float tot = o + OF[oi];
                sv[r * 512 + tid] = tot;
                const float ss = wave_sum(tot * tot); if ((tid & 63) == 0) red[r * 8 + wv] = ss;
            }
        }
        if (DIR == 1) {
            __syncthreads();
#pragma unroll 1
            for (int r = 0; r < 16; ++r) {
                const float ms = (red[r * 8 + hh * 2] + red[r * 8 + hh * 2 + 1]) * (1.0f / 128.0f);
                const size_t gi = (size_t)(row0 + t0 + r) * 512 + hh * 128 + vc;
                const float gate = bf2f(GG[gi]);
                GG[gi] = f2bf(sv[r * 512 + tid] * rsqrtf(ms + RMS_EPS) * gn * siluf_(gate));
            }
        }
    }
    __syncthreads();
}
__device__ __forceinline__ void gla_naive_batch(const Params& p, int l, int b, float* lds) {
    gla_naive_dir<0>(p, l, b, lds);
    gla_naive_dir<1>(p, l, b, lds);
}

__device__ __forceinline__ void diff_naive_tile(const Params& p, int l, int unit, float* lds) {
    const int tid = ltid(), qi = tid & 127, c = (tid >> 7) & 1, hv = tid >> 8;
    const int qt = unit % 34, bh = unit / 34, hh = bh & 3, b = bh >> 2;
    const int nkeys = qt < 2 ? LC : LB;
    const size_t rowq = (size_t)b * LB + qt * 128 + qi;
    bf16_t* DQ = (bf16_t*)(p.ws + OFF_DQ); const bf16_t* DK = (const bf16_t*)(p.ws + OFF_DK); const bf16_t* DV = (const bf16_t*)(p.ws + OFF_DV);
    float q[64], o[64];
    { const bf16_t* qp = DQ + rowq * 512 + hh * 128 + c * 64;
#pragma unroll
      for (int d8 = 0; d8 < 8; ++d8) { const u32x4_t v = *(const u32x4_t*)(qp + d8 * 8);
#pragma unroll
          for (int j = 0; j < 4; ++j) { q[d8 * 8 + 2 * j] = bflo(v[j]); q[d8 * 8 + 2 * j + 1] = bfhi(v[j]); } } }
#pragma unroll
    for (int d = 0; d < 64; ++d) o[d] = 0.f;
    float m = -INFINITY, lsum = 0.f;
    constexpr int KT = 8; float* kb = lds; float* vb = lds + KT * 128;
    for (int k0 = 0; k0 < nkeys; k0 += KT) {
        __syncthreads();
        for (int i = tid; i < KT * 128; i += 512) { const int r = i >> 7, j = i & 127; const size_t row = (size_t)b * LB + k0 + r;
            kb[i] = bf2f(DK[row * 512 + hh * 128 + j]); vb[i] = bf2f(DV[row * 512 + hh * 128 + j]); }
        __syncthreads();
        float s[KT]; float mt = -INFINITY;
#pragma unroll
        for (int j = 0; j < KT; ++j) { const float* kp = kb + j * 128 + c * 64; float a = 0.f;
#pragma unroll
            for (int d = 0; d < 64; ++d) a += q[d] * kp[d];
            s[j] = a; mt = fmaxf(mt, a); }
        const float mn = fmaxf(m, mt), corr = __expf(m - mn);
        lsum *= corr;
#pragma unroll
        for (int d = 0; d < 64; ++d) o[d] *= corr;
#pragma unroll
        for (int j = 0; j < KT; ++j) { const float pj = __expf(s[j] - mn); lsum += pj; const float* vp = vb + j * 128 + hv * 64;
#pragma unroll
            for (int d = 0; d < 64; ++d) o[d] += pj * vp[d]; }
        m = mn;
    }
    __syncthreads();
    { const float inv = 1.f / lsum; float* cp = lds + ((size_t)qi * 2 + c) * 128 + hv * 64;
#pragma unroll
      for (int d = 0; d < 64; ++d) cp[d] = o[d] * inv; }
    __syncthreads();
    {
        float dq = 0.f, dk2 = 0.f; const float* lq = p.in[I_LQ] + l * 128; const float* lk = p.in[I_LK] + l * 128;
        for (int d = 0; d < 64; ++d) { dq += lq[d] * lk[d]; dk2 += lq[64 + d] * lk[64 + d]; }
        const float lam_init = 0.8f - 0.6f * expf(-0.3f * (float)l);
        const float lam = expf(dq) - expf(dk2) + lam_init;
        const int q2 = tid >> 2, part = tid & 3;
        const float* c0 = lds + ((size_t)q2 * 2) * 128 + part * 32; const float* c1 = c0 + 128;
        float v[32]; float ss = 0.f;
#pragma unroll
        for (int d = 0; d < 32; ++d) { v[d] = c0[d] - lam * c1[d]; ss += v[d] * v[d]; }
        ss += __shfl_xor(ss, 1); ss += __shfl_xor(ss, 2);
        const float sc = rsqrtf(ss * (1.0f / 128.0f) + RMS_EPS) * (1.0f - lam_init);
        const float* g = p.in[I_DNG] + l * 128 + part * 32;
        bf16_t* op = DQ + ((size_t)b * LB + qt * 128 + q2) * 512 + hh * 128 + part * 32;
#pragma unroll
        for (int d = 0; d < 32; d += 2) *(unsigned*)(op + d) = pk2(v[d] * sc * g[d], v[d + 1] * sc * g[d + 1]);
    }
    __syncthreads();
}

__device__ __forceinline__ void na_naive_unit(const Params& p, int l, int unit) {
    const int tid = ltid(), h = tid >> 6, lane = tid & 63;
    const size_t row = (size_t)unit * 64 + lane; const int b = (int)(row / LB), t = (int)(row - (size_t)b * LB);
    bf16_t* NQ = (bf16_t*)(p.ws + OFF_NQ); const bf16_t* NK = (const bf16_t*)(p.ws + OFF_NK); const bf16_t* NV = (const bf16_t*)(p.ws + OFF_NV);
    const float* rpb = p.in[I_RPB] + ((size_t)l * 8 + h) * 15 * 31;
    float q[64], o[64];
    { const bf16_t* qp = NQ + row * 512 + h * 64;
#pragma unroll
      for (int d8 = 0; d8 < 8; ++d8) { const u32x4_t v = *(const u32x4_t*)(qp + d8 * 8);
#pragma unroll
          for (int j = 0; j < 4; ++j) { q[d8 * 8 + 2 * j] = bflo(v[j]); q[d8 * 8 + 2 * j + 1] = bfhi(v[j]); } } }
#pragma unroll
    for (int d = 0; d < 64; ++d) o[d] = 0.f;
    float m = -INFINITY, lsum = 0.f;
    const bool lat = t >= LC; const int tp = t - LC, r = tp >> 6, qc = tp & 63;
    const int rs = min(max(r - 4, 0), 56), cs = min(max(qc - 8, 0), 48);
    const int nloc = lat ? 128 : 0;
    for (int kk = 0; kk < nloc + LC; ++kk) {
        size_t krow; float bias = 0.f;
        if (kk < nloc) { const int kr = rs + (kk >> 4), kc = cs + (kk & 15); krow = (size_t)b * LB + LC + kr * 64 + kc; bias = rpb[(kr - r + 7) * 31 + (kc - qc + 15)]; }
        else krow = (size_t)b * LB + (kk - nloc);
        const bf16_t* kp = NK + krow * 512 + h * 64; const bf16_t* vp = NV + krow * 512 + h * 64;
        float s = bias;
#pragma unroll
        for (int d8 = 0; d8 < 8; ++d8) { const u32x4_t v = *(const u32x4_t*)(kp + d8 * 8);
#pragma unroll
            for (int j = 0; j < 4; ++j) { s += q[d8 * 8 + 2 * j] * bflo(v[j]); s += q[d8 * 8 + 2 * j + 1] * bfhi(v[j]); } }
        const float mn = fmaxf(m, s), corr = __expf(m - mn), pj = __expf(s - mn);
        lsum = lsum * corr + pj; m = mn;
#pragma unroll
        for (int d8 = 0; d8 < 8; ++d8) { const u32x4_t v = *(const u32x4_t*)(vp + d8 * 8);
#pragma unroll
            for (int j = 0; j < 4; ++j) { o[d8 * 8 + 2 * j] = o[d8 * 8 + 2 * j] * corr + pj * bflo(v[j]); o[d8 * 8 + 2 * j + 1] = o[d8 * 8 + 2 * j + 1] * corr + pj * bfhi(v[j]); } }
    }
    const float inv = 1.f / lsum;
    bf16_t* op = NQ + row * 512 + h * 64;
#pragma unroll
    for (int d8 = 0; d8 < 8; ++d8) { u32x4_t v;
#pragma unroll
        for (int j = 0; j < 4; ++j) v[j] = pk2(o[d8 * 8 + 2 * j] * inv, o[d8 * 8 + 2 * j + 1] * inv);
        *(u32x4_t*)(op + d8 * 8) = v; }
}

__device__ __forceinline__ void ln_row(float (&v)[16], const float* g, const float* bb, int lane) {
    float s = 0.f;
#pragma unroll
    for (int i = 0; i < 16; ++i) s += v[i];
    const float mu = wave_sum(s) * (1.0f / 1024.0f);
    float q = 0.f;
#pragma unroll
    for (int i = 0; i < 16; ++i) { v[i] -= mu; q += v[i] * v[i]; }
    const float rstd = rsqrtf(wave_sum(q) * (1.0f / 1024.0f) + LN_EPS);
#pragma unroll
    for (int i = 0; i < 4; ++i) { const f32x4 gv = *(const f32x4*)(g + i * 256 + lane * 4), bv = *(const f32x4*)(bb + i * 256 + lane * 4);
#pragma unroll
        for (int j = 0; j < 4; ++j) v[i * 4 + j] = v[i * 4 + j] * rstd * gv[j] + bv[j]; }
}

__device__ __forceinline__ void ln_row_r(float (&v)[16], const float (&g)[16], const float (&b)[16]) {
    float s = 0.f;
#pragma unroll
    for (int i = 0; i < 16; ++i) s += v[i];
    const float mu = wave_sum(s) * (1.0f / 1024.0f);
    float q = 0.f;
#pragma unroll
    for (int i = 0; i < 16; ++i) { v[i] -= mu; q += v[i] * v[i]; }
    const float rstd = rsqrtf(wave_sum(q) * (1.0f / 1024.0f) + LN_EPS);
#pragma unroll
    for (int i = 0; i < 16; ++i) v[i] = v[i] * rstd * g[i] + b[i];
}
__device__ __forceinline__ void ld_cols(float (&d)[16], const float* src, int lane) {
#pragma unroll
    for (int i = 0; i < 4; ++i) { const f32x4 t = *(const f32x4*)(src + i * 256 + lane * 4); d[i * 4] = t[0]; d[i * 4 + 1] = t[1]; d[i * 4 + 2] = t[2]; d[i * 4 + 3] = t[3]; }
}

__device__ __forceinline__ void top2of4(const float s0, const float s1, const float s2, const float s3, int& i1, int& i2, float& sum) {
    i1 = 0; float m1 = s0;
    if (s1 > m1) { m1 = s1; i1 = 1; } if (s2 > m1) { m1 = s2; i1 = 2; } if (s3 > m1) { m1 = s3; i1 = 3; }
    float m2 = -INFINITY; i2 = 0;
    if (i1 != 0 && s0 > m2) { m2 = s0; i2 = 0; } if (i1 != 1 && s1 > m2) { m2 = s1; i2 = 1; }
    if (i1 != 2 && s2 > m2) { m2 = s2; i2 = 2; } if (i1 != 3 && s3 > m2) { m2 = s3; i2 = 3; }
    sum = m1 + m2;
}

__device__ __forceinline__ void phase_ln1_router(const Params& p, int l, float* lds, bool commit = true) {
    const int tid = ltid(), lane = tid & 63, wv = tid >> 6;
    xs_t* xs = (xs_t*)(p.ws + OFF_XS); bf16_t* h = (bf16_t*)(p.ws + OFF_H); const float* mod = (const float*)(p.ws + OFF_MOD);
    int* tok = (int*)(p.ws + OFF_TOK); unsigned* blkcnt = (unsigned*)(p.ws + OFF_BLKCNT);
    const float* g = p.in[I_LNG] + (size_t)(l * 2 + 0) * 1024; const float* bb = p.in[I_LNB] + (size_t)(l * 2 + 0) * 1024;
    const float* wr = p.in[I_WR]; const float* br = p.in[I_BR];
    float* wt = lds; unsigned* lcnt = (unsigned*)(lds + 16 * 1024);
    __syncthreads();
    for (int i = tid; i < 16 * 1024; i += NTHR) { const int col = i >> 4, e = i & 15; wt[e * 1024 + col] = wr[i]; }
    if (tid < 16) lcnt[tid] = 0u;
    __syncthreads();
    const int rpb = (T + (int)gridDim.x - 1) / (int)gridDim.x, r_begin = (int)blockIdx.x * rpb, r_end = min(T, r_begin + rpb);
    float gR[16], bR[16], shR[16], scR[16]; int cur_slot = -1;
    ld_cols(gR, g, lane); ld_cols(bR, bb, lane);
    for (int row = r_begin + wv; row < r_end; row += NTHR / 64) {
        const int slot = row_slot(row);
        if (l == DEPTH - 1 && slot == 8) continue;
        if (slot != cur_slot) { const float* msh = mod + ((size_t)(l * 9 + slot) * 6 + 3) * 1024; ld_cols(shR, msh, lane); ld_cols(scR, msh + 1024, lane); cur_slot = slot; }
        float v[16];
#pragma unroll
        for (int i = 0; i < 4; ++i) { const f32x4 t4 = xs_ld4(xs + (size_t)row * 1024 + i * 256 + lane * 4);
#pragma unroll
            for (int j = 0; j < 4; ++j) v[i * 4 + j] = t4[j]; }
        ln_row_r(v, gR, bR);
        float lg[16];
#pragma unroll
        for (int e = 0; e < 16; ++e) lg[e] = 0.f;
#pragma unroll
        for (int i = 0; i < 4; ++i) {
            const int c0 = i * 256 + lane * 4;
            f32x4 x4; x4[0] = v[i * 4]; x4[1] = v[i * 4 + 1]; x4[2] = v[i * 4 + 2]; x4[3] = v[i * 4 + 3];
            if (commit) xs_st4(xs + (size_t)row * 1024 + c0, x4);
            f32x4 hv; hv[0] = x4[0] * (scR[i * 4] + 1.0f) + shR[i * 4]; hv[1] = x4[1] * (scR[i * 4 + 1] + 1.0f) + shR[i * 4 + 1]; hv[2] = x4[2] * (scR[i * 4 + 2] + 1.0f) + shR[i * 4 + 2]; hv[3] = x4[3] * (scR[i * 4 + 3] + 1.0f) + shR[i * 4 + 3];
            u32x2_t o; o[0] = pk2(hv[0], hv[1]); o[1] = pk2(hv[2], hv[3]);
            if (commit) *(u32x2_t*)(h + (size_t)row * 1024 + c0) = o;
#pragma unroll
            for (int e = 0; e < 16; ++e) { const f32x4 w4 = *(const f32x4*)(wt + e * 1024 + c0);
                lg[e] += hv[0] * w4[0] + hv[1] * w4[1] + hv[2] * w4[2] + hv[3] * w4[3]; }
        }
        float t8[8], t4[4], t2[2], t1;
        { const bool hi = (lane & 32) != 0;
#pragma unroll
          for (int i = 0; i < 8; ++i) { const float keep = hi ? lg[8 + i] : lg[i], give = hi ? lg[i] : lg[8 + i]; t8[i] = keep + __shfl_xor(give, 32); } }
        { const bool hi = (lane & 16) != 0;
#pragma unroll
          for (int i = 0; i < 4; ++i) { const float keep = hi ? t8[4 + i] : t8[i], give = hi ? t8[i] : t8[4 + i]; t4[i] = keep + __shfl_xor(give, 16); } }
        { const bool hi = (lane & 8) != 0;
#pragma unroll
          for (int i = 0; i < 2; ++i) { const float keep = hi ? t4[2 + i] : t4[i], give = hi ? t4[i] : t4[2 + i]; t2[i] = keep + __shfl_xor(give, 8); } }
        { const bool hi = (lane & 4) != 0; const float keep = hi ? t2[1] : t2[0], give = hi ? t2[0] : t2[1]; t1 = keep + __shfl_xor(give, 4); }
        t1 += __shfl_xor(t1, 2); t1 += __shfl_xor(t1, 1);
        float aff[16], sel[16];
#pragma unroll
        for (int e = 0; e < 16; ++e) { const int src = ((e >> 3) & 1) * 32 + ((e >> 2) & 1) * 16 + ((e >> 1) & 1) * 8 + (e & 1) * 4;
            const float lgt = __builtin_bit_cast(float, __builtin_amdgcn_readlane(__builtin_bit_cast(int, t1), src));
            aff[e] = sigmoidf_(lgt); sel[e] = aff[e] + br[e]; }
        int bi1 = 0, bi2 = 0, bg = 0; float best = -INFINITY;
#pragma unroll
        for (int gq = 0; gq < 4; ++gq) { int i1, i2; float sm; top2of4(sel[gq * 4], sel[gq * 4 + 1], sel[gq * 4 + 2], sel[gq * 4 + 3], i1, i2, sm);
            if (sm > best) { best = sm; bg = gq; bi1 = i1; bi2 = i2; } }
        const int e1 = bg * 4 + bi1, e2 = bg * 4 + bi2;
        float a1 = 0.f, a2 = 0.f;
#pragma unroll
        for (int e = 0; e < 16; ++e) { a1 = (e == e1) ? aff[e] : a1; a2 = (e == e2) ? aff[e] : a2; }
        const float inv = 1.f / (a1 + a2);
        if (lane == 0 && commit) {
            const unsigned s1 = atomicAdd(lcnt + e1, 1u), s2 = atomicAdd(lcnt + e2, 1u);
            int* tp = tok + (size_t)row * 8;
            tp[0] = e1; tp[1] = e2; tp[2] = (int)s1; tp[3] = (int)s2; tp[4] = __float_as_int(a1 * inv); tp[5] = __float_as_int(a2 * inv);
        }
    }
    __syncthreads();
    if (tid < 16 && commit) blkcnt[(size_t)blockIdx.x * 16 + tid] = lcnt[tid];
    __syncthreads();
}

__device__ __forceinline__ void phase_gather(const Params& p, int l, float* lds) {
    const int tid = ltid(), lane = tid & 63, wv = tid >> 6;
    const unsigned* blkcnt = (const unsigned*)(p.ws + OFF_BLKCNT); unsigned* cnt = (unsigned*)(p.ws + OFF_CNT) + l * 16;
    int* sbase = (int*)lds;
    int* pairtok = (int*)(p.ws + OFF_PAIRTOK);
    __syncthreads();
    {
        unsigned* lc = (unsigned*)(lds + 64);
        for (int i = tid; i < (int)gridDim.x * 4; i += NTHR) *(u32x4_t*)(lc + i * 4) = *(const u32x4_t*)(blkcnt + (size_t)i * 4);
        __syncthreads();
        if (tid < 16) { unsigned tot = 0, pre = 0;
            for (int b2 = 0; b2 < (int)gridDim.x; ++b2) { const unsigned v = lc[b2 * 16 + tid]; pre += (b2 < (int)blockIdx.x) ? v : 0u; tot += v; }
            sbase[16 + tid] = (int)tot; sbase[32 + tid] = (int)pre;
            if (blockIdx.x == 0) cnt[tid] = tot; } }
    __syncthreads();
    if (tid < 16) { int s = 0; for (int e = 0; e < tid; ++e) s += ((sbase[16 + e] + 255) >> 8) * 256; sbase[48 + tid] = s; sbase[tid] = s + sbase[32 + tid]; }
    __syncthreads();
    if (blockIdx.x == 0) {
        for (int e = 0; e < 16; ++e) { const int lo = sbase[48 + e] + sbase[16 + e], hi = sbase[48 + e] + ((sbase[16 + e] + 255) >> 8) * 256;
            for (int q = lo + tid; q < hi; q += NTHR) pairtok[q] = 0; } }
    int* tok = (int*)(p.ws + OFF_TOK);
    const int rpb = (T + (int)gridDim.x - 1) / (int)gridDim.x, r_begin = (int)blockIdx.x * rpb, r_end = min(T, r_begin + rpb);
    for (int row = r_begin + tid; row < r_end; row += NTHR) {
        if (l == DEPTH - 1 && row_slot(row) == 8) continue;
        int* tp = tok + (size_t)row * 8;
        const int p1 = sbase[tp[0]] + tp[2], p2 = sbase[tp[1]] + tp[3];
        pairtok[p1] = row; pairtok[p2] = row; tp[6] = p1; tp[7] = p2;
    }
    (void)lane; (void)wv;
    __syncthreads();
}

__device__ __forceinline__ void phase_ln2(const Params& p, int l, bool commit = true) {
    const int lane = ltid() & 63, wv = ltid() >> 6;
    xs_t* xs = (xs_t*)(p.ws + OFF_XS); bf16_t* h = (bf16_t*)(p.ws + OFF_H); const float* mod = (const float*)(p.ws + OFF_MOD);
    const int* tok = (const int*)(p.ws + OFF_TOK); const bf16_t* y = (const bf16_t*)(p.ws + OFF_Y);
    float gR[16], bR[16], mgR[16], shR[16], scR[16]; int cur_slot = -1;
    ld_cols(gR, p.in[I_LNG] + (size_t)(l * 2 + 1) * 1024, lane); ld_cols(bR, p.in[I_LNB] + (size_t)(l * 2 + 1) * 1024, lane);
    const int rpb = (T + (int)gridDim.x - 1) / (int)gridDim.x, r_begin = (int)blockIdx.x * rpb, r_end = min(T, r_begin + rpb);
    for (int row = r_begin + wv; row < r_end; row += NTHR / 64) {
        const int slot = row_slot(row);
        if (l == DEPTH - 1 && slot == 8) continue;
        if (slot != cur_slot) { ld_cols(mgR, mod + ((size_t)(l * 9 + slot) * 6 + 5) * 1024, lane);
            if (l < DEPTH - 1) { const float* msh = mod + ((size_t)((l + 1) * 9 + slot) * 6 + 0) * 1024; ld_cols(shR, msh, lane); ld_cols(scR, msh + 1024, lane); }
            cur_slot = slot; }
        const int* tp = tok + (size_t)row * 8;
        const float w0 = __int_as_float(tp[4]), w1 = __int_as_float(tp[5]); const size_t p0 = (size_t)tp[6], p1 = (size_t)tp[7];
        float v[16];
#pragma unroll
        for (int i = 0; i < 4; ++i) { const int c0 = i * 256 + lane * 4;
            const f32x4 x4 = xs_ld4(xs + (size_t)row * 1024 + c0);
            const u32x2_t ya = *(const u32x2_t*)(y + p0 * 1024 + c0), yb = *(const u32x2_t*)(y + p1 * 1024 + c0);
            v[i * 4 + 0] = ALPHA * x4[0] + mgR[i * 4 + 0] * (w0 * bflo(ya[0]) + w1 * bflo(yb[0]));
            v[i * 4 + 1] = ALPHA * x4[1] + mgR[i * 4 + 1] * (w0 * bfhi(ya[0]) + w1 * bfhi(yb[0]));
            v[i * 4 + 2] = ALPHA * x4[2] + mgR[i * 4 + 2] * (w0 * bflo(ya[1]) + w1 * bflo(yb[1]));
            v[i * 4 + 3] = ALPHA * x4[3] + mgR[i * 4 + 3] * (w0 * bfhi(ya[1]) + w1 * bfhi(yb[1])); }
        ln_row_r(v, gR, bR);
        const int b = row / LB, t = row - b * LB;
        if (l == DEPTH - 1) {
            if (t >= LC) { float* op = p.out + ((size_t)b * LL + (t - LC)) * 1024;
#pragma unroll
                for (int i = 0; i < 4; ++i) { f32x4 x4; x4[0] = v[i * 4]; x4[1] = v[i * 4 + 1]; x4[2] = v[i * 4 + 2]; x4[3] = v[i * 4 + 3]; if (commit) *(f32x4*)(op + i * 256 + lane * 4) = x4; } }
        } else {
#pragma unroll
            for (int i = 0; i < 4; ++i) { const int c0 = i * 256 + lane * 4;
                f32x4 x4; x4[0] = v[i * 4]; x4[1] = v[i * 4 + 1]; x4[2] = v[i * 4 + 2]; x4[3] = v[i * 4 + 3];
                if (commit) xs_st4(xs + (size_t)row * 1024 + c0, x4);
                f32x4 hv; hv[0] = x4[0] * (scR[i * 4] + 1.0f) + shR[i * 4]; hv[1] = x4[1] * (scR[i * 4 + 1] + 1.0f) + shR[i * 4 + 1]; hv[2] = x4[2] * (scR[i * 4 + 2] + 1.0f) + shR[i * 4 + 2]; hv[3] = x4[3] * (scR[i * 4 + 3] + 1.0f) + shR[i * 4 + 3];
                u32x2_t o; o[0] = pk2(hv[0], hv[1]); o[1] = pk2(hv[2], hv[3]);
                if (commit) *(u32x2_t*)(h + (size_t)row * 1024 + c0) = o; }
        }
    }
}

typedef float f32x16 __attribute__((ext_vector_type(16)));
typedef short bf16x8_t __attribute__((ext_vector_type(8)));
constexpr float LOG2E = 1.4426950408889634f;

__device__ __forceinline__ void vtrans_buf(const bf16_t* src, bf16_t* dst, bf16_t* lds) {
    const int tid = ltid();
    constexpr int LS = 72;
    for (int it = blockIdx.x; it < NB * 8 * (LB / 64); it += gridDim.x) {
        const int kt = it % (LB / 64), bc = it / (LB / 64), cg = bc & 7, b = bc >> 3;
        __syncthreads();
        { const int key = tid >> 3, d8 = (tid & 7) * 8;
          const u32x4_t v = *(const u32x4_t*)(src + ((size_t)b * LB + kt * 64 + key) * 512 + cg * 64 + d8);
#pragma unroll
          for (int j = 0; j < 4; ++j) { lds[(d8 + 2 * j) * LS + key] = (bf16_t)(v[j] & 0xffffu); lds[(d8 + 2 * j + 1) * LS + key] = (bf16_t)(v[j] >> 16); } }
        __syncthreads();
        { const int dv = tid >> 3, k8 = (tid & 7) * 8;
          const u32x4_t v = *(const u32x4_t*)(lds + dv * LS + k8);
          *(u32x4_t*)(dst + ((size_t)(b * 512 + cg * 64 + dv)) * LB + kt * 64 + k8) = v; }
    }
    __syncthreads();
}
__device__ __forceinline__ void phase_vtrans(const Params& p, int l, bf16_t* lds) {
    (void)lds;
    { float* bt = (float*)(p.ws + OFF_NBT); const float* rpb = p.in[I_RPB] + (size_t)l * 8 * 15 * 31;
      for (int i = blockIdx.x * NTHR + ltid(); i < 8 * 15 * 4 * 64 * 16; i += gridDim.x * NTHR) {
          const int r = i & 15, lane = (i >> 4) & 63, ib = (i >> 10) & 1, kb = (i >> 11) & 1, hd = i >> 12;
          const int kc = 32 * kb + (r & 3) + 8 * (r >> 2) + 4 * (lane >> 5), qc = 32 * ib + (lane & 31);
          const int cs = min(max(qc - 8, 0), 48);
          bt[i] = (kc >= cs && kc < cs + 16) ? rpb[hd * 31 + (kc - qc + 15)] : -1e30f; } }
}

constexpr int DA_KS = 272, DA_VS = 144, DA_KB = 64 * DA_KS  , DA_VB = 128 * DA_VS  ;
constexpr int DA_UNITS = NB * 4 * 34;
constexpr float DA_THR = 8.0f;
#ifndef DPV
#define DPV 0
#endif
__device__ __forceinline__ void diff_attn_unit(const Params& p, int l, int unit, unsigned char* shm, bool commit = true) {
    const bool dry = !commit;
    const int tid = ltid(), lane = tid & 63, wid = tid >> 6, c = wid & 1, qb = wid >> 1, m32 = lane & 31, h = lane >> 5;
    int bh, qt;
    if (unit < NB * 4 * 32) { bh = (unit >> 8) * 8 + (unit & 7); qt = 2 + ((unit & 255) >> 3); } else { const int u2 = unit - NB * 4 * 32; bh = u2 >> 1; qt = u2 & 1; }
    const int hh = bh & 3, b = bh >> 2, nkt = qt < 2 ? LC / 64 : LB / 64;
    const size_t rowb = (size_t)b * LB;
    bf16_t* DQ = (bf16_t*)(p.ws + OFF_DQ); const bf16_t* DK = (const bf16_t*)(p.ws + OFF_DK); const bf16_t* VT = (const bf16_t*)(p.ws + OFF_VT);
    const size_t qrow = rowb + qt * 128 + qb * 32 + m32;
    bf16x8_t qf[4];
#pragma unroll
    for (int s = 0; s < 4; ++s) qf[s] = *(const bf16x8_t*)(DQ + qrow * 512 + hh * 128 + c * 64 + 16 * s + 8 * h);
    f32x16 O[4];
#pragma unroll
    for (int d = 0; d < 4; ++d)
#pragma unroll
        for (int r = 0; r < 16; ++r) O[d][r] = 0.f;
    float mrun = 0.f, lrun = 0.f;
    f32x16 minit;
#pragma unroll
    for (int r = 0; r < 16; ++r) minit[r] = 0.f;
    const bf16_t* kg[2]; const bf16_t* vg[2]; int kl[2], vl[2];
#pragma unroll
    for (int j = 0; j < 2; ++j) { const int i = tid + j * 512;
        kg[j] = DK + (rowb + (i >> 4)) * 512 + hh * 128 + (i & 15) * 8; kl[j] = (i >> 4) * DA_KS + (i & 15) * 16;
        vg[j] = VT + ((size_t)(bh * 128 + (i >> 3))) * LB + (i & 7) * 8; vl[j] = 2 * DA_KB + (i >> 3) * DA_VS + ((i & 7) >> 1) * 32 + (i & 1) * 8; }
    u32x4_t rk[2], rv[2];
    __syncthreads();
#pragma unroll
    for (int j = 0; j < 2; ++j) { rk[j] = *(const u32x4_t*)(kg[j]); rv[j] = *(const u32x4_t*)(vg[j]); }
#pragma unroll
    for (int j = 0; j < 2; ++j) { *(u32x4_t*)(shm + kl[j]) = rk[j]; u32x2_t a, bq; a[0] = rv[j][0]; a[1] = rv[j][1]; bq[0] = rv[j][2]; bq[1] = rv[j][3];
        *(u32x2_t*)(shm + vl[j]) = a; *(u32x2_t*)(shm + vl[j] + 16) = bq; }
    __syncthreads();
    for (int kt = 0; kt < nkt; ++kt) {
        const int buf = kt & 1; const bool more = kt + 1 < nkt;
        if (more && !((DPV & 8) && dry)) {
#pragma unroll
            for (int j = 0; j < 2; ++j) { rk[j] = *(const u32x4_t*)(kg[j] + (size_t)(kt + 1) * 64 * 512); rv[j] = *(const u32x4_t*)(vg[j] + (kt + 1) * 64); }
        }
        const unsigned char* kbase = shm + buf * DA_KB + m32 * DA_KS + (c * 64 + 8 * h) * 2;
        const unsigned char* vbase = shm + 2 * DA_KB + buf * DA_VB + m32 * DA_VS + 16 * h;
        bf16x8_t kf[2][4]; bf16x8_t vq[2][4];
#pragma unroll
        for (int kb = 0; kb < 2; ++kb)
#pragma unroll
            for (int s = 0; s < 4; ++s) kf[kb][s] = *(const bf16x8_t*)(kbase + kb * 32 * DA_KS + s * 32);
#pragma unroll
        for (int ks = 0; ks < 4; ++ks) vq[0][ks] = ((DPV & 32) && dry) ? kf[0][ks] : *(const bf16x8_t*)(vbase + ks * 32);
        __builtin_amdgcn_sched_barrier(0);
        bf16x8_t pf[4];
        {
            f32x16 S[2];
#pragma unroll
            for (int kb = 0; kb < 2; ++kb) {
                if ((DPV & 4) && dry) { S[kb] = minit; S[kb][0] += __builtin_bit_cast(float, (int)kf[kb][0][0] + (int)kf[kb][3][1]) * 1e-30f; } else {
                S[kb] = __builtin_amdgcn_mfma_f32_32x32x16_bf16(kf[kb][0], qf[0], minit, 0, 0, 0);
#pragma unroll
                for (int s = 1; s < 4; ++s) S[kb] = __builtin_amdgcn_mfma_f32_32x32x16_bf16(kf[kb][s], qf[s], S[kb], 0, 0, 0); }
            }
            if (!((DPV & 1) && dry)) {
            float mx = S[0][0];
#pragma unroll
            for (int r = 1; r < 16; ++r) mx = fmaxf(mx, S[0][r]);
#pragma unroll
            for (int r = 0; r < 16; ++r) mx = fmaxf(mx, S[1][r]);
            { auto rr = __builtin_amdgcn_permlane32_swap(__float_as_uint(mx), __float_as_uint(mx), false, false); mx = fmaxf(__uint_as_float(rr[0]), __uint_as_float(rr[1])); }
            float corr = 1.f;
            if (kt == 0 || !__all(mx <= DA_THR * LOG2E)) { const float dm = kt == 0 ? mx : fmaxf(mx, 0.f); corr = __builtin_amdgcn_exp2f(-dm); mrun += dm;
#pragma unroll
                for (int d = 0; d < 4; ++d)
#pragma unroll
                    for (int r = 0; r < 16; ++r) O[d][r] *= corr;
#pragma unroll
                for (int kb = 0; kb < 2; ++kb)
#pragma unroll
                    for (int r = 0; r < 16; ++r) S[kb][r] -= dm;
#pragma unroll
                for (int r = 0; r < 16; ++r) minit[r] = -mrun; }
            float sum = 0.f;
#pragma unroll
            for (int kb = 0; kb < 2; ++kb)
#pragma unroll
                for (int r = 0; r < 16; ++r) { const float e = __builtin_amdgcn_exp2f(S[kb][r]); S[kb][r] = e; sum += e; }
            { auto rr = __builtin_amdgcn_permlane32_swap(__float_as_uint(sum), __float_as_uint(sum), false, false); sum = __uint_as_float(rr[0]) + __uint_as_float(rr[1]); }
            lrun = lrun * corr + sum;
            }
#pragma unroll
            for (int ks = 0; ks < 4; ++ks) { const int kb = ks >> 1, r0 = (ks & 1) * 8; u32x4_t pk;
#pragma unroll
                for (int j = 0; j < 4; ++j) pk[j] = pk2(S[kb][r0 + 2 * j], S[kb][r0 + 2 * j + 1]);
                pf[ks] = __builtin_bit_cast(bf16x8_t, pk); }
        }
#pragma unroll
        for (int d = 0; d < 4; ++d) {
            if (d < 3) {
#pragma unroll
                for (int ks = 0; ks < 4; ++ks) vq[(d + 1) & 1][ks] = ((DPV & 32) && dry) ? kf[1][ks] : *(const bf16x8_t*)(vbase + (d + 1) * 32 * DA_VS + ks * 32);
            }
            __builtin_amdgcn_sched_barrier(0);
#pragma unroll
            for (int ks = 0; ks < 4; ++ks) O[d] = __builtin_amdgcn_mfma_f32_32x32x16_bf16(vq[d & 1][ks], pf[ks], O[d], 0, 0, 0);
        }
        if (more && !((DPV & 8) && dry)) {
#pragma unroll
            for (int j = 0; j < 2; ++j) { *(u32x4_t*)(shm + (buf ^ 1) * DA_KB + kl[j]) = rk[j]; u32x2_t a, bq; a[0] = rv[j][0]; a[1] = rv[j][1]; bq[0] = rv[j][2]; bq[1] = rv[j][3];
                *(u32x2_t*)(shm + (buf ^ 1) * DA_VB + vl[j]) = a; *(u32x2_t*)(shm + (buf ^ 1) * DA_VB + vl[j] + 16) = bq; }
        }
        if (!((DPV & 16) && dry)) __syncthreads();
    }
    float* xch = (float*)shm;
    { const float inv = 1.f / lrun;
#pragma unroll
        for (int d = 0; d < 4; ++d)
#pragma unroll
            for (int r = 0; r < 16; ++r) O[d][r] *= inv; }
    if (c == 1) {
#pragma unroll
        for (int d = 0; d < 4; ++d)
#pragma unroll
            for (int r = 0; r < 16; ++r) xch[(((qb * 4 + d) * 16 + r) << 6) + lane] = O[d][r];
    }
    __syncthreads();
    if (c == 0) {
        float dq = 0.f, dk2 = 0.f; const float* lq = p.in[I_LQ] + l * 128; const float* lk = p.in[I_LK] + l * 128;
        for (int d = 0; d < 64; ++d) { dq += lq[d] * lk[d]; dk2 += lq[64 + d] * lk[64 + d]; }
        const float lam_init = 0.8f - 0.6f * expf(-0.3f * (float)l);
        const float lam = expf(dq) - expf(dk2) + lam_init;
        const float* g = p.in[I_DNG] + l * 128;
        float ss = 0.f;
#pragma unroll
        for (int d = 0; d < 4; ++d)
#pragma unroll
            for (int r = 0; r < 16; ++r) { const float v = O[d][r] - lam * xch[(((qb * 4 + d) * 16 + r) << 6) + lane]; O[d][r] = v; ss += v * v; }
        ss += __shfl_xor(ss, 32);
        const float sc = rsqrtf(ss * (1.0f / 128.0f) + RMS_EPS) * (1.0f - lam_init);
        bf16_t* op = DQ + qrow * 512 + hh * 128 + 4 * h;
#pragma unroll
        for (int d = 0; d < 4; ++d)
#pragma unroll
            for (int r4 = 0; r4 < 4; ++r4) { const int dv = 32 * d + 8 * r4; const f32x4 gv = *(const f32x4*)(g + dv + 4 * h);
                u32x2_t o; o[0] = pk2(O[d][4 * r4] * sc * gv[0], O[d][4 * r4 + 1] * sc * gv[1]); o[1] = pk2(O[d][4 * r4 + 2] * sc * gv[2], O[d][4 * r4 + 3] * sc * gv[3]);
                if (commit) *(u32x2_t*)(op + dv) = o; }
    }
    __syncthreads();
}

constexpr int NA_KS = 528, NA_VS = 136, NA_KB = 64 * NA_KS  , NA_VB = 256 * NA_VS  ;
constexpr int NA_UNITS = NB * 64 * 2 + NB * 4 * 2;
__device__ __forceinline__ void na_attn_unit(const Params& p, int l, int unit, unsigned char* shm, bool commit = true) {
    const int tid = ltid(), lane = tid & 63, wid = tid >> 6, hgi = wid & 3, ib = wid >> 2, m32 = lane & 31, h = lane >> 5;
    int b, hg, r, ntile; size_t rowq0;
    if (unit < NB * 64 * 2) { hg = unit & 1; r = (unit >> 1) & 63; b = unit >> 7; ntile = 12; rowq0 = (size_t)b * LB + LC + r * 64; }
    else { const int u2 = unit - NB * 64 * 2; hg = u2 & 1; r = -1; b = u2 >> 3; ntile = 4; rowq0 = (size_t)b * LB + ((u2 >> 1) & 3) * 64; }
    const int rs = min(max(r - 4, 0), 56), head = hg * 4 + hgi;
    const size_t rowb = (size_t)b * LB;
    bf16_t* NQ = (bf16_t*)(p.ws + OFF_NQ); const bf16_t* NK = (const bf16_t*)(p.ws + OFF_NK); const bf16_t* NVT = (const bf16_t*)(p.ws + OFF_NVT);
    const float* BT = (const float*)(p.ws + OFF_NBT);
    const size_t qrow = rowq0 + ib * 32 + m32;
    bf16x8_t qf[4];
#pragma unroll
    for (int s = 0; s < 4; ++s) qf[s] = *(const bf16x8_t*)(NQ + qrow * 512 + head * 64 + 16 * s + 8 * h);
    f32x16 O[2];
#pragma unroll
    for (int d = 0; d < 2; ++d)
#pragma unroll
        for (int q = 0; q < 16; ++q) O[d][q] = 0.f;
    float mrun = -INFINITY, lrun = 0.f;
    const bf16_t* kg[4]; const bf16_t* vg[4]; int kl[4], vl[4];
#pragma unroll
    for (int j = 0; j < 4; ++j) { const int i = tid + j * 512;
        kg[j] = NK + (rowb + (i >> 5)) * 512 + hg * 256 + (i & 31) * 8; kl[j] = (i >> 5) * NA_KS + (i & 31) * 16;
        vg[j] = NVT + ((size_t)(b * 512 + hg * 256 + (i >> 3))) * LB + (i & 7) * 8; vl[j] = 2 * NA_KB + (i >> 3) * NA_VS + (i & 7) * 16; }
    auto tile_of = [&](int t) -> int { return ntile == 12 ? (t < 8 ? 4 + rs + t : t - 8) : t; };
    u32x4_t rk[4], rv[4];
    __syncthreads();
    { const int tt = tile_of(0);
#pragma unroll
      for (int j = 0; j < 4; ++j) { rk[j] = *(const u32x4_t*)(kg[j] + (size_t)tt * 64 * 512); rv[j] = *(const u32x4_t*)(vg[j] + tt * 64); } }
#pragma unroll
    for (int j = 0; j < 4; ++j) { *(u32x4_t*)(shm + kl[j]) = rk[j]; u32x2_t a, bq; a[0] = rv[j][0]; a[1] = rv[j][1]; bq[0] = rv[j][2]; bq[1] = rv[j][3];
        *(u32x2_t*)(shm + vl[j]) = a; *(u32x2_t*)(shm + vl[j] + 8) = bq; }
    __syncthreads();
    for (int t = 0; t < ntile; ++t) {
        const int buf = t & 1; const bool more = t + 1 < ntile;
        if (more) { const int tt = tile_of(t + 1);
#pragma unroll
            for (int j = 0; j < 4; ++j) { rk[j] = *(const u32x4_t*)(kg[j] + (size_t)tt * 64 * 512); rv[j] = *(const u32x4_t*)(vg[j] + tt * 64); }
        }
        const unsigned char* kbase = shm + buf * NA_KB + m32 * NA_KS + (hgi * 64 + 8 * h) * 2;
        const unsigned char* vbase = shm + 2 * NA_KB + buf * NA_VB + (hgi * 64 + m32) * NA_VS + 8 * h;
        bf16x8_t pf[4];
        {
            bf16x8_t kf[2][4];
#pragma unroll
            for (int kb = 0; kb < 2; ++kb)
#pragma unroll
                for (int s = 0; s < 4; ++s) kf[kb][s] = *(const bf16x8_t*)(kbase + kb * 32 * NA_KS + s * 32);
            f32x16 S[2];
            const bool local = (ntile == 12) && (t < 8);
            if (local) { const int dr = rs + t - r + 7; const float* bp = BT + ((size_t)(((head * 15 + dr) * 2) * 2 + ib) * 64 + lane) * 16;
#pragma unroll
                for (int kb = 0; kb < 2; ++kb)
#pragma unroll
                    for (int q4 = 0; q4 < 4; ++q4) { const f32x4 bv = *(const f32x4*)(bp + kb * 2 * 64 * 16 + q4 * 4);
                        S[kb][q4 * 4] = bv[0]; S[kb][q4 * 4 + 1] = bv[1]; S[kb][q4 * 4 + 2] = bv[2]; S[kb][q4 * 4 + 3] = bv[3]; }
            } else {
#pragma unroll
                for (int kb = 0; kb < 2; ++kb)
#pragma unroll
                    for (int q = 0; q < 16; ++q) S[kb][q] = 0.f;
            }
#pragma unroll
            for (int kb = 0; kb < 2; ++kb)
#pragma unroll
                for (int s = 0; s < 4; ++s) S[kb] = __builtin_amdgcn_mfma_f32_32x32x16_bf16(kf[kb][s], qf[s], S[kb], 0, 0, 0);
            float mx = S[0][0];
#pragma unroll
            for (int q = 1; q < 16; ++q) mx = fmaxf(mx, S[0][q]);
#pragma unroll
            for (int q = 0; q < 16; ++q) mx = fmaxf(mx, S[1][q]);
            { auto rr = __builtin_amdgcn_permlane32_swap(__float_as_uint(mx), __float_as_uint(mx), false, false); mx = fmaxf(__uint_as_float(rr[0]), __uint_as_float(rr[1])); }
            float corr = 1.f;
            if (!__all(mx - mrun <= DA_THR)) { const float mn = fmaxf(mrun, mx); corr = __builtin_amdgcn_exp2f((mrun - mn) * LOG2E); mrun = mn;
#pragma unroll
                for (int d = 0; d < 2; ++d)
#pragma unroll
                    for (int q = 0; q < 16; ++q) O[d][q] *= corr; }
            const float mnl = mrun * LOG2E;
            float sum = 0.f;
#pragma unroll
            for (int kb = 0; kb < 2; ++kb)
#pragma unroll
                for (int q = 0; q < 16; ++q) { const float e = __builtin_amdgcn_exp2f(S[kb][q] * LOG2E - mnl); S[kb][q] = e; sum += e; }
            { auto rr = __builtin_amdgcn_permlane32_swap(__float_as_uint(sum), __float_as_uint(sum), false, false); sum = __uint_as_float(rr[0]) + __uint_as_float(rr[1]); }
            lrun = lrun * corr + sum;
#pragma unroll
            for (int ks = 0; ks < 4; ++ks) { const int kb = ks >> 1, r0 = (ks & 1) * 8; u32x4_t pk;
#pragma unroll
                for (int j = 0; j < 4; ++j) pk[j] = pk2(S[kb][r0 + 2 * j], S[kb][r0 + 2 * j + 1]);
                pf[ks] = __builtin_bit_cast(bf16x8_t, pk); }
        }
        { u32x2_t vq[2][4][2];
#pragma unroll
          for (int d = 0; d < 2; ++d)
#pragma unroll
              for (int ks = 0; ks < 4; ++ks) { vq[d][ks][0] = *(const u32x2_t*)(vbase + d * 32 * NA_VS + ks * 32); vq[d][ks][1] = *(const u32x2_t*)(vbase + d * 32 * NA_VS + ks * 32 + 16); }
          __builtin_amdgcn_sched_barrier(0);
#pragma unroll
          for (int d = 0; d < 2; ++d)
#pragma unroll
              for (int ks = 0; ks < 4; ++ks) { u32x4_t vv; vv[0] = vq[d][ks][0][0]; vv[1] = vq[d][ks][0][1]; vv[2] = vq[d][ks][1][0]; vv[3] = vq[d][ks][1][1];
                  O[d] = __builtin_amdgcn_mfma_f32_32x32x16_bf16(__builtin_bit_cast(bf16x8_t, vv), pf[ks], O[d], 0, 0, 0); } }
        if (more) {
#pragma unroll
            for (int j = 0; j < 4; ++j) { *(u32x4_t*)(shm + (buf ^ 1) * NA_KB + kl[j]) = rk[j]; u32x2_t a, bq; a[0] = rv[j][0]; a[1] = rv[j][1]; bq[0] = rv[j][2]; bq[1] = rv[j][3];
                *(u32x2_t*)(shm + (buf ^ 1) * NA_VB + vl[j]) = a; *(u32x2_t*)(shm + (buf ^ 1) * NA_VB + vl[j] + 8) = bq; }
        }
        __syncthreads();
    }
    { const float inv = 1.f / lrun; bf16_t* op = NQ + qrow * 512 + head * 64 + 4 * h;
#pragma unroll
        for (int d = 0; d < 2; ++d)
#pragma unroll
            for (int r4 = 0; r4 < 4; ++r4) { u32x2_t o; o[0] = pk2(O[d][4 * r4] * inv, O[d][4 * r4 + 1] * inv); o[1] = pk2(O[d][4 * r4 + 2] * inv, O[d][4 * r4 + 3] * inv);
                if (commit) *(u32x2_t*)(op + 32 * d + 8 * r4) = o; } }
    __syncthreads();
}

constexpr int GL_XS = 144;
__device__ __forceinline__ void gla_stage_gr(const Params& p, int row0, float* grs, int tid) {
    const float* gr = (const float*)(p.ws + OFF_GR);
    __syncthreads();
    *(f32x4*)(grs + tid * 4) = *(const f32x4*)(gr + (size_t)row0 * 32 + tid * 4);
    __syncthreads();
}
struct GlaCol { float w[16]; float bcol; };
__device__ __forceinline__ void gla_col_init(const Params& p, int l, int hh, int dir, int lane, GlaCol& gc) {
    const int col = hh * 64 + lane;
    const float* wd = p.in[I_GWD] + ((size_t)(l * 2 + dir) * 16) * 256 + col;
#pragma unroll
    for (int i = 0; i < 16; ++i) gc.w[i] = wd[i * 256];
    gc.bcol = p.in[I_GBD][(size_t)(l * 2 + dir) * 256 + col];
}
__device__ __forceinline__ float gla_logd(const GlaCol& gc, const float* grs, int r, int dir) {
    const float* gp = grs + r * 32 + dir * 16;
    float z = gc.bcol;
#pragma unroll
    for (int i4 = 0; i4 < 4; ++i4) { const f32x4 g4 = *(const f32x4*)(gp + i4 * 4);
        z += g4[0] * gc.w[i4 * 4] + g4[1] * gc.w[i4 * 4 + 1] + g4[2] * gc.w[i4 * 4 + 2] + g4[3] * gc.w[i4 * 4 + 3]; }
    return (fminf(z, 0.f) - 0.6931471805599453f * __builtin_amdgcn_logf(1.f + __builtin_amdgcn_exp2f(-fabsf(z) * LOG2E))) * (1.0f / 16.0f);
}
__device__ __forceinline__ float gla_total(const GlaCol& gc, const float* grs, int dir) {
    float run = 0.f;
#pragma unroll 4
    for (int r = 0; r < 64; ++r) run += gla_logd(gc, grs, r, dir);
    return run;
}

struct GlaCum { f32x16 cum[2][2]; float last[2]; };
__device__ __forceinline__ void gla_cum_mfma(const Params& p, int l, int hh, int dir, int lane, const float* grs, GlaCum& G) {
    const int m32 = lane & 31, h = lane >> 5;
    bf16x8_t ga[2];
#pragma unroll
    for (int mb = 0; mb < 2; ++mb) { const float* gp = grs + (32 * mb + m32) * 32 + dir * 16 + 8 * h; const f32x4 a = *(const f32x4*)gp, b4 = *(const f32x4*)(gp + 4);
        u32x4_t pk; pk[0] = pk2(a[0], a[1]); pk[1] = pk2(a[2], a[3]); pk[2] = pk2(b4[0], b4[1]); pk[3] = pk2(b4[2], b4[3]); ga[mb] = __builtin_bit_cast(bf16x8_t, pk); }
    bf16x8_t wb[2]; float bcol[2];
#pragma unroll
    for (int nb = 0; nb < 2; ++nb) { const int col = hh * 64 + 32 * nb + m32; const float* wd = p.in[I_GWD] + ((size_t)(l * 2 + dir) * 16 + 8 * h) * 256 + col;
        u32x4_t pk;
#pragma unroll
        for (int j = 0; j < 4; ++j) pk[j] = pk2(wd[(2 * j) * 256], wd[(2 * j + 1) * 256]);
        wb[nb] = __builtin_bit_cast(bf16x8_t, pk); bcol[nb] = p.in[I_GBD][(size_t)(l * 2 + dir) * 256 + col]; }
    f32x16 ls[2][2];
#pragma unroll
    for (int mb = 0; mb < 2; ++mb)
#pragma unroll
        for (int nb = 0; nb < 2; ++nb) {
            f32x16 z;
#pragma unroll
            for (int r = 0; r < 16; ++r) z[r] = bcol[nb];
            z = __builtin_amdgcn_mfma_f32_32x32x16_bf16(ga[mb], wb[nb], z, 0, 0, 0);
#pragma unroll
            for (int r = 0; r < 16; ++r) { const float zz = z[r];
                ls[mb][nb][r] = (fminf(zz, 0.f) - 0.6931471805599453f * __builtin_amdgcn_logf(1.f + __builtin_amdgcn_exp2f(-fabsf(zz) * LOG2E))) * (1.0f / 16.0f); }
        }
#pragma unroll
    for (int ib = 0; ib < 2; ++ib)
#pragma unroll
        for (int nb = 0; nb < 2; ++nb) {
#pragma unroll
            for (int r = 0; r < 16; ++r) G.cum[ib][nb][r] = 0.f; }
#pragma unroll
    for (int ib = 0; ib < 2; ++ib)
#pragma unroll
        for (int jb = 0; jb < 2; ++jb) {
            if (jb != ib && ((jb > ib) != (dir == 1))) continue;
#pragma unroll
            for (int s = 0; s < 2; ++s) {
                u32x4_t lk;
#pragma unroll
                for (int j = 0; j < 4; ++j) { unsigned w2 = 0u;
#pragma unroll
                    for (int q = 0; q < 2; ++q) { const int e = 2 * j + q, jr = 32 * jb + 16 * s + 8 * (e >> 2) + 4 * h + (e & 3), ir = 32 * ib + m32;
                        const bool on = dir ? (jr >= ir) : (jr <= ir); w2 |= on ? (0x3F80u << (16 * q)) : 0u; }
                    lk[j] = w2; }
                const bf16x8_t lf = __builtin_bit_cast(bf16x8_t, lk);
#pragma unroll
                for (int nb = 0; nb < 2; ++nb) { u32x4_t pk;
#pragma unroll
                    for (int j = 0; j < 4; ++j) pk[j] = pk2(ls[jb][nb][8 * s + 2 * j], ls[jb][nb][8 * s + 2 * j + 1]);
                    G.cum[ib][nb] = __builtin_amdgcn_mfma_f32_32x32x16_bf16(lf, __builtin_bit_cast(bf16x8_t, pk), G.cum[ib][nb], 0, 0, 0); }
            }
        }
#pragma unroll
    for (int nb = 0; nb < 2; ++nb) { const float v = dir ? G.cum[0][nb][0] : G.cum[1][nb][15]; G.last[nb] = __shfl(v, dir ? m32 : m32 + 32); }
}

__device__ __forceinline__ void gla_a_unit(const Params& p, int l, int unit, unsigned char* shm) {
    const int tid = ltid(), lane = tid & 63, wid = tid >> 6, hh = wid >> 1, dir = wid & 1, m32 = lane & 31, h = lane >> 5;
    const int b = unit / 68, n = unit - b * 68; const int row0 = b * LB + n * 64; const int bhd = (b * 4 + hh) * 2 + dir;
    float* grs = (float*)shm; unsigned char* kt = shm + 8192 + wid * 18432;
    unsigned char* kraw = kt + 9216;
    const bf16_t* gvt = (const bf16_t*)(p.ws + OFF_GVT) + ((size_t)(b * 512 + hh * 128 + m32)) * LB + n * 64 + 8 * h;
    bf16x8_t bfr[4][4];
#pragma unroll
    for (int s = 0; s < 4; ++s)
#pragma unroll
        for (int nb = 0; nb < 4; ++nb) bfr[s][nb] = *(const bf16x8_t*)(gvt + (size_t)(32 * nb) * LB + 16 * s);
    gla_stage_gr(p, row0, grs, tid);
    {
        const bf16_t* gk = (const bf16_t*)(p.ws + OFF_GK) + (size_t)row0 * 256 + hh * 64;
        u32x4_t t8[8];
#pragma unroll
        for (int i = 0; i < 8; ++i) t8[i] = *(const u32x4_t*)(gk + (size_t)(8 * i + (lane >> 3)) * 256 + (lane & 7) * 8);
#pragma unroll
        for (int i = 0; i < 8; ++i) *(u32x4_t*)(kraw + (8 * i + (lane >> 3)) * GL_XS + (lane & 7) * 16) = t8[i];
    }
    {
        GlaCum G; gla_cum_mfma(p, l, hh, dir, lane, grs, G);
        if (h == 0) {
#pragma unroll
            for (int nb = 0; nb < 2; ++nb) ((float*)(p.ws + OFF_DECAY))[((size_t)bhd * 68 + n) * 64 + 32 * nb + m32] = __expf(G.last[nb]); }
        asm volatile("s_waitcnt lgkmcnt(0)" ::: "memory"); __builtin_amdgcn_wave_barrier();
#pragma unroll
        for (int ib = 0; ib < 2; ++ib)
#pragma unroll
            for (int nb = 0; nb < 2; ++nb)
#pragma unroll
                for (int r = 0; r < 16; ++r) { const int row = 32 * ib + (r & 3) + 8 * (r >> 2) + 4 * h, col = 32 * nb + m32;
                    *(bf16_t*)(kt + col * GL_XS + row * 2) = f2bf(bf2f(*(const bf16_t*)(kraw + row * GL_XS + col * 2)) * __expf(G.last[nb] - G.cum[ib][nb][r])); }
    }
    asm volatile("s_waitcnt lgkmcnt(0)" ::: "memory"); __builtin_amdgcn_wave_barrier();
    f32x16 acc[2][4];
#pragma unroll
    for (int mb = 0; mb < 2; ++mb)
#pragma unroll
        for (int nb = 0; nb < 4; ++nb)
#pragma unroll
            for (int r = 0; r < 16; ++r) acc[mb][nb][r] = 0.f;
#pragma unroll
    for (int s = 0; s < 4; ++s) {
        bf16x8_t af[2];
#pragma unroll
        for (int mb = 0; mb < 2; ++mb) af[mb] = *(const bf16x8_t*)(kt + (32 * mb + m32) * GL_XS + (16 * s + 8 * h) * 2);
#pragma unroll
        for (int mb = 0; mb < 2; ++mb)
#pragma unroll
            for (int nb = 0; nb < 4; ++nb) acc[mb][nb] = __builtin_amdgcn_mfma_f32_32x32x16_bf16(af[mb], bfr[s][nb], acc[mb][nb], 0, 0, 0);
    }
    bf16_t* kv = (bf16_t*)(p.ws + OFF_KV) + (((size_t)bhd * 68 + n) * 128 + m32) * 64 + 4 * h;
#pragma unroll
    for (int mb = 0; mb < 2; ++mb)
#pragma unroll
        for (int nb = 0; nb < 4; ++nb)
#pragma unroll
            for (int r4 = 0; r4 < 4; ++r4) { u32x2_t o; o[0] = pk2(acc[mb][nb][4 * r4], acc[mb][nb][4 * r4 + 1]); o[1] = pk2(acc[mb][nb][4 * r4 + 2], acc[mb][nb][4 * r4 + 3]);
                *(u32x2_t*)(kv + (size_t)(32 * nb) * 64 + 32 * mb + 8 * r4) = o; }
}

__device__ __forceinline__ void gla_scan(const Params& p, bool commit = true) {
    bf16_t* kv = (bf16_t*)(p.ws + OFF_KV); const float* dec = (const float*)(p.ws + OFF_DECAY);
    for (int gid = blockIdx.x * NTHR + ltid(); gid < 64 * 128 * 16; gid += gridDim.x * NTHR) {
        const int dk4 = gid & 15, dv = (gid >> 4) & 127, bhd = gid >> 11, dir = bhd & 1;
        float z0 = 0.f; asm volatile("" : "+v"(z0));
        f32x4 s = {z0, z0, z0, z0};
        for (int step = 0; step < 68; ++step) {
            const int ch = dir == 0 ? step : (step < 4 ? 3 - step : 71 - step);
            u32x2_t* ptr = (u32x2_t*)(kv + (((size_t)bhd * 68 + ch) * 128 + dv) * 64 + dk4 * 4);
            const u32x2_t kvv = *ptr; const f32x4 d4 = *(const f32x4*)(dec + ((size_t)bhd * 68 + ch) * 64 + dk4 * 4);
            u32x2_t o; o[0] = pk2(s[0], s[1]); o[1] = pk2(s[2], s[3]); if (commit) *ptr = o;
            s[0] = d4[0] * s[0] + bflo(kvv[0]); s[1] = d4[1] * s[1] + bfhi(kvv[0]); s[2] = d4[2] * s[2] + bflo(kvv[1]); s[3] = d4[3] * s[3] + bfhi(kvv[1]);
        }
    }
}

__device__ __forceinline__ void gla_c_unit(const Params& p, int l, int unit, unsigned char* shm, bool commit = true) {
    const int tid = ltid(), lane = tid & 63, wid = tid >> 6, hh = wid >> 1, dir = wid & 1, m32 = lane & 31, h = lane >> 5;
    const int b = unit / 68, n = unit - b * 68; const int row0 = b * LB + n * 64; const int bhd = (b * 4 + hh) * 2 + dir;
    float* grs = (float*)shm; unsigned char* xq = shm + 8192 + wid * 18432; unsigned char* yk = xq + 9216;
    bf16x8_t sfr[4][4];
    { const bf16_t* sp = (const bf16_t*)(p.ws + OFF_KV) + (((size_t)bhd * 68 + n) * 128 + m32) * 64 + 8 * h;
#pragma unroll
      for (int s = 0; s < 4; ++s)
#pragma unroll
          for (int d = 0; d < 4; ++d) sfr[s][d] = *(const bf16x8_t*)(sp + (size_t)(32 * d) * 64 + 16 * s); }
    gla_stage_gr(p, row0, grs, tid);
    {
        {
            const bf16_t* gq = (const bf16_t*)(p.ws + OFF_GQ) + (size_t)row0 * 256 + hh * 64;
            const bf16_t* gk = (const bf16_t*)(p.ws + OFF_GK) + (size_t)row0 * 256 + hh * 64;
            u32x4_t tq[8], tk[8];
#pragma unroll
            for (int i = 0; i < 8; ++i) { tq[i] = *(const u32x4_t*)(gq + (size_t)(8 * i + (lane >> 3)) * 256 + (lane & 7) * 8); tk[i] = *(const u32x4_t*)(gk + (size_t)(8 * i + (lane >> 3)) * 256 + (lane & 7) * 8); }
#pragma unroll
            for (int i = 0; i < 8; ++i) { *(u32x4_t*)(xq + (8 * i + (lane >> 3)) * GL_XS + (lane & 7) * 16) = tq[i]; *(u32x4_t*)(yk + (8 * i + (lane >> 3)) * GL_XS + (lane & 7) * 16) = tk[i]; }
        }
        GlaCum G; gla_cum_mfma(p, l, hh, dir, lane, grs, G);
        asm volatile("s_waitcnt lgkmcnt(0)" ::: "memory"); __builtin_amdgcn_wave_barrier();
#pragma unroll
        for (int ib = 0; ib < 2; ++ib)
#pragma unroll
            for (int nb = 0; nb < 2; ++nb)
#pragma unroll
                for (int r = 0; r < 16; ++r) { const int row = 32 * ib + (r & 3) + 8 * (r >> 2) + 4 * h, col = 32 * nb + m32; const float c = G.cum[ib][nb][r];
                    bf16_t* xp = (bf16_t*)(xq + row * GL_XS + col * 2); bf16_t* yp = (bf16_t*)(yk + row * GL_XS + col * 2);
                    *xp = f2bf(bf2f(*xp) * __expf(c)); *yp = f2bf(bf2f(*yp) * __expf(-c)); }
    }
    asm volatile("s_waitcnt lgkmcnt(0)" ::: "memory"); __builtin_amdgcn_wave_barrier();
    const unsigned char* xrd = xq + m32 * GL_XS + 16 * h;
    f32x16 O[4][2];
#pragma unroll
    for (int d = 0; d < 4; ++d)
#pragma unroll
        for (int ib = 0; ib < 2; ++ib)
#pragma unroll
            for (int r = 0; r < 16; ++r) O[d][ib][r] = 0.f;
    {
#pragma unroll
      for (int s = 0; s < 4; ++s) {
#pragma unroll
          for (int ib = 0; ib < 2; ++ib) { const bf16x8_t xf = *(const bf16x8_t*)(xrd + 32 * ib * GL_XS + 32 * s);
#pragma unroll
              for (int d = 0; d < 4; ++d) O[d][ib] = __builtin_amdgcn_mfma_f32_32x32x16_bf16(sfr[s][d], xf, O[d][ib], 0, 0, 0); } } }
    const bf16_t* gvt = (const bf16_t*)(p.ws + OFF_GVT) + ((size_t)(b * 512 + hh * 128 + m32)) * LB + n * 64 + 4 * h;
#pragma unroll
    for (int jb = 0; jb < 2; ++jb)
#pragma unroll
        for (int ib = 0; ib < 2; ++ib) {
            if (jb != ib && ((jb > ib) != (dir == 1))) continue;
            u32x2_t vfr[2][4][2];
#pragma unroll
            for (int s2 = 0; s2 < 2; ++s2)
#pragma unroll
                for (int d = 0; d < 4; ++d) { const bf16_t* vp = gvt + (size_t)(32 * d) * LB + 32 * jb + 16 * s2; vfr[s2][d][0] = *(const u32x2_t*)vp; vfr[s2][d][1] = *(const u32x2_t*)(vp + 8); }
            __builtin_amdgcn_sched_barrier(0);
            f32x16 A;
#pragma unroll
            for (int r = 0; r < 16; ++r) A[r] = 0.f;
#pragma unroll
            for (int s = 0; s < 4; ++s) { const bf16x8_t kf = *(const bf16x8_t*)(yk + (32 * jb + m32) * GL_XS + (16 * s + 8 * h) * 2);
                const bf16x8_t xf = *(const bf16x8_t*)(xrd + 32 * ib * GL_XS + 32 * s);
                A = __builtin_amdgcn_mfma_f32_32x32x16_bf16(kf, xf, A, 0, 0, 0); }
            if (jb == ib) {
#pragma unroll
                for (int r = 0; r < 16; ++r) { const int jj = (r & 3) + 8 * (r >> 2) + 4 * h; const bool keep = dir ? (jj >= m32) : (jj <= m32); A[r] = keep ? A[r] : 0.f; }
            }
#pragma unroll
            for (int s2 = 0; s2 < 2; ++s2) { u32x4_t pk;
#pragma unroll
                for (int j = 0; j < 4; ++j) pk[j] = pk2(A[s2 * 8 + 2 * j], A[s2 * 8 + 2 * j + 1]);
                const bf16x8_t pf = __builtin_bit_cast(bf16x8_t, pk);
#pragma unroll
                for (int d = 0; d < 4; ++d) { const u32x2_t v0 = vfr[s2][d][0], v1 = vfr[s2][d][1];
                    u32x4_t vv; vv[0] = v0[0]; vv[1] = v0[1]; vv[2] = v1[0]; vv[3] = v1[1];
                    O[d][ib] = __builtin_amdgcn_mfma_f32_32x32x16_bf16(__builtin_bit_cast(bf16x8_t, vv), pf, O[d][ib], 0, 0, 0); } }
        }
    __syncthreads();
    float* xch = (float*)(shm + 8192);
    if (dir == 1) {
#pragma unroll
        for (int d = 0; d < 4; ++d)
#pragma unroll
            for (int ib = 0; ib < 2; ++ib)
#pragma unroll
                for (int r = 0; r < 16; ++r) xch[((((hh * 4 + d) * 2 + ib) * 16 + r) << 6) + lane] = O[d][ib][r];
    }
    __syncthreads();
    if (dir == 0) {
        const float* gn = p.in[I_GNG] + l * 128;
        bf16_t* gg = (bf16_t*)(p.ws + OFF_GG);
#pragma unroll
        for (int ib = 0; ib < 2; ++ib) {
            float ss = 0.f;
#pragma unroll
            for (int d = 0; d < 4; ++d) {
                asm volatile("" ::: "memory");
#pragma unroll
                for (int r = 0; r < 16; ++r) { const float v = O[d][ib][r] + xch[((((hh * 4 + d) * 2 + ib) * 16 + r) << 6) + lane]; O[d][ib][r] = v; ss += v * v; } }
            ss += __shfl_xor(ss, 32);
            const float sc = rsqrtf(ss * (1.0f / 128.0f) + RMS_EPS);
            bf16_t* op = gg + (size_t)(row0 + 32 * ib + m32) * 512 + hh * 128 + 4 * h;
#pragma unroll
            for (int d = 0; d < 4; ++d)
#pragma unroll
                for (int r4 = 0; r4 < 4; ++r4) { asm volatile("" ::: "memory"); const int dv = 32 * d + 8 * r4; const f32x4 gv = *(const f32x4*)(gn + dv + 4 * h);
                    const u32x2_t gt = *(const u32x2_t*)(op + dv);
                    u32x2_t o; o[0] = pk2(O[d][ib][4 * r4] * sc * gv[0] * siluf_(bflo(gt[0])), O[d][ib][4 * r4 + 1] * sc * gv[1] * siluf_(bfhi(gt[0])));
                    o[1] = pk2(O[d][ib][4 * r4 + 2] * sc * gv[2] * siluf_(bflo(gt[1])), O[d][ib][4 * r4 + 3] * sc * gv[3] * siluf_(bfhi(gt[1])));
                    if (commit) *(u32x2_t*)(op + dv) = o; }
        }
    }
    __syncthreads();
}

enum { PH_MOD = 0, PH_INIT, PH_CONVERT, PH_INPROJ, PH_ROPEDEC, PH_MIX_GLA, PH_MIX_DIFF, PH_MIX_NA, PH_VTRANS, PH_DIFF, PH_NA, PH_GLA_A, PH_GLA_SCAN, PH_GLA_C, PH_GATES, PH_MERGE, PH_WO, PH_LN1, PH_GATHER, PH_UP, PH_DOWN, PH_LN2, PH_COUNT };

template <class Epi, class Sched>
__device__ __forceinline__ void run_gemm(PG8_LAS unsigned char* lds, const void* A, const void* Bt, int K, const Sched& S, const Epi& E, const int* gidx = nullptr) {
    pg8::Gemm g; g.A = (const pg8::bf16_t*)A; g.Bt = (const pg8::bf16_t*)Bt; g.M = 0; g.N = 0; g.K = K; g.gidx = gidx;
    pg8::gemm_phase<Epi, Sched, false>(lds, g, S, E, nullptr);
}

#ifndef PHASE_INLINE
#define PHASE_INLINE __forceinline__
#endif
template <int PH>
__device__ PHASE_INLINE void run_phase(const Params& p0, int l, unsigned char* shm, bool force_dry = false) {
    Params p;
#if defined(__HIP_DEVICE_COMPILE__)
    (void)p0;
    { const __attribute__((address_space(4))) Params* kp = (const __attribute__((address_space(4))) Params*)__builtin_amdgcn_kernarg_segment_ptr();
      asm volatile("" : "+s"(kp));
#pragma unroll
      for (int i = 0; i < 23; ++i) p.in[i] = (const float*)(const __attribute__((address_space(1))) float*)kp->in[i];
      p.out = (float*)(__attribute__((address_space(1))) float*)kp->out; p.ws = (char*)(__attribute__((address_space(1))) char*)kp->ws; }
#else
    p = p0;
#endif
#ifdef SKIP_MASK
    if constexpr ((SKIP_MASK >> PH) & 1) return;
#endif
#ifdef PROBE_MASK
    constexpr int probe_reps = ((PROBE_MASK >> PH) & 1) ? 2 : 1;
#else
    constexpr int probe_reps = 1;
#endif
#pragma unroll 1
    for (int probe_rep = 0; probe_rep < probe_reps; ++probe_rep) {
    PG8_LAS unsigned char* lds = (PG8_LAS unsigned char*)shm;
    float* ldsf = (float*)shm;
    const int G = gridDim.x, c = blockIdx.x;
    bool commit = true;
    const bool lastl = (l == DEPTH - 1);
    if (force_dry) commit = (*(volatile const unsigned*)(p.ws + OFF_CNT + 2048) != 0u);
    if (probe_reps > 1 && probe_rep == 0) commit = (*(volatile const unsigned*)(p.ws + OFF_CNT + 2048) != 0u);
    if constexpr (PH == PH_MOD) phase_mod(p, ldsf);
    else if constexpr (PH == PH_INIT) phase_init(p);
    else if constexpr (PH == PH_CONVERT) phase_convert(p, l, 0, G);
    else if constexpr (PH == PH_INPROJ) { SchedGrid S{NPANEL, 19, 0, G, c, false}; EpiInProj E{p.ws}; run_gemm(lds, p.ws + OFF_H, p.ws + wdelta(l) + OFF_WIN, 1024, S, E); }
    else if constexpr (PH == PH_ROPEDEC) phase_rope_decay(p, l, commit);
    else if constexpr (PH == PH_MIX_GLA) { for (int u = blockIdx.x; u < NB; u += gridDim.x) gla_naive_batch(p, l, u, ldsf); }
    else if constexpr (PH == PH_MIX_DIFF) { for (int u = blockIdx.x; u < NB * 4 * 34; u += gridDim.x) diff_naive_tile(p, l, u, ldsf); }
    else if constexpr (PH == PH_MIX_NA) { for (int u = blockIdx.x; u < T / 64; u += gridDim.x) na_naive_unit(p, l, u); }
    else if constexpr (PH == PH_VTRANS) phase_vtrans(p, l, (bf16_t*)shm);
    else if constexpr (PH == PH_DIFF) { for (int u = blockIdx.x; u < (lastl ? NB * 4 * 32 : DA_UNITS); u += gridDim.x) diff_attn_unit(p, l, u, shm, commit); }
    else if constexpr (PH == PH_NA) { for (int u = blockIdx.x; u < (lastl ? NB * 64 * 2 : NA_UNITS); u += gridDim.x) na_attn_unit(p, l, u, shm, commit); }
#if FAST_GLA
    else if constexpr (PH == PH_GLA_A) { for (int u = blockIdx.x; u < NB * 68; u += gridDim.x) gla_a_unit(p, l, u, shm); }
    else if constexpr (PH == PH_GLA_SCAN) gla_scan(p, commit);
    else if constexpr (PH == PH_GLA_C) { if (lastl) { for (int u = blockIdx.x; u < NB * 64; u += gridDim.x) gla_c_unit(p, l, (u >> 6) * 68 + 4 + (u & 63), shm, commit); }
        else { for (int u = blockIdx.x; u < NB * 68; u += gridDim.x) gla_c_unit(p, l, u, shm, commit);
               if (G >= 64) phase_convert(p, l + 1, 32, G - 32, 1); else phase_convert(p, l + 1, 0, G, 1); } }
#endif
    else if constexpr (PH == PH_GATES) { SchedGrid S{lastl ? NB * 16 : NPANEL, 12, 19, G, c, lastl}; EpiGates E{p.ws}; run_gemm(lds, p.ws + OFF_H, p.ws + wdelta(l) + OFF_WIN, 1024, S, E); }
    else if constexpr (PH == PH_MERGE) { SchedMerge S{G, c, lastl}; EpiMerge E{p.ws}; run_gemm(lds, p.ws + OFF_BR, p.ws + wdelta(l) + OFF_WB, 512, S, E);
        if (!lastl) { if (G >= 64) phase_convert(p, l + 1, 32, G - 32, 2); else phase_convert(p, l + 1, 0, G, 2); } }
    else if constexpr (PH == PH_WO) { SchedGrid S{lastl ? NB * 16 : NPANEL, 4, 0, G, c, lastl}; EpiWo E{p.ws, l, commit}; run_gemm(lds, p.ws + OFF_H, p.ws + wdelta(l) + OFF_WO, 1024, S, E);
        if (!lastl && probe_rep == probe_reps - 1) { if (G >= 64) phase_convert(p, l + 1, 32, G - 32, 4); else phase_convert(p, l + 1, 0, G, 4); } }
    else if constexpr (PH == PH_LN1) phase_ln1_router(p, l, ldsf, commit);
    else if constexpr (PH == PH_GATHER) phase_gather(p, l, ldsf);
    else if constexpr (PH == PH_UP) { SchedMoe S; S.init((const unsigned*)(p.ws + OFF_CNT) + l * 16, G, c); EpiUp E{p.ws}; run_gemm(lds, p.ws + OFF_H, p.ws + wdelta(l) + OFF_WUP, 1024, S, E, (const int*)(p.ws + OFF_PAIRTOK)); }
    else if constexpr (PH == PH_DOWN) { SchedMoe S; S.init((const unsigned*)(p.ws + OFF_CNT) + l * 16, G, c); EpiDown E{p.ws}; run_gemm(lds, p.ws + OFF_ACT, p.ws + wdelta(l) + OFF_WDN, 512, S, E); }
    else if constexpr (PH == PH_LN2) phase_ln2(p, l, commit);
    }
}

#ifdef PROBE_SLOT
#ifndef PROBE_MULT
#define PROBE_MULT 5
#endif
#define XBAR(b, slot) do { xcd_barrier(b); if (blockIdx.x == 0 && threadIdx.x == 0) { volatile LAS unsigned long long* tw = (volatile LAS unsigned long long*)(shm + LDS_XBW + 16); \
    const unsigned long long now_ = wall_clock64(); if ((slot) == PROBE_SLOT) tw[1] += now_ - tw[0]; tw[0] = now_; } } while (0)
#else
#define XBAR(b, slot) xcd_barrier(b)
#endif
#if !MEGA
template <int PH>
__global__ void __launch_bounds__(512, 2) k_phase(Params p, int l) {
    extern __shared__ __attribute__((aligned(16))) unsigned char shm[];
    run_phase<PH>(p, l, shm);
}
template <int PH> static void launch_phase(const Params& p, int l, hipStream_t st) {
    static bool attr = false;
    if (!attr) { (void)hipFuncSetAttribute((const void*)k_phase<PH>, hipFuncAttributeMaxDynamicSharedMemorySize, LDS_BYTES); attr = true; }
    hipLaunchKernelGGL((k_phase<PH>), dim3(256), dim3(NTHR), LDS_BYTES, st, p, l);
}
#else
__global__ void __launch_bounds__(512, 2) k_mega(Params p) {
    extern __shared__ __attribute__((aligned(16))) unsigned char shm[];
    volatile LAS unsigned* xbw = (volatile LAS unsigned*)(shm + LDS_XBW);
    if (threadIdx.x == 0) { xbw[0] = 0u; xbw[1] = 0u; xbw[2] = 0u; xbw[3] = 0u; }
    __syncthreads();
    XcdBarrier bar = xcd_barrier_post((unsigned*)(p.ws + OFF_BAR), xbw);
#ifdef PROBE_SLOT
    if (blockIdx.x == 0 && threadIdx.x == 0) { volatile LAS unsigned long long* tw = (volatile LAS unsigned long long*)(shm + LDS_XBW + 16); tw[0] = wall_clock64(); tw[1] = 0ull; }
#endif
    run_phase<PH_MOD>(p, 0, shm);
    run_phase<PH_CONVERT>(p, 0, shm);
    XBAR(bar, 0);
    run_phase<PH_INIT>(p, 0, shm);
    XBAR(bar, 1);
    for (int l = 0; l < DEPTH; ++l) {
        run_phase<PH_INPROJ>(p, l, shm); XBAR(bar, 3);
        run_phase<PH_ROPEDEC>(p, l, shm); run_phase<PH_VTRANS>(p, l, shm);
#if FAST_GLA
        run_phase<PH_GLA_A>(p, l, shm); XBAR(bar, 5);
        run_phase<PH_GLA_SCAN>(p, l, shm);
#else
        run_phase<PH_MIX_GLA>(p, l, shm);
#endif
#if FAST_DIFF
        run_phase<PH_DIFF>(p, l, shm);
#else
        run_phase<PH_MIX_DIFF>(p, l, shm);
#endif
#if FAST_NA
        run_phase<PH_NA>(p, l, shm);
#else
        run_phase<PH_MIX_NA>(p, l, shm);
#endif
        XBAR(bar, 6);
#if FAST_GLA
        run_phase<PH_GLA_C>(p, l, shm); XBAR(bar, 7);
#endif
        run_phase<PH_GATES>(p, l, shm); XBAR(bar, 8);
        run_phase<PH_MERGE>(p, l, shm); XBAR(bar, 9);
        run_phase<PH_WO>(p, l, shm); XBAR(bar, 10);
#ifdef PROBE_LN1
        run_phase<PH_LN1>(p, l, shm, true);
#endif
        run_phase<PH_LN1>(p, l, shm); XBAR(bar, 11);
        run_phase<PH_GATHER>(p, l, shm); XBAR(bar, 12);
        run_phase<PH_UP>(p, l, shm); XBAR(bar, 13);
        run_phase<PH_DOWN>(p, l, shm); XBAR(bar, 14);
        run_phase<PH_LN2>(p, l, shm); XBAR(bar, 15);
    }
#ifdef PROBE_SLOT
    if (blockIdx.x == 0 && threadIdx.x == 0) { volatile LAS unsigned long long* tw = (volatile LAS unsigned long long*)(shm + LDS_XBW + 16);
        const unsigned long long until = wall_clock64() + tw[1] * (PROBE_MULT - 1);
        while (wall_clock64() < until) __builtin_amdgcn_s_sleep(32); }
#endif
}
#endif

extern "C" void kernel_launch(void* const* d_in, const int* in_sizes, int n_in, void* d_out, int out_size, void* d_ws, size_t ws_size, hipStream_t stream) {
    (void)in_sizes; (void)n_in; (void)out_size;
    if (ws_size < WS_NEED) { fprintf(stderr, "workspace too small: %zu < %zu\n", ws_size, (size_t)WS_NEED); return; }
    Params p{};
    for (int i = 0; i < 23; ++i) p.in[i] = (const float*)d_in[i];
    p.out = (float*)d_out; p.ws = (char*)d_ws;
    (void)hipMemsetAsync(d_ws, 0, ZERO_BYTES, stream);
#if !MEGA
    launch_phase<PH_MOD>(p, 0, stream);
    launch_phase<PH_INIT>(p, 0, stream);
    for (int l = 0; l < DEPTH; ++l) {
        launch_phase<PH_CONVERT>(p, l, stream);
        launch_phase<PH_INPROJ>(p, l, stream);
        launch_phase<PH_ROPEDEC>(p, l, stream);
        launch_phase<PH_MIX_GLA>(p, l, stream);
        launch_phase<PH_VTRANS>(p, l, stream);
        launch_phase<PH_DIFF>(p, l, stream);
        launch_phase<PH_MIX_NA>(p, l, stream);
        launch_phase<PH_GATES>(p, l, stream);
        launch_phase<PH_MERGE>(p, l, stream);
        launch_phase<PH_WO>(p, l, stream);
        launch_phase<PH_LN1>(p, l, stream);
        launch_phase<PH_GATHER>(p, l, stream);
        launch_phase<PH_UP>(p, l, stream);
        launch_phase<PH_DOWN>(p, l, stream);
        launch_phase<PH_LN2>(p, l, stream);
    }
#else
    static int grid = 0;
    if (!grid) {
        (void)hipFuncSetAttribute((const void*)k_mega, hipFuncAttributeMaxDynamicSharedMemorySize, LDS_BYTES);
        int dev = 0, cus = 0, per_cu = 0;
        (void)hipGetDevice(&dev);
        (void)hipDeviceGetAttribute(&cus, hipDeviceAttributeMultiprocessorCount, dev);
        (void)hipOccupancyMaxActiveBlocksPerMultiprocessor(&per_cu, (const void*)k_mega, 512, LDS_BYTES);
        if (cus <= 0) cus = 256;
        grid = per_cu >= 1 ? cus : 0;
        if (!grid) { fprintf(stderr, "k_mega does not fit a CU\n"); return; }
    }
    hipLaunchKernelGGL(k_mega, dim3(grid), dim3(NTHR), LDS_BYTES, stream, p);
#endif
}
```

```cpp
#include <hip/hip_runtime.h>
#include <stdint.h>
#include <stdio.h>

#ifndef MEGA
#define MEGA 1
#endif

constexpr int NB = 8, LL = 4096, LC = 256, LB = LL + LC  , T = NB * LB  , D = 1024, DEPTH = 4;
constexpr int NPANEL = T / 256;
constexpr int PB = LB / 256;
constexpr int PAIR_ROWS = 2 * T + 16 * 256;
constexpr float ALPHA = 1.681792830507429f;
constexpr float LN_EPS = 1e-5f, RMS_EPS = 1e-6f;

constexpr size_t AL256(size_t x) { return (x + 255) & ~(size_t)255; }
constexpr size_t OFF_BAR = 0;
constexpr size_t OFF_CNT = 16384;
constexpr size_t OFF_KMAX = OFF_CNT + 4096;
constexpr size_t OFF_QUEUE = OFF_CNT + 8192;
constexpr size_t ZERO_BYTES = 32768;
constexpr size_t OFF_BLKCNT = ZERO_BYTES;
constexpr size_t OFF_LAM = OFF_BLKCNT + 1024 * 16 * 4;
constexpr size_t OFF_MOD0 = OFF_LAM + 256;
constexpr size_t OFF_MOD = OFF_MOD0;
constexpr size_t OFF_ROPE = AL256(OFF_MOD + (size_t)DEPTH * 9 * 6144 * 4);
constexpr size_t OFF_TOK = AL256(OFF_ROPE + (size_t)4096 * 32 * 2 * 4);
constexpr size_t OFF_GR = AL256(OFF_TOK + (size_t)T * 8 * 4);
constexpr size_t OFF_XS = AL256(OFF_GR + (size_t)T * 32 * 4);
constexpr size_t OFF_H = AL256(OFF_XS + (size_t)T * D * 4);
constexpr size_t OFF_W = AL256(OFF_H + (size_t)T * D * 2);
constexpr size_t W_IN_ROWS = 4864 + 3072;
constexpr size_t OFF_WIN = OFF_W;
constexpr size_t OFF_WB = OFF_WIN + W_IN_ROWS * 1024 * 2;
constexpr size_t OFF_WO = OFF_WB + (size_t)3 * 1024 * 512 * 2;
constexpr size_t OFF_WUP = OFF_WO + (size_t)1024 * 1024 * 2;
constexpr size_t OFF_WDN = OFF_WUP + (size_t)16 * 1024 * 1024 * 2;
constexpr size_t OFF_P = AL256(OFF_WDN + (size_t)16 * 1024 * 512 * 2);
constexpr size_t W_BYTES = OFF_WDN + (size_t)16 * 1024 * 512 * 2 - OFF_W;
constexpr size_t PCOL = (size_t)T * 2;
constexpr size_t OFF_GQ = OFF_P, OFF_GK = OFF_P + 256 * PCOL, OFF_GV = OFF_P + 512 * PCOL;
constexpr size_t OFF_DK = OFF_P + 1024 * PCOL, OFF_DV = OFF_P + 1536 * PCOL;
constexpr size_t OFF_NK = OFF_P + 2048 * PCOL, OFF_NV = OFF_P + 2560 * PCOL;
constexpr size_t OFF_BR = OFF_P + 3072 * PCOL;
constexpr size_t OFF_GG = OFF_BR, OFF_DQ = OFF_BR + 512 * PCOL, OFF_NQ = OFF_BR + 1024 * PCOL;
constexpr size_t OFF_GATE = OFF_P;
constexpr size_t OFF_S1 = AL256(OFF_P + 4608 * PCOL);
constexpr size_t OFF_S2 = AL256(OFF_S1 + (size_t)T * 512 * 4);
constexpr size_t OFF_R3 = AL256(OFF_S2 + (size_t)T * 512 * 4);
constexpr size_t OFF_R4 = AL256(OFF_R3 + (size_t)T * 512 * 2);
constexpr size_t VT_BYTES = (size_t)T * 512 * 2;
#ifndef FAST_GLA
#define FAST_GLA 1
#endif
#ifndef FAST_DIFF
#define FAST_DIFF 1
#endif
#ifndef FAST_NA
#define FAST_NA 1
#endif
constexpr size_t OFF_KV = OFF_S1;
constexpr size_t OFF_GVT = OFF_GV;
constexpr size_t OFF_VT = OFF_DV;
constexpr size_t OFF_NVT = OFF_NV;
static_assert(FAST_GLA && FAST_DIFF && FAST_NA, "the naive mixers read row-major values");
constexpr int GE_PANELS = 8, GE_UNITS = GE_PANELS * 12;
constexpr size_t OFF_GEARLY = OFF_R4 - (size_t)3 * GE_PANELS * 256 * 1024 * 2;
constexpr size_t OFF_TOTAL = OFF_R3;
constexpr size_t OFF_CUM = OFF_S2;
constexpr size_t OFF_W2 = OFF_S2;
static_assert(OFF_W2 + W_BYTES <= OFF_GEARLY && OFF_GEARLY % 256 == 0, "second weight buffer");
__device__ __forceinline__ size_t wdelta(int l) { return (l & 1) ? (OFF_W2 - OFF_W) : 0; }
constexpr size_t OFF_NBT = OFF_R4;
constexpr size_t OFF_DECAY = AL256(OFF_NBT + (size_t)8 * 15 * 4 * 64 * 16 * 4);
constexpr size_t OFF_END1 = AL256(OFF_DECAY + (size_t)64 * 68 * 64 * 4);
constexpr size_t OFF_XA = OFF_P;
constexpr size_t OFF_PAIRTOK = OFF_XA;
constexpr size_t OFF_ACT = AL256(OFF_XA + (size_t)PAIR_ROWS * 1024 * 2);
constexpr size_t OFF_Y = AL256(OFF_ACT + (size_t)PAIR_ROWS * 512 * 2);
constexpr size_t OFF_END2 = AL256(OFF_Y + (size_t)PAIR_ROWS * 1024 * 2);
constexpr size_t WS_NEED = OFF_END1 > OFF_END2 ? OFF_END1 : OFF_END2;
static_assert(WS_NEED < (size_t)812 * 1000 * 1000, "workspace budget");

typedef float f32x16 __attribute__((ext_vector_type(16)));
typedef short bf16x8_t __attribute__((ext_vector_type(8)));
constexpr int NTHR = 512;
constexpr int LDS_STAGE = 131072;
constexpr int LDS_BYTES = 159744;
constexpr int LDS_XBW = LDS_BYTES - 256;

typedef unsigned short bf16_t;

struct Params {
    const float* in[23];
    float* out;
    char* ws;
};
enum { I_X = 0, I_C, I_CTX, I_CCTX, I_WADA, I_BADA, I_WIN, I_GWD, I_GBD, I_GNG, I_LQ, I_LK, I_DNG, I_RPB, I_WBR, I_WO, I_LNG, I_LNB, I_WR, I_BR, I_WEG, I_WEU, I_WED };

__device__ __forceinline__ float bf2f(bf16_t v) { return __uint_as_float(((unsigned)v) << 16); }
__device__ __forceinline__ float bflo(unsigned u) { return __uint_as_float(u << 16); }
__device__ __forceinline__ float bfhi(unsigned u) { return __uint_as_float(u & 0xffff0000u); }
typedef float f32x2_t __attribute__((ext_vector_type(2)));
typedef __bf16 bf16x2_t __attribute__((ext_vector_type(2)));
__device__ __forceinline__ unsigned pk2(float lo, float hi) { f32x2_t v; v[0] = lo; v[1] = hi; return __builtin_bit_cast(unsigned, __builtin_convertvector(v, bf16x2_t)); }
__device__ __forceinline__ bf16_t f2bf(float f) { return (bf16_t)(pk2(f, 0.f) & 0xffffu); }
__device__ __forceinline__ float wave_sum(float v) {
#pragma unroll
    for (int o = 32; o >= 1; o >>= 1) v += __shfl_xor(v, o);
    return v;
}
__device__ __forceinline__ float sigmoidf_(float x) { return 1.f / (1.f + __expf(-x)); }
__device__ __forceinline__ float siluf_(float x) { return x / (1.f + __expf(-x)); }
__device__ __forceinline__ float siluf_fast(float x) { return x * __builtin_amdgcn_rcpf(1.f + __builtin_amdgcn_exp2f(-x * 1.4426950408889634f)); }
__device__ __forceinline__ int row_slot(int row) { const int b = row / LB, t = row - b * LB; return t < LC ? 8 : b; }
__device__ __forceinline__ int ltid() { int t = threadIdx.x; asm volatile("" : "+v"(t)); return t; }
#ifndef XS_BF16
#define XS_BF16 0
#endif
#ifndef XS_F16
#define XS_F16 1
#endif
#if XS_BF16
typedef bf16_t xs_t;
#elif XS_F16
typedef _Float16 xs_t;
typedef _Float16 f16x4_a __attribute__((ext_vector_type(4)));
#else
typedef float xs_t;
#endif
typedef float f32x4_a __attribute__((ext_vector_type(4)));
typedef unsigned u32x2_a __attribute__((ext_vector_type(2)));
__device__ __forceinline__ f32x4_a xs_ld4(const xs_t* p) {
#if XS_BF16
    const u32x2_a v = *(const u32x2_a*)p; f32x4_a r; r[0] = bflo(v[0]); r[1] = bfhi(v[0]); r[2] = bflo(v[1]); r[3] = bfhi(v[1]); return r;
#elif XS_F16
    const f16x4_a v = *(const f16x4_a*)p; return __builtin_convertvector(v, f32x4_a);
#else
    return *(const f32x4_a*)p;
#endif
}
__device__ __forceinline__ void xs_st4(xs_t* p, f32x4_a x) {
#if XS_BF16
    u32x2_a v; v[0] = pk2(x[0], x[1]); v[1] = pk2(x[2], x[3]); *(u32x2_a*)p = v;
#elif XS_F16
    f32x4_a y;
#pragma unroll
    for (int j = 0; j < 4; ++j) y[j] = fminf(fmaxf(x[j], -65504.0f), 65504.0f);
    *(f16x4_a*)p = __builtin_convertvector(y, f16x4_a);
#else
    *(f32x4_a*)p = x;
#endif
}
#include <hip/hip_runtime.h>
namespace pg8 {
#define PG8_LAS __attribute__((address_space(3)))
typedef unsigned short bf16_t;
typedef short bf16x8 __attribute__((ext_vector_type(8)));
typedef float f32x4 __attribute__((ext_vector_type(4)));
typedef unsigned u32x4 __attribute__((ext_vector_type(4)));
constexpr int BM = 256, BK = 64, HALF = 128, HTB = HALF * BK * 2  , STAGE_BYTES = 8 * HTB, NXCD = 8, WGM = 8;

__host__ __device__ __forceinline__ int lds_byte(int r, int c) { const int st = (r >> 4) * 2 + (c >> 5), rr = r & 15, cc = c & 31, ob = rr * 64 + cc * 2; return st * 1024 + (ob ^ (((ob >> 9) & 1) << 5)); }
__host__ __device__ __forceinline__ void stage_rc(int b, int& R, int& C) { const int st = b / 1024, sb = b % 1024, swz = sb ^ (((sb >> 9) & 1) << 5); R = (st >> 1) * 16 + swz / 64; C = (st & 1) * 32 + (swz % 64) / 2; }
__host__ __device__ __forceinline__ int perm32(int rho) { const int n = rho >> 4, i = rho & 15; return 8 * (i >> 2) + 4 * n + (i & 3); }

struct Unit { int pm, pn; };
struct Gemm { const bf16_t* A; const bf16_t* Bt; int M, N, K; const int* gidx; };
__device__ __forceinline__ unsigned cvt_pk_bf16(float lo, float hi) { unsigned r; asm volatile("v_cvt_pk_bf16_f32 %0, %1, %2" : "=v"(r) : "v"(lo), "v"(hi)); return r; }

template <class Epi, class Sched, bool STAMP = false>
__device__ __forceinline__ void gemm_phase(PG8_LAS unsigned char* lds, const Gemm g, const Sched& S, const Epi& E, unsigned long long* stamps) {
    int tid_l = threadIdx.x; asm volatile("" : "+v"(tid_l));
    const int tid = tid_l, wid = __builtin_amdgcn_readfirstlane(tid >> 6), lane = tid & 63, wr = wid >> 2, wc = wid & 3, fr = lane & 15, fq = lane >> 4;
    const int K = g.K, nt = K / BK;
    int ts_lo = 0, ts_hi = 0, nts = 0; const unsigned long long rt_entry = STAMP ? (unsigned long long)wall_clock64() : 0ull;
#define PG8_STAMP() do { if (STAMP && wid == 0 && nts < 64) { const unsigned long long _c = (unsigned long long)clock64(); \
        ts_lo = (lane == nts) ? (int)(unsigned)_c : ts_lo; ts_hi = (lane == nts) ? (int)(unsigned)(_c >> 32) : ts_hi; ++nts; } } while (0)
    PG8_STAMP();
    unsigned voffA[2], voffB[2];
#pragma unroll
    for (int i = 0; i < 2; ++i) { int R, C; stage_rc(tid * 16 + i * 8192, R, C); const int Rb = Epi::PERM ? ((R & ~31) + perm32(R & 31)) : R;
        voffA[i] = (unsigned)(R * K + C) * 2u; voffB[i] = (unsigned)(Rb * K + C) * 2u; }
    const size_t kstep = (size_t)(BK * 2);
    const size_t hstep = (size_t)HALF * K * 2;
    const size_t tstep = 2 * hstep;
    int Rg[2], Cg[2];
#pragma unroll
    for (int i = 0; i < 2; ++i) stage_rc(tid * 16 + i * 8192, Rg[i], Cg[i]);
    unsigned gA[2][2], gN[2][2];
#define PG8_GLOAD(dst, unit) do { int gr_[2][2]; _Pragma("unroll") for (int hh_ = 0; hh_ < 2; ++hh_) _Pragma("unroll") for (int i = 0; i < 2; ++i) gr_[hh_][i] = g.gidx[(unit).pm * BM + hh_ * HALF + Rg[i]]; \
        __builtin_amdgcn_sched_barrier(0);     \
        _Pragma("unroll") for (int hh_ = 0; hh_ < 2; ++hh_) _Pragma("unroll") for (int i = 0; i < 2; ++i) dst[hh_][i] = (unsigned)gr_[hh_][i] * (unsigned)(K * 2) + (unsigned)(Cg[i] * 2); } while (0)
    const size_t hstepA = Epi::GATHER ? 0 : hstep;
    const unsigned ldsw = (unsigned)wid * 1024u;
    const int aoff = lds_byte(wr * 64 + fr, fq * 8), boff = lds_byte(wc * 32 + fr, fq * 8);
#define PG8_SA(b, h) (((b) * 2 + (h)) * HTB)
#define PG8_SB(b, h) ((4 + (b) * 2 + (h)) * HTB)
#define PG8_STAGE(bufoff, gbase, voff) do { _Pragma("unroll") for (int _i = 0; _i < 2; ++_i) \
        __builtin_amdgcn_global_load_lds((const unsigned*)((const char*)(gbase) + (voff)[_i]), (PG8_LAS unsigned*)(lds + (bufoff) + ldsw + _i * 8192), 16, 0, 0); } while (0)
#define PG8_STAGEA(bufoff, gbase, half, usenext) do { if constexpr (Epi::GATHER) { _Pragma("unroll") for (int _i = 0; _i < 2; ++_i) { const unsigned _o = (usenext) ? gN[half][_i] : gA[half][_i]; \
            __builtin_amdgcn_global_load_lds((const unsigned*)((const char*)(gbase) + _o), (PG8_LAS unsigned*)(lds + (bufoff) + ldsw + _i * 8192), 16, 0, 0); } } \
        else { PG8_STAGE(bufoff, (gbase) + (half) * hstepA, voffA); } } while (0)
#define PG8_LDA(dst, b, h) do { _Pragma("unroll") for (int m = 0; m < 4; ++m) _Pragma("unroll") for (int k = 0; k < 2; ++k) dst[m][k] = *(const PG8_LAS bf16x8*)(lds + PG8_SA(b, h) + aoff + m * 2048 + k * 1024); } while (0)
#define PG8_LDB(dst, b, h) do { _Pragma("unroll") for (int n = 0; n < 2; ++n) _Pragma("unroll") for (int k = 0; k < 2; ++k) dst[n][k] = *(const PG8_LAS bf16x8*)(lds + PG8_SB(b, h) + boff + n * 2048 + k * 1024); } while (0)
#define PG8_MMA(ai, bj, At, Bt) do { __builtin_amdgcn_s_setprio(1); _Pragma("unroll") for (int m = 0; m < 4; ++m) _Pragma("unroll") for (int n = 0; n < 2; ++n) _Pragma("unroll") for (int k = 0; k < 2; ++k) \
        acc[ai][bj][m][n] = __builtin_amdgcn_mfma_f32_16x16x32_bf16(Bt[n][k], At[m][k], acc[ai][bj][m][n], 0, 0, 0); __builtin_amdgcn_s_setprio(0); } while (0)
#define PG8_WAIT_V(n) asm volatile("s_waitcnt vmcnt(" #n ")" ::: "memory")
#define PG8_WAIT_L(n) asm volatile("s_waitcnt lgkmcnt(" #n ")" ::: "memory")
#define PG8_BAR __builtin_amdgcn_s_barrier()
#define PG8_SCHED __builtin_amdgcn_sched_barrier(0)
    Unit cur, nxt; int ui = 0;
    if (!S.next(0, cur)) return;
    f32x4 acc[2][2][4][2];
#pragma unroll
    for (int a = 0; a < 2; ++a)
#pragma unroll
        for (int b = 0; b < 2; ++b)
#pragma unroll
            for (int m = 0; m < 4; ++m)
#pragma unroll
                for (int n = 0; n < 2; ++n) acc[a][b][m][n] = (f32x4){0.f, 0.f, 0.f, 0.f};
    bf16x8 At[4][2], B0[2][2], B1[2][2];
    const char* cA = Epi::GATHER ? (const char*)g.A : (const char*)g.A + (size_t)cur.pm * tstep; const char* cB = (const char*)g.Bt + (size_t)cur.pn * tstep;
    S.a_ready(cur);
    if constexpr (Epi::GATHER) PG8_GLOAD(gA, cur);
    PG8_STAGE(PG8_SB(0, 0), cB, voffB); PG8_STAGEA(PG8_SA(0, 0), cA, 0, false); PG8_STAGE(PG8_SB(0, 1), cB + hstep, voffB); PG8_STAGEA(PG8_SA(0, 1), cA, 1, false);
    if (wr == 1) PG8_BAR;
    PG8_WAIT_V(4); PG8_BAR;
    PG8_STAGE(PG8_SB(1, 0), cB + kstep, voffB); PG8_STAGEA(PG8_SA(1, 0), cA + kstep, 0, false); PG8_STAGE(PG8_SB(1, 1), cB + hstep + kstep, voffB);
    PG8_WAIT_V(6); PG8_BAR;
    PG8_STAMP();
    for (;;) {
        const bool has_next = S.next(ui + 1, nxt);
        const char* nA = Epi::GATHER ? (const char*)g.A : (has_next ? (const char*)g.A + (size_t)nxt.pm * tstep : cA);
        if constexpr (Epi::GATHER) { if (has_next) PG8_GLOAD(gN, nxt); else { _Pragma("unroll") for (int hh_ = 0; hh_ < 2; ++hh_) _Pragma("unroll") for (int i = 0; i < 2; ++i) gN[hh_][i] = gA[hh_][i]; } } const char* nB = has_next ? (const char*)g.Bt + (size_t)nxt.pn * tstep : cB;
        for (int t = 0; t < nt; t += 2) {
            const bool last = (t == nt - 2);
            const char* a1 = cA + (size_t)(t + 1) * kstep;
            const char* a2 = last ? nA : cA + (size_t)(t + 2) * kstep; const char* b2 = last ? nB : cB + (size_t)(t + 2) * kstep;
            const char* a3 = a2 + kstep; const char* b3 = b2 + kstep;
            if (last && has_next) S.a_ready(nxt);
            PG8_LDB(B0, 0, 0); PG8_SCHED; PG8_LDA(At, 0, 0); PG8_STAGEA(PG8_SA(1, 1), a1, 1, false);
            PG8_WAIT_L(8); PG8_BAR; PG8_WAIT_L(0); PG8_MMA(0, 0, At, B0); PG8_BAR; PG8_SCHED;
            PG8_LDB(B1, 0, 1); PG8_STAGE(PG8_SB(0, 0), b2, voffB);
            PG8_BAR; PG8_WAIT_L(0); PG8_MMA(0, 1, At, B1); PG8_BAR;
            PG8_LDA(At, 0, 1); PG8_STAGEA(PG8_SA(0, 0), a2, 0, last);
            PG8_BAR; PG8_WAIT_L(0); PG8_MMA(1, 0, At, B0); PG8_BAR; PG8_SCHED;
            PG8_STAGE(PG8_SB(0, 1), b2 + hstep, voffB);
            PG8_WAIT_V(6); PG8_BAR; PG8_MMA(1, 1, At, B1); PG8_BAR;
            PG8_LDB(B0, 1, 0); PG8_SCHED; PG8_LDA(At, 1, 0); PG8_STAGEA(PG8_SA(0, 1), a2, 1, last);
            PG8_WAIT_L(8); PG8_BAR; PG8_WAIT_L(0); PG8_MMA(0, 0, At, B0); PG8_BAR; PG8_SCHED;
            PG8_LDB(B1, 1, 1); PG8_STAGE(PG8_SB(1, 0), b3, voffB);
            PG8_BAR; PG8_WAIT_L(0); PG8_MMA(0, 1, At, B1); PG8_BAR;
            PG8_LDA(At, 1, 1); PG8_STAGEA(PG8_SA(1, 0), a3, 0, last);
            PG8_BAR; PG8_WAIT_L(0); PG8_MMA(1, 0, At, B0); PG8_BAR; PG8_SCHED;
            PG8_STAGE(PG8_SB(1, 1), b3 + hstep, voffB);
            PG8_WAIT_V(6); PG8_BAR; PG8_MMA(1, 1, At, B1); PG8_BAR;
        }
        PG8_STAMP();
        if constexpr (!Epi::AFTER_DRAIN) { E(acc, cur, wr, wc, fr, fq); S.done(cur); }
        PG8_STAMP();
        if (!has_next) break;
        bool zero_acc = true;
        if constexpr (Epi::KEEP) zero_acc = !E.keep(cur);
        if (zero_acc) {
#pragma unroll
        for (int a = 0; a < 2; ++a)
#pragma unroll
            for (int b = 0; b < 2; ++b)
#pragma unroll
                for (int m = 0; m < 4; ++m)
#pragma unroll
                    for (int n = 0; n < 2; ++n) acc[a][b][m][n] = (f32x4){0.f, 0.f, 0.f, 0.f};
        }
        cur = nxt; cA = nA; cB = nB; ++ui;
        if constexpr (Epi::GATHER) { _Pragma("unroll") for (int hh_ = 0; hh_ < 2; ++hh_) _Pragma("unroll") for (int i = 0; i < 2; ++i) gA[hh_][i] = gN[hh_][i]; }
    }
    PG8_WAIT_V(0);
    if (wr == 0) PG8_BAR;
    PG8_BAR;
    if constexpr (Epi::AFTER_DRAIN) { E.fused(acc, cur, wr, wc, fr, fq, lds, wid, lane); S.done(cur); }
    PG8_STAMP();
    if (STAMP && wid == 0) { stamps[lane] = lane < nts ? (((unsigned long long)(unsigned)ts_hi << 32) | (unsigned)ts_lo) : 0ull;
        if (lane == 62) stamps[62] = rt_entry; if (lane == 63) stamps[63] = (unsigned long long)wall_clock64(); }
#undef PG8_STAMP
#undef PG8_SA
#undef PG8_SB
#undef PG8_STAGE
#undef PG8_STAGEA
#undef PG8_GLOAD
#undef PG8_LDA
#undef PG8_LDB
#undef PG8_MMA
#undef PG8_WAIT_V
#undef PG8_WAIT_L
#undef PG8_BAR
#undef PG8_SCHED
}
}
#define XB_TMO      128
#define XB_XCNT(j)  (256  + 64 * (j))
#define XB_XSUB(j)  (1280 + 64 * (j))
#define XB_XGEN(j)  (2304 + 64 * (j))
#define XB_TOP      3328
#define XB_TOPGEN   3392
#define XCD_BAR_WORDS 3456
#define XB_SPIN_CAP (1u << 18)
#define LAS __attribute__((address_space(3)))

__device__ __forceinline__ unsigned xb_ld(unsigned* p)              { return __hip_atomic_load(p, __ATOMIC_RELAXED, __HIP_MEMORY_SCOPE_AGENT); }
__device__ __forceinline__ unsigned xb_add(unsigned* p, unsigned v) { return __hip_atomic_fetch_add(p, v, __ATOMIC_RELAXED, __HIP_MEMORY_SCOPE_AGENT); }
__device__ __forceinline__ unsigned xb_xcc_id() { return (unsigned)__builtin_amdgcn_s_getreg((3 << 11) | 20) & 0xFu; }
#define XB_SPIN(cond, bar) do { unsigned _sp = 0; while (cond) { __builtin_amdgcn_s_sleep(1); \
    if ((++_sp & 255u) == 0u) { if (xb_ld(&(bar)[XB_TMO])) break; if (_sp > XB_SPIN_CAP) { atomicAdd(&(bar)[XB_TMO], 1u); break; } } } } while (0)

struct XcdBarrier {
    unsigned* bar; unsigned x;
    volatile LAS unsigned* st;
};

__device__ __forceinline__ XcdBarrier xcd_barrier_post(unsigned* bar, volatile LAS unsigned* st) {
    XcdBarrier b; b.bar = bar; b.x = xb_xcc_id(); b.st = st;
    if (threadIdx.x == 0) (void)xb_add(&bar[XB_XCNT(b.x)], 1u);
    return b;
}
__device__ __forceinline__ void xcd_barrier_complete(unsigned* bar, unsigned x, unsigned& nloc, unsigned& nx) {
    const unsigned G = gridDim.x * gridDim.y * gridDim.z;
    unsigned sum, cnt, mine, sp = 0u;
    for (;;) {
        sum = 0u; cnt = 0u; mine = 0u;
#pragma unroll
        for (unsigned j = 0; j < 16; ++j) { const unsigned c = xb_ld(&bar[XB_XCNT(j)]); sum += c; cnt += (c > 0u) ? 1u : 0u; mine = (j == x) ? c : mine; }
        if (sum == G) break;
        __builtin_amdgcn_s_sleep(1);
        if ((++sp & 255u) == 0u) { if (xb_ld(&bar[XB_TMO])) break; if (sp > XB_SPIN_CAP) { atomicAdd(&bar[XB_TMO], 1u); break; } }
    }
    nloc = mine > 0u ? mine : 1u; nx = cnt > 0u ? cnt : 1u;
}

__device__ __forceinline__ void xcd_barrier(const XcdBarrier& b_in) {
    XcdBarrier b = b_in; asm volatile("" : "+s"(b.bar), "+s"(b.x));
    asm volatile("s_waitcnt vmcnt(0)" ::: "memory");
    __syncthreads();
    if (threadIdx.x == 0) {
        unsigned* bar = b.bar;
        __builtin_amdgcn_s_waitcnt(0);
        unsigned nloc = b.st[0], nx = b.st[1];
        if (nloc == 0u) { xcd_barrier_complete(bar, b.x, nloc, nx); b.st[0] = nloc; b.st[1] = nx; }
        const unsigned old = xb_add(&bar[XB_XSUB(b.x)], 1u);
        const unsigned gen = old / nloc;
        if (old + 1u == (gen + 1u) * nloc) {
            __builtin_amdgcn_fence(__ATOMIC_RELEASE, "agent");
            asm volatile("s_waitcnt vmcnt(0)" ::: "memory");
            const unsigned og = xb_add(&bar[XB_TOP], 1u);
            const unsigned tg = og / nx;
            if (og + 1u == (tg + 1u) * nx) xb_add(&bar[XB_TOPGEN], 1u);
            else XB_SPIN(xb_ld(&bar[XB_TOPGEN]) == tg, bar);
            __builtin_amdgcn_fence(__ATOMIC_ACQUIRE, "agent");
            xb_add(&bar[XB_XGEN(b.x)], 1u);
            asm volatile("s_waitcnt vmcnt(0)" ::: "memory");
        } else {
            XB_SPIN(xb_ld(&bar[XB_XGEN(b.x)]) == gen, bar);
            __builtin_amdgcn_fence(__ATOMIC_ACQUIRE, "agent");
            asm volatile("s_waitcnt vmcnt(0)" ::: "memory");
        }
    }
    __syncthreads();
}

using pg8::f32x4;
using pg8::Unit;
typedef unsigned u32x4_t __attribute__((ext_vector_type(4)));
typedef unsigned u32x2_t __attribute__((ext_vector_type(2)));

struct SchedGrid {
    int nM, nN, pn0, G, c; bool lat_only; int L0 = 0;
    __device__ __forceinline__ bool next(int i, Unit& u) const {
        const int L = L0 + i * G + c; if (L >= nM * nN) return false;
        int pm = L / nN; u.pn = pn0 + (L - pm * nN);
        if (lat_only) pm = (pm >> 4) * PB + 1 + (pm & 15);
        u.pm = pm; return true;
    }
    __device__ __forceinline__ void a_ready(const Unit&) const {}
    __device__ __forceinline__ void done(const Unit&) const {}
};
struct SchedInProj {
    int G, c, nN;
    __device__ __forceinline__ bool next(int i, Unit& u) const {
        const int L = i * G + c; if (L >= NPANEL * nN) return false;
        const int pm = L / nN, j = L - pm * nN; u.pm = pm; u.pn = (nN == 18 && j >= 6) ? j + 1 : j; return true;
    }
    __device__ __forceinline__ void a_ready(const Unit&) const {}
    __device__ __forceinline__ void done(const Unit&) const {}
};
struct SchedMerge {
    int G, c; bool lat_only; int t0, nt; unsigned* flag;
    __device__ __forceinline__ bool next(int i, Unit& u) const {
        const int i3 = i / 3, n = i - i3 * 3, ti = t0 + i3 * G + c; if (ti >= nt) return false;
        int pm = ti >> 2; if (lat_only) pm = (pm >> 4) * PB + 1 + (pm & 15);
        u.pm = n * NPANEL + pm; u.pn = n * 4 + (ti & 3); return true;
    }
    __device__ __forceinline__ void a_ready(const Unit&) const {}
    __device__ __forceinline__ void done(const Unit& u) const {
        if (flag != nullptr && u.pm >= 2 * NPANEL) {
            asm volatile("s_waitcnt vmcnt(0)" ::: "memory");
            if ((threadIdx.x & 63) == 0) (void)xb_add(flag, 1u);
        }
    }
};
struct SchedWoY {
    int c; unsigned* flag; unsigned* bar;
    __device__ __forceinline__ bool next(int i, Unit& u) const {
        int ti;
        if (c < 32) { if (i > 0) return false; ti = 512 + c; }
        else { if (i < 2) ti = i * 224 + (c - 32); else if (i == 2 && c < 96) ti = 448 + (c - 32); else return false; }
        u.pm = ti >> 2; u.pn = ti & 3; return true;
    }
    __device__ __forceinline__ void a_ready(const Unit& u) const {
        if (u.pm >= 128) {
            XB_SPIN(xb_ld(flag) < 32u * 8u, bar);
            __builtin_amdgcn_fence(__ATOMIC_ACQUIRE, "agent");
        }
    }
    __device__ __forceinline__ void done(const Unit&) const {}
};
struct SchedMoe {
    int cum[17]; int G, c;
    __device__ __forceinline__ void init(const unsigned* cnt, int G_, int c_) {
        G = G_; c = c_; int s = 0;
#pragma unroll
        for (int e = 0; e < 16; ++e) { cum[e] = s; const unsigned n = __builtin_amdgcn_readfirstlane(cnt[e]); s += (int)((n + 255u) >> 8); }
        cum[16] = s;
    }
    __device__ __forceinline__ bool next(int i, Unit& u) const {
        const int L = i * G + c; if (L >= cum[16] * 4) return false;
        const int rt = L >> 2; int e = 0;
#pragma unroll
        for (int j = 1; j < 16; ++j) e += (rt >= cum[j]) ? 1 : 0;
        u.pm = rt; u.pn = e * 4 + (L & 3); return true;
    }
    __device__ __forceinline__ void a_ready(const Unit&) const {}
    __device__ __forceinline__ void done(const Unit&) const {}
};

__device__ __forceinline__ u32x4_t pack8(const f32x4& a, const f32x4& b) {
    u32x4_t r; r[0] = pk2(a[0], a[1]); r[1] = pk2(a[2], a[3]); r[2] = pk2(b[0], b[1]); r[3] = pk2(b[2], b[3]); return r;
}
__device__ __forceinline__ float gate_e(float x) { return 1.0f + __builtin_amdgcn_exp2f(fminf(x, 80.0f)); }
__device__ __forceinline__ void gates_store(char* ws, int early, const f32x4 (&acc)[2][2][4][2], const Unit& u, int wr, int wc, int fr, int fq) {
    const int pl = u.pn - 19, n = pl >> 2, col0 = (pl & 3) * 256; const int row0 = u.pm * 256 + wr * 64 + fr;
    const bool e = u.pm < early;
    bf16_t* base = (e ? (bf16_t*)(ws + OFF_GEARLY) + (size_t)n * (GE_PANELS * 256 * 1024) : (bf16_t*)(ws + OFF_GATE) + (size_t)n * T * 1024) + col0 + wc * 32 + 8 * fq;
#pragma unroll
    for (int ai = 0; ai < 2; ++ai)
#pragma unroll
        for (int m = 0; m < 4; ++m) { bf16_t* rp = base + (size_t)(row0 + ai * 128 + m * 16) * 1024;
#pragma unroll
            for (int bj = 0; bj < 2; ++bj) { f32x4 a = acc[ai][bj][m][0], b = acc[ai][bj][m][1];
#pragma unroll
                for (int j = 0; j < 4; ++j) { a[j] = gate_e(a[j]); b[j] = gate_e(b[j]); }
                *(u32x4_t*)(rp + bj * 128) = pack8(a, b); } }
}
struct EpiInProj {
    static constexpr bool PERM = true, AFTER_DRAIN = false; static constexpr bool KEEP = false; static constexpr bool GATHER = false;
    char* ws;
    __device__ __forceinline__ void operator()(const f32x4 (&acc)[2][2][4][2], const Unit& u, int wr, int wc, int fr, int fq) const {
        const int pn = u.pn; const int row0 = u.pm * 256 + wr * 64 + fr;
        if (pn == 6) {
            if (wc == 0) { float* gr = (float*)(ws + OFF_GR);
#pragma unroll
                for (int ai = 0; ai < 2; ++ai)
#pragma unroll
                    for (int m = 0; m < 4; ++m) { float* rp = gr + (size_t)(row0 + ai * 128 + m * 16) * 32 + 8 * fq;
                        *(f32x4*)(rp) = acc[ai][0][m][0]; *(f32x4*)(rp + 4) = acc[ai][0][m][1]; } }
            return;
        }
        if (pn == 2 || pn == 3 || pn == 11 || pn == 12 || pn == 17 || pn == 18) {
            const size_t voff = pn < 4 ? OFF_GVT : (pn < 13 ? OFF_VT : OFF_NVT); const int colt = ((pn < 4 ? pn - 2 : (pn < 13 ? pn - 11 : pn - 17)) * 256) + wc * 32 + 8 * fq;
            const int b = u.pm / PB, key0 = (u.pm - b * PB) * 256 + wr * 64 + fr;
            bf16_t* vt = (bf16_t*)(ws + voff) + ((size_t)b * 512 + colt) * LB + key0;
#pragma unroll
            for (int ai = 0; ai < 2; ++ai)
#pragma unroll
                for (int m = 0; m < 4; ++m)
#pragma unroll
                    for (int bj = 0; bj < 2; ++bj) { const u32x4_t pk = pack8(acc[ai][bj][m][0], acc[ai][bj][m][1]); bf16_t* cp = vt + (size_t)(bj * 128) * LB + ai * 128 + m * 16;
#pragma unroll
                        for (int j = 0; j < 4; ++j) { cp[(size_t)(2 * j) * LB] = (bf16_t)(pk[j] & 0xffffu); cp[(size_t)(2 * j + 1) * LB] = (bf16_t)(pk[j] >> 16); } }
            return;
        }
        size_t off; int ld, col0;
        if (pn == 0) { off = OFF_GQ; ld = 256; col0 = 0; }
        else if (pn == 1) { off = OFF_GK; ld = 256; col0 = 0; }
        else if (pn < 4) { off = OFF_GV; ld = 512; col0 = (pn - 2) * 256; }
        else if (pn < 6) { off = OFF_GG; ld = 512; col0 = (pn - 4) * 256; }
        else if (pn < 9) { off = OFF_DQ; ld = 512; col0 = (pn - 7) * 256; }
        else if (pn < 11) { off = OFF_DK; ld = 512; col0 = (pn - 9) * 256; }
        else if (pn < 13) { off = OFF_DV; ld = 512; col0 = (pn - 11) * 256; }
        else if (pn < 15) { off = OFF_NQ; ld = 512; col0 = (pn - 13) * 256; }
        else if (pn < 17) { off = OFF_NK; ld = 512; col0 = (pn - 15) * 256; }
        else { off = OFF_NV; ld = 512; col0 = (pn - 17) * 256; }
        bf16_t* base = (bf16_t*)(ws + off) + col0 + wc * 32 + 8 * fq;
#pragma unroll
        for (int ai = 0; ai < 2; ++ai)
#pragma unroll
            for (int m = 0; m < 4; ++m) { bf16_t* rp = base + (size_t)(row0 + ai * 128 + m * 16) * ld;
#pragma unroll
                for (int bj = 0; bj < 2; ++bj) *(u32x4_t*)(rp + bj * 128) = pack8(acc[ai][bj][m][0], acc[ai][bj][m][1]); }
    }
};
struct EpiGates {
    static constexpr bool PERM = true, AFTER_DRAIN = false; static constexpr bool KEEP = false; static constexpr bool GATHER = false;
    char* ws; int early;
    __device__ __forceinline__ void operator()(const f32x4 (&acc)[2][2][4][2], const Unit& u, int wr, int wc, int fr, int fq) const { gates_store(ws, early, acc, u, wr, wc, fr, fq); }
};
struct EpiMerge {
    static constexpr bool PERM = true, AFTER_DRAIN = false; static constexpr bool KEEP = true; static constexpr bool GATHER = false;
    char* ws; int early; bool wt;
    __device__ __forceinline__ bool keep(const Unit& u) const { return u.pm < 2 * NPANEL; }
    __device__ __forceinline__ void operator()(f32x4 (&acc)[2][2][4][2], const Unit& u, int wr, int wc, int fr, int fq) const {
        const int n = u.pm / NPANEL, pm = u.pm - n * NPANEL, pn = u.pn & 3; const int row0 = pm * 256 + wr * 64 + fr;
        const size_t cb = (size_t)pn * 256 + wc * 32 + 8 * fq;
        const size_t plane = pm < early ? (size_t)GE_PANELS * 256 * 1024 : (size_t)T * 1024;
        const bf16_t* gnum = (const bf16_t*)(ws + (pm < early ? OFF_GEARLY : OFF_GATE)) + (size_t)n * plane + cb;
        const bf16_t* gden = n < 2 ? gnum + plane : gnum;
        bf16_t* obase = (bf16_t*)(ws + OFF_H) + cb;
        u32x4_t gnb[2][2][2], gdb[2][2][2];
#define MERGE_ISSUE(q) do { _Pragma("unroll") for (int mm = 0; mm < 2; ++mm) _Pragma("unroll") for (int bj = 0; bj < 2; ++bj) { \
            const size_t ro_ = (size_t)(row0 + ((q) >> 1) * 128 + (2 * ((q) & 1) + mm) * 16) * 1024 + bj * 128; \
            gnb[(q) & 1][mm][bj] = *(const u32x4_t*)(gnum + ro_); gdb[(q) & 1][mm][bj] = *(const u32x4_t*)(gden + ro_); } } while (0)
        MERGE_ISSUE(0);
#pragma unroll
        for (int q = 0; q < 4; ++q) { const int ai = q >> 1;
            if (q < 3) MERGE_ISSUE(q + 1);
            __builtin_amdgcn_sched_barrier(0);
#pragma unroll
            for (int mm = 0; mm < 2; ++mm) { const int m = 2 * (q & 1) + mm; const size_t ro = (size_t)(row0 + ai * 128 + m * 16) * 1024;
#pragma unroll
                for (int bj = 0; bj < 2; ++bj) {
                    const u32x4_t g = gnb[q & 1][mm][bj];
                    float f[8];
#pragma unroll
                    for (int j = 0; j < 4; ++j) { f[2 * j] = bflo(g[j]); f[2 * j + 1] = bfhi(g[j]); }
#pragma unroll
                    for (int j = 0; j < 8; ++j) f[j] = __builtin_amdgcn_rcpf(f[j]);
                    if (n < 2) { const u32x4_t gd = gdb[q & 1][mm][bj];
#pragma unroll
                        for (int j = 0; j < 4; ++j) { f[2 * j] *= bflo(gd[j]); f[2 * j + 1] *= bfhi(gd[j]); }
#pragma unroll
                        for (int j = 0; j < 4; ++j) { acc[ai][bj][m][0][j] *= f[j]; acc[ai][bj][m][1][j] *= f[4 + j]; }
                    } else {
                        f32x4 a = acc[ai][bj][m][0], b = acc[ai][bj][m][1];
#pragma unroll
                        for (int j = 0; j < 4; ++j) { a[j] *= f[j]; b[j] *= f[4 + j]; }
                        const u32x4_t ov = pack8(a, b);
                        if (wt) { unsigned long long* qp = (unsigned long long*)(obase + ro + bj * 128);
                            __hip_atomic_store(qp, ((unsigned long long)ov[1] << 32) | ov[0], __ATOMIC_RELAXED, __HIP_MEMORY_SCOPE_AGENT);
                            __hip_atomic_store(qp + 1, ((unsigned long long)ov[3] << 32) | ov[2], __ATOMIC_RELAXED, __HIP_MEMORY_SCOPE_AGENT); }
                        else *(u32x4_t*)(obase + ro + bj * 128) = ov; } } }
        }
#undef MERGE_ISSUE
    }
};
struct EpiWo {
    static constexpr bool PERM = false, AFTER_DRAIN = false; static constexpr bool KEEP = false; static constexpr bool GATHER = false;
    char* ws; int layer; bool commit;
    __device__ __forceinline__ void operator()(const f32x4 (&acc)[2][2][4][2], const Unit& u, int wr, int wc, int fr, int fq) const {
        const int b = u.pm / PB, slot = (u.pm - b * PB) == 0 ? 8 : b;
        const int row0 = u.pm * 256 + wr * 64 + fr, col0 = u.pn * 256 + wc * 32 + 4 * fq;
        const float* mg = (const float*)(ws + OFF_MOD) + ((size_t)(layer * 9 + slot) * 6 + 2) * 1024 + col0;
        xs_t* xs = (xs_t*)(ws + OFF_XS) + col0;
        f32x4 g[2][2];
#pragma unroll
        for (int bj = 0; bj < 2; ++bj)
#pragma unroll
            for (int n = 0; n < 2; ++n) g[bj][n] = *(const f32x4*)(mg + bj * 128 + n * 16);
#pragma unroll
        for (int ai = 0; ai < 2; ++ai) {
            f32x4 xv[4][2][2];
#pragma unroll
            for (int m = 0; m < 4; ++m)
#pragma unroll
                for (int bj = 0; bj < 2; ++bj)
#pragma unroll
                    for (int n = 0; n < 2; ++n) xv[m][bj][n] = xs_ld4(xs + (size_t)(row0 + ai * 128 + m * 16) * 1024 + bj * 128 + n * 16);
            __builtin_amdgcn_sched_barrier(0);
#pragma unroll
            for (int m = 0; m < 4; ++m) { xs_t* rp = xs + (size_t)(row0 + ai * 128 + m * 16) * 1024;
#pragma unroll
                for (int bj = 0; bj < 2; ++bj)
#pragma unroll
                    for (int n = 0; n < 2; ++n) { if (commit) xs_st4(rp + bj * 128 + n * 16, xv[m][bj][n] * ALPHA + g[bj][n] * acc[ai][bj][m][n]); } }
        }
    }
};
struct EpiUp {
    static constexpr bool PERM = true, AFTER_DRAIN = false; static constexpr bool KEEP = false; static constexpr bool GATHER = true;
    char* ws;
    __device__ __forceinline__ void operator()(const f32x4 (&acc)[2][2][4][2], const Unit& u, int wr, int wc, int fr, int fq) const {
        const int ct = u.pn & 3; const int row0 = u.pm * 256 + wr * 64 + fr;
        bf16_t* base = (bf16_t*)(ws + OFF_ACT) + ct * 128 + wc * 32 + 8 * fq;
#pragma unroll
        for (int ai = 0; ai < 2; ++ai)
#pragma unroll
            for (int m = 0; m < 4; ++m) { f32x4 a, b;
#pragma unroll
                for (int j = 0; j < 4; ++j) { a[j] = siluf_fast(acc[ai][0][m][0][j]) * acc[ai][1][m][0][j]; b[j] = siluf_fast(acc[ai][0][m][1][j]) * acc[ai][1][m][1][j]; }
                *(u32x4_t*)(base + (size_t)(row0 + ai * 128 + m * 16) * 512) = pack8(a, b); }
    }
};
struct EpiDown {
    static constexpr bool PERM = true, AFTER_DRAIN = false; static constexpr bool KEEP = false; static constexpr bool GATHER = false;
    char* ws;
    __device__ __forceinline__ void operator()(const f32x4 (&acc)[2][2][4][2], const Unit& u, int wr, int wc, int fr, int fq) const {
        const int ct = u.pn & 3; const int row0 = u.pm * 256 + wr * 64 + fr;
        bf16_t* base = (bf16_t*)(ws + OFF_Y) + ct * 256 + wc * 32 + 8 * fq;
#pragma unroll
        for (int ai = 0; ai < 2; ++ai)
#pragma unroll
            for (int m = 0; m < 4; ++m) { bf16_t* rp = base + (size_t)(row0 + ai * 128 + m * 16) * 1024;
#pragma unroll
                for (int bj = 0; bj < 2; ++bj) *(u32x4_t*)(rp + bj * 128) = pack8(acc[ai][bj][m][0], acc[ai][bj][m][1]); }
    }
};

#define GSTRIDE_BEGIN(var, n) for (long var = (long)blockIdx.x * NTHR + ltid(); var < (long)(n); var += (long)gridDim.x * NTHR)

__device__ __forceinline__ void phase_mod(const Params& p, float* lds) {
    const int tid = ltid();
    if (blockIdx.x == 0 && tid < DEPTH) {
        float dq = 0.f, dk2 = 0.f; const float* lq = p.in[I_LQ] + tid * 128; const float* lk = p.in[I_LK] + tid * 128;
        for (int d = 0; d < 64; ++d) { dq += lq[d] * lk[d]; dk2 += lq[64 + d] * lk[64 + d]; }
        ((float*)(p.ws + OFF_LAM))[tid] = expf(dq) - expf(dk2) + (0.8f - 0.6f * expf(-0.3f * (float)tid)); }
    for (int i = tid; i < 9 * 1024; i += NTHR) { const int s = i >> 10, k = i & 1023; const float v = s < 8 ? p.in[I_C][s * 1024 + k] : p.in[I_CCTX][k]; lds[i] = siluf_(v); }
    __syncthreads();
    float* mod = (float*)(p.ws + OFF_MOD);
    float* part = lds + 9 * 1024;
    for (int u = blockIdx.x; u < DEPTH * 6144 / 64; u += gridDim.x) {
        const int l = u / 96, j0 = (u - l * 96) * 64, kc = tid >> 6, jj = tid & 63;
        const float* w = p.in[I_WADA] + ((size_t)l * 1024 + kc * 128) * 6144 + j0 + jj;
        float acc[9];
#pragma unroll
        for (int s = 0; s < 9; ++s) acc[s] = 0.f;
#pragma unroll 8
        for (int k = 0; k < 128; ++k) { const float wv = w[(size_t)k * 6144];
#pragma unroll
            for (int s = 0; s < 9; ++s) acc[s] += lds[s * 1024 + kc * 128 + k] * wv; }
        __syncthreads();
#pragma unroll
        for (int s = 0; s < 9; ++s) part[(kc * 9 + s) * 64 + jj] = acc[s];
        __syncthreads();
        for (int i = tid; i < 9 * 64; i += NTHR) { const int s = i >> 6, j2 = i & 63; float t = p.in[I_BADA][l * 6144 + j0 + j2];
#pragma unroll
            for (int q = 0; q < 8; ++q) t += part[(q * 9 + s) * 64 + j2];
            mod[(size_t)(l * 9 + s) * 6144 + j0 + j2] = t; }
    }
    float* rope = (float*)(p.ws + OFF_ROPE);
    GSTRIDE_BEGIN(idx, 4096 * 32) {
        const int t = (int)(idx >> 5), i = (int)(idx & 31);
        const float pos = (float)(i < 16 ? (t >> 6) : (t & 63));
        const float inv = powf(10000.0f, -(float)(i & 15) / 16.0f);
        const float ang = pos * inv;
        rope[idx * 2] = cosf(ang); rope[idx * 2 + 1] = sinf(ang);
    }
    __syncthreads();
}

__device__ __forceinline__ void gr_job(const Params& p, int lyr, int r_begin, int r_end, bool commit) {
    __syncthreads();
    const int lane = ltid() & 63, wv = ltid() >> 6, m32 = lane & 31, hf = lane >> 5;
    const bf16_t* h = (const bf16_t*)(p.ws + OFF_H);
    const bf16_t* wg = (const bf16_t*)(p.ws + wdelta(lyr) + OFF_WIN) + (size_t)(1536 + m32) * 1024 + 8 * hf;
    float* gr = (float*)(p.ws + OFF_GR);
    for (int rb = r_begin + 32 * wv; rb < r_end; rb += 32 * (NTHR / 64)) {
        const int arow = min(rb + m32, r_end - 1);
        const bf16_t* ap = h + (size_t)arow * 1024 + 8 * hf;
        f32x16 acc;
#pragma unroll
        for (int r = 0; r < 16; ++r) acc[r] = 0.f;
#pragma unroll 1
        for (int s0 = 0; s0 < 64; s0 += 16) { bf16x8_t af[16], bfr[16];
#pragma unroll
            for (int j = 0; j < 16; ++j) { af[j] = *(const bf16x8_t*)(ap + (s0 + j) * 16); bfr[j] = *(const bf16x8_t*)(wg + (s0 + j) * 16); }
            __builtin_amdgcn_sched_barrier(0);
#pragma unroll
            for (int j = 0; j < 16; ++j) acc = __builtin_amdgcn_mfma_f32_32x32x16_bf16(af[j], bfr[j], acc, 0, 0, 0); }
#pragma unroll
        for (int r = 0; r < 16; ++r) { const int row = rb + (r & 3) + 8 * (r >> 2) + 4 * hf; if (row < r_end && commit) gr[(size_t)row * 32 + m32] = acc[r]; }
    }
}
__device__ __forceinline__ void phase_init(const Params& p) {
    const float* mod = (const float*)(p.ws + OFF_MOD);
    xs_t* xs = (xs_t*)(p.ws + OFF_XS); bf16_t* h = (bf16_t*)(p.ws + OFF_H);
    const int lane = ltid() & 63, wv = ltid() >> 6;
    const int rpb = (T + (int)gridDim.x - 1) / (int)gridDim.x, r_begin = (int)blockIdx.x * rpb, r_end = min(T, r_begin + rpb);
    for (int row = r_begin + wv; row < r_end; row += NTHR / 64) {
        const int b = row / LB, t = row - b * LB;
        const float* src = t < LC ? p.in[I_CTX] + ((size_t)(b * LC + t)) * 1024 : p.in[I_X] + ((size_t)(b * LL + (t - LC))) * 1024;
        const int slot = t < LC ? 8 : b;
        f32x4 v[4], sh[4], sc[4];
#pragma unroll
        for (int i = 0; i < 4; ++i) { const int c4 = i * 256 + lane * 4; v[i] = *(const f32x4*)(src + c4);
            sh[i] = *(const f32x4*)(mod + (size_t)(slot * 6 + 0) * 1024 + c4); sc[i] = *(const f32x4*)(mod + (size_t)(slot * 6 + 1) * 1024 + c4); }
#pragma unroll
        for (int i = 0; i < 4; ++i) { const int c4 = i * 256 + lane * 4;
            xs_st4(xs + (size_t)row * 1024 + c4, v[i]);
            const f32x4 hv = v[i] * (sc[i] + 1.0f) + sh[i];
            u32x2_t o; o[0] = pk2(hv[0], hv[1]); o[1] = pk2(hv[2], hv[3]);
            *(u32x2_t*)(h + (size_t)row * 1024 + c4) = o; }
    }
    gr_job(p, 0, r_begin, r_end, true);
}

__device__ __forceinline__ int winmap(int rho, float& scale) {
    scale = 1.f;
    if (rho < 1568) { if (rho < 256) scale = 0.125f; return rho; }
    if (rho < 1792) return -1;
    if (rho < 2304) scale = 0.125f * 1.4426950408889634f;
    else if (rho >= 3328 && rho < 3840) scale = 0.125f;
    else if (rho >= 4864) scale = -1.4426950408889634f;
    return rho - 224;
}
__device__ __forceinline__ void convert_job(const float* src, const float* src2, int ld, int K, bf16_t* dst, int nrows, int mode, int& itemctr, int cvt_blk0, int cvt_nblk, int dld = 0) {
    if (dld == 0) dld = K;
    const int tid = ltid(), lane = tid & 63, wv = tid >> 6, nwv = cvt_nblk * (NTHR / 64), me = ((int)blockIdx.x - cvt_blk0) * (NTHR / 64) + wv;
    const int nkc = K >> 6, nitems = (nrows >> 6) * nkc;
    int first = (me - itemctr) % nwv; if (first < 0) first += nwv;
    itemctr = (itemctr + nitems) % nwv;
    for (int it = first; it < nitems; it += nwv) {
        const int rg = it / nkc, kc = it - rg * nkc, rho = rg * 64 + lane, k0 = kc * 64;
        float sc = 1.f; int col; const float* s = src;
        if (mode == 0) col = winmap(rho, sc);
        else if (mode == 1) col = rho;
        else { const int ct = rho >> 8, half = (rho >> 7) & 1, i = rho & 127; col = ct * 128 + i; s = half ? src2 : src; }
        const float* sp = s + (size_t)k0 * ld + (col >= 0 ? col : 0);
        if (col < 0) sc = 0.f;
        bf16_t* dp = dst + (size_t)rho * dld + k0;
        float v[8][8];
#pragma unroll
        for (int k8 = 0; k8 < 8; ++k8)
#pragma unroll
            for (int j = 0; j < 8; ++j) v[k8][j] = sp[(size_t)(k8 * 8 + j) * ld];
        __builtin_amdgcn_sched_barrier(0);
#pragma unroll
        for (int k8 = 0; k8 < 8; ++k8) {
            u32x4_t o; o[0] = pk2(v[k8][0] * sc, v[k8][1] * sc); o[1] = pk2(v[k8][2] * sc, v[k8][3] * sc); o[2] = pk2(v[k8][4] * sc, v[k8][5] * sc); o[3] = pk2(v[k8][6] * sc, v[k8][7] * sc);
            *(u32x4_t*)(dp + k8 * 8) = o; }
    }
}
__device__ __forceinline__ void phase_convert(const Params& p, int l, int blk0, int nblk, int pieces = 15) {
    if ((int)blockIdx.x < blk0 || (int)blockIdx.x >= blk0 + nblk) return;
    char* wb = p.ws + wdelta(l);
    int ctr = 0;
    if (pieces & 1) convert_job(p.in[I_WIN] + (size_t)l * 1024 * 7712, nullptr, 7712, 1024, (bf16_t*)(wb + OFF_WIN), (int)W_IN_ROWS, 0, ctr, blk0, nblk);
    if (pieces & 4) {
        for (int n = 0; n < 3; ++n)
            convert_job(p.in[I_WBR] + ((size_t)l * 3 + n) * 512 * 1024, nullptr, 1024, 512, (bf16_t*)(wb + OFF_WB) + (size_t)n * 1024 * 512, 1024, 1, ctr, blk0, nblk);
        convert_job(p.in[I_WO] + (size_t)l * 1024 * 1024, nullptr, 1024, 1024, (bf16_t*)(wb + OFF_WO), 1024, 1, ctr, blk0, nblk); }
    for (int e = 0; e < 16; ++e) {
        const size_t eo = ((size_t)l * 16 + e) * 1024 * 512;
        if (pieces & (e < 8 ? 2 : 8)) convert_job(p.in[I_WEG] + eo, p.in[I_WEU] + eo, 512, 1024, (bf16_t*)(wb + OFF_WUP) + (size_t)e * 1024 * 1024, 1024, 2, ctr, blk0, nblk);
        if (pieces & 4) convert_job(p.in[I_WED] + eo, nullptr, 1024, 512, (bf16_t*)(wb + OFF_WDN) + (size_t)e * 1024 * 512, 1024, 1, ctr, blk0, nblk);
    }
}

__device__ __forceinline__ void phase_rope_decay(const Params& p, int l, unsigned* kml, bool commit = true) {
    const float* rope = (const float*)(p.ws + OFF_ROPE);
    const int G = (int)gridDim.x, rb0 = G >= 64 ? 32 : 0, rnb = G - rb0;
    if ((int)blockIdx.x < rb0) return;
    const int tid = ltid(); const long gt0 = (long)((int)blockIdx.x - rb0) * NTHR + tid, gstr = (long)rnb * NTHR;
    __syncthreads();
    if (tid < NB * 8) kml[tid] = 0u;
    __syncthreads();
    for (long idx = gt0; idx < (long)NB * LC * 8; idx += gstr) {
        const int hc = (int)(idx & 7), t = (int)(idx >> 3) & (LC - 1), b = (int)(idx >> 11);
        const bf16_t* kp = (const bf16_t*)(p.ws + OFF_DK) + ((size_t)b * LB + t) * 512 + hc * 64;
        float ss = 0.f;
#pragma unroll
        for (int i = 0; i < 8; ++i) { const u32x4_t v = *(const u32x4_t*)(kp + i * 8);
#pragma unroll
            for (int j = 0; j < 4; ++j) { const float a0 = bflo(v[j]), a1 = bfhi(v[j]); ss += a0 * a0 + a1 * a1; } }
        atomicMax(kml + b * 8 + hc, __float_as_uint(ss));
    }
    const long nitem = (long)NB * LL * 2 * 8 * 8;
    for (long idx0 = gt0; idx0 < nitem; idx0 += 2 * gstr) {
        u32x2_t a_[2], b_[2]; f32x4 r0_[2], r1_[2]; bf16_t* base_[2]; bool ok_[2];
#pragma unroll
        for (int u = 0; u < 2; ++u) { const long idx = idx0 + u * gstr; ok_[u] = idx < nitem; const long ix = ok_[u] ? idx : idx0;
            const int i4 = (int)(ix & 7) * 4, hc = (int)(ix >> 3) & 7, which = (int)(ix >> 6) & 1; const int lat = (int)(ix >> 7);
            const int b = lat >> 12, t = lat & 4095; const int row = b * LB + LC + t;
            base_[u] = (bf16_t*)(p.ws + (which ? OFF_DK : OFF_DQ)) + (size_t)row * 512 + hc * 64 + i4;
            a_[u] = *(const u32x2_t*)base_[u]; b_[u] = *(const u32x2_t*)(base_[u] + 32);
            const float* rp = rope + ((size_t)t * 32 + i4) * 2; r0_[u] = *(const f32x4*)rp; r1_[u] = *(const f32x4*)(rp + 4); }
        __builtin_amdgcn_sched_barrier(0);
#pragma unroll
        for (int u = 0; u < 2; ++u) { if (!ok_[u]) continue;
            const long idx = idx0 + u * gstr; const int hc = (int)(idx >> 3) & 7, which = (int)(idx >> 6) & 1; const int b = (int)(idx >> 7) >> 12;
            const u32x2_t a = a_[u], bq = b_[u];
            const float x1[4] = {bflo(a[0]), bfhi(a[0]), bflo(a[1]), bfhi(a[1])}, x2[4] = {bflo(bq[0]), bfhi(bq[0]), bflo(bq[1]), bfhi(bq[1])};
            if (which) {
                float ss = 0.f;
#pragma unroll
                for (int j = 0; j < 4; ++j) ss += x1[j] * x1[j] + x2[j] * x2[j];
                ss += __shfl_xor(ss, 1); ss += __shfl_xor(ss, 2); ss += __shfl_xor(ss, 4);
                if ((idx & 7) == 0) atomicMax(kml + b * 8 + hc, __float_as_uint(ss));
            }
            const float cs[4] = {r0_[u][0], r0_[u][2], r1_[u][0], r1_[u][2]}, sn[4] = {r0_[u][1], r0_[u][3], r1_[u][1], r1_[u][3]};
            float y1[4], y2[4];
#pragma unroll
            for (int j = 0; j < 4; ++j) { y1[j] = x1[j] * cs[j] - x2[j] * sn[j]; y2[j] = x1[j] * sn[j] + x2[j] * cs[j]; }
            u32x2_t o1, o2; o1[0] = pk2(y1[0], y1[1]); o1[1] = pk2(y1[2], y1[3]); o2[0] = pk2(y2[0], y2[1]); o2[1] = pk2(y2[2], y2[3]);
            if (commit) { *(u32x2_t*)base_[u] = o1; *(u32x2_t*)(base_[u] + 32) = o2; } }
    }
    __syncthreads();
    if (tid < NB * 8 && commit) atomicMax((unsigned*)(p.ws + OFF_KMAX) + l * (NB * 8) + tid, kml[tid]);
#if !FAST_GLA
    const float* gr = (const float*)(p.ws + OFF_GR); float* dec = (float*)(p.ws + OFF_S1);
    const float* wd = p.in[I_GWD] + (size_t)l * 2 * 16 * 256; const float* bd = p.in[I_GBD] + (size_t)l * 2 * 256;
    GSTRIDE_BEGIN(idx, (long)T * 512) {
        const int row = (int)(idx >> 9), dj = (int)(idx & 511), dir = dj >> 8, j = dj & 255;
        float z = bd[dir * 256 + j];
#pragma unroll
        for (int r = 0; r < 16; ++r) z += gr[(size_t)row * 32 + dir * 16 + r] * wd[(dir * 16 + r) * 256 + j];
        const float ls = fminf(z, 0.f) - log1pf(__expf(-fabsf(z)));
        dec[idx] = __expf(ls * (1.0f / 16.0f));
    }
#endif
}

template <int DIR>
__device__ __forceinline__ void gla_naive_dir(const Params& p, int l, int b, float* lds) {
    const int tid = ltid(), hh = tid >> 7, vc = tid & 127, wv = tid >> 6;
    const bf16_t* GQ = (const bf16_t*)(p.ws + OFF_GQ); const bf16_t* GK = (const bf16_t*)(p.ws + OFF_GK); const bf16_t* GV = (const bf16_t*)(p.ws + OFF_GV);
    bf16_t* GG = (bf16_t*)(p.ws + OFF_GG); const float* DEC = (const float*)(p.ws + OFF_S1); float* OF = (float*)(p.ws + OFF_S2);
    float* sq = lds; float* sk = lds + 16 * 256; float* sd = lds + 32 * 256; float* red = lds + 48 * 256;
    float* sv = lds + 49 * 256;
    const float gn = p.in[I_GNG][l * 128 + vc];
    const int row0 = b * LB;
    float S[64];
#pragma unroll
    for (int d = 0; d < 64; ++d) S[d] = 0.f;
    for (int blk = 0; blk < LB / 16; ++blk) {
        int t0;
        if (DIR == 0) t0 = blk * 16; else t0 = blk < 16 ? (15 - blk) * 16 : (LB / 16 - 1 - (blk - 16)) * 16;
        __syncthreads();
        for (int i = tid; i < 16 * 256; i += 512) { const int r = i >> 8, j = i & 255; const size_t row = row0 + t0 + r;
            sq[i] = bf2f(GQ[row * 256 + j]); sk[i] = bf2f(GK[row * 256 + j]); sd[i] = DEC[(row * 2 + DIR) * 256 + j]; }
#pragma unroll 1
        for (int r = 0; r < 16; ++r) sv[r * 512 + tid] = bf2f(GV[(size_t)(row0 + t0 + r) * 512 + hh * 128 + vc]);
        __syncthreads();
#pragma unroll 1
        for (int rr = 0; rr < 16; ++rr) {
            const int r = DIR == 0 ? rr : 15 - rr;
            const float* pq = sq + r * 256 + hh * 64; const float* pk = sk + r * 256 + hh * 64; const float* pd = sd + r * 256 + hh * 64;
            const float vr = sv[r * 512 + tid];
            float o = 0.f;
#pragma unroll
            for (int d = 0; d < 64; ++d) { S[d] = pd[d] * S[d] + pk[d] * vr; o += pq[d] * S[d]; }
            const size_t oi = (size_t)(row0 + t0 + r) * 512 + hh * 128 + vc;
            if (DIR == 0) OF[oi] = o;
            else {
                const float tot = o + OF[oi];
                sv[r * 512 + tid] = tot;
                const float ss = wave_sum(tot * tot); if ((tid & 63) == 0) red[r * 8 + wv] = ss;
            }
        }
        if (DIR == 1) {
            __syncthreads();
#pragma unroll 1
            for (int r = 0; r < 16; ++r) {
                const float ms = (red[r * 8 + hh * 2] + red[r * 8 + hh * 2 + 1]) * (1.0f / 128.0f);
                const size_t gi = (size_t)(row0 + t0 + r) * 512 + hh * 128 + vc;
                const float gate = bf2f(GG[gi]);
                GG[gi] = f2bf(sv[r * 512 + tid] * rsqrtf(ms + RMS_EPS) * gn * siluf_(gate));
            }
        }
    }
    __syncthreads();
}
__device__ __forceinline__ void gla_naive_batch(const Params& p, int l, int b, float* lds) {
    gla_naive_dir<0>(p, l, b, lds);
    gla_naive_dir<1>(p, l, b, lds);
}

__device__ __forceinline__ void diff_naive_tile(const Params& p, int l, int unit, float* lds) {
    const int tid = ltid(), qi = tid & 127, c = (tid >> 7) & 1, hv = tid >> 8;
    const int qt = unit % 34, bh = unit / 34, hh = bh & 3, b = bh >> 2;
    const int nkeys = qt < 2 ? LC : LB;
    const size_t rowq = (size_t)b * LB + qt * 128 + qi;
    bf16_t* DQ = (bf16_t*)(p.ws + OFF_DQ); const bf16_t* DK = (const bf16_t*)(p.ws + OFF_DK); const bf16_t* DV = (const bf16_t*)(p.ws + OFF_DV);
    float q[64], o[64];
    { const bf16_t* qp = DQ + rowq * 512 + hh * 128 + c * 64;
#pragma unroll
      for (int d8 = 0; d8 < 8; ++d8) { const u32x4_t v = *(const u32x4_t*)(qp + d8 * 8);
#pragma unroll
          for (int j = 0; j < 4; ++j) { q[d8 * 8 + 2 * j] = bflo(v[j]); q[d8 * 8 + 2 * j + 1] = bfhi(v[j]); } } }
#pragma unroll
    for (int d = 0; d < 64; ++d) o[d] = 0.f;
    float m = -INFINITY, lsum = 0.f;
    constexpr int KT = 8; float* kb = lds; float* vb = lds + KT * 128;
    for (int k0 = 0; k0 < nkeys; k0 += KT) {
        __syncthreads();
        for (int i = tid; i < KT * 128; i += 512) { const int r = i >> 7, j = i & 127; const size_t row = (size_t)b * LB + k0 + r;
            kb[i] = bf2f(DK[row * 512 + hh * 128 + j]); vb[i] = bf2f(DV[row * 512 + hh * 128 + j]); }
        __syncthreads();
        float s[KT]; float mt = -INFINITY;
#pragma unroll
        for (int j = 0; j < KT; ++j) { const float* kp = kb + j * 128 + c * 64; float a = 0.f;
#pragma unroll
            for (int d = 0; d < 64; ++d) a += q[d] * kp[d];
            s[j] = a; mt = fmaxf(mt, a); }
        const float mn = fmaxf(m, mt), corr = __expf(m - mn);
        lsum *= corr;
#pragma unroll
        for (int d = 0; d < 64; ++d) o[d] *= corr;
#pragma unroll
        for (int j = 0; j < KT; ++j) { const float pj = __expf(s[j] - mn); lsum += pj; const float* vp = vb + j * 128 + hv * 64;
#pragma unroll
            for (int d = 0; d < 64; ++d) o[d] += pj * vp[d]; }
        m = mn;
    }
    __syncthreads();
    { const float inv = 1.f / lsum; float* cp = lds + ((size_t)qi * 2 + c) * 128 + hv * 64;
#pragma unroll
      for (int d = 0; d < 64; ++d) cp[d] = o[d] * inv; }
    __syncthreads();
    {
        float dq = 0.f, dk2 = 0.f; const float* lq = p.in[I_LQ] + l * 128; const float* lk = p.in[I_LK] + l * 128;
        for (int d = 0; d < 64; ++d) { dq += lq[d] * lk[d]; dk2 += lq[64 + d] * lk[64 + d]; }
        const float lam_init = 0.8f - 0.6f * expf(-0.3f * (float)l);
        const float lam = expf(dq) - expf(dk2) + lam_init;
        const int q2 = tid >> 2, part = tid & 3;
        const float* c0 = lds + ((size_t)q2 * 2) * 128 + part * 32; const float* c1 = c0 + 128;
        float v[32]; float ss = 0.f;
#pragma unroll
        for (int d = 0; d < 32; ++d) { v[d] = c0[d] - lam * c1[d]; ss += v[d] * v[d]; }
        ss += __shfl_xor(ss, 1); ss += __shfl_xor(ss, 2);
        const float sc = rsqrtf(ss * (1.0f / 128.0f) + RMS_EPS) * (1.0f - lam_init);
        const float* g = p.in[I_DNG] + l * 128 + part * 32;
        bf16_t* op = DQ + ((size_t)b * LB + qt * 128 + q2) * 512 + hh * 128 + part * 32;
#pragma unroll
        for (int d = 0; d < 32; d += 2) *(unsigned*)(op + d) = pk2(v[d] * sc * g[d], v[d + 1] * sc * g[d + 1]);
    }
    __syncthreads();
}

__device__ __forceinline__ void na_naive_unit(const Params& p, int l, int unit) {
    const int tid = ltid(), h = tid >> 6, lane = tid & 63;
    const size_t row = (size_t)unit * 64 + lane; const int b = (int)(row / LB), t = (int)(row - (size_t)b * LB);
    bf16_t* NQ = (bf16_t*)(p.ws + OFF_NQ); const bf16_t* NK = (const bf16_t*)(p.ws + OFF_NK); const bf16_t* NV = (const bf16_t*)(p.ws + OFF_NV);
    const float* rpb = p.in[I_RPB] + ((size_t)l * 8 + h) * 15 * 31;
    float q[64], o[64];
    { const bf16_t* qp = NQ + row * 512 + h * 64;
#pragma unroll
      for (int d8 = 0; d8 < 8; ++d8) { const u32x4_t v = *(const u32x4_t*)(qp + d8 * 8);
#pragma unroll
          for (int j = 0; j < 4; ++j) { q[d8 * 8 + 2 * j] = bflo(v[j]); q[d8 * 8 + 2 * j + 1] = bfhi(v[j]); } } }
#pragma unroll
    for (int d = 0; d < 64; ++d) o[d] = 0.f;
    float m = -INFINITY, lsum = 0.f;
    const bool lat = t >= LC; const int tp = t - LC, r = tp >> 6, qc = tp & 63;
    const int rs = min(max(r - 4, 0), 56), cs = min(max(qc - 8, 0), 48);
    const int nloc = lat ? 128 : 0;
    for (int kk = 0; kk < nloc + LC; ++kk) {
        size_t krow; float bias = 0.f;
        if (kk < nloc) { const int kr = rs + (kk >> 4), kc = cs + (kk & 15); krow = (size_t)b * LB + LC + kr * 64 + kc; bias = rpb[(kr - r + 7) * 31 + (kc - qc + 15)]; }
        else krow = (size_t)b * LB + (kk - nloc);
        const bf16_t* kp = NK + krow * 512 + h * 64; const bf16_t* vp = NV + krow * 512 + h * 64;
        float s = bias;
#pragma unroll
        for (int d8 = 0; d8 < 8; ++d8) { const u32x4_t v = *(const u32x4_t*)(kp + d8 * 8);
#pragma unroll
            for (int j = 0; j < 4; ++j) { s += q[d8 * 8 + 2 * j] * bflo(v[j]); s += q[d8 * 8 + 2 * j + 1] * bfhi(v[j]); } }
        const float mn = fmaxf(m, s), corr = __expf(m - mn), pj = __expf(s - mn);
        lsum = lsum * corr + pj; m = mn;
#pragma unroll
        for (int d8 = 0; d8 < 8; ++d8) { const u32x4_t v = *(const u32x4_t*)(vp + d8 * 8);
#pragma unroll
            for (int j = 0; j < 4; ++j) { o[d8 * 8 + 2 * j] = o[d8 * 8 + 2 * j] * corr + pj * bflo(v[j]); o[d8 * 8 + 2 * j + 1] = o[d8 * 8 + 2 * j + 1] * corr + pj * bfhi(v[j]); } }
    }
    const float inv = 1.f / lsum;
    bf16_t* op = NQ + row * 512 + h * 64;
#pragma unroll
    for (int d8 = 0; d8 < 8; ++d8) { u32x4_t v;
#pragma unroll
        for (int j = 0; j < 4; ++j) v[j] = pk2(o[d8 * 8 + 2 * j] * inv, o[d8 * 8 + 2 * j + 1] * inv);
        *(u32x4_t*)(op + d8 * 8) = v; }
}

__device__ __forceinline__ void ln_row(float (&v)[16], const float* g, const float* bb, int lane) {
    float s = 0.f;
#pragma unroll
    for (int i = 0; i < 16; ++i) s += v[i];
    const float mu = wave_sum(s) * (1.0f / 1024.0f);
    float q = 0.f;
#pragma unroll
    for (int i = 0; i < 16; ++i) { v[i] -= mu; q += v[i] * v[i]; }
    const float rstd = rsqrtf(wave_sum(q) * (1.0f / 1024.0f) + LN_EPS);
#pragma unroll
    for (int i = 0; i < 4; ++i) { const f32x4 gv = *(const f32x4*)(g + i * 256 + lane * 4), bv = *(const f32x4*)(bb + i * 256 + lane * 4);
#pragma unroll
        for (int j = 0; j < 4; ++j) v[i * 4 + j] = v[i * 4 + j] * rstd * gv[j] + bv[j]; }
}

__device__ __forceinline__ void ln_row_r(float (&v)[16], const float (&g)[16], const float (&b)[16]) {
    float s = 0.f;
#pragma unroll
    for (int i = 0; i < 16; ++i) s += v[i];
    const float mu = wave_sum(s) * (1.0f / 1024.0f);
    float q = 0.f;
#pragma unroll
    for (int i = 0; i < 16; ++i) { v[i] -= mu; q += v[i] * v[i]; }
    const float rstd = rsqrtf(wave_sum(q) * (1.0f / 1024.0f) + LN_EPS);
#pragma unroll
    for (int i = 0; i < 16; ++i) v[i] = v[i] * rstd * g[i] + b[i];
}
__device__ __forceinline__ void ld_cols(float (&d)[16], const float* src, int lane) {
#pragma unroll
    for (int i = 0; i < 4; ++i) { const f32x4 t = *(const f32x4*)(src + i * 256 + lane * 4); d[i * 4] = t[0]; d[i * 4 + 1] = t[1]; d[i * 4 + 2] = t[2]; d[i * 4 + 3] = t[3]; }
}

__device__ __forceinline__ void top2of4(const float s0, const float s1, const float s2, const float s3, int& i1, int& i2, float& sum) {
    i1 = 0; float m1 = s0;
    if (s1 > m1) { m1 = s1; i1 = 1; } if (s2 > m1) { m1 = s2; i1 = 2; } if (s3 > m1) { m1 = s3; i1 = 3; }
    float m2 = -INFINITY; i2 = 0;
    if (i1 != 0 && s0 > m2) { m2 = s0; i2 = 0; } if (i1 != 1 && s1 > m2) { m2 = s1; i2 = 1; }
    if (i1 != 2 && s2 > m2) { m2 = s2; i2 = 2; } if (i1 != 3 && s3 > m2) { m2 = s3; i2 = 3; }
    sum = m1 + m2;
}

__device__ __forceinline__ void phase_ln1_router(const Params& p, int l, float* lds, bool commit = true) {
    const int tid = ltid(), lane = tid & 63, wv = tid >> 6;
    xs_t* xs = (xs_t*)(p.ws + OFF_XS); bf16_t* h = (bf16_t*)(p.ws + OFF_H); const float* mod = (const float*)(p.ws + OFF_MOD);
    int* tok = (int*)(p.ws + OFF_TOK); unsigned* blkcnt = (unsigned*)(p.ws + OFF_BLKCNT);
    const float* g = p.in[I_LNG] + (size_t)(l * 2 + 0) * 1024; const float* bb = p.in[I_LNB] + (size_t)(l * 2 + 0) * 1024;
    const float* wr = p.in[I_WR]; const float* br = p.in[I_BR];
    float* wt = lds; unsigned* lcnt = (unsigned*)(lds + 16 * 1024);
    __syncthreads();
    for (int i = tid; i < 16 * 1024; i += NTHR) { const int col = i >> 4, e = i & 15; wt[e * 1024 + col] = wr[i]; }
    if (tid < 16) lcnt[tid] = 0u;
    __syncthreads();
    const int rpb = (T + (int)gridDim.x - 1) / (int)gridDim.x, r_begin = (int)blockIdx.x * rpb, r_end = min(T, r_begin + rpb);
    float gR[16], bR[16], shR[16], scR[16]; int cur_slot = -1;
    ld_cols(gR, g, lane); ld_cols(bR, bb, lane);
    f32x4 wR0[16];
#pragma unroll
    for (int e = 0; e < 16; ++e) wR0[e] = *(const f32x4*)(wt + e * 1024 + lane * 4);
    float lgrow[16]; int nrow = 0, myrow = 0;
#pragma unroll
    for (int e = 0; e < 16; ++e) lgrow[e] = 0.f;
    auto route_rows = [&]() {
    if (lane < nrow) {
        float aff[16], sel[16];
#pragma unroll
        for (int e = 0; e < 16; ++e) { aff[e] = sigmoidf_(lgrow[e]); sel[e] = aff[e] + br[e]; }
        int bi1 = 0, bi2 = 0, bg = 0; float best = -INFINITY;
#pragma unroll
        for (int gq = 0; gq < 4; ++gq) { int i1, i2; float sm; top2of4(sel[gq * 4], sel[gq * 4 + 1], sel[gq * 4 + 2], sel[gq * 4 + 3], i1, i2, sm);
            if (sm > best) { best = sm; bg = gq; bi1 = i1; bi2 = i2; } }
        const int e1 = bg * 4 + bi1, e2 = bg * 4 + bi2;
        float a1 = 0.f, a2 = 0.f;
#pragma unroll
        for (int e = 0; e < 16; ++e) { a1 = (e == e1) ? aff[e] : a1; a2 = (e == e2) ? aff[e] : a2; }
        const float inv = 1.f / (a1 + a2);
        if (commit) {
            const unsigned s1 = atomicAdd(lcnt + e1, 1u), s2 = atomicAdd(lcnt + e2, 1u);
            int* tp = tok + (size_t)myrow * 8;
            tp[0] = e1; tp[1] = e2; tp[2] = (int)s1; tp[3] = (int)s2; tp[4] = __float_as_int(a1 * inv); tp[5] = __float_as_int(a2 * inv);
        }
    }
        nrow = 0;
    };
    for (int row = r_begin + wv; row < r_end; row += NTHR / 64) {
        const int slot = row_slot(row);
        if (l == DEPTH - 1 && slot == 8) continue;
        if (slot != cur_slot) { const float* msh = mod + ((size_t)(l * 9 + slot) * 6 + 3) * 1024; ld_cols(shR, msh, lane); ld_cols(scR, msh + 1024, lane); cur_slot = slot; }
        float v[16];
#pragma unroll
        for (int i = 0; i < 4; ++i) { const f32x4 t4 = xs_ld4(xs + (size_t)row * 1024 + i * 256 + lane * 4);
#pragma unroll
            for (int j = 0; j < 4; ++j) v[i * 4 + j] = t4[j]; }
        ln_row_r(v, gR, bR);
        float lg[16];
#pragma unroll
        for (int e = 0; e < 16; ++e) lg[e] = 0.f;
#pragma unroll
        for (int i = 0; i < 4; ++i) {
            const int c0 = i * 256 + lane * 4;
            f32x4 x4; x4[0] = v[i * 4]; x4[1] = v[i * 4 + 1]; x4[2] = v[i * 4 + 2]; x4[3] = v[i * 4 + 3];
            if (commit) xs_st4(xs + (size_t)row * 1024 + c0, x4);
            f32x4 hv; hv[0] = x4[0] * (scR[i * 4] + 1.0f) + shR[i * 4]; hv[1] = x4[1] * (scR[i * 4 + 1] + 1.0f) + shR[i * 4 + 1]; hv[2] = x4[2] * (scR[i * 4 + 2] + 1.0f) + shR[i * 4 + 2]; hv[3] = x4[3] * (scR[i * 4 + 3] + 1.0f) + shR[i * 4 + 3];
            u32x2_t o; o[0] = pk2(hv[0], hv[1]); o[1] = pk2(hv[2], hv[3]);
            if (commit) *(u32x2_t*)(h + (size_t)row * 1024 + c0) = o;
            if (i == 0) {
#pragma unroll
                for (int e = 0; e < 16; ++e) { const f32x4 w4 = wR0[e]; lg[e] = __builtin_fmaf(hv[3], w4[3], __builtin_fmaf(hv[2], w4[2], __builtin_fmaf(hv[1], w4[1], __builtin_fmaf(hv[0], w4[0], lg[e])))); }
            } else {
#pragma unroll
                for (int eh = 0; eh < 2; ++eh) { f32x4 wb[8];
#pragma unroll
                    for (int e = 0; e < 8; ++e) wb[e] = *(const f32x4*)(wt + (eh * 8 + e) * 1024 + c0);
                    __builtin_amdgcn_sched_barrier(0);
#pragma unroll
                    for (int e = 0; e < 8; ++e) { const f32x4 w4 = wb[e]; lg[eh * 8 + e] = __builtin_fmaf(hv[3], w4[3], __builtin_fmaf(hv[2], w4[2], __builtin_fmaf(hv[1], w4[1], __builtin_fmaf(hv[0], w4[0], lg[eh * 8 + e])))); } }
            }
        }
        float t8[8], t4[4], t2[2], t1;
        { const bool hi = (lane & 32) != 0;
#pragma unroll
          for (int i = 0; i < 8; ++i) { const float keep = hi ? lg[8 + i] : lg[i], give = hi ? lg[i] : lg[8 + i]; t8[i] = keep + __shfl_xor(give, 32); } }
        { const bool hi = (lane & 16) != 0;
#pragma unroll
          for (int i = 0; i < 4; ++i) { const float keep = hi ? t8[4 + i] : t8[i], give = hi ? t8[i] : t8[4 + i]; t4[i] = keep + __shfl_xor(give, 16); } }
        { const bool hi = (lane & 8) != 0;
#pragma unroll
          for (int i = 0; i < 2; ++i) { const float keep = hi ? t4[2 + i] : t4[i], give = hi ? t4[i] : t4[2 + i]; t2[i] = keep + __shfl_xor(give, 8); } }
        { const bool hi = (lane & 4) != 0; const float keep = hi ? t2[1] : t2[0], give = hi ? t2[0] : t2[1]; t1 = keep + __shfl_xor(give, 4); }
        t1 += __shfl_xor(t1, 2); t1 += __shfl_xor(t1, 1);
#pragma unroll
        for (int e = 0; e < 16; ++e) { const int src = ((e >> 3) & 1) * 32 + ((e >> 2) & 1) * 16 + ((e >> 1) & 1) * 8 + (e & 1) * 4;
            const float lgt = __builtin_bit_cast(float, __builtin_amdgcn_readlane(__builtin_bit_cast(int, t1), src));
            lgrow[e] = (lane == nrow) ? lgt : lgrow[e]; }
        myrow = (lane == nrow) ? row : myrow;
        if (++nrow == 64) route_rows();
    }
    route_rows();
    __syncthreads();
    if (tid < 16 && commit) blkcnt[(size_t)blockIdx.x * 16 + tid] = lcnt[tid];
    __syncthreads();
}

__device__ __forceinline__ void phase_gather(const Params& p, int l, float* lds) {
    const int tid = ltid(), lane = tid & 63, wv = tid >> 6;
    const unsigned* blkcnt = (const unsigned*)(p.ws + OFF_BLKCNT); unsigned* cnt = (unsigned*)(p.ws + OFF_CNT) + l * 16;
    int* sbase = (int*)lds;
    int* pairtok = (int*)(p.ws + OFF_PAIRTOK);
    __syncthreads();
    {
        unsigned* lc = (unsigned*)(lds + 64);
        for (int i = tid; i < (int)gridDim.x * 4; i += NTHR) *(u32x4_t*)(lc + i * 4) = *(const u32x4_t*)(blkcnt + (size_t)i * 4);
        __syncthreads();
        if (tid < 16) { unsigned tot = 0, pre = 0;
            for (int b2 = 0; b2 < (int)gridDim.x; ++b2) { const unsigned v = lc[b2 * 16 + tid]; pre += (b2 < (int)blockIdx.x) ? v : 0u; tot += v; }
            sbase[16 + tid] = (int)tot; sbase[32 + tid] = (int)pre;
            if (blockIdx.x == 0) cnt[tid] = tot; } }
    __syncthreads();
    if (tid < 16) { int s = 0; for (int e = 0; e < tid; ++e) s += ((sbase[16 + e] + 255) >> 8) * 256; sbase[48 + tid] = s; sbase[tid] = s + sbase[32 + tid]; }
    __syncthreads();
    if (blockIdx.x == 0) {
        for (int e = 0; e < 16; ++e) { const int lo = sbase[48 + e] + sbase[16 + e], hi = sbase[48 + e] + ((sbase[16 + e] + 255) >> 8) * 256;
            for (int q = lo + tid; q < hi; q += NTHR) pairtok[q] = 0; } }
    int* tok = (int*)(p.ws + OFF_TOK);
    const int rpb = (T + (int)gridDim.x - 1) / (int)gridDim.x, r_begin = (int)blockIdx.x * rpb, r_end = min(T, r_begin + rpb);
    for (int row = r_begin + tid; row < r_end; row += NTHR) {
        if (l == DEPTH - 1 && row_slot(row) == 8) continue;
        int* tp = tok + (size_t)row * 8;
        const int p1 = sbase[tp[0]] + tp[2], p2 = sbase[tp[1]] + tp[3];
        pairtok[p1] = row; pairtok[p2] = row; tp[6] = p1; tp[7] = p2;
    }
    (void)lane; (void)wv;
    __syncthreads();
}

__device__ __forceinline__ void phase_ln2(const Params& p, int l, bool commit = true) {
    const int lane = ltid() & 63, wv = ltid() >> 6;
    xs_t* xs = (xs_t*)(p.ws + OFF_XS); bf16_t* h = (bf16_t*)(p.ws + OFF_H); const float* mod = (const float*)(p.ws + OFF_MOD);
    const int* tok = (const int*)(p.ws + OFF_TOK); const bf16_t* y = (const bf16_t*)(p.ws + OFF_Y);
    float gR[16], bR[16], mgR[16], shR[16], scR[16]; int cur_slot = -1;
    ld_cols(gR, p.in[I_LNG] + (size_t)(l * 2 + 1) * 1024, lane); ld_cols(bR, p.in[I_LNB] + (size_t)(l * 2 + 1) * 1024, lane);
    const int rpb = (T + (int)gridDim.x - 1) / (int)gridDim.x, r_begin = (int)blockIdx.x * rpb, r_end = min(T, r_begin + rpb);
    for (int row = r_begin + wv; row < r_end; row += NTHR / 64) {
        const int slot = row_slot(row);
        if (l == DEPTH - 1 && slot == 8) continue;
        if (slot != cur_slot) { ld_cols(mgR, mod + ((size_t)(l * 9 + slot) * 6 + 5) * 1024, lane);
            if (l < DEPTH - 1) { const float* msh = mod + ((size_t)((l + 1) * 9 + slot) * 6 + 0) * 1024; ld_cols(shR, msh, lane); ld_cols(scR, msh + 1024, lane); }
            cur_slot = slot; }
        const int* tp = tok + (size_t)row * 8;
        const float w0 = __int_as_float(tp[4]), w1 = __int_as_float(tp[5]); const size_t p0 = (size_t)tp[6], p1 = (size_t)tp[7];
        float v[16];
#pragma unroll
        for (int i = 0; i < 4; ++i) { const int c0 = i * 256 + lane * 4;
            const f32x4 x4 = xs_ld4(xs + (size_t)row * 1024 + c0);
            const u32x2_t ya = *(const u32x2_t*)(y + p0 * 1024 + c0), yb = *(const u32x2_t*)(y + p1 * 1024 + c0);
            v[i * 4 + 0] = ALPHA * x4[0] + mgR[i * 4 + 0] * (w0 * bflo(ya[0]) + w1 * bflo(yb[0]));
            v[i * 4 + 1] = ALPHA * x4[1] + mgR[i * 4 + 1] * (w0 * bfhi(ya[0]) + w1 * bfhi(yb[0]));
            v[i * 4 + 2] = ALPHA * x4[2] + mgR[i * 4 + 2] * (w0 * bflo(ya[1]) + w1 * bflo(yb[1]));
            v[i * 4 + 3] = ALPHA * x4[3] + mgR[i * 4 + 3] * (w0 * bfhi(ya[1]) + w1 * bfhi(yb[1])); }
        ln_row_r(v, gR, bR);
        const int b = row / LB, t = row - b * LB;
        if (l == DEPTH - 1) {
            if (t >= LC) { float* op = p.out + ((size_t)b * LL + (t - LC)) * 1024;
#pragma unroll
                for (int i = 0; i < 4; ++i) { f32x4 x4; x4[0] = v[i * 4]; x4[1] = v[i * 4 + 1]; x4[2] = v[i * 4 + 2]; x4[3] = v[i * 4 + 3]; if (commit) *(f32x4*)(op + i * 256 + lane * 4) = x4; } }
        } else {
#pragma unroll
            for (int i = 0; i < 4; ++i) { const int c0 = i * 256 + lane * 4;
                f32x4 x4; x4[0] = v[i * 4]; x4[1] = v[i * 4 + 1]; x4[2] = v[i * 4 + 2]; x4[3] = v[i * 4 + 3];
                if (commit) xs_st4(xs + (size_t)row * 1024 + c0, x4);
                f32x4 hv; hv[0] = x4[0] * (scR[i * 4] + 1.0f) + shR[i * 4]; hv[1] = x4[1] * (scR[i * 4 + 1] + 1.0f) + shR[i * 4 + 1]; hv[2] = x4[2] * (scR[i * 4 + 2] + 1.0f) + shR[i * 4 + 2]; hv[3] = x4[3] * (scR[i * 4 + 3] + 1.0f) + shR[i * 4 + 3];
                u32x2_t o; o[0] = pk2(hv[0], hv[1]); o[1] = pk2(hv[2], hv[3]);
                if (commit) *(u32x2_t*)(h + (size_t)row * 1024 + c0) = o; }
        }
    }
    if (l < DEPTH - 1) gr_job(p, l + 1, r_begin, r_end, commit);
}

constexpr float LOG2E = 1.4426950408889634f;
__device__ __forceinline__ u32x4_t widen_pair(u32x2_t a, u32x2_t b) {
    const auto r0 = __builtin_amdgcn_permlane32_swap(a[0], b[0], false, false);
    const auto r1 = __builtin_amdgcn_permlane32_swap(a[1], b[1], false, false);
    u32x4_t o; o[0] = r0[0]; o[1] = r1[0]; o[2] = r0[1]; o[3] = r1[1]; return o;
}

__device__ __forceinline__ void vtrans_buf(const bf16_t* src, bf16_t* dst, bf16_t* lds) {
    const int tid = ltid();
    constexpr int LS = 72;
    for (int it = blockIdx.x; it < NB * 8 * (LB / 64); it += gridDim.x) {
        const int kt = it % (LB / 64), bc = it / (LB / 64), cg = bc & 7, b = bc >> 3;
        __syncthreads();
        { const int key = tid >> 3, d8 = (tid & 7) * 8;
          const u32x4_t v = *(const u32x4_t*)(src + ((size_t)b * LB + kt * 64 + key) * 512 + cg * 64 + d8);
#pragma unroll
          for (int j = 0; j < 4; ++j) { lds[(d8 + 2 * j) * LS + key] = (bf16_t)(v[j] & 0xffffu); lds[(d8 + 2 * j + 1) * LS + key] = (bf16_t)(v[j] >> 16); } }
        __syncthreads();
        { const int dv = tid >> 3, k8 = (tid & 7) * 8;
          const u32x4_t v = *(const u32x4_t*)(lds + dv * LS + k8);
          *(u32x4_t*)(dst + ((size_t)(b * 512 + cg * 64 + dv)) * LB + kt * 64 + k8) = v; }
    }
    __syncthreads();
}
__device__ __forceinline__ void phase_vtrans(const Params& p, int l, bf16_t* lds) {
    (void)lds;
    { float* bt = (float*)(p.ws + OFF_NBT); const float* rpb = p.in[I_RPB] + (size_t)l * 8 * 15 * 31;
      for (int i = blockIdx.x * NTHR + ltid(); i < 8 * 15 * 4 * 64 * 16; i += gridDim.x * NTHR) {
          const int r = i & 15, lane = (i >> 4) & 63, ib = (i >> 10) & 1, kb = (i >> 11) & 1, hd = i >> 12;
          const int kc = 32 * kb + (r & 3) + 8 * (r >> 2) + 4 * (lane >> 5), qc = 32 * ib + (lane & 31);
          const int cs = min(max(qc - 8, 0), 48);
          bt[i] = (kc >= cs && kc < cs + 16) ? rpb[hd * 31 + (kc - qc + 15)] : -1e30f; } }
}

constexpr int DA_KS = 272, DA_VS = 144, DA_KB = 64 * DA_KS  , DA_VB = 128 * DA_VS  ;
constexpr int DA_UNITS = NB * 4 * 34;
constexpr int DA_GOFF = 150016;
constexpr float DA_THR = 8.0f;
#ifndef DPV
#define DPV 0
#endif
__device__ __forceinline__ void diff_attn_unit(const Params& p, int l, int unit, unsigned char* shm, bool commit = true) {
    const bool dry = !commit;
    const int tid = ltid(), lane = tid & 63, wid = tid >> 6, c = wid & 1, qb = wid >> 1, m32 = lane & 31, h = lane >> 5;
    if (tid < 128) ((float*)(shm + DA_GOFF))[tid] = (p.in[I_DNG] + l * 128)[tid];
    int bh, qt;
    if (unit < NB * 4 * 32) { bh = (unit >> 8) * 8 + (unit & 7); qt = 2 + ((unit & 255) >> 3); } else { const int u2 = unit - NB * 4 * 32; bh = u2 >> 1; qt = u2 & 1; }
    const int hh = bh & 3, b = bh >> 2, nkt = qt < 2 ? LC / 64 : LB / 64;
    const size_t rowb = (size_t)b * LB;
    bf16_t* DQ = (bf16_t*)(p.ws + OFF_DQ); const bf16_t* DK = (const bf16_t*)(p.ws + OFF_DK); const bf16_t* VT = (const bf16_t*)(p.ws + OFF_VT);
    const size_t qrow = rowb + qt * 128 + qb * 32 + m32;
    bf16x8_t qf[4];
#pragma unroll
    for (int s = 0; s < 4; ++s) qf[s] = *(const bf16x8_t*)(DQ + qrow * 512 + hh * 128 + c * 64 + 16 * s + 8 * h);
    f32x16 O[4];
#pragma unroll
    for (int d = 0; d < 4; ++d)
#pragma unroll
        for (int r = 0; r < 16; ++r) O[d][r] = 0.f;
    float lrun = 0.f;
    f32x16 minit;
    { float qn = 0.f;
#pragma unroll
      for (int s = 0; s < 4; ++s)
#pragma unroll
          for (int j = 0; j < 8; ++j) { const float x = bf2f((bf16_t)qf[s][j]); qn += x * x; }
      { auto rr = __builtin_amdgcn_permlane32_swap(__float_as_uint(qn), __float_as_uint(qn), false, false); qn = __uint_as_float(rr[0]) + __uint_as_float(rr[1]); }
      const float km = __uint_as_float(((const unsigned*)(p.ws + OFF_KMAX))[l * (NB * 8) + (b * 4 + hh) * 2 + c]);
      const float bound = sqrtf(qn * km) * 1.02f + 1e-3f - 64.0f;
#pragma unroll
      for (int r = 0; r < 16; ++r) minit[r] = -bound; }
    const bf16_t* kg[2]; const bf16_t* vg[2]; int kl[2], vl[2];
#pragma unroll
    for (int j = 0; j < 2; ++j) { const int i = tid + j * 512;
        kg[j] = DK + (rowb + (i >> 4)) * 512 + hh * 128 + (i & 15) * 8; kl[j] = (i >> 4) * DA_KS + (i & 15) * 16;
        vg[j] = VT + ((size_t)(bh * 128 + (i >> 3))) * LB + (i & 7) * 8; vl[j] = 3 * DA_KB + (i >> 3) * DA_VS + ((i & 7) >> 1) * 32 + (i & 1) * 8; }
    u32x4_t rk[2], rv[2];
    bf16x8_t kf[2][4];
    __syncthreads();
#pragma unroll
    for (int j = 0; j < 2; ++j) { rk[j] = *(const u32x4_t*)(kg[j]); rv[j] = *(const u32x4_t*)(vg[j]); }
#pragma unroll
    for (int j = 0; j < 2; ++j) { *(u32x4_t*)(shm + kl[j]) = rk[j]; u32x2_t a, bq; a[0] = rv[j][0]; a[1] = rv[j][1]; bq[0] = rv[j][2]; bq[1] = rv[j][3];
        *(u32x2_t*)(shm + vl[j]) = a; *(u32x2_t*)(shm + vl[j] + 16) = bq; }
#pragma unroll
    for (int j = 0; j < 2; ++j) rk[j] = *(const u32x4_t*)(kg[j] + (size_t)64 * 512);
#pragma unroll
    for (int j = 0; j < 2; ++j) *(u32x4_t*)(shm + DA_KB + kl[j]) = rk[j];
    __syncthreads();
    { const unsigned char* kbase = shm + m32 * DA_KS + (c * 64 + 8 * h) * 2;
#pragma unroll
      for (int kb = 0; kb < 2; ++kb)
#pragma unroll
          for (int s = 0; s < 4; ++s) kf[kb][s] = *(const bf16x8_t*)(kbase + kb * 32 * DA_KS + s * 32); }
    int k3 = 0;
    for (int kt = 0; kt < nkt; ++kt) {
        const int buf = kt & 1; const bool more = kt + 1 < nkt;
        const int k3n = k3 == 2 ? 0 : k3 + 1, k3nn = k3n == 2 ? 0 : k3n + 1;
        if (kt + 2 < nkt) {
#pragma unroll
            for (int j = 0; j < 2; ++j) rk[j] = *(const u32x4_t*)(kg[j] + (size_t)(kt + 2) * 64 * 512); }
        if (more) {
#pragma unroll
            for (int j = 0; j < 2; ++j) rv[j] = *(const u32x4_t*)(vg[j] + (kt + 1) * 64); }
        {
        const unsigned char* vbase = shm + 3 * DA_KB + buf * DA_VB + m32 * DA_VS + 16 * h;
        bf16x8_t va[4][2], vb[4][2];
#pragma unroll
        for (int d = 0; d < 4; ++d)
#pragma unroll
            for (int k2 = 0; k2 < 2; ++k2) va[d][k2] = *(const bf16x8_t*)(vbase + d * 32 * DA_VS + k2 * 32);
        __builtin_amdgcn_sched_barrier(0);
        f32x16 S0, S1;
        S0 = __builtin_amdgcn_mfma_f32_32x32x16_bf16(kf[0][0], qf[0], minit, 0, 0, 0);
#pragma unroll
        for (int s = 1; s < 4; ++s) S0 = __builtin_amdgcn_mfma_f32_32x32x16_bf16(kf[0][s], qf[s], S0, 0, 0, 0);
        __builtin_amdgcn_sched_barrier(0);
        float sum = 0.f;
        unsigned pkA[8], pkB[8];
#pragma unroll
        for (int j = 0; j < 4; ++j) {
            S1 = __builtin_amdgcn_mfma_f32_32x32x16_bf16(kf[1][j], qf[j], j == 0 ? minit : S1, 0, 0, 0);
            __builtin_amdgcn_sched_barrier(0);
            { const float e0 = __builtin_amdgcn_exp2f(S0[4 * j]), e1 = __builtin_amdgcn_exp2f(S0[4 * j + 1]), e2 = __builtin_amdgcn_exp2f(S0[4 * j + 2]), e3 = __builtin_amdgcn_exp2f(S0[4 * j + 3]);
              sum += (e0 + e1) + (e2 + e3); pkA[2 * j] = pk2(e0, e1); pkA[2 * j + 1] = pk2(e2, e3); }
            __builtin_amdgcn_sched_barrier(0);
        }
        bf16x8_t pf0, pf1;
        { u32x4_t t0; t0[0] = pkA[0]; t0[1] = pkA[1]; t0[2] = pkA[2]; t0[3] = pkA[3]; pf0 = __builtin_bit_cast(bf16x8_t, t0);
          u32x4_t t1; t1[0] = pkA[4]; t1[1] = pkA[5]; t1[2] = pkA[6]; t1[3] = pkA[7]; pf1 = __builtin_bit_cast(bf16x8_t, t1); }
#pragma unroll
        for (int i = 0; i < 8; ++i) {
            const int d = i >> 1, k2 = i & 1;
            O[d] = __builtin_amdgcn_mfma_f32_32x32x16_bf16(va[d][k2], k2 ? pf1 : pf0, O[d], 0, 0, 0);
            __builtin_amdgcn_sched_barrier(0);
            { const float e0 = __builtin_amdgcn_exp2f(S1[2 * i]), e1 = __builtin_amdgcn_exp2f(S1[2 * i + 1]); sum += e0 + e1; pkB[i] = pk2(e0, e1); }
            vb[d][k2] = *(const bf16x8_t*)(vbase + d * 32 * DA_VS + (2 + k2) * 32);
            __builtin_amdgcn_sched_barrier(0);
        }
        bf16x8_t pf2, pf3;
        { u32x4_t t0; t0[0] = pkB[0]; t0[1] = pkB[1]; t0[2] = pkB[2]; t0[3] = pkB[3]; pf2 = __builtin_bit_cast(bf16x8_t, t0);
          u32x4_t t1; t1[0] = pkB[4]; t1[1] = pkB[5]; t1[2] = pkB[6]; t1[3] = pkB[7]; pf3 = __builtin_bit_cast(bf16x8_t, t1); }
#pragma unroll
        for (int i = 0; i < 8; ++i) { const int d = i >> 1, k2 = i & 1;
            O[d] = __builtin_amdgcn_mfma_f32_32x32x16_bf16(vb[d][k2], k2 ? pf3 : pf2, O[d], 0, 0, 0);
            if (more) kf[i >> 2][i & 3] = *(const bf16x8_t*)(shm + k3n * DA_KB + m32 * DA_KS + (c * 64 + 8 * h) * 2 + (i >> 2) * 32 * DA_KS + (i & 3) * 32); }
        { auto rr = __builtin_amdgcn_permlane32_swap(__float_as_uint(sum), __float_as_uint(sum), false, false); sum = __uint_as_float(rr[0]) + __uint_as_float(rr[1]); }
        lrun += sum;
        }
        if (kt + 2 < nkt) {
#pragma unroll
            for (int j = 0; j < 2; ++j) *(u32x4_t*)(shm + k3nn * DA_KB + kl[j]) = rk[j]; }
        if (more) {
#pragma unroll
            for (int j = 0; j < 2; ++j) { u32x2_t a, bq; a[0] = rv[j][0]; a[1] = rv[j][1]; bq[0] = rv[j][2]; bq[1] = rv[j][3];
                *(u32x2_t*)(shm + (buf ^ 1) * DA_VB + vl[j]) = a; *(u32x2_t*)(shm + (buf ^ 1) * DA_VB + vl[j] + 16) = bq; } }
        k3 = k3n;
        if (!((DPV & 16) && dry)) __syncthreads();
    }
    float* xch = (float*)shm;
    { const float inv = 1.f / lrun;
#pragma unroll
        for (int d = 0; d < 4; ++d)
#pragma unroll
            for (int r = 0; r < 16; ++r) O[d][r] *= inv; }
    if (c == 1) {
#pragma unroll
        for (int d = 0; d < 4; ++d)
#pragma unroll
            for (int r = 0; r < 16; ++r) xch[(((qb * 4 + d) * 16 + r) << 6) + lane] = O[d][r];
    }
    float lam = 0.f; if (c == 0) lam = ((const float*)(p.ws + OFF_LAM))[l];
    __syncthreads();
    if (c == 0) {
        const float lam_init = 0.8f - 0.6f * expf(-0.3f * (float)l);
        const float* g = (const float*)(shm + DA_GOFF);
        float ss = 0.f;
#pragma unroll
        for (int d = 0; d < 4; ++d)
#pragma unroll
            for (int r = 0; r < 16; ++r) { const float v = O[d][r] - lam * xch[(((qb * 4 + d) * 16 + r) << 6) + lane]; O[d][r] = v; ss += v * v; }
        ss += __shfl_xor(ss, 32);
        const float sc = rsqrtf(ss * (1.0f / 128.0f) + RMS_EPS) * (1.0f - lam_init);
        bf16_t* op = DQ + qrow * 512 + hh * 128 + 8 * h;
#pragma unroll
        for (int d = 0; d < 4; ++d) {
            f32x4 gv_[4];
#pragma unroll
            for (int r4 = 0; r4 < 4; ++r4) gv_[r4] = *(const f32x4*)(g + 32 * d + 8 * r4 + 4 * h);
            __builtin_amdgcn_sched_barrier(0);
            u32x2_t o_[4];
#pragma unroll
            for (int r4 = 0; r4 < 4; ++r4) { const f32x4 gv = gv_[r4];
                o_[r4][0] = pk2(O[d][4 * r4] * sc * gv[0], O[d][4 * r4 + 1] * sc * gv[1]); o_[r4][1] = pk2(O[d][4 * r4 + 2] * sc * gv[2], O[d][4 * r4 + 3] * sc * gv[3]); }
#pragma unroll
            for (int rp = 0; rp < 2; ++rp) { const u32x4_t w = widen_pair(o_[2 * rp], o_[2 * rp + 1]);
                if (commit) *(u32x4_t*)(op + 32 * d + 16 * rp) = w; } }
    }
    __syncthreads();
}

constexpr int NA_KS = 272, NA_VS = 144, NA_KB = 64 * NA_KS  , NA_VB = 128 * NA_VS  ;
constexpr int NA_LAT_UNITS = NB * 32 * 4, NA_UNITS = NA_LAT_UNITS + NB * 2 * 4;
__device__ __forceinline__ void na_attn_unit(const Params& p, int l, int unit, unsigned char* shm, bool commit = true) {
    const int tid = ltid(), lane = tid & 63, wid = tid >> 6, hgi = wid & 1, ib = (wid >> 1) & 1, x = wid >> 2, m32 = lane & 31, h = lane >> 5;
    int b, hp, r, u0, nloc; size_t rowq0;
    if (unit < NA_LAT_UNITS) { hp = unit & 3; const int rp = (unit >> 2) & 31; b = unit >> 7; r = 2 * rp + x;
        u0 = min(max(2 * rp - 4, 0), 56); nloc = min(max(2 * rp - 3, 0), 56) + 8 - u0; rowq0 = (size_t)b * LB + LC + r * 64; }
    else { const int u2 = unit - NA_LAT_UNITS; hp = u2 & 3; b = u2 >> 3; r = -1; u0 = 0; nloc = 0; rowq0 = (size_t)b * LB + (((u2 >> 2) & 1) * 2 + x) * 64; }
    const int ntile = nloc + 4;
    const int rs = min(max(r - 4, 0), 56), head = hp * 2 + hgi;
    const size_t rowb = (size_t)b * LB;
    bf16_t* NQ = (bf16_t*)(p.ws + OFF_NQ); const bf16_t* NK = (const bf16_t*)(p.ws + OFF_NK); const bf16_t* NVT = (const bf16_t*)(p.ws + OFF_NVT);
    const float* BT = (const float*)(p.ws + OFF_NBT);
    const size_t qrow = rowq0 + ib * 32 + m32;
    bf16x8_t qf[4];
#pragma unroll
    for (int s = 0; s < 4; ++s) qf[s] = *(const bf16x8_t*)(NQ + qrow * 512 + head * 64 + 16 * s + 8 * h);
    f32x16 O[2];
#pragma unroll
    for (int d = 0; d < 2; ++d)
#pragma unroll
        for (int q = 0; q < 16; ++q) O[d][q] = 0.f;
    float mrun = -INFINITY, lrun = 0.f;
    const bf16_t* kg[2]; const bf16_t* vg[2]; int kl[2], vl[2];
#pragma unroll
    for (int j = 0; j < 2; ++j) { const int i = tid + j * 512;
        kg[j] = NK + (rowb + (i >> 4)) * 512 + hp * 128 + (i & 15) * 8; kl[j] = (i >> 4) * NA_KS + (i & 15) * 16;
        vg[j] = NVT + ((size_t)(b * 512 + hp * 128 + (i >> 3))) * LB + (i & 7) * 8; vl[j] = 2 * NA_KB + (i >> 3) * NA_VS + ((i & 7) >> 1) * 32 + (i & 1) * 8; }
    auto tile_of = [&](int t) -> int { return t < nloc ? 4 + u0 + t : t - nloc; };
    u32x4_t rk[2], rv[2];
    __syncthreads();
    { const int tt = tile_of(0);
#pragma unroll
      for (int j = 0; j < 2; ++j) { rk[j] = *(const u32x4_t*)(kg[j] + (size_t)tt * 64 * 512); rv[j] = *(const u32x4_t*)(vg[j] + tt * 64); } }
#pragma unroll
    for (int j = 0; j < 2; ++j) { *(u32x4_t*)(shm + kl[j]) = rk[j]; u32x2_t a, bq; a[0] = rv[j][0]; a[1] = rv[j][1]; bq[0] = rv[j][2]; bq[1] = rv[j][3];
        *(u32x2_t*)(shm + vl[j]) = a; *(u32x2_t*)(shm + vl[j] + 16) = bq; }
    __syncthreads();
    for (int t = 0; t < ntile; ++t) {
        const int buf = t & 1; const bool more = t + 1 < ntile;
        if (more) { const int tt = tile_of(t + 1);
#pragma unroll
            for (int j = 0; j < 2; ++j) { rk[j] = *(const u32x4_t*)(kg[j] + (size_t)tt * 64 * 512); rv[j] = *(const u32x4_t*)(vg[j] + tt * 64); }
        }
        const bool local = t < nloc; const int kr = u0 + t;
        if (!local || (kr >= rs && kr < rs + 8)) {
        const unsigned char* kbase = shm + buf * NA_KB + m32 * NA_KS + (hgi * 64 + 8 * h) * 2;
        const unsigned char* vbase = shm + 2 * NA_KB + buf * NA_VB + (hgi * 64 + m32) * NA_VS + 16 * h;
        bf16x8_t pf[4];
        {
            bf16x8_t kf[2][4];
#pragma unroll
            for (int kb = 0; kb < 2; ++kb)
#pragma unroll
                for (int s = 0; s < 4; ++s) kf[kb][s] = *(const bf16x8_t*)(kbase + kb * 32 * NA_KS + s * 32);
            f32x16 S[2];
            if (local) { const int dr = kr - r + 7; const float* bp = BT + ((size_t)(((head * 15 + dr) * 2) * 2 + ib) * 64 + lane) * 16;
#pragma unroll
                for (int kb = 0; kb < 2; ++kb)
#pragma unroll
                    for (int q4 = 0; q4 < 4; ++q4) { const f32x4 bv = *(const f32x4*)(bp + kb * 2 * 64 * 16 + q4 * 4);
                        S[kb][q4 * 4] = bv[0]; S[kb][q4 * 4 + 1] = bv[1]; S[kb][q4 * 4 + 2] = bv[2]; S[kb][q4 * 4 + 3] = bv[3]; }
            } else {
#pragma unroll
                for (int kb = 0; kb < 2; ++kb)
#pragma unroll
                    for (int q = 0; q < 16; ++q) S[kb][q] = 0.f;
            }
#pragma unroll
            for (int kb = 0; kb < 2; ++kb)
#pragma unroll
                for (int s = 0; s < 4; ++s) S[kb] = __builtin_amdgcn_mfma_f32_32x32x16_bf16(kf[kb][s], qf[s], S[kb], 0, 0, 0);
            float mx = S[0][0];
#pragma unroll
            for (int q = 1; q < 16; ++q) mx = fmaxf(mx, S[0][q]);
#pragma unroll
            for (int q = 0; q < 16; ++q) mx = fmaxf(mx, S[1][q]);
            { auto rr = __builtin_amdgcn_permlane32_swap(__float_as_uint(mx), __float_as_uint(mx), false, false); mx = fmaxf(__uint_as_float(rr[0]), __uint_as_float(rr[1])); }
            float corr = 1.f;
            if (!__all(mx - mrun <= DA_THR)) { const float mn = fmaxf(mrun, mx); corr = __builtin_amdgcn_exp2f((mrun - mn) * LOG2E); mrun = mn;
#pragma unroll
                for (int d = 0; d < 2; ++d)
#pragma unroll
                    for (int q = 0; q < 16; ++q) O[d][q] *= corr; }
            const float mnl = mrun * LOG2E;
            float sum = 0.f;
#pragma unroll
            for (int kb = 0; kb < 2; ++kb)
#pragma unroll
                for (int q = 0; q < 16; ++q) { const float e = __builtin_amdgcn_exp2f(S[kb][q] * LOG2E - mnl); S[kb][q] = e; sum += e; }
            { auto rr = __builtin_amdgcn_permlane32_swap(__float_as_uint(sum), __float_as_uint(sum), false, false); sum = __uint_as_float(rr[0]) + __uint_as_float(rr[1]); }
            lrun = lrun * corr + sum;
#pragma unroll
            for (int ks = 0; ks < 4; ++ks) { const int kb = ks >> 1, r0 = (ks & 1) * 8; u32x4_t pk;
#pragma unroll
                for (int j = 0; j < 4; ++j) pk[j] = pk2(S[kb][r0 + 2 * j], S[kb][r0 + 2 * j + 1]);
                pf[ks] = __builtin_bit_cast(bf16x8_t, pk); }
        }
        { bf16x8_t vq[2][4];
#pragma unroll
          for (int d = 0; d < 2; ++d)
#pragma unroll
              for (int ks = 0; ks < 4; ++ks) vq[d][ks] = *(const bf16x8_t*)(vbase + d * 32 * NA_VS + ks * 32);
          __builtin_amdgcn_sched_barrier(0);
#pragma unroll
          for (int d = 0; d < 2; ++d)
#pragma unroll
              for (int ks = 0; ks < 4; ++ks) O[d] = __builtin_amdgcn_mfma_f32_32x32x16_bf16(vq[d][ks], pf[ks], O[d], 0, 0, 0); }
        }
        if (more) {
#pragma unroll
            for (int j = 0; j < 2; ++j) { *(u32x4_t*)(shm + (buf ^ 1) * NA_KB + kl[j]) = rk[j]; u32x2_t a, bq; a[0] = rv[j][0]; a[1] = rv[j][1]; bq[0] = rv[j][2]; bq[1] = rv[j][3];
                *(u32x2_t*)(shm + (buf ^ 1) * NA_VB + vl[j]) = a; *(u32x2_t*)(shm + (buf ^ 1) * NA_VB + vl[j] + 16) = bq; }
        }
        __syncthreads();
    }
    { const float inv = 1.f / lrun; bf16_t* op = NQ + qrow * 512 + head * 64 + 8 * h;
#pragma unroll
        for (int d = 0; d < 2; ++d)
#pragma unroll
            for (int rp = 0; rp < 2; ++rp) { u32x2_t oa, ob; const int r4 = 2 * rp;
                oa[0] = pk2(O[d][4 * r4] * inv, O[d][4 * r4 + 1] * inv); oa[1] = pk2(O[d][4 * r4 + 2] * inv, O[d][4 * r4 + 3] * inv);
                ob[0] = pk2(O[d][4 * r4 + 4] * inv, O[d][4 * r4 + 5] * inv); ob[1] = pk2(O[d][4 * r4 + 6] * inv, O[d][4 * r4 + 7] * inv);
                const u32x4_t w = widen_pair(oa, ob);
                if (commit) *(u32x4_t*)(op + 32 * d + 16 * rp) = w; } }
    __syncthreads();
}

constexpr int GL_XS = 144;
__device__ __forceinline__ void gla_stage_gr(const Params& p, int row0, float* grs, int tid) {
    const float* gr = (const float*)(p.ws + OFF_GR);
    __syncthreads();
    *(f32x4*)(grs + tid * 4) = *(const f32x4*)(gr + (size_t)row0 * 32 + tid * 4);
    __syncthreads();
}
struct GlaCol { float w[16]; float bcol; };
__device__ __forceinline__ void gla_col_init(const Params& p, int l, int hh, int dir, int lane, GlaCol& gc) {
    const int col = hh * 64 + lane;
    const float* wd = p.in[I_GWD] + ((size_t)(l * 2 + dir) * 16) * 256 + col;
#pragma unroll
    for (int i = 0; i < 16; ++i) gc.w[i] = wd[i * 256];
    gc.bcol = p.in[I_GBD][(size_t)(l * 2 + dir) * 256 + col];
}
__device__ __forceinline__ float gla_logd(const GlaCol& gc, const float* grs, int r, int dir) {
    const float* gp = grs + r * 32 + dir * 16;
    float z = gc.bcol;
#pragma unroll
    for (int i4 = 0; i4 < 4; ++i4) { const f32x4 g4 = *(const f32x4*)(gp + i4 * 4);
        z += g4[0] * gc.w[i4 * 4] + g4[1] * gc.w[i4 * 4 + 1] + g4[2] * gc.w[i4 * 4 + 2] + g4[3] * gc.w[i4 * 4 + 3]; }
    return (fminf(z, 0.f) - 0.6931471805599453f * __builtin_amdgcn_logf(1.f + __builtin_amdgcn_exp2f(-fabsf(z) * LOG2E))) * (1.0f / 16.0f);
}
__device__ __forceinline__ float gla_total(const GlaCol& gc, const float* grs, int dir) {
    float run = 0.f;
#pragma unroll 4
    for (int r = 0; r < 64; ++r) run += gla_logd(gc, grs, r, dir);
    return run;
}

struct GlaCum { f32x16 cum[2][2]; float last[2]; };
__device__ __forceinline__ void gla_cum_mfma(const Params& p, int l, int hh, int dir, int lane, const float* grs, GlaCum& G) {
    const int m32 = lane & 31, h = lane >> 5;
    bf16x8_t ga[2];
#pragma unroll
    for (int mb = 0; mb < 2; ++mb) { const float* gp = grs + (32 * mb + m32) * 32 + dir * 16 + 8 * h; const f32x4 a = *(const f32x4*)gp, b4 = *(const f32x4*)(gp + 4);
        u32x4_t pk; pk[0] = pk2(a[0], a[1]); pk[1] = pk2(a[2], a[3]); pk[2] = pk2(b4[0], b4[1]); pk[3] = pk2(b4[2], b4[3]); ga[mb] = __builtin_bit_cast(bf16x8_t, pk); }
    bf16x8_t wb[2]; float bcol[2];
#pragma unroll
    for (int nb = 0; nb < 2; ++nb) { const int col = hh * 64 + 32 * nb + m32; const float* wd = p.in[I_GWD] + ((size_t)(l * 2 + dir) * 16 + 8 * h) * 256 + col;
        u32x4_t pk;
#pragma unroll
        for (int j = 0; j < 4; ++j) pk[j] = pk2(wd[(2 * j) * 256], wd[(2 * j + 1) * 256]);
        wb[nb] = __builtin_bit_cast(bf16x8_t, pk); bcol[nb] = p.in[I_GBD][(size_t)(l * 2 + dir) * 256 + col]; }
    f32x16 ls[2][2];
#pragma unroll
    for (int mb = 0; mb < 2; ++mb)
#pragma unroll
        for (int nb = 0; nb < 2; ++nb) {
            f32x16 z;
#pragma unroll
            for (int r = 0; r < 16; ++r) z[r] = bcol[nb];
            z = __builtin_amdgcn_mfma_f32_32x32x16_bf16(ga[mb], wb[nb], z, 0, 0, 0);
#pragma unroll
            for (int r = 0; r < 16; ++r) { const float zz = z[r];
                ls[mb][nb][r] = (fminf(zz, 0.f) - 0.6931471805599453f * __builtin_amdgcn_logf(1.f + __builtin_amdgcn_exp2f(-fabsf(zz) * LOG2E))) * (1.0f / 16.0f); }
        }
#pragma unroll
    for (int ib = 0; ib < 2; ++ib)
#pragma unroll
        for (int nb = 0; nb < 2; ++nb) {
#pragma unroll
            for (int r = 0; r < 16; ++r) G.cum[ib][nb][r] = 0.f; }
#pragma unroll
    for (int ib = 0; ib < 2; ++ib)
#pragma unroll
        for (int jb = 0; jb < 2; ++jb) {
            if (jb != ib && ((jb > ib) != (dir == 1))) continue;
#pragma unroll
            for (int s = 0; s < 2; ++s) {
                u32x4_t lk;
#pragma unroll
                for (int j = 0; j < 4; ++j) { unsigned w2 = 0u;
#pragma unroll
                    for (int q = 0; q < 2; ++q) { const int e = 2 * j + q, jr = 32 * jb + 16 * s + 8 * (e >> 2) + 4 * h + (e & 3), ir = 32 * ib + m32;
                        const bool on = dir ? (jr >= ir) : (jr <= ir); w2 |= on ? (0x3F80u << (16 * q)) : 0u; }
                    lk[j] = w2; }
                const bf16x8_t lf = __builtin_bit_cast(bf16x8_t, lk);
#pragma unroll
                for (int nb = 0; nb < 2; ++nb) { u32x4_t pk;
#pragma unroll
                    for (int j = 0; j < 4; ++j) pk[j] = pk2(ls[jb][nb][8 * s + 2 * j], ls[jb][nb][8 * s + 2 * j + 1]);
                    G.cum[ib][nb] = __builtin_amdgcn_mfma_f32_32x32x16_bf16(lf, __builtin_bit_cast(bf16x8_t, pk), G.cum[ib][nb], 0, 0, 0); }
            }
        }
#pragma unroll
    for (int nb = 0; nb < 2; ++nb) { const float v = dir ? G.cum[0][nb][0] : G.cum[1][nb][15]; G.last[nb] = __shfl(v, dir ? m32 : m32 + 32); }
}

__device__ __forceinline__ void gla_a_unit(const Params& p, int l, int unit, unsigned char* shm) {
    const int tid = ltid(), lane = tid & 63, wid = tid >> 6, hh = wid >> 1, dir = wid & 1, m32 = lane & 31, h = lane >> 5;
    const int b = unit / 68, n = unit - b * 68; const int row0 = b * LB + n * 64; const int bhd = (b * 4 + hh) * 2 + dir;
    float* grs = (float*)shm; unsigned char* kt = shm + 8192 + wid * 18432;
    unsigned char* kraw = kt + 9216;
    const bf16_t* gvt = (const bf16_t*)(p.ws + OFF_GVT) + ((size_t)(b * 512 + hh * 128 + m32)) * LB + n * 64 + 8 * h;
    bf16x8_t bfr[4][4];
#pragma unroll
    for (int s = 0; s < 4; ++s)
#pragma unroll
        for (int nb = 0; nb < 4; ++nb) bfr[s][nb] = *(const bf16x8_t*)(gvt + (size_t)(32 * nb) * LB + 16 * s);
    gla_stage_gr(p, row0, grs, tid);
    {
        const bf16_t* gk = (const bf16_t*)(p.ws + OFF_GK) + (size_t)row0 * 256 + hh * 64;
        u32x4_t t8[8];
#pragma unroll
        for (int i = 0; i < 8; ++i) t8[i] = *(const u32x4_t*)(gk + (size_t)(8 * i + (lane >> 3)) * 256 + (lane & 7) * 8);
#pragma unroll
        for (int i = 0; i < 8; ++i) *(u32x4_t*)(kraw + (8 * i + (lane >> 3)) * GL_XS + (lane & 7) * 16) = t8[i];
    }
    {
        GlaCum G; gla_cum_mfma(p, l, hh, dir, lane, grs, G);
        if (h == 0) {
#pragma unroll
            for (int nb = 0; nb < 2; ++nb) ((float*)(p.ws + OFF_DECAY))[((size_t)bhd * 68 + n) * 64 + 32 * nb + m32] = __expf(G.last[nb]); }
        asm volatile("s_waitcnt lgkmcnt(0)" ::: "memory"); __builtin_amdgcn_wave_barrier();
#pragma unroll
        for (int ib = 0; ib < 2; ++ib)
#pragma unroll
            for (int nb = 0; nb < 2; ++nb)
#pragma unroll
                for (int r = 0; r < 16; ++r) { const int row = 32 * ib + (r & 3) + 8 * (r >> 2) + 4 * h, col = 32 * nb + m32;
                    *(bf16_t*)(kt + col * GL_XS + row * 2) = f2bf(bf2f(*(const bf16_t*)(kraw + row * GL_XS + col * 2)) * __expf(G.last[nb] - G.cum[ib][nb][r])); }
    }
    asm volatile("s_waitcnt lgkmcnt(0)" ::: "memory"); __builtin_amdgcn_wave_barrier();
    f32x16 acc[2][4];
#pragma unroll
    for (int mb = 0; mb < 2; ++mb)
#pragma unroll
        for (int nb = 0; nb < 4; ++nb)
#pragma unroll
            for (int r = 0; r < 16; ++r) acc[mb][nb][r] = 0.f;
#pragma unroll
    for (int s = 0; s < 4; ++s) {
        bf16x8_t af[2];
#pragma unroll
        for (int mb = 0; mb < 2; ++mb) af[mb] = *(const bf16x8_t*)(kt + (32 * mb + m32) * GL_XS + (16 * s + 8 * h) * 2);
#pragma unroll
        for (int mb = 0; mb < 2; ++mb)
#pragma unroll
            for (int nb = 0; nb < 4; ++nb) acc[mb][nb] = __builtin_amdgcn_mfma_f32_32x32x16_bf16(af[mb], bfr[s][nb], acc[mb][nb], 0, 0, 0);
    }
    bf16_t* kv = (bf16_t*)(p.ws + OFF_KV) + (((size_t)bhd * 68 + n) * 128 + m32) * 64 + 8 * h;
#pragma unroll
    for (int mb = 0; mb < 2; ++mb)
#pragma unroll
        for (int nb = 0; nb < 4; ++nb)
#pragma unroll
            for (int rp = 0; rp < 2; ++rp) { u32x2_t oa, ob; const int r4 = 2 * rp;
                oa[0] = pk2(acc[mb][nb][4 * r4], acc[mb][nb][4 * r4 + 1]); oa[1] = pk2(acc[mb][nb][4 * r4 + 2], acc[mb][nb][4 * r4 + 3]);
                ob[0] = pk2(acc[mb][nb][4 * r4 + 4], acc[mb][nb][4 * r4 + 5]); ob[1] = pk2(acc[mb][nb][4 * r4 + 6], acc[mb][nb][4 * r4 + 7]);
                *(u32x4_t*)(kv + (size_t)(32 * nb) * 64 + 32 * mb + 16 * rp) = widen_pair(oa, ob); }
}

__device__ __forceinline__ void gla_scan(const Params& p, bool commit = true) {
    bf16_t* kv = (bf16_t*)(p.ws + OFF_KV); const float* dec = (const float*)(p.ws + OFF_DECAY);
    for (int gid = blockIdx.x * NTHR + ltid(); gid < 64 * 128 * 16; gid += gridDim.x * NTHR) {
        const int dk4 = gid & 15, dv = (gid >> 4) & 127, bhd = gid >> 11, dir = bhd & 1;
        float z0 = 0.f; asm volatile("" : "+v"(z0));
        f32x4 s = {z0, z0, z0, z0};
#pragma unroll 1
        for (int step0 = 0; step0 < 68; step0 += 4) {
            u32x2_t* ptr[4]; u32x2_t kvv[4]; f32x4 d4[4];
#pragma unroll
            for (int q = 0; q < 4; ++q) { const int step = step0 + q; const int ch = dir == 0 ? step : (step < 4 ? 3 - step : 71 - step);
                ptr[q] = (u32x2_t*)(kv + (((size_t)bhd * 68 + ch) * 128 + dv) * 64 + dk4 * 4);
                kvv[q] = *ptr[q]; d4[q] = *(const f32x4*)(dec + ((size_t)bhd * 68 + ch) * 64 + dk4 * 4); }
            __builtin_amdgcn_sched_barrier(0);
#pragma unroll
            for (int q = 0; q < 4; ++q) {
                u32x2_t o; o[0] = pk2(s[0], s[1]); o[1] = pk2(s[2], s[3]); if (commit) *ptr[q] = o;
                s[0] = d4[q][0] * s[0] + bflo(kvv[q][0]); s[1] = d4[q][1] * s[1] + bfhi(kvv[q][0]); s[2] = d4[q][2] * s[2] + bflo(kvv[q][1]); s[3] = d4[q][3] * s[3] + bfhi(kvv[q][1]); }
        }
    }
}

__device__ __forceinline__ void gla_c_unit(const Params& p, int l, int unit, unsigned char* shm, bool commit = true) {
    const int tid = ltid(), lane = tid & 63, wid = tid >> 6, hh = wid >> 1, dir = wid & 1, m32 = lane & 31, h = lane >> 5;
    const int b = unit / 68, n = unit - b * 68; const int row0 = b * LB + n * 64; const int bhd = (b * 4 + hh) * 2 + dir;
    float* grs = (float*)shm; unsigned char* xq = shm + 8192 + wid * 18432; unsigned char* yk = xq + 9216;
    bf16x8_t sfr[4][4];
    { const bf16_t* sp = (const bf16_t*)(p.ws + OFF_KV) + (((size_t)bhd * 68 + n) * 128 + m32) * 64 + 8 * h;
#pragma unroll
      for (int s = 0; s < 4; ++s)
#pragma unroll
          for (int d = 0; d < 4; ++d) sfr[s][d] = *(const bf16x8_t*)(sp + (size_t)(32 * d) * 64 + 16 * s); }
    gla_stage_gr(p, row0, grs, tid);
    {
        {
            const bf16_t* gq = (const bf16_t*)(p.ws + OFF_GQ) + (size_t)row0 * 256 + hh * 64;
            const bf16_t* gk = (const bf16_t*)(p.ws + OFF_GK) + (size_t)row0 * 256 + hh * 64;
            u32x4_t tq[8], tk[8];
#pragma unroll
            for (int i = 0; i < 8; ++i) { tq[i] = *(const u32x4_t*)(gq + (size_t)(8 * i + (lane >> 3)) * 256 + (lane & 7) * 8); tk[i] = *(const u32x4_t*)(gk + (size_t)(8 * i + (lane >> 3)) * 256 + (lane & 7) * 8); }
#pragma unroll
            for (int i = 0; i < 8; ++i) { *(u32x4_t*)(xq + (8 * i + (lane >> 3)) * GL_XS + (lane & 7) * 16) = tq[i]; *(u32x4_t*)(yk + (8 * i + (lane >> 3)) * GL_XS + (lane & 7) * 16) = tk[i]; }
        }
        GlaCum G; gla_cum_mfma(p, l, hh, dir, lane, grs, G);
        asm volatile("s_waitcnt lgkmcnt(0)" ::: "memory"); __builtin_amdgcn_wave_barrier();
#pragma unroll
        for (int ib = 0; ib < 2; ++ib)
#pragma unroll
            for (int nb = 0; nb < 2; ++nb)
#pragma unroll
                for (int r = 0; r < 16; ++r) { const int row = 32 * ib + (r & 3) + 8 * (r >> 2) + 4 * h, col = 32 * nb + m32; const float c = G.cum[ib][nb][r];
                    bf16_t* xp = (bf16_t*)(xq + row * GL_XS + col * 2); bf16_t* yp = (bf16_t*)(yk + row * GL_XS + col * 2);
                    *xp = f2bf(bf2f(*xp) * __expf(c)); *yp = f2bf(bf2f(*yp) * __expf(-c)); }
    }
    asm volatile("s_waitcnt lgkmcnt(0)" ::: "memory"); __builtin_amdgcn_wave_barrier();
    const unsigned char* xrd = xq + m32 * GL_XS + 16 * h;
    f32x16 O[4][2];
#pragma unroll
    for (int d = 0; d < 4; ++d)
#pragma unroll
        for (int ib = 0; ib < 2; ++ib)
#pragma unroll
            for (int r = 0; r < 16; ++r) O[d][ib][r] = 0.f;
    {
#pragma unroll
      for (int s = 0; s < 4; ++s) {
#pragma unroll
          for (int ib = 0; ib < 2; ++ib) { const bf16x8_t xf = *(const bf16x8_t*)(xrd + 32 * ib * GL_XS + 32 * s);
#pragma unroll
              for (int d = 0; d < 4; ++d) O[d][ib] = __builtin_amdgcn_mfma_f32_32x32x16_bf16(sfr[s][d], xf, O[d][ib], 0, 0, 0); } } }
    const bf16_t* gvt = (const bf16_t*)(p.ws + OFF_GVT) + ((size_t)(b * 512 + hh * 128 + m32)) * LB + n * 64 + 4 * h;
#pragma unroll
    for (int jb = 0; jb < 2; ++jb)
#pragma unroll
        for (int ib = 0; ib < 2; ++ib) {
            if (jb != ib && ((jb > ib) != (dir == 1))) continue;
            u32x2_t vfr[2][4][2];
#pragma unroll
            for (int s2 = 0; s2 < 2; ++s2)
#pragma unroll
                for (int d = 0; d < 4; ++d) { const bf16_t* vp = gvt + (size_t)(32 * d) * LB + 32 * jb + 16 * s2; vfr[s2][d][0] = *(const u32x2_t*)vp; vfr[s2][d][1] = *(const u32x2_t*)(vp + 8); }
            __builtin_amdgcn_sched_barrier(0);
            f32x16 A;
#pragma unroll
            for (int r = 0; r < 16; ++r) A[r] = 0.f;
#pragma unroll
            for (int s = 0; s < 4; ++s) { const bf16x8_t kf = *(const bf16x8_t*)(yk + (32 * jb + m32) * GL_XS + (16 * s + 8 * h) * 2);
                const bf16x8_t xf = *(const bf16x8_t*)(xrd + 32 * ib * GL_XS + 32 * s);
                A = __builtin_amdgcn_mfma_f32_32x32x16_bf16(kf, xf, A, 0, 0, 0); }
            if (jb == ib) {
#pragma unroll
                for (int r = 0; r < 16; ++r) { const int jj = (r & 3) + 8 * (r >> 2) + 4 * h; const bool keep = dir ? (jj >= m32) : (jj <= m32); A[r] = keep ? A[r] : 0.f; }
            }
#pragma unroll
            for (int s2 = 0; s2 < 2; ++s2) { u32x4_t pk;
#pragma unroll
                for (int j = 0; j < 4; ++j) pk[j] = pk2(A[s2 * 8 + 2 * j], A[s2 * 8 + 2 * j + 1]);
                const bf16x8_t pf = __builtin_bit_cast(bf16x8_t, pk);
#pragma unroll
                for (int d = 0; d < 4; ++d) { const u32x2_t v0 = vfr[s2][d][0], v1 = vfr[s2][d][1];
                    u32x4_t vv; vv[0] = v0[0]; vv[1] = v0[1]; vv[2] = v1[0]; vv[3] = v1[1];
                    O[d][ib] = __builtin_amdgcn_mfma_f32_32x32x16_bf16(__builtin_bit_cast(bf16x8_t, vv), pf, O[d][ib], 0, 0, 0); } }
        }
    __syncthreads();
    float* xch = (float*)(shm + 8192);
    if (dir == 1) {
#pragma unroll
        for (int d = 0; d < 4; ++d)
#pragma unroll
            for (int r = 0; r < 16; ++r) { const float t0 = O[d][0][r]; O[d][0][r] = O[d][1][r]; O[d][1][r] = t0; } }
    const int ibm = dir, ibo = 1 - dir;
#pragma unroll
    for (int d = 0; d < 4; ++d)
#pragma unroll
        for (int r = 0; r < 16; ++r) xch[((((hh * 4 + d) * 2 + ibo) * 16 + r) << 6) + lane] = O[d][1][r];
    __syncthreads();
    {
        const float* gn = p.in[I_GNG] + l * 128;
        bf16_t* gg = (bf16_t*)(p.ws + OFF_GG);
        float ss = 0.f;
#pragma unroll
        for (int d = 0; d < 4; ++d) {
            asm volatile("" ::: "memory");
#pragma unroll
            for (int r = 0; r < 16; ++r) { const float v = O[d][0][r] + xch[((((hh * 4 + d) * 2 + ibm) * 16 + r) << 6) + lane]; O[d][0][r] = v; ss += v * v; } }
        ss += __shfl_xor(ss, 32);
        const float sc = rsqrtf(ss * (1.0f / 128.0f) + RMS_EPS);
        bf16_t* op = gg + (size_t)(row0 + 32 * ibm + m32) * 512 + hh * 128 + 8 * h;
#pragma unroll
        for (int d2 = 0; d2 < 8; ++d2) { const int d = d2 >> 1, rb = (d2 & 1) * 2;
            f32x4 gv_[2];
            asm volatile("" ::: "memory");
#pragma unroll
            for (int q = 0; q < 2; ++q) gv_[q] = *(const f32x4*)(gn + 32 * d + 8 * (rb + q) + 4 * h);
            const u32x4_t gl = *(const u32x4_t*)(op + 32 * d + 8 * rb);
            __builtin_amdgcn_sched_barrier(0);
            u32x2_t gt_[2], o_[2];
            { u32x2_t gx, gy; gx[0] = gl[0]; gx[1] = gl[1]; gy[0] = gl[2]; gy[1] = gl[3]; const u32x4_t u = widen_pair(gx, gy);
              gt_[0][0] = u[0]; gt_[0][1] = u[1]; gt_[1][0] = u[2]; gt_[1][1] = u[3]; }
#pragma unroll
            for (int q = 0; q < 2; ++q) { const int r4 = rb + q; const f32x4 gv = gv_[q]; const u32x2_t gt = gt_[q];
                o_[q][0] = pk2(O[d][0][4 * r4] * sc * gv[0] * siluf_fast(bflo(gt[0])), O[d][0][4 * r4 + 1] * sc * gv[1] * siluf_fast(bfhi(gt[0])));
                o_[q][1] = pk2(O[d][0][4 * r4 + 2] * sc * gv[2] * siluf_fast(bflo(gt[1])), O[d][0][4 * r4 + 3] * sc * gv[3] * siluf_fast(bfhi(gt[1]))); }
            const u32x4_t w = widen_pair(o_[0], o_[1]);
            if (commit) *(u32x4_t*)(op + 32 * d + 8 * rb) = w; }
    }
    __syncthreads();
}

enum { PH_MOD = 0, PH_INIT, PH_CONVERT, PH_INPROJ, PH_ROPEDEC, PH_MIX_GLA, PH_MIX_DIFF, PH_MIX_NA, PH_VTRANS, PH_DIFF, PH_NA, PH_GLA_A, PH_GLA_SCAN, PH_GLA_C, PH_GATES, PH_MERGE, PH_WO, PH_LN1, PH_GATHER, PH_UP, PH_DOWN, PH_LN2, PH_COUNT };

template <class Epi, class Sched>
__device__ __forceinline__ void run_gemm(PG8_LAS unsigned char* lds, const void* A, const void* Bt, int K, const Sched& S, const Epi& E, const int* gidx = nullptr) {
    pg8::Gemm g; g.A = (const pg8::bf16_t*)A; g.Bt = (const pg8::bf16_t*)Bt; g.M = 0; g.N = 0; g.K = K; g.gidx = gidx;
    pg8::gemm_phase<Epi, Sched, false>(lds, g, S, E, nullptr);
}

__device__ __forceinline__ void reload_params(Params& p, const Params& p0) {
#if defined(__HIP_DEVICE_COMPILE__)
    (void)p0;
    { const __attribute__((address_space(4))) Params* kp = (const __attribute__((address_space(4))) Params*)__builtin_amdgcn_kernarg_segment_ptr();
      asm volatile("" : "+s"(kp));
#pragma unroll
      for (int i = 0; i < 23; ++i) p.in[i] = (const float*)(const __attribute__((address_space(1))) float*)kp->in[i];
      p.out = (float*)(__attribute__((address_space(1))) float*)kp->out; p.ws = (char*)(__attribute__((address_space(1))) char*)kp->ws; }
#else
    p = p0;
#endif
}
#ifndef STAG_MERGE
#define STAG_MERGE 0
#endif
#ifndef STAG_WO
#define STAG_WO 0
#endif
__device__ __forceinline__ void phase_stagger(int c, int step_ticks) {
    const int g = (c >> 3) & 3;
    if (step_ticks > 0 && g > 0) { const unsigned long long until = wall_clock64() + (unsigned long long)(g * step_ticks);
        while (wall_clock64() < until) __builtin_amdgcn_s_sleep(8); }
}
#ifndef PHASE_INLINE
#define PHASE_INLINE __forceinline__
#endif
template <int PH>
__device__ PHASE_INLINE void run_phase(const Params& p0, int l, unsigned char* shm, bool force_dry = false) {
    Params p;
    reload_params(p, p0);
#ifdef SKIP_MASK
    if constexpr ((SKIP_MASK >> PH) & 1) return;
#endif
#ifdef PROBE_MASK
    constexpr int probe_reps = ((PROBE_MASK >> PH) & 1) ? 2 : 1;
#else
    constexpr int probe_reps = 1;
#endif
#pragma unroll 1
    for (int probe_rep = 0; probe_rep < probe_reps; ++probe_rep) {
    PG8_LAS unsigned char* lds = (PG8_LAS unsigned char*)shm;
    float* ldsf = (float*)shm;
    const int G = gridDim.x, c = blockIdx.x;
    bool commit = true;
    const bool lastl = (l == DEPTH - 1);
    if (force_dry) commit = (*(volatile const unsigned*)(p.ws + OFF_CNT + 2048) != 0u);
    if (probe_reps > 1 && probe_rep == 0) commit = (*(volatile const unsigned*)(p.ws + OFF_CNT + 2048) != 0u);
    if constexpr (PH == PH_MOD) phase_mod(p, ldsf);
    else if constexpr (PH == PH_INIT) phase_init(p);
    else if constexpr (PH == PH_CONVERT) phase_convert(p, l, 0, G);
    else if constexpr (PH == PH_INPROJ) { const int nN = 18; SchedInProj S{G, c, nN}; EpiInProj E{p.ws}; run_gemm(lds, p.ws + OFF_H, p.ws + wdelta(l) + OFF_WIN, 1024, S, E);
        if (!lastl) { const int r = (NPANEL * nN) % G; SchedGrid S2{GE_PANELS, 12, 19, G, c >= r ? c - r : c - r + G, false}; EpiGates E2{p.ws, GE_PANELS}; run_gemm(lds, p.ws + OFF_H, p.ws + wdelta(l) + OFF_WIN, 1024, S2, E2);
 } }
    else if constexpr (PH == PH_ROPEDEC) phase_rope_decay(p, l, (unsigned*)shm, commit);
    else if constexpr (PH == PH_MIX_GLA) { for (int u = blockIdx.x; u < NB; u += gridDim.x) gla_naive_batch(p, l, u, ldsf); }
    else if constexpr (PH == PH_MIX_DIFF) { for (int u = blockIdx.x; u < NB * 4 * 34; u += gridDim.x) diff_naive_tile(p, l, u, ldsf); }
    else if constexpr (PH == PH_MIX_NA) { for (int u = blockIdx.x; u < T / 64; u += gridDim.x) na_naive_unit(p, l, u); }
    else if constexpr (PH == PH_VTRANS) phase_vtrans(p, l, (bf16_t*)shm);
    else if constexpr (PH == PH_DIFF) { for (int u = blockIdx.x; u < (lastl ? NB * 4 * 32 : DA_UNITS); u += gridDim.x) diff_attn_unit(p, l, u, shm, commit); }
    else if constexpr (PH == PH_NA) {
        const int nC = lastl ? NB * 64 : NB * 68, nN = lastl ? NA_LAT_UNITS : NA_UNITS;
        unsigned* qc = (unsigned*)(p.ws + OFF_QUEUE) + l * 64;
        volatile LAS unsigned* qw = (volatile LAS unsigned*)(shm + LDS_XBW + 128);
        const bool t0 = ltid() == 0;
        unsigned nxt = 0u; if (t0) nxt = xb_add(qc, 1u);
#pragma unroll 1
        for (int par = 0;; par ^= 1) {
            if (t0) qw[par] = nxt;
            __syncthreads();
            const int u = __builtin_amdgcn_readfirstlane((int)qw[par]);
            if (u >= nC + nN) break;
            if (t0) nxt = xb_add(qc, 1u);
            Params pu; reload_params(pu, p0);
            int lu = l; asm volatile("" : "+s"(lu));
            if (u < nC) gla_c_unit(pu, lu, lastl ? (u >> 6) * 68 + 4 + (u & 63) : u, shm, commit);
            else na_attn_unit(pu, lu, u - nC, shm, commit);
        }
    }
#if FAST_GLA
    else if constexpr (PH == PH_GLA_A) { for (int u = blockIdx.x; u < NB * 68; u += gridDim.x) gla_a_unit(p, l, u, shm); }
    else if constexpr (PH == PH_GLA_SCAN) gla_scan(p, commit);
    else if constexpr (PH == PH_GLA_C) { if (lastl) { for (int u = blockIdx.x; u < NB * 64; u += gridDim.x) gla_c_unit(p, l, (u >> 6) * 68 + 4 + (u & 63), shm, commit); }
        else { for (int u = blockIdx.x; u < NB * 68; u += gridDim.x) gla_c_unit(p, l, u, shm, commit);
               if (G >= 64) phase_convert(p, l + 1, 32, G - 32, 1); else phase_convert(p, l + 1, 0, G, 1); } }
#endif
    else if constexpr (PH == PH_GATES) { SchedGrid S{lastl ? NB * 16 : NPANEL, 12, 19, G, c, lastl, lastl ? 0 : GE_UNITS}; EpiGates E{p.ws, lastl ? 0 : GE_PANELS}; run_gemm(lds, p.ws + OFF_H, p.ws + wdelta(l) + OFF_WIN, 1024, S, E); }
    else if constexpr (PH == PH_MERGE) {
        const bool split = (G == 256) && !lastl;
        SchedMerge S{G, c, lastl, 0, split ? 512 : (lastl ? NB * 16 : NPANEL) * 4, nullptr}; EpiMerge E{p.ws, lastl ? 0 : GE_PANELS, false};
        run_gemm(lds, p.ws + OFF_BR, p.ws + wdelta(l) + OFF_WB, 512, S, E);
        if (!lastl && !split) { if (G >= 64) phase_convert(p, l + 1, 32, G - 32, 11); else phase_convert(p, l + 1, 0, G, 11); } }
    else if constexpr (PH == PH_WO) {
        const bool split = (G == 256) && !lastl;
        if (split) {
            unsigned* flag = (unsigned*)(p.ws + OFF_QUEUE) + l * 64 + 16;
            if (c < 32) { SchedMerge S{G, c, false, 512, 544, flag}; EpiMerge E{p.ws, GE_PANELS, true}; run_gemm(lds, p.ws + OFF_BR, p.ws + wdelta(l) + OFF_WB, 512, S, E); }
            SchedWoY S2{c, flag, (unsigned*)(p.ws + OFF_BAR)}; EpiWo E2{p.ws, l, commit}; run_gemm(lds, p.ws + OFF_H, p.ws + wdelta(l) + OFF_WO, 1024, S2, E2);
            if (probe_rep == probe_reps - 1) phase_convert(p, l + 1, 96, G - 96, 15);
        } else {
            SchedGrid S{lastl ? NB * 16 : NPANEL, 4, 0, G, c, lastl}; EpiWo E{p.ws, l, commit}; run_gemm(lds, p.ws + OFF_H, p.ws + wdelta(l) + OFF_WO, 1024, S, E);
            if (!lastl && probe_rep == probe_reps - 1) { if (G >= 64) phase_convert(p, l + 1, 32, G - 32, 4); else phase_convert(p, l + 1, 0, G, 4); } } }
    else if constexpr (PH == PH_LN1) phase_ln1_router(p, l, ldsf, commit);
    else if constexpr (PH == PH_GATHER) phase_gather(p, l, ldsf);
    else if constexpr (PH == PH_UP) { SchedMoe S; S.init((const unsigned*)(p.ws + OFF_CNT) + l * 16, G, c); EpiUp E{p.ws}; run_gemm(lds, p.ws + OFF_H, p.ws + wdelta(l) + OFF_WUP, 1024, S, E, (const int*)(p.ws + OFF_PAIRTOK)); }
    else if constexpr (PH == PH_DOWN) { SchedMoe S; S.init((const unsigned*)(p.ws + OFF_CNT) + l * 16, G, c); EpiDown E{p.ws}; run_gemm(lds, p.ws + OFF_ACT, p.ws + wdelta(l) + OFF_WDN, 512, S, E); }
    else if constexpr (PH == PH_LN2) phase_ln2(p, l, commit);
    }
}

#ifdef PROBE_SLOT
#ifndef PROBE_MULT
#define PROBE_MULT 5
#endif
#ifdef PROBE_BLK
#define XBAR(b, slot) do { if (threadIdx.x == 0) { volatile LAS unsigned long long* tw = (volatile LAS unsigned long long*)(shm + LDS_XBW + 16); \
        if ((slot) == PROBE_SLOT && blockIdx.x == PROBE_BLK) *(volatile unsigned long long*)(p.ws + OFF_CNT + 3072) = wall_clock64() - tw[0]; } \
    xcd_barrier(b); if (threadIdx.x == 0) { volatile LAS unsigned long long* tw = (volatile LAS unsigned long long*)(shm + LDS_XBW + 16); \
        if ((slot) == PROBE_SLOT && blockIdx.x == 0) tw[1] += *(volatile unsigned long long*)(p.ws + OFF_CNT + 3072); tw[0] = wall_clock64(); } } while (0)
#else
#define XBAR(b, slot) do { xcd_barrier(b); if (blockIdx.x == 0 && threadIdx.x == 0) { volatile LAS unsigned long long* tw = (volatile LAS unsigned long long*)(shm + LDS_XBW + 16); \
    const unsigned long long now_ = wall_clock64(); if ((slot) == PROBE_SLOT) tw[1] += now_ - tw[0]; tw[0] = now_; } } while (0)
#endif
#else
#define XBAR(b, slot) xcd_barrier(b)
#endif
#if !MEGA
template <int PH>
__global__ void __launch_bounds__(512, 2) k_phase(Params p, int l) {
    extern __shared__ __attribute__((aligned(16))) unsigned char shm[];
    run_phase<PH>(p, l, shm);
}
template <int PH> static void launch_phase(const Params& p, int l, hipStream_t st) {
    static bool attr = false;
    if (!attr) { (void)hipFuncSetAttribute((const void*)k_phase<PH>, hipFuncAttributeMaxDynamicSharedMemorySize, LDS_BYTES); attr = true; }
    hipLaunchKernelGGL((k_phase<PH>), dim3(256), dim3(NTHR), LDS_BYTES, st, p, l);
}
#else
__global__ void __launch_bounds__(512, 2) k_mega(Params p) {
    extern __shared__ __attribute__((aligned(16))) unsigned char shm[];
    volatile LAS unsigned* xbw = (volatile LAS unsigned*)(shm + LDS_XBW);
    if (threadIdx.x == 0) { xbw[0] = 0u; xbw[1] = 0u; xbw[2] = 0u; xbw[3] = 0u; }
    __syncthreads();
    XcdBarrier bar = xcd_barrier_post((unsigned*)(p.ws + OFF_BAR), xbw);
#ifdef PROBE_SLOT
    if (threadIdx.x == 0) { volatile LAS unsigned long long* tw = (volatile LAS unsigned long long*)(shm + LDS_XBW + 16); tw[0] = wall_clock64(); tw[1] = 0ull; }
#endif
    run_phase<PH_MOD>(p, 0, shm);
    run_phase<PH_CONVERT>(p, 0, shm);
    XBAR(bar, 0);
    run_phase<PH_INIT>(p, 0, shm);
    XBAR(bar, 1);
    for (int l = 0; l < DEPTH; ++l) {
        run_phase<PH_INPROJ>(p, l, shm); XBAR(bar, 3);
        run_phase<PH_ROPEDEC>(p, l, shm); run_phase<PH_VTRANS>(p, l, shm);
#if FAST_GLA
        run_phase<PH_GLA_A>(p, l, shm); XBAR(bar, 5);
        run_phase<PH_GLA_SCAN>(p, l, shm); XBAR(bar, 16);
#else
        run_phase<PH_MIX_GLA>(p, l, shm);
#endif
#if FAST_DIFF
        run_phase<PH_DIFF>(p, l, shm);
#else
        run_phase<PH_MIX_DIFF>(p, l, shm);
#endif
#if FAST_NA
        run_phase<PH_NA>(p, l, shm);
#else
        run_phase<PH_MIX_NA>(p, l, shm);
#endif
        XBAR(bar, 6);
        run_phase<PH_GATES>(p, l, shm); XBAR(bar, 8);
        run_phase<PH_MERGE>(p, l, shm); XBAR(bar, 9);
        run_phase<PH_WO>(p, l, shm); XBAR(bar, 10);
#ifdef PROBE_LN1
        run_phase<PH_LN1>(p, l, shm, true);
#endif
        run_phase<PH_LN1>(p, l, shm); XBAR(bar, 11);
        run_phase<PH_GATHER>(p, l, shm); XBAR(bar, 12);
        run_phase<PH_UP>(p, l, shm); XBAR(bar, 13);
        run_phase<PH_DOWN>(p, l, shm); XBAR(bar, 14);
        run_phase<PH_LN2>(p, l, shm); XBAR(bar, 15);
    }
#ifdef PROBE_SLOT
    if (blockIdx.x == 0 && threadIdx.x == 0) { volatile LAS unsigned long long* tw = (volatile LAS unsigned long long*)(shm + LDS_XBW + 16);
        const unsigned long long until = wall_clock64() + tw[1] * (PROBE_MULT - 1);
        while (wall_clock64() < until) __builtin_amdgcn_s_sleep(32); }
#endif
}
#endif

extern "C" void kernel_launch(void* const* d_in, const int* in_sizes, int n_in, void* d_out, int out_size, void* d_ws, size_t ws_size, hipStream_t stream) {
    (void)in_sizes; (void)n_in; (void)out_size;
    if (ws_size < WS_NEED) { fprintf(stderr, "workspace too small: %zu < %zu\n", ws_size, (size_t)WS_NEED); return; }
    Params p{};
    for (int i = 0; i < 23; ++i) p.in[i] = (const float*)d_in[i];
    p.out = (float*)d_out; p.ws = (char*)d_ws;
    (void)hipMemsetAsync(d_ws, 0, ZERO_BYTES, stream);
#if !MEGA
    launch_phase<PH_MOD>(p, 0, stream);
    launch_phase<PH_INIT>(p, 0, stream);
    for (int l = 0; l < DEPTH; ++l) {
        launch_phase<PH_CONVERT>(p, l, stream);
        launch_phase<PH_INPROJ>(p, l, stream);
        launch_phase<PH_ROPEDEC>(p, l, stream);
        launch_phase<PH_MIX_GLA>(p, l, stream);
        launch_phase<PH_VTRANS>(p, l, stream);
        launch_phase<PH_DIFF>(p, l, stream);
        launch_phase<PH_MIX_NA>(p, l, stream);
        launch_phase<PH_GATES>(p, l, stream);
        launch_phase<PH_MERGE>(p, l, stream);
        launch_phase<PH_WO>(p, l, stream);
        launch_phase<PH_LN1>(p, l, stream);
        launch_phase<PH_GATHER>(p, l, stream);
        launch_phase<PH_UP>(p, l, stream);
        launch_phase<PH_DOWN>(p, l, stream);
        launch_phase<PH_LN2>(p, l, stream);
    }
#else
    static int grid = 0;
    if (!grid) {
        (void)hipFuncSetAttribute((const void*)k_mega, hipFuncAttributeMaxDynamicSharedMemorySize, LDS_BYTES);
        int dev = 0, cus = 0, per_cu = 0;
        (void)hipGetDevice(&dev);
        (void)hipDeviceGetAttribute(&cus, hipDeviceAttributeMultiprocessorCount, dev);
        (void)hipOccupancyMaxActiveBlocksPerMultiprocessor(&per_cu, (const void*)k_mega, 512, LDS_BYTES);
        if (cus <= 0) cus = 256;
        grid = per_cu >= 1 ? cus : 0;
        if (!grid) { fprintf(stderr, "k_mega does not fit a CU\n"); return; }
    }
    hipLaunchKernelGGL(k_mega, dim3(grid), dim3(NTHR), LDS_BYTES, stream, p);
#endif
}
```
